# Optimizing an MI355X kernel written in HIP

```python
import math
import jax, jax.numpy as jnp
from jax import lax
import numpy as np

D_MODEL = 1024
BATCH = 8
SEQ = 2048
DEPTH = 1
DEC_BATCH = 128
DEC_SEQ = 1
PAST_LEN = 16384
PAGE_SIZE = 128

M_HEADS = 4
M_DH = 128
M_WIDTH = M_HEADS * M_DH
G_HEADS = 4
G_DK = 64
G_DV = 128
G_KW = G_HEADS * G_DK
G_VW = G_HEADS * G_DV
G_RANK = 16
G_TAU = 16.0
MIX_WIDTH = M_WIDTH + G_VW
CONV_W = 4
QK_CONV = 2 * M_WIDTH
D_FF = 4 * D_MODEL
D_PLE = 256
CHUNK = 64
EPS = 1e-6
F_BIAS = 3.0
IN_SIZES = (QK_CONV, M_WIDTH, M_WIDTH, M_HEADS, M_HEADS, G_KW, G_KW, G_VW, G_VW, G_RANK)
D_IN = sum(IN_SIZES)

kernel_name = "hymba_mlstm_gla_step"


def rmsnorm(x, g):
    xf = x.astype(jnp.float32)
    y = xf * lax.rsqrt(jnp.mean(xf * xf, axis=-1, keepdims=True) + EPS)
    return (y * g.astype(jnp.float32)).astype(x.dtype)


def headnorm(h, g):
    B, T, H, d = h.shape
    y = h * lax.rsqrt(jnp.mean(h * h, axis=-1, keepdims=True) + EPS)
    return y.reshape(B, T, H * d) * g.astype(jnp.float32)


def to_heads(a, H):
    B, T, _ = a.shape
    return a.reshape(B, T, H, -1).transpose(0, 2, 1, 3).astype(jnp.float32)


def causal_conv(x, buf, w, b):
    T = x.shape[1]
    xpad = jnp.concatenate([buf.astype(x.dtype), x], axis=1)
    y = b
    for j in range(CONV_W):
        y = y + xpad[:, j:j + T] * w[j]
    return jax.nn.silu(y), xpad[:, -(CONV_W - 1):]


def split_chunks(a, nc, L):
    return jnp.moveaxis(a.reshape(a.shape[:2] + (nc, L) + a.shape[3:]), 2, 0)


def mlstm_chunked(q, k, v, ig, lf, C0, n0, m0):
    B, H, T, d = q.shape
    L = math.gcd(T, CHUNK)
    nc = T // L
    causal = jnp.tril(jnp.ones((L, L), dtype=bool))

    def step(carry, inp):
        C, n, m = carry
        qc, kc, vc, ic, fc = inp
        b = jnp.cumsum(fc, axis=-1)
        D = jnp.where(causal, b[..., :, None] - b[..., None, :] + ic[..., None, :], -jnp.inf)
        inter = b + m[..., None]
        m_out = jnp.maximum(inter, jnp.max(D, axis=-1))
        s = jnp.einsum('bhtd,bhsd->bhts', qc, kc) * jnp.exp(D - m_out[..., None])
        scale = jnp.exp(inter - m_out)
        num = scale[..., None] * jnp.einsum('bhtd,bhde->bhte', qc, C) + jnp.einsum('bhts,bhse->bhte', s, vc)
        den = scale * jnp.einsum('bhtd,bhd->bht', qc, n) + jnp.sum(s, axis=-1)
        h = num / jnp.maximum(jnp.abs(den), jnp.exp(-m_out))[..., None]
        bL = b[..., -1]
        dec = bL[..., None] - b + ic
        m_new = jnp.maximum(bL + m, jnp.max(dec, axis=-1))
        wk = jnp.exp(dec - m_new[..., None])
        cs = jnp.exp(bL + m - m_new)
        C_new = cs[..., None, None] * C + jnp.einsum('bhs,bhsd,bhse->bhde', wk, kc, vc)
        n_new = cs[..., None] * n + jnp.einsum('bhs,bhsd->bhd', wk, kc)
        return (C_new, n_new, m_new), h

    xs = (split_chunks(q, nc, L), split_chunks(k, nc, L), split_chunks(v, nc, L),
          split_chunks(ig, nc, L), split_chunks(lf, nc, L))
    (C, n, m), hs = lax.scan(step, (C0, n0, m0), xs)
    h = jnp.moveaxis(hs, 0, 2).reshape(B, H, T, v.shape[-1])
    return h, C, n, m


def gla_chunked(q, k, v, la, S0):
    B, H, T, dk = q.shape
    L = math.gcd(T, CHUNK)
    nc = T // L
    causal = jnp.tril(jnp.ones((L, L), dtype=bool))

    def step(S, inp):
        qc, kc, vc, lc = inp
        bc = jnp.cumsum(lc, axis=-2)
        rel = jnp.where(causal[..., None], bc[..., :, None, :] - bc[..., None, :, :], -jnp.inf)
        A = jnp.einsum('bhtd,bhsd,bhtsd->bhts', qc, kc, jnp.exp(rel))
        o = jnp.einsum('bhtd,bhde->bhte', qc * jnp.exp(bc), S) + jnp.einsum('bhts,bhse->bhte', A, vc)
        bL = bc[..., -1:, :]
        S_new = jnp.exp(bL[..., 0, :])[..., None] * S + jnp.einsum('bhsd,bhse->bhde', kc * jnp.exp(bL - bc), vc)
        return S_new, o

    xs = (split_chunks(q, nc, L), split_chunks(k, nc, L), split_chunks(v, nc, L), split_chunks(la, nc, L))
    S, os_ = lax.scan(step, S0, xs)
    o = jnp.moveaxis(os_, 0, 2).reshape(B, H, T, v.shape[-1])
    return o, S


def hybrid_mixer(h, buf, C0, n0, m0, S0, w_in, conv_w, conv_b, b_gate, w_a2, b_a, g_mhead, g_ghead, w_out):
    B, T, _ = h.shape
    proj = h @ w_in
    splits = [int(s) for s in np.cumsum(IN_SIZES)[:-1]]
    qk_raw, mv, mo, mi, mf, gq, gk, gv, gr, ga = jnp.split(proj, splits, axis=-1)
    qk, new_buf = causal_conv(qk_raw, buf, conv_w, conv_b)
    mq, mk = jnp.split(qk, 2, axis=-1)
    gates = jnp.concatenate([mi, mf], axis=-1).astype(jnp.float32) + b_gate.astype(jnp.float32)
    ig = gates[..., :M_HEADS].transpose(0, 2, 1)
    lf = jax.nn.log_sigmoid(gates[..., M_HEADS:]).transpose(0, 2, 1)
    hm, C, n, m = mlstm_chunked(to_heads(mq, M_HEADS), to_heads(mk, M_HEADS) * (M_DH ** -0.5),
                                to_heads(mv, M_HEADS), ig, lf,
                                C0.astype(jnp.float32), n0.astype(jnp.float32), m0.astype(jnp.float32))
    hm = headnorm(hm.transpose(0, 2, 1, 3), g_mhead) * jax.nn.sigmoid(mo.astype(jnp.float32))
    la = jax.nn.log_sigmoid(ga.astype(jnp.float32) @ w_a2.astype(jnp.float32) + b_a.astype(jnp.float32)) / G_TAU
    hg, S = gla_chunked(to_heads(gq, G_HEADS) * (G_DK ** -0.5), to_heads(gk, G_HEADS), to_heads(gv, G_HEADS),
                        to_heads(la, G_HEADS), S0.astype(jnp.float32))
    hg = headnorm(hg.transpose(0, 2, 1, 3), g_ghead) * jax.nn.silu(gr.astype(jnp.float32))
    out = jnp.concatenate([hm, hg], axis=-1).astype(h.dtype) @ w_out
    return out, new_buf, C, n, m, S


def layer(x, p, buf, C0, n0, m0, S0, w_in, conv_w, conv_b, b_gate, w_a2, b_a, g_mhead, g_ghead, w_out,
          g_mix, g_mlp, w1, w2, g_ple, w_ple, w_pg):
    a, new_buf, C, n, m, S = hybrid_mixer(rmsnorm(x, g_mix), buf, C0, n0, m0, S0, w_in, conv_w, conv_b,
                                          b_gate, w_a2, b_a, g_mhead, g_ghead, w_out)
    x = x + a
    u = rmsnorm(x, g_mlp) @ w1
    x = x + jnp.square(jax.nn.relu(u)) @ w2
    x = x + (p @ w_ple) * jax.nn.sigmoid(rmsnorm(x, g_ple) @ w_pg)
    return x, new_buf, C, n, m, S


def setup_inputs(seed: int = 0) -> dict:
    key = jax.random.key(seed)
    ks = jax.random.split(key, 32)
    f32 = jnp.float32
    nrm = lambda k, shape, s=1.0: (jax.random.normal(k, shape, f32) * s)
    Dp = DEPTH
    b_gate = jnp.concatenate([nrm(ks[0], (Dp, M_HEADS), 0.1),
                              F_BIAS + nrm(ks[1], (Dp, M_HEADS), 0.1)], axis=-1)
    return {
        "x_prompt": nrm(ks[2], (BATCH, SEQ, D_MODEL)),
        "x_sample": nrm(ks[3], (DEC_BATCH, DEC_SEQ, D_MODEL)),
        "p_prompt": nrm(ks[4], (Dp, BATCH, SEQ, D_PLE)),
        "p_sample": nrm(ks[5], (Dp, DEC_BATCH, DEC_SEQ, D_PLE)),
        "state_mlstm_C": nrm(ks[6], (Dp, DEC_BATCH, M_HEADS, M_DH, M_DH), 0.05),
        "state_mlstm_n": nrm(ks[7], (Dp, DEC_BATCH, M_HEADS, M_DH), 0.1),
        "state_mlstm_m": nrm(ks[8], (Dp, DEC_BATCH, M_HEADS)),
        "state_conv": nrm(ks[9], (Dp, DEC_BATCH, CONV_W - 1, QK_CONV)),
        "state_gla_S": nrm(ks[10], (Dp, DEC_BATCH, G_HEADS, G_DK, G_DV), 0.1),
        "w_in": nrm(ks[11], (Dp, D_MODEL, D_IN), D_MODEL ** -0.5),
        "conv_w": nrm(ks[12], (Dp, CONV_W, QK_CONV), CONV_W ** -0.5),
        "conv_b": nrm(ks[13], (Dp, QK_CONV), 0.02),
        "b_gate": b_gate,
        "w_a2": nrm(ks[14], (Dp, G_RANK, G_KW), G_RANK ** -0.5),
        "b_a": nrm(ks[15], (Dp, G_KW), 0.1),
        "g_mhead": 1.0 + nrm(ks[16], (Dp, M_WIDTH), 0.02),
        "g_ghead": 1.0 + nrm(ks[17], (Dp, G_VW), 0.02),
        "w_out": nrm(ks[18], (Dp, MIX_WIDTH, D_MODEL), MIX_WIDTH ** -0.5),
        "g_mix": 1.0 + nrm(ks[19], (Dp, D_MODEL), 0.02),
        "g_mlp": 1.0 + nrm(ks[20], (Dp, D_MODEL), 0.02),
        "w1": nrm(ks[21], (Dp, D_MODEL, D_FF), D_MODEL ** -0.5),
        "w2": nrm(ks[22], (Dp, D_FF, D_MODEL), D_FF ** -0.5),
        "g_ple": 1.0 + nrm(ks[23], (Dp, D_MODEL), 0.02),
        "w_ple": nrm(ks[24], (Dp, D_PLE, D_MODEL), D_PLE ** -0.5),
        "w_pg": nrm(ks[25], (Dp, D_MODEL, D_MODEL), D_MODEL ** -0.5),
        "g_final": 1.0 + nrm(ks[26], (D_MODEL,), 0.02),
    }


def reference(x_prompt, x_sample, p_prompt, p_sample, state_mlstm_C, state_mlstm_n, state_mlstm_m,
              state_conv, state_gla_S, w_in, conv_w, conv_b, b_gate, w_a2, b_a, g_mhead, g_ghead, w_out,
              g_mix, g_mlp, w1, w2, g_ple, w_ple, w_pg, g_final):
    Bp = x_prompt.shape[0]
    f32 = jnp.float32
    xp, xs = x_prompt, x_sample
    new_p = ([], [], [], [], [])
    new_s = ([], [], [], [], [])
    for i in range(DEPTH):
        w = (w_in[i], conv_w[i], conv_b[i], b_gate[i], w_a2[i], b_a[i], g_mhead[i], g_ghead[i], w_out[i],
             g_mix[i], g_mlp[i], w1[i], w2[i], g_ple[i], w_ple[i], w_pg[i])
        xp, bp, Cp, np_, mp, Sp = layer(xp, p_prompt[i],
                                        jnp.zeros((Bp, CONV_W - 1, QK_CONV), x_prompt.dtype),
                                        jnp.zeros((Bp, M_HEADS, M_DH, M_DH), f32),
                                        jnp.zeros((Bp, M_HEADS, M_DH), f32),
                                        jnp.zeros((Bp, M_HEADS), f32),
                                        jnp.zeros((Bp, G_HEADS, G_DK, G_DV), f32), *w)
        xs, bs, Cs, ns, ms, Ss = layer(xs, p_sample[i], state_conv[i], state_mlstm_C[i], state_mlstm_n[i],
                                       state_mlstm_m[i], state_gla_S[i], *w)
        for lst, val in zip(new_p, (bp, Cp, np_, mp, Sp)):
            lst.append(val)
        for lst, val in zip(new_s, (bs, Cs, ns, ms, Ss)):
            lst.append(val)
    y_prompt = rmsnorm(xp, g_final)
    y_sample = rmsnorm(xs, g_final)
    conv_p, C_p, n_p, m_p, S_p = [jnp.stack(l, axis=0) for l in new_p]
    conv_s, C_s, n_s, m_s, S_s = [jnp.stack(l, axis=0) for l in new_s]
    return (y_prompt, y_sample, C_p, n_p, m_p, conv_p, S_p, C_s, n_s, m_s, conv_s, S_s)
```

```cpp
#include <hip/hip_runtime.h>
#include <cstdio>
#include <cstdint>

#ifndef MK_N_LAUNCHES
#define MK_N_LAUNCHES 1
#endif

namespace pg8 {
#define PG8_LAS __attribute__((address_space(3)))
typedef unsigned short bf16_t;
typedef short bf16x8 __attribute__((ext_vector_type(8)));
typedef float f32x4 __attribute__((ext_vector_type(4)));
typedef unsigned u32x4 __attribute__((ext_vector_type(4)));
constexpr int BM = 256, BK = 64, HALF = 128, HTB = HALF * BK * 2, STAGE_BYTES = 8 * HTB, NXCD = 8, WGM = 8;

__host__ __device__ __forceinline__ int lds_byte(int r, int c) { const int st = (r >> 4) * 2 + (c >> 5), rr = r & 15, cc = c & 31, ob = rr * 64 + cc * 2; return st * 1024 + (ob ^ (((ob >> 9) & 1) << 5)); }
__host__ __device__ __forceinline__ void stage_rc(int b, int& R, int& C) { const int st = b / 1024, sb = b % 1024, swz = sb ^ (((sb >> 9) & 1) << 5); R = (st >> 1) * 16 + swz / 64; C = (st & 1) * 32 + (swz % 64) / 2; }
__host__ __device__ __forceinline__ int perm32(int rho) { const int n = rho >> 4, i = rho & 15; return 8 * (i >> 2) + 4 * n + (i & 3); }

struct Unit { int pm, pn; };
struct Gemm { const bf16_t* A; const bf16_t* Bt; int M, N, K; };

struct StaticOrder {
    int nM, nN, nwg, G, c;
    __host__ __device__ void init(int M, int N, int G_, int c_) { nM = M / BM; nN = N / BM; nwg = nM * nN; G = G_; c = c_; }
    __host__ __device__ bool next(int i, Unit& u) const {
        const long L = (long)i * G + c; if (L >= nwg) return false;
        int wgid = (int)L; { const int q = nwg / NXCD, r = nwg % NXCD, xcd = wgid % NXCD, off = wgid / NXCD; wgid = (xcd < r ? xcd * (q + 1) : r * (q + 1) + (xcd - r) * q) + off; }
        const int nig = WGM * nN, gid = wgid / nig, fm = gid * WGM, gsz = (nM - fm) < WGM ? (nM - fm) : WGM;
        u.pm = fm + ((wgid % nig) % gsz); u.pn = (wgid % nig) / gsz; return true;
    }
    __device__ __forceinline__ void a_ready(const Unit&) const {}
    __device__ __forceinline__ void done(const Unit&) const {}
};

__device__ __forceinline__ unsigned cvt_pk_bf16(float lo, float hi) { unsigned r; asm volatile("v_cvt_pk_bf16_f32 %0, %1, %2" : "=v"(r) : "v"(lo), "v"(hi)); return r; }


template <class Epi, class Sched, bool ALIGN_EPI = false, bool SP2 = false>
__device__ __forceinline__ void gemm_phase(PG8_LAS unsigned char* lds, const Gemm g, const Sched& S, const Epi& E) {
    int tid_ = threadIdx.x; asm volatile("" : "+v"(tid_));
    const int tid = tid_, wid = __builtin_amdgcn_readfirstlane(tid >> 6), lane = tid & 63, wr = wid >> 2, wc = wid & 3, fr = lane & 15, fq = lane >> 4;
    const int K = g.K, nt = K / BK;
    unsigned voffA[2], voffB[2];
#pragma unroll
    for (int i = 0; i < 2; ++i) { int R, C; stage_rc(tid * 16 + i * 8192, R, C); const int Rb = Epi::PERM ? ((R & ~31) + perm32(R & 31)) : R;
        voffA[i] = (unsigned)(R * K + C) * 2u; voffB[i] = (unsigned)(Rb * K + C) * 2u; }
    const size_t kstep = (size_t)(BK * 2);
    const size_t hstep = (size_t)HALF * K * 2;
    const size_t tstep = 2 * hstep;
    const unsigned ldsw = (unsigned)wid * 1024u;
    const int aoff = lds_byte(wr * 64 + fr, fq * 8), boff = lds_byte(wc * 32 + fr, fq * 8);
#define PG8_SA(b, h) (((b) * 2 + (h)) * HTB)
#define PG8_SB(b, h) ((4 + (b) * 2 + (h)) * HTB)
#define PG8_STAGE(bufoff, gbase, voff) do { _Pragma("unroll") for (int _i = 0; _i < 2; ++_i) \
        __builtin_amdgcn_global_load_lds((const unsigned*)((const char*)(gbase) + (voff)[_i]), (PG8_LAS unsigned*)(lds + (bufoff) + ldsw + _i * 8192), 16, 0, 0); } while (0)
#define PG8_LDA(dst, b, h) do { _Pragma("unroll") for (int m = 0; m < 4; ++m) _Pragma("unroll") for (int k = 0; k < 2; ++k) dst[m][k] = *(const PG8_LAS bf16x8*)(lds + PG8_SA(b, h) + aoff + m * 2048 + k * 1024); } while (0)
#define PG8_LDB(dst, b, h) do { _Pragma("unroll") for (int n = 0; n < 2; ++n) _Pragma("unroll") for (int k = 0; k < 2; ++k) dst[n][k] = *(const PG8_LAS bf16x8*)(lds + PG8_SB(b, h) + boff + n * 2048 + k * 1024); } while (0)
#define PG8_MMA(ai, bj, At, Bt) do { __builtin_amdgcn_s_setprio(1); _Pragma("unroll") for (int m = 0; m < 4; ++m) _Pragma("unroll") for (int n = 0; n < 2; ++n) _Pragma("unroll") for (int k = 0; k < 2; ++k) \
        acc[ai][bj][m][n] = __builtin_amdgcn_mfma_f32_16x16x32_bf16(Bt[n][k], At[m][k], acc[ai][bj][m][n], 0, 0, 0); __builtin_amdgcn_s_setprio(0); } while (0)
#define PG8_WAIT_V(n) asm volatile("s_waitcnt vmcnt(" #n ")" ::: "memory")
#define PG8_WAIT_L(n) asm volatile("s_waitcnt lgkmcnt(" #n ")" ::: "memory")
#define PG8_BAR __builtin_amdgcn_s_barrier()
#define PG8_SCHED __builtin_amdgcn_sched_barrier(0)
    Unit cur, nxt; int ui = 0;
    if (!S.next(0, cur)) return;
    f32x4 acc[2][2][4][2];
#pragma unroll
    for (int a = 0; a < 2; ++a)
#pragma unroll
        for (int b = 0; b < 2; ++b)
#pragma unroll
            for (int m = 0; m < 4; ++m)
#pragma unroll
                for (int n = 0; n < 2; ++n) acc[a][b][m][n] = (f32x4){0.f, 0.f, 0.f, 0.f};
    bf16x8 At[4][2], B0[2][2], B1[2][2];
    const char* cA = (const char*)g.A + (size_t)cur.pm * tstep; const char* cB = (const char*)g.Bt + (size_t)cur.pn * tstep;
    S.a_ready(cur);
    if constexpr (SP2) {
        PG8_STAGE(PG8_SB(0, 0), cB, voffB); PG8_STAGE(PG8_SB(0, 1), cB + hstep, voffB); PG8_STAGE(PG8_SA(0, 0), cA, voffA); PG8_STAGE(PG8_SA(0, 1), cA + hstep, voffA);
        if (wr == 1) PG8_BAR;
        PG8_WAIT_V(2); PG8_BAR;
        PG8_STAGE(PG8_SB(1, 0), cB + kstep, voffB); PG8_STAGE(PG8_SA(1, 0), cA + kstep, voffA); PG8_STAGE(PG8_SB(1, 1), cB + hstep + kstep, voffB);
        PG8_WAIT_V(6); PG8_BAR;
    } else {
        PG8_STAGE(PG8_SB(0, 0), cB, voffB); PG8_STAGE(PG8_SA(0, 0), cA, voffA); PG8_STAGE(PG8_SB(0, 1), cB + hstep, voffB); PG8_STAGE(PG8_SA(0, 1), cA + hstep, voffA);
        if (wr == 1) PG8_BAR;
        PG8_WAIT_V(4); PG8_BAR;
        PG8_STAGE(PG8_SB(1, 0), cB + kstep, voffB); PG8_STAGE(PG8_SA(1, 0), cA + kstep, voffA); PG8_STAGE(PG8_SB(1, 1), cB + hstep + kstep, voffB);
        PG8_WAIT_V(6); PG8_BAR;
    }
    for (;;) {
        const bool has_next = S.next(ui + 1, nxt);
        const char* nA = has_next ? (const char*)g.A + (size_t)nxt.pm * tstep : cA; const char* nB = has_next ? (const char*)g.Bt + (size_t)nxt.pn * tstep : cB;
        for (int t = 0; t < nt; t += 2) {
            const bool last = (t == nt - 2);
            const char* a1 = cA + (size_t)(t + 1) * kstep;
            const char* a2 = last ? nA : cA + (size_t)(t + 2) * kstep; const char* b2 = last ? nB : cB + (size_t)(t + 2) * kstep;
            const char* a3 = a2 + kstep; const char* b3 = b2 + kstep;
            if (last && has_next) S.a_ready(nxt);
            if constexpr (SP2) {
            PG8_LDB(B0, 0, 0); PG8_LDB(B1, 0, 1); PG8_SCHED; PG8_LDA(At, 0, 0); PG8_STAGE(PG8_SA(1, 1), a1 + hstep, voffA);
            PG8_WAIT_V(8); PG8_WAIT_L(0); PG8_BAR; PG8_MMA(0, 0, At, B0); PG8_MMA(0, 1, At, B1); PG8_BAR; PG8_SCHED;
            PG8_LDA(At, 0, 1); PG8_STAGE(PG8_SB(0, 0), b2, voffB); PG8_STAGE(PG8_SB(0, 1), b2 + hstep, voffB); PG8_STAGE(PG8_SA(0, 0), a2, voffA);
            PG8_WAIT_V(8); PG8_WAIT_L(0); PG8_BAR; PG8_MMA(1, 0, At, B0); PG8_MMA(1, 1, At, B1); PG8_BAR; PG8_SCHED;
            PG8_LDB(B0, 1, 0); PG8_LDB(B1, 1, 1); PG8_SCHED; PG8_LDA(At, 1, 0); PG8_STAGE(PG8_SA(0, 1), a2 + hstep, voffA);
            PG8_WAIT_V(8); PG8_WAIT_L(0); PG8_BAR; PG8_MMA(0, 0, At, B0); PG8_MMA(0, 1, At, B1); PG8_BAR; PG8_SCHED;
            PG8_LDA(At, 1, 1); PG8_STAGE(PG8_SB(1, 0), b3, voffB); PG8_STAGE(PG8_SB(1, 1), b3 + hstep, voffB); PG8_STAGE(PG8_SA(1, 0), a3, voffA);
            PG8_WAIT_V(8); PG8_WAIT_L(0); PG8_BAR; PG8_MMA(1, 0, At, B0); PG8_MMA(1, 1, At, B1); PG8_BAR; PG8_SCHED;
            } else {
            PG8_LDB(B0, 0, 0); PG8_SCHED; PG8_LDA(At, 0, 0); PG8_STAGE(PG8_SA(1, 1), a1 + hstep, voffA);
            PG8_WAIT_L(8); PG8_BAR; PG8_WAIT_L(0); PG8_MMA(0, 0, At, B0); PG8_BAR; PG8_SCHED;
            PG8_LDB(B1, 0, 1); PG8_STAGE(PG8_SB(0, 0), b2, voffB);
            PG8_BAR; PG8_WAIT_L(0); PG8_MMA(0, 1, At, B1); PG8_BAR;
            PG8_LDA(At, 0, 1); PG8_STAGE(PG8_SA(0, 0), a2, voffA);
            PG8_BAR; PG8_WAIT_L(0); PG8_MMA(1, 0, At, B0); PG8_BAR; PG8_SCHED;
            PG8_STAGE(PG8_SB(0, 1), b2 + hstep, voffB);
            PG8_WAIT_V(6); PG8_BAR; PG8_MMA(1, 1, At, B1); PG8_BAR;
            PG8_LDB(B0, 1, 0); PG8_SCHED; PG8_LDA(At, 1, 0); PG8_STAGE(PG8_SA(0, 1), a2 + hstep, voffA);
            PG8_WAIT_L(8); PG8_BAR; PG8_WAIT_L(0); PG8_MMA(0, 0, At, B0); PG8_BAR; PG8_SCHED;
            PG8_LDB(B1, 1, 1); PG8_STAGE(PG8_SB(1, 0), b3, voffB);
            PG8_BAR; PG8_WAIT_L(0); PG8_MMA(0, 1, At, B1); PG8_BAR;
            PG8_LDA(At, 1, 1); PG8_STAGE(PG8_SA(1, 0), a3, voffA);
            PG8_BAR; PG8_WAIT_L(0); PG8_MMA(1, 0, At, B0); PG8_BAR; PG8_SCHED;
            PG8_STAGE(PG8_SB(1, 1), b3 + hstep, voffB);
            PG8_WAIT_V(6); PG8_BAR; PG8_MMA(1, 1, At, B1); PG8_BAR;
            }
        }
        if constexpr (ALIGN_EPI) { if (wr == 0) PG8_BAR; }
        E(acc, cur, wr, wc, fr, fq); S.done(cur);
        if (!has_next) break;
#pragma unroll
        for (int a = 0; a < 2; ++a)
#pragma unroll
            for (int b = 0; b < 2; ++b)
#pragma unroll
                for (int m = 0; m < 4; ++m)
#pragma unroll
                    for (int n = 0; n < 2; ++n) acc[a][b][m][n] = (f32x4){0.f, 0.f, 0.f, 0.f};
        cur = nxt; cA = nA; cB = nB; ++ui;
        if constexpr (ALIGN_EPI) { if (wr == 1) PG8_BAR; }
    }
    PG8_WAIT_V(0);
    if constexpr (!ALIGN_EPI) { if (wr == 0) PG8_BAR; }
    PG8_BAR;
#undef PG8_SA
#undef PG8_SB
#undef PG8_STAGE
#undef PG8_LDA
#undef PG8_LDB
#undef PG8_MMA
#undef PG8_WAIT_V
#undef PG8_WAIT_L
#undef PG8_BAR
#undef PG8_SCHED
}
}

#ifndef PG8_SP2
#define PG8_SP2 true
#endif
#ifndef PG8_ALIGN
#define PG8_ALIGN true
#endif

constexpr int NWAVES = 8;
constexpr int D = 1024, SEQ = 2048, NB = 8, MP = NB * SEQ  , MSMP = 128  , MV = MP + MSMP  , MR = 16640  ;
constexpr int FF = 4096, DPLE = 256, NCH = SEQ / 64  ;
constexpr int PS = 3840;
constexpr int C_MQ = 0, C_MK = 512, C_MV = 1024, C_MO = 1536, C_GQ = 2048, C_GK = 2304, C_GV = 2560, C_GR = 3072, C_SM = 3584;
constexpr float EPS = 1e-6f;
constexpr size_t O_YP = 0, O_YS = 16777216, O_CP = 16908288, O_NP = 17432576, O_MP = 17436672, O_CVP = 17436704, O_SP = 17461280,
                 O_CS = 17723424, O_NS = 26112032, O_MS = 26177568, O_CVS = 26178080, O_SS = 26571296;
constexpr size_t MiB = 1u << 20;
constexpr size_t WS_CTL = 0, CTL_ZERO_BYTES = 1 * MiB;
constexpr size_t CTL_BAR_B = 16384, CTL_SS1_B = 262144, CTL_SS2_B = 393216, CTL_SS3_B = 524288;
constexpr size_t WS_WIN = 1 * MiB, WS_WOUT = 9 * MiB, WS_W1 = 11 * MiB, WS_W2 = 19 * MiB, WS_WPG = 27 * MiB, WS_WPLE = 29 * MiB;
constexpr size_t WS_PB = 30 * MiB, WS_NC = 39 * MiB, WS_MC = WS_NC + 512 * 1024, WS_R1 = 40 * MiB, WS_R2 = 73 * MiB, WS_CSM = 195 * MiB, WS_CSG = 227 * MiB;
constexpr size_t WS_X1B = WS_R2, WS_U = 106 * MiB, WS_PP = 106 * MiB, WS_END = 243 * MiB;
static_assert(WS_R2 + (size_t)MR * PS * 2 <= WS_CSM && WS_R1 + (size_t)MR * D * 2 <= WS_R2 && WS_U + (size_t)MR * FF * 2 <= WS_END && WS_X1B + (size_t)MR * D * 2 <= WS_U && WS_PB + (size_t)MR * DPLE * 2 <= WS_NC, "ws map");
constexpr int LDS_BYTES = 147456, MISC_OFF = LDS_BYTES - 256;

#define GAS __attribute__((address_space(1)))
#define LAS __attribute__((address_space(3)))
typedef unsigned short bf16;
typedef unsigned v4u __attribute__((ext_vector_type(4)));
typedef unsigned v2u __attribute__((ext_vector_type(2)));
typedef float f32x4 __attribute__((ext_vector_type(4)));
typedef short bf16x8 __attribute__((ext_vector_type(8)));
typedef GAS unsigned gu32;
#define RLX_AGENT __ATOMIC_RELAXED, __HIP_MEMORY_SCOPE_AGENT
#define LDS_WAIT() asm volatile("s_waitcnt lgkmcnt(0)" ::: "memory")
#define VM_WAIT() asm volatile("s_waitcnt vmcnt(0)" ::: "memory")
__device__ __forceinline__ unsigned f2bf(float f) { unsigned u = __builtin_bit_cast(unsigned, f); return (u + 0x7fffu + ((u >> 16) & 1u)) >> 16; }
__device__ __forceinline__ unsigned pk2(float lo, float hi) { return f2bf(lo) | (f2bf(hi) << 16); }
__device__ __forceinline__ float bf2f(unsigned b) { return __builtin_bit_cast(float, b << 16); }
__device__ __forceinline__ float bflo(unsigned w) { return __builtin_bit_cast(float, w << 16); }
__device__ __forceinline__ float bfhi(unsigned w) { return __builtin_bit_cast(float, w & 0xffff0000u); }
__device__ __forceinline__ float logsig(float x) { return fminf(x, 0.f) - log1pf(__expf(-fabsf(x))); }
__device__ __forceinline__ float sigmoidf(float x) { return 1.f / (1.f + __expf(-x)); }

#define XB_TMO      128
#define XB_XCNT(j)  (256  + 64 * (j))
#define XB_XSUB(j)  (1280 + 64 * (j))
#define XB_XGEN(j)  (2304 + 64 * (j))
#define XB_TOP      3328
#define XB_TOPGEN   3392
#define XCD_BAR_WORDS 3456
#define XB_SPIN_CAP (1u << 22)
__device__ __forceinline__ unsigned xb_ld(unsigned* p)              { return __hip_atomic_load(p, __ATOMIC_RELAXED, __HIP_MEMORY_SCOPE_AGENT); }
__device__ __forceinline__ unsigned xb_add(unsigned* p, unsigned v) { return __hip_atomic_fetch_add(p, v, __ATOMIC_RELAXED, __HIP_MEMORY_SCOPE_AGENT); }
__device__ __forceinline__ unsigned xb_xcc_id() { return (unsigned)__builtin_amdgcn_s_getreg((3 << 11) | 20) & 0xFu; }
#define XB_SPIN(cond, bar) do { unsigned _sp = 0; while (cond) { __builtin_amdgcn_s_sleep(1); \
    if ((++_sp & 255u) == 0u) { if (xb_ld(&(bar)[XB_TMO])) break; if (_sp > XB_SPIN_CAP) { atomicAdd(&(bar)[XB_TMO], 1u); break; } } } } while (0)
struct XcdBarrier { unsigned* bar; unsigned x; volatile LAS unsigned* st; };
__device__ __forceinline__ XcdBarrier xcd_barrier_post(unsigned* bar, volatile LAS unsigned* st) {
    XcdBarrier b; b.bar = bar; b.x = xb_xcc_id(); b.st = st;
    if (threadIdx.x == 0) (void)xb_add(&bar[XB_XCNT(b.x)], 1u);
    return b;
}
__device__ __forceinline__ void xcd_barrier_complete(unsigned* bar, unsigned x, unsigned& nloc, unsigned& nx) {
    const unsigned G = gridDim.x * gridDim.y * gridDim.z;
    unsigned sum, cnt, mine, sp = 0u;
    for (;;) {
        sum = 0u; cnt = 0u; mine = 0u;
#pragma unroll
        for (unsigned j = 0; j < 16; ++j) { const unsigned c = xb_ld(&bar[XB_XCNT(j)]); sum += c; cnt += (c > 0u) ? 1u : 0u; mine = (j == x) ? c : mine; }
        if (sum == G) break;
        __builtin_amdgcn_s_sleep(1);
        if ((++sp & 255u) == 0u) { if (xb_ld(&bar[XB_TMO])) break; if (sp > XB_SPIN_CAP) { atomicAdd(&bar[XB_TMO], 1u); break; } }
    }
    nloc = mine > 0u ? mine : 1u; nx = cnt > 0u ? cnt : 1u;
}
__device__ __forceinline__ void xcd_barrier(const XcdBarrier& b) {
    asm volatile("s_waitcnt vmcnt(0)" ::: "memory");
    __syncthreads();
    if (threadIdx.x == 0) {
        unsigned* bar = b.bar;
        __builtin_amdgcn_s_waitcnt(0);
        unsigned nloc = b.st[0], nx = b.st[1];
        if (nloc == 0u) { xcd_barrier_complete(bar, b.x, nloc, nx); b.st[0] = nloc; b.st[1] = nx; }
        const unsigned old = xb_add(&bar[XB_XSUB(b.x)], 1u);
        const unsigned gen = old / nloc;
        if (old + 1u == (gen + 1u) * nloc) {
            __builtin_amdgcn_fence(__ATOMIC_RELEASE, "agent");
            asm volatile("s_waitcnt vmcnt(0)" ::: "memory");
            const unsigned og = xb_add(&bar[XB_TOP], 1u);
            const unsigned tg = og / nx;
            if (og + 1u == (tg + 1u) * nx) xb_add(&bar[XB_TOPGEN], 1u);
            else XB_SPIN(xb_ld(&bar[XB_TOPGEN]) == tg, bar);
            __builtin_amdgcn_fence(__ATOMIC_ACQUIRE, "agent");
            xb_add(&bar[XB_XGEN(b.x)], 1u);
            asm volatile("s_waitcnt vmcnt(0)" ::: "memory");
        } else {
            XB_SPIN(xb_ld(&bar[XB_XGEN(b.x)]) == gen, bar);
            __builtin_amdgcn_fence(__ATOMIC_ACQUIRE, "agent");
            asm volatile("s_waitcnt vmcnt(0)" ::: "memory");
        }
    }
    __syncthreads();
}

struct Args { const float* in[26]; float* out; unsigned char* ws; int ph_lo, ph_hi, li, pad; };
typedef const Args __attribute__((address_space(4))) CArgs;
struct Frame {
    LAS unsigned char* lds;
    char* ldsg;
    int G;
    CArgs* a;
};
#define F_TID ((int)threadIdx.x)
#define F_LANE ((int)(threadIdx.x & 63))
#define F_WAVE (__builtin_amdgcn_readfirstlane((int)(threadIdx.x >> 6)))
#define IN_F(k) (F.a->in[k])
#define X_P IN_F(0)
#define X_S IN_F(1)
#define P_P IN_F(2)
#define P_S IN_F(3)
#define ST_C IN_F(4)
#define ST_N IN_F(5)
#define ST_M IN_F(6)
#define ST_CONV IN_F(7)
#define ST_S IN_F(8)
#define W_IN IN_F(9)
#define CONV_W IN_F(10)
#define CONV_B IN_F(11)
#define B_GATE CONSTF(IN_F(12))
#define W_A2 CONSTF(IN_F(13))
#define B_A CONSTF(IN_F(14))
#define G_MHEAD IN_F(15)
#define G_GHEAD IN_F(16)
#define W_OUT IN_F(17)
#define G_MIX IN_F(18)
#define G_MLP IN_F(19)
#define W1 IN_F(20)
#define W2 IN_F(21)
#define G_PLE IN_F(22)
#define W_PLE IN_F(23)
#define W_PG IN_F(24)
#define G_FINAL IN_F(25)
typedef const float __attribute__((address_space(4))) cfloat;
#define CONSTF(p) ((cfloat*)(unsigned long long)(p))
#define OUTP (F.a->out)
#define WSB (F.a->ws)
#define WIN_T ((bf16*)(WSB + WS_WIN))
#define WOUT_T ((bf16*)(WSB + WS_WOUT))
#define W1_T ((bf16*)(WSB + WS_W1))
#define W2_T ((bf16*)(WSB + WS_W2))
#define WPG_T ((bf16*)(WSB + WS_WPG))
#define WPLE_T ((bf16*)(WSB + WS_WPLE))
#define PBUF ((bf16*)(WSB + WS_PB))
#define R1B ((bf16*)(WSB + WS_R1))
#define PROJ ((bf16*)(WSB + WS_R2))
#define X1B ((bf16*)(WSB + WS_X1B))
#define UBUF ((bf16*)(WSB + WS_U))
#define CSM ((bf16*)(WSB + WS_CSM))
#define CSG ((bf16*)(WSB + WS_CSG))
#define NCS ((float*)(WSB + WS_NC))
#define MCS ((float*)(WSB + WS_MC))
#define SS1 ((float*)(WSB + CTL_SS1_B))
#define SS2 ((float*)(WSB + CTL_SS2_B))
#define SS3 ((float*)(WSB + CTL_SS3_B))
#define PPB ((bf16*)(WSB + WS_PP))

__device__ __forceinline__ float wave_sum(float v) {
#pragma unroll
    for (int o = 1; o < 64; o <<= 1) v += __shfl_xor(v, o);
    return v;
}
__device__ __forceinline__ float wave_max(float v) {
#pragma unroll
    for (int o = 1; o < 64; o <<= 1) v = fmaxf(v, __shfl_xor(v, o));
    return v;
}
__device__ __forceinline__ float wave_scan_sum(float v, int lane) {
#pragma unroll
    for (int o = 1; o < 64; o <<= 1) { const float t = __shfl_up(v, o); if (lane >= o) v += t; }
    return v;
}
__device__ __forceinline__ float wave_scan_max(float v, int lane) {
#pragma unroll
    for (int o = 1; o < 64; o <<= 1) { const float t = __shfl_up(v, o); if (lane >= o) v = fmaxf(v, t); }
    return v;
}

__device__ __forceinline__ int win_src_col(int np) {
    if (np < 2048) return np;
    if (np < 3584) return np + 8;
    const int j = np - 3584;
    if (j < 8) return 2048 + j;
    if (j < 24) return 3592 + (j - 8);
    return -1;
}
template <int MODE>
__device__ __forceinline__ void p0_transpose_item(const float* W, int K, int N, bf16* WT, const float* gain, LAS float* scr, int item, int nblk, int lane) {
    const int kb = item / nblk, nb = item % nblk, k0 = 64 * kb, n0 = 32 * nb;
    int src = n0 + (lane & 31); float cs = 1.f;
    if (MODE == 1) { const int np = n0 + (lane & 31); src = win_src_col(np); if (np >= C_GQ && np < C_GK) cs = 0.125f; }
#pragma unroll 8
    for (int i = 0; i < 32; ++i) { const int kk = 2 * i + (lane >> 5); float v = 0.f; if (src >= 0) v = W[(size_t)(k0 + kk) * N + src] * cs; if (gain) v *= gain[k0 + kk]; scr[kk * 33 + (lane & 31)] = v; }
    LDS_WAIT(); asm volatile("" ::: "memory");
    const int c = lane & 7;
#pragma unroll
    for (int j = 0; j < 4; ++j) { const int n = (lane >> 3) + 8 * j; const LAS float* s = scr + (8 * c) * 33 + n;
        v4u o; o.x = pk2(s[0 * 33], s[1 * 33]); o.y = pk2(s[2 * 33], s[3 * 33]); o.z = pk2(s[4 * 33], s[5 * 33]); o.w = pk2(s[6 * 33], s[7 * 33]);
        *(GAS v4u*)(WT + (size_t)(n0 + n) * K + k0 + 8 * c) = o; }
    LDS_WAIT(); asm volatile("" ::: "memory");
}
__device__ __forceinline__ void p0_prologue(Frame& F) {
    LAS float* scr = (LAS float*)(F.lds + F_WAVE * 16384);
    const int gw = blockIdx.x * NWAVES + F_WAVE, NGW = F.G * NWAVES;
    constexpr int NB_IN = PS / 32, NB_D = D / 32, NB_FF = FF / 32;
    constexpr int I_IN = (D / 64) * NB_IN, I_OUT = (D / 64) * NB_D, I_1 = (D / 64) * NB_FF, I_2 = (FF / 64) * NB_D, I_PG = I_OUT, I_PLE = (DPLE / 64) * NB_D;
    constexpr int NITEMS = I_IN + I_OUT + I_1 + I_2 + I_PG + I_PLE;
    for (int it = gw; it < NITEMS; it += NGW) {
        int r = it;
        if (r < I_IN) { p0_transpose_item<1>(W_IN, D, 3608, WIN_T, G_MIX, scr, r, NB_IN, F_LANE); continue; } r -= I_IN;
        if (r < I_OUT) { p0_transpose_item<0>(W_OUT, D, D, WOUT_T, nullptr, scr, r, NB_D, F_LANE); continue; } r -= I_OUT;
        if (r < I_1) { p0_transpose_item<0>(W1, D, FF, W1_T, G_MLP, scr, r, NB_FF, F_LANE); continue; } r -= I_1;
        if (r < I_2) { p0_transpose_item<0>(W2, FF, D, W2_T, nullptr, scr, r, NB_D, F_LANE); continue; } r -= I_2;
        if (r < I_PG) { p0_transpose_item<0>(W_PG, D, D, WPG_T, G_PLE, scr, r, NB_D, F_LANE); continue; } r -= I_PG;
        p0_transpose_item<0>(W_PLE, DPLE, D, WPLE_T, nullptr, scr, r, NB_D, F_LANE);
    }
    for (int m = gw; m < MV; m += NGW) {
        const float* xrow = m < MP ? X_P + (size_t)m * D : X_S + (size_t)(m - MP) * D;
        const GAS f32x4* xr = (const GAS f32x4*)xrow + F_LANE;
        f32x4 v[4]; float s = 0.f;
#pragma unroll
        for (int j = 0; j < 4; ++j) { v[j] = xr[64 * j]; s += (v[j].x * v[j].x + v[j].y * v[j].y) + (v[j].z * v[j].z + v[j].w * v[j].w); }
        const float r = 1.f / sqrtf(wave_sum(s) * (1.f / D) + EPS);
        GAS unsigned long long* o8 = (GAS unsigned long long*)(R1B + (size_t)m * D) + F_LANE;
#pragma unroll
        for (int j = 0; j < 4; ++j) o8[64 * j] = (unsigned long long)pk2(v[j].x * r, v[j].y * r) | ((unsigned long long)pk2(v[j].z * r, v[j].w * r) << 32);
        const float* prow = m < MP ? P_P + (size_t)m * DPLE : P_S + (size_t)(m - MP) * DPLE;
        const f32x4 pv = ((const GAS f32x4*)prow)[F_LANE];
        ((GAS unsigned long long*)(PBUF + (size_t)m * DPLE))[F_LANE] = (unsigned long long)pk2(pv.x, pv.y) | ((unsigned long long)pk2(pv.z, pv.w) << 32);
    }
}

struct EpiProj {
    static constexpr bool PERM = true;
    bf16* O; int ldc;
    __device__ __forceinline__ void operator()(const f32x4 (&acc)[2][2][4][2], const pg8::Unit& u, int wr, int wc, int fr, int fq) const {
        const int row0 = u.pm * 256 + wr * 64 + fr, col0 = u.pn * 256 + wc * 32 + 8 * fq;
#pragma unroll
        for (int ai = 0; ai < 2; ++ai)
#pragma unroll
            for (int m = 0; m < 4; ++m) { bf16* rowp = O + (size_t)(row0 + ai * 128 + m * 16) * ldc + col0;
#pragma unroll
                for (int bj = 0; bj < 2; ++bj) { const f32x4 v0 = acc[ai][bj][m][0], v1 = acc[ai][bj][m][1];
                    v4u w; w.x = pg8::cvt_pk_bf16(v0[0], v0[1]); w.y = pg8::cvt_pk_bf16(v0[2], v0[3]); w.z = pg8::cvt_pk_bf16(v1[0], v1[1]); w.w = pg8::cvt_pk_bf16(v1[2], v1[3]);
                    *(v4u*)(rowp + bj * 128) = w; } }
    }
};
struct EpiRes {
    static constexpr bool PERM = true;
    const float* res_p; const float* res_s; float* out; bf16* ob; float* ss;
    __device__ __forceinline__ void operator()(const f32x4 (&acc)[2][2][4][2], const pg8::Unit& u, int wr, int wc, int fr, int fq) const {
        const int row0 = u.pm * 256 + wr * 64 + fr, col0 = u.pn * 256 + wc * 32 + 8 * fq;
#pragma unroll
        for (int ai = 0; ai < 2; ++ai)
#pragma unroll
            for (int m = 0; m < 4; ++m) { const int row = row0 + ai * 128 + m * 16; const bool valid = row < MV;
                const float* rp = (row < MP ? res_p + (size_t)row * D : res_s + (size_t)(row - MP) * D) + col0;
                float s = 0.f;
#pragma unroll
                for (int bj = 0; bj < 2; ++bj) {
                    f32x4 r0 = (f32x4){0.f, 0.f, 0.f, 0.f}, r1 = r0;
                    if (valid) { r0 = *(const f32x4*)(rp + bj * 128); r1 = *(const f32x4*)(rp + bj * 128 + 4); }
                    const f32x4 v0 = acc[ai][bj][m][0] + r0, v1 = acc[ai][bj][m][1] + r1;
                    if (valid) { float* op = out + (size_t)row * D + col0 + bj * 128; *(f32x4*)op = v0; *(f32x4*)(op + 4) = v1; }
                    v4u w; w.x = pg8::cvt_pk_bf16(v0[0], v0[1]); w.y = pg8::cvt_pk_bf16(v0[2], v0[3]); w.z = pg8::cvt_pk_bf16(v1[0], v1[1]); w.w = pg8::cvt_pk_bf16(v1[2], v1[3]);
                    *(v4u*)(ob + (size_t)row * D + col0 + bj * 128) = w;
                    s += (v0[0] * v0[0] + v0[1] * v0[1]) + (v0[2] * v0[2] + v0[3] * v0[3]) + (v1[0] * v1[0] + v1[1] * v1[1]) + (v1[2] * v1[2] + v1[3] * v1[3]);
                }
                s += __shfl_xor(s, 16); s += __shfl_xor(s, 32);
                if (fq == 0) atomicAdd(ss + row, s);
                asm volatile("" ::: "memory"); }
    }
};
struct EpiU {
    static constexpr bool PERM = true;
    bf16* O; const float* ss;
    __device__ __forceinline__ void operator()(const f32x4 (&acc)[2][2][4][2], const pg8::Unit& u, int wr, int wc, int fr, int fq) const {
        const int row0 = u.pm * 256 + wr * 64 + fr, col0 = u.pn * 256 + wc * 32 + 8 * fq;
#pragma unroll
        for (int ai = 0; ai < 2; ++ai)
#pragma unroll
            for (int m = 0; m < 4; ++m) { const int row = row0 + ai * 128 + m * 16; const float r = 1.f / sqrtf(ss[row] * (1.f / D) + EPS);
                bf16* rowp = O + (size_t)row * FF + col0;
#pragma unroll
                for (int bj = 0; bj < 2; ++bj) { f32x4 v0 = acc[ai][bj][m][0] * r, v1 = acc[ai][bj][m][1] * r;
#pragma unroll
                    for (int j = 0; j < 4; ++j) { const float a = fmaxf(v0[j], 0.f), b = fmaxf(v1[j], 0.f); v0[j] = a * a; v1[j] = b * b; }
                    v4u w; w.x = pg8::cvt_pk_bf16(v0[0], v0[1]); w.y = pg8::cvt_pk_bf16(v0[2], v0[3]); w.z = pg8::cvt_pk_bf16(v1[0], v1[1]); w.w = pg8::cvt_pk_bf16(v1[2], v1[3]);
                    *(v4u*)(rowp + bj * 128) = w; } }
    }
};
struct EpiPle {
    static constexpr bool PERM = true;
    float* out; const bf16* Pp; const float* ss2; float* ss3;
    __device__ __forceinline__ void operator()(const f32x4 (&acc)[2][2][4][2], const pg8::Unit& u, int wr, int wc, int fr, int fq) const {
        const int row0 = u.pm * 256 + wr * 64 + fr, col0 = u.pn * 256 + wc * 32 + 8 * fq;
#pragma unroll
        for (int ai = 0; ai < 2; ++ai)
#pragma unroll
            for (int m = 0; m < 4; ++m) { const int row = row0 + ai * 128 + m * 16; const bool valid = row < MV;
                const float r = 1.f / sqrtf(ss2[row] * (1.f / D) + EPS);
                float s = 0.f;
#pragma unroll
                for (int bj = 0; bj < 2; ++bj) {
                    const size_t off = (size_t)row * D + col0 + bj * 128;
                    const v4u pw = *(const v4u*)(Pp + off);
#pragma unroll
                    for (int n = 0; n < 2; ++n) {
                        f32x4 x0 = (f32x4){0.f, 0.f, 0.f, 0.f};
                        if (valid) x0 = *(const f32x4*)(out + off + 4 * n);
                        const float p0[4] = {bflo(pw[2 * n]), bfhi(pw[2 * n]), bflo(pw[2 * n + 1]), bfhi(pw[2 * n + 1])};
                        f32x4 v0;
#pragma unroll
                        for (int j = 0; j < 4; ++j) v0[j] = x0[j] + p0[j] * sigmoidf(acc[ai][bj][m][n][j] * r);
                        if (valid) *(f32x4*)(out + off + 4 * n) = v0;
                        s += (v0[0] * v0[0] + v0[1] * v0[1]) + (v0[2] * v0[2] + v0[3] * v0[3]);
                    }
                    asm volatile("" ::: "memory");
                }
                s += __shfl_xor(s, 16); s += __shfl_xor(s, 32);
                if (fq == 0) atomicAdd(ss3 + row, s);
                asm volatile("" ::: "memory"); }
    }
};

__device__ __forceinline__ f32x4 mfma16(bf16x8 a, bf16x8 b, f32x4 c) { return __builtin_amdgcn_mfma_f32_16x16x32_bf16(a, b, c, 0, 0, 0); }
__device__ __forceinline__ bf16x8 lds_frag(const char* p) { return *(const bf16x8*)p; }
constexpr int TS = 144;
constexpr int QS_P = 272;
constexpr float KSCALE = 0.08838834764831845f;

__device__ __forceinline__ void chain_mlstm(Frame& F, int b, int h) {
    char* L = F.ldsg; char* KT = L; char* VT = L + 128 * TS; float* NPART = (float*)(L + 2 * 128 * TS);
    const int tid = F_TID, lane = F_LANE, w = F_WAVE, dp = tid & 63, sg = tid >> 6, r = lane & 15, g = lane >> 4;
    const int bh = b * 4 + h; const size_t rowb = (size_t)b * SEQ;
    const bf16* P = PROJ;
    const int chk = 512 + h * 128 + 2 * dp;
    float cw[4][2], cb[2];
#pragma unroll
    for (int j = 0; j < 4; ++j) { cw[j][0] = CONV_W[j * 1024 + chk]; cw[j][1] = CONV_W[j * 1024 + chk + 1]; }
    cb[0] = CONV_B[chk]; cb[1] = CONV_B[chk + 1];
    const float bgi = B_GATE[h], bgf = B_GATE[4 + h];
    f32x4 acc[8];
#pragma unroll
    for (int i = 0; i < 8; ++i) acc[i] = (f32x4){0.f, 0.f, 0.f, 0.f};
    float nst = 0.f, mst = 0.f;
    for (int c = 0; c < NCH; ++c) {
        const int t0 = c * 64;
        float wk, cs, M, bL;
        { const size_t row = rowb + t0 + lane;
          const float ig = bf2f(P[row * PS + C_SM + h]) + bgi, lf = logsig(bf2f(P[row * PS + C_SM + 4 + h]) + bgf);
          const float bc = wave_scan_sum(lf, lane), a = ig - bc; const float pmax = wave_max(a);
          bL = __shfl(bc, 63); M = fmaxf(mst, pmax); cs = __expf(mst - M); wk = __expf(a - M); }
        unsigned kr[11];
#pragma unroll
        for (int i = 0; i < 11; ++i) { const int t = t0 + 8 * sg - 3 + i; kr[i] = (t >= 0) ? *(const unsigned*)(P + (rowb + t) * PS + C_MK + h * 128 + 2 * dp) : 0u; }
        unsigned vr[8];
#pragma unroll
        for (int i = 0; i < 8; ++i) vr[i] = *(const unsigned*)(P + (rowb + t0 + 8 * sg + i) * PS + C_MV + h * 128 + 2 * dp);
        float ns0 = 0.f, ns1 = 0.f; unsigned k0p[4], k1p[4], v0p[4], v1p[4];
#pragma unroll
        for (int i = 0; i < 8; i += 2) {
            float y[2][2];
#pragma unroll
            for (int q = 0; q < 2; ++q) {
                float a0 = cb[0], a1 = cb[1];
#pragma unroll
                for (int j = 0; j < 4; ++j) { a0 += cw[j][0] * bflo(kr[i + q + j]); a1 += cw[j][1] * bfhi(kr[i + q + j]); }
                const float wki = __shfl(wk, 8 * sg + i + q) * KSCALE;
                y[q][0] = a0 * sigmoidf(a0) * wki; y[q][1] = a1 * sigmoidf(a1) * wki;
                ns0 += y[q][0]; ns1 += y[q][1];
            }
            k0p[i >> 1] = pk2(y[0][0], y[1][0]); k1p[i >> 1] = pk2(y[0][1], y[1][1]);
            v0p[i >> 1] = (vr[i] & 0xffffu) | (vr[i + 1] << 16); v1p[i >> 1] = (vr[i] >> 16) | (vr[i + 1] & 0xffff0000u);
        }
        *(v4u*)(KT + (2 * dp) * TS + 16 * sg) = (v4u){k0p[0], k0p[1], k0p[2], k0p[3]};
        *(v4u*)(KT + (2 * dp + 1) * TS + 16 * sg) = (v4u){k1p[0], k1p[1], k1p[2], k1p[3]};
        *(v4u*)(VT + (2 * dp) * TS + 16 * sg) = (v4u){v0p[0], v0p[1], v0p[2], v0p[3]};
        *(v4u*)(VT + (2 * dp + 1) * TS + 16 * sg) = (v4u){v1p[0], v1p[1], v1p[2], v1p[3]};
        NPART[sg * 128 + 2 * dp] = ns0; NPART[sg * 128 + 2 * dp + 1] = ns1;
        { bf16* cst = CSM + (size_t)(bh * NCH + c) * 16384;
#pragma unroll
          for (int et = 0; et < 8; ++et) { const int e = 16 * et + r, d = 16 * w + 4 * g;
              *(v2u*)(cst + e * 128 + d) = (v2u){pg8::cvt_pk_bf16(acc[et][0], acc[et][1]), pg8::cvt_pk_bf16(acc[et][2], acc[et][3])}; }
          if (tid < 128) NCS[(size_t)(bh * NCH + c) * 128 + tid] = nst;
          if (tid == 0) MCS[bh * NCH + c] = mst; }
        __syncthreads();
        if (tid < 128) { float s = 0.f;
#pragma unroll
            for (int q = 0; q < 8; ++q) s += NPART[q * 128 + tid];
            nst = cs * nst + s; }
#pragma unroll
        for (int et = 0; et < 8; ++et) acc[et] = acc[et] * cs;
#pragma unroll
        for (int kk = 0; kk < 2; ++kk) {
            const bf16x8 af = lds_frag(KT + (16 * w + r) * TS + (32 * kk + 8 * g) * 2);
#pragma unroll
            for (int et = 0; et < 8; ++et) acc[et] = mfma16(af, lds_frag(VT + (16 * et + r) * TS + (32 * kk + 8 * g) * 2), acc[et]);
        }
        mst = bL + M;
        __syncthreads();
    }
    { float* Co = OUTP + O_CP + (size_t)bh * 16384;
#pragma unroll
      for (int et = 0; et < 8; ++et)
#pragma unroll
          for (int j = 0; j < 4; ++j) Co[(16 * w + 4 * g + j) * 128 + 16 * et + r] = acc[et][j];
      if (tid < 128) OUTP[O_NP + (size_t)bh * 128 + tid] = nst;
      if (tid == 0) OUTP[O_MP + bh] = mst; }
}

__device__ __forceinline__ void chain_gla(Frame& F, int b, int hg) {
    char* L = F.ldsg; char* KT = L; char* VT = L + 64 * TS; float* EBL = (float*)(L + 64 * TS + 128 * TS);
    const int tid = F_TID, lane = F_LANE, w = F_WAVE, dp = tid & 63, sg = tid >> 6, r = lane & 15, g = lane >> 4;
    const int bh = b * 4 + hg; const size_t rowb = (size_t)b * SEQ;
    const bf16* P = PROJ;
    const int dt = w & 3, eb = 4 * (w >> 2);
    f32x4 acc[4];
#pragma unroll
    for (int i = 0; i < 4; ++i) acc[i] = (f32x4){0.f, 0.f, 0.f, 0.f};
    for (int c = 0; c < NCH; ++c) {
        const int t0 = c * 64;
        {
          const size_t row = rowb + t0 + lane;
          const v4u ga0 = *(const v4u*)(P + row * PS + C_SM + 8), ga1 = *(const v4u*)(P + row * PS + C_SM + 16);
          const v4u k8 = *(const v4u*)(P + row * PS + C_GK + hg * 64 + 8 * w);
          float ga[16];
#pragma unroll
          for (int i = 0; i < 4; ++i) { ga[2 * i] = bflo(ga0[i]); ga[2 * i + 1] = bfhi(ga0[i]); ga[8 + 2 * i] = bflo(ga1[i]); ga[8 + 2 * i + 1] = bfhi(ga1[i]); }
#pragma unroll
          for (int dd = 0; dd < 8; ++dd) { const int d = 8 * w + dd, col = hg * 64 + d;
              float z = B_A[col];
#pragma unroll
              for (int q = 0; q < 16; ++q) z += ga[q] * W_A2[q * 256 + col];
              const float la = logsig(z) * (1.f / 16.f);
              const float bc = wave_scan_sum(la, lane); const float bLd = __shfl(bc, 63);
              const float kv = (dd & 1) ? bfhi(k8[dd >> 1]) : bflo(k8[dd >> 1]);
              *(bf16*)(KT + d * TS + 2 * lane) = (bf16)f2bf(kv * __expf(bLd - bc));
              if (lane == 0) EBL[d] = __expf(bLd); } }
        unsigned vr[8];
#pragma unroll
        for (int i = 0; i < 8; ++i) vr[i] = *(const unsigned*)(P + (rowb + t0 + 8 * sg + i) * PS + C_GV + hg * 128 + 2 * dp);
        { unsigned v0p[4], v1p[4];
#pragma unroll
          for (int i = 0; i < 8; i += 2) { v0p[i >> 1] = (vr[i] & 0xffffu) | (vr[i + 1] << 16); v1p[i >> 1] = (vr[i] >> 16) | (vr[i + 1] & 0xffff0000u); }
          *(v4u*)(VT + (2 * dp) * TS + 16 * sg) = (v4u){v0p[0], v0p[1], v0p[2], v0p[3]};
          *(v4u*)(VT + (2 * dp + 1) * TS + 16 * sg) = (v4u){v1p[0], v1p[1], v1p[2], v1p[3]}; }
        { bf16* cst = CSG + (size_t)(bh * NCH + c) * 8192;
#pragma unroll
          for (int i = 0; i < 4; ++i) { const int e = 16 * (eb + i) + r, d = 16 * dt + 4 * g;
              *(v2u*)(cst + e * 64 + d) = (v2u){pg8::cvt_pk_bf16(acc[i][0], acc[i][1]), pg8::cvt_pk_bf16(acc[i][2], acc[i][3])}; } }
        __syncthreads();
        { const f32x4 eb4 = *(const f32x4*)(EBL + 16 * dt + 4 * g);
#pragma unroll
          for (int i = 0; i < 4; ++i) acc[i] = acc[i] * eb4; }
#pragma unroll
        for (int kk = 0; kk < 2; ++kk) {
            const bf16x8 af = lds_frag(KT + (16 * dt + r) * TS + (32 * kk + 8 * g) * 2);
#pragma unroll
            for (int i = 0; i < 4; ++i) acc[i] = mfma16(af, lds_frag(VT + (16 * (eb + i) + r) * TS + (32 * kk + 8 * g) * 2), acc[i]);
        }
        __syncthreads();
    }
    { float* So = OUTP + O_SP + (size_t)bh * 8192;
#pragma unroll
      for (int i = 0; i < 4; ++i)
#pragma unroll
          for (int j = 0; j < 4; ++j) So[(16 * dt + 4 * g + j) * 128 + 16 * (eb + i) + r] = acc[i][j]; }
}

__device__ __forceinline__ void sample_item(Frame& F, int n, int hh) {
    float* L = (float*)F.ldsg;
    float* qv = L; float* kv = L + 128; float* vv = L + 256; float* part = L + 512; float* sc = L + 512 + 2048;
    const int tid = F_TID, lane = F_LANE, w = F_WAVE;
    const size_t row = (size_t)MP + n;
    const bf16* Pr = PROJ + row * PS;
    const bool gla = hh >= 4; const int h = hh & 3;
    if (!gla) {
        if (tid < 256) { const int d = tid & 127, isk = tid >> 7, ch = isk * 512 + h * 128 + d;
            const float* scv = ST_CONV + (size_t)n * 3 * 1024 + ch;
            float a = CONV_B[ch] + CONV_W[ch] * scv[0] + CONV_W[1024 + ch] * scv[1024] + CONV_W[2048 + ch] * scv[2048] + CONV_W[3072 + ch] * bf2f(Pr[(isk ? C_MK : C_MQ) + h * 128 + d]);
            a = a * sigmoidf(a); if (isk) kv[d] = a * KSCALE; else qv[d] = a;
        } else if (tid < 384) { const int e = tid - 256; vv[e] = bf2f(Pr[C_MV + h * 128 + e]); }
    } else {
        if (tid < 64) qv[tid] = bf2f(Pr[C_GQ + h * 64 + tid]);
        else if (tid < 128) kv[tid - 64] = bf2f(Pr[C_GK + h * 64 + tid - 64]);
        else if (tid < 256) vv[tid - 128] = bf2f(Pr[C_GV + h * 128 + tid - 128]);
        else if (tid < 320) { const int d = tid - 256, col = h * 64 + d; float z = B_A[col];
#pragma unroll
            for (int q = 0; q < 16; ++q) z += bf2f(Pr[C_SM + 8 + q]) * W_A2[q * 256 + col];
            sc[16 + d] = __expf(logsig(z) * (1.f / 16.f)); }
    }
    __syncthreads();
    float cs = 1.f, wkk = 1.f, dinv = 1.f;
    if (!gla) {
        const float* n0 = ST_N + ((size_t)n * 4 + h) * 128;
        if (w == 0) { const float s = wave_sum(qv[lane] * kv[lane] + qv[lane + 64] * kv[lane + 64]); if (lane == 0) sc[0] = s; }
        if (w == 1) { const float s = wave_sum(qv[lane] * n0[lane] + qv[lane + 64] * n0[lane + 64]); if (lane == 0) sc[1] = s; }
        __syncthreads();
        const float ig = bf2f(Pr[C_SM + h]) + B_GATE[h], lf = logsig(bf2f(Pr[C_SM + 4 + h]) + B_GATE[4 + h]);
        const float m0 = ST_M[n * 4 + h], mn = fmaxf(lf + m0, ig);
        wkk = __expf(ig - mn); cs = __expf(lf + m0 - mn);
        const float den = cs * sc[1] + sc[0] * wkk;
        dinv = 1.f / fmaxf(fabsf(den), __expf(-mn));
        if (tid < 128) OUTP[O_NS + ((size_t)n * 4 + h) * 128 + tid] = cs * n0[tid] + wkk * kv[tid];
        if (tid == 0) OUTP[O_MS + n * 4 + h] = mn;
    }
    const int e4 = tid & 31, dg = tid >> 5;
    const f32x4 v4 = *(const f32x4*)(vv + 4 * e4);
    f32x4 hp = (f32x4){0.f, 0.f, 0.f, 0.f};
    if (!gla) {
        const float* C0 = ST_C + ((size_t)n * 4 + h) * 16384; float* Cn = OUTP + O_CS + ((size_t)n * 4 + h) * 16384;
#pragma unroll
        for (int i = 0; i < 8; ++i) { const int d = 8 * dg + i; const f32x4 c0 = *(const f32x4*)(C0 + d * 128 + 4 * e4);
            const f32x4 cn = c0 * cs + v4 * (wkk * kv[d]); *(f32x4*)(Cn + d * 128 + 4 * e4) = cn; hp += cn * qv[d]; }
    } else {
        const float* S0 = ST_S + ((size_t)n * 4 + h) * 8192; float* Sn = OUTP + O_SS + ((size_t)n * 4 + h) * 8192;
#pragma unroll
        for (int i = 0; i < 4; ++i) { const int d = 4 * dg + i; const f32x4 s0 = *(const f32x4*)(S0 + d * 128 + 4 * e4);
            const f32x4 sn = s0 * sc[16 + d] + v4 * kv[d]; *(f32x4*)(Sn + d * 128 + 4 * e4) = sn; hp += sn * qv[d]; }
    }
    *(f32x4*)(part + dg * 128 + 4 * e4) = hp;
    __syncthreads();
    float hv = 0.f;
    if (tid < 128) {
#pragma unroll
        for (int q = 0; q < 16; ++q) hv += part[q * 128 + tid];
        hv *= dinv;
        const float s = wave_sum(hv * hv); if (lane == 0) sc[2 + w] = s;
    }
    __syncthreads();
    if (tid < 128) {
        const float rn = 1.f / sqrtf((sc[2] + sc[3]) * (1.f / 128.f) + EPS);
        float o;
        if (!gla) o = hv * rn * G_MHEAD[h * 128 + tid] * sigmoidf(bf2f(Pr[C_MO + h * 128 + tid]));
        else { const float gr = bf2f(Pr[C_GR + h * 128 + tid]); o = hv * rn * G_GHEAD[h * 128 + tid] * gr * sigmoidf(gr); }
        R1B[row * D + (gla ? 512 : 0) + h * 128 + tid] = (bf16)f2bf(o);
    }
    __syncthreads();
}

constexpr int P2B_QS = 0, P2B_KS = 64 * QS_P, P2B_VT = P2B_KS + 80 * QS_P, P2B_PS = P2B_VT + 128 * TS, P2B_FL = P2B_PS + 64 * TS, P2B_HALF = P2B_FL + 2304;
static_assert(2 * P2B_HALF <= MISC_OFF, "P2b LDS");
template <bool GLA>
__device__ __forceinline__ void p2b_unit(Frame& F, int u, char* L, int ltid, int lw, int lane) {
    const int v = u & 1023, bh = v >> 5, c = v & 31, b = bh >> 2, h = bh & 3, r = lane & 15, g = lane >> 4;
    const size_t rowb = (size_t)b * SEQ + c * 64;
    const bf16* P = PROJ;
    char* QSp = L + P2B_QS; char* KSp = L + P2B_KS; char* VTp = L + P2B_VT; char* PSp = L + P2B_PS;
    float* af = (float*)(L + P2B_FL); float* Mf = af + 64; float* scf = af + 128; float* enf = af + 192; float* dinvf = af + 256; float* ssq = af + 320;
    constexpr int QP = GLA ? TS : QS_P;
    constexpr int NK = GLA ? 2 : 4;
    bf16x8 cfr[2][NK];
    { const bf16* CT = GLA ? CSG + (size_t)(bh * NCH + c) * 8192 : CSM + (size_t)(bh * NCH + c) * 16384;
#pragma unroll
      for (int n2 = 0; n2 < 2; ++n2)
#pragma unroll
          for (int kk = 0; kk < NK; ++kk) cfr[n2][kk] = *(const bf16x8*)(CT + (32 * lw + 16 * n2 + r) * (GLA ? 64 : 128) + 32 * kk + 8 * g); }
    const int dp = ltid & 63, sg = ltid >> 6;
    if constexpr (!GLA) {
        { const size_t row = rowb + lane;
          const float ig = bf2f(P[row * PS + C_SM + h]) + B_GATE[h], lf = logsig(bf2f(P[row * PS + C_SM + 4 + h]) + B_GATE[4 + h]);
          const float bc = wave_scan_sum(lf, lane), a = ig - bc; const float pm = wave_scan_max(a, lane);
          const float mc = MCS[bh * NCH + c], Mt = fmaxf(mc, pm);
          if (lw == 0) { af[lane] = a; Mf[lane] = Mt; scf[lane] = __expf(mc - Mt); enf[lane] = __expf(-(bc + Mt)); } }
#pragma unroll
        for (int isk = 0; isk < 2; ++isk) {
            const int ch = isk * 512 + h * 128 + 2 * dp;
            float cw[4][2], cb[2];
#pragma unroll
            for (int j = 0; j < 4; ++j) { cw[j][0] = CONV_W[j * 1024 + ch]; cw[j][1] = CONV_W[j * 1024 + ch + 1]; }
            cb[0] = CONV_B[ch]; cb[1] = CONV_B[ch + 1];
            unsigned raw[19];
#pragma unroll
            for (int i = 0; i < 19; ++i) { const int t = c * 64 + 16 * sg - 3 + i; raw[i] = (t >= 0) ? *(const unsigned*)(P + ((size_t)b * SEQ + t) * PS + (isk ? C_MK : C_MQ) + h * 128 + 2 * dp) : 0u; }
            char* dst = (isk ? KSp : QSp) + 4 * dp;
#pragma unroll
            for (int i = 0; i < 16; ++i) { float a0 = cb[0], a1 = cb[1];
#pragma unroll
                for (int j = 0; j < 4; ++j) { a0 += cw[j][0] * bflo(raw[i + j]); a1 += cw[j][1] * bfhi(raw[i + j]); }
                a0 = a0 * sigmoidf(a0); a1 = a1 * sigmoidf(a1); if (isk) { a0 *= KSCALE; a1 *= KSCALE; }
                *(unsigned*)(dst + (16 * sg + i) * QS_P) = pk2(a0, a1); }
        }
        if (ltid < 128) *(bf16*)(KSp + 64 * QS_P + 2 * ltid) = (bf16)f2bf(NCS[(size_t)(bh * NCH + c) * 128 + ltid]);
        for (int i = ltid; i < 15 * 64; i += 256) *(unsigned*)(KSp + (65 + i / 64) * QS_P + 4 * (i & 63)) = 0u;
    } else {
        const size_t row = rowb + lane;
        const v4u ga0 = *(const v4u*)(P + row * PS + C_SM + 8), ga1 = *(const v4u*)(P + row * PS + C_SM + 16);
        const v4u q0 = *(const v4u*)(P + row * PS + C_GQ + h * 64 + 16 * lw), q1 = *(const v4u*)(P + row * PS + C_GQ + h * 64 + 16 * lw + 8);
        const v4u k0 = *(const v4u*)(P + row * PS + C_GK + h * 64 + 16 * lw), k1 = *(const v4u*)(P + row * PS + C_GK + h * 64 + 16 * lw + 8);
        float ga[16];
#pragma unroll
        for (int i = 0; i < 4; ++i) { ga[2 * i] = bflo(ga0[i]); ga[2 * i + 1] = bfhi(ga0[i]); ga[8 + 2 * i] = bflo(ga1[i]); ga[8 + 2 * i + 1] = bfhi(ga1[i]); }
        unsigned qo[8], ko[8];
#pragma unroll
        for (int dd = 0; dd < 16; dd += 2) {
            float qt[2], kt[2];
#pragma unroll
            for (int q2 = 0; q2 < 2; ++q2) { const int col = h * 64 + 16 * lw + dd + q2;
                float z = B_A[col];
#pragma unroll
                for (int q = 0; q < 16; ++q) z += ga[q] * W_A2[q * 256 + col];
                const float bc = wave_scan_sum(logsig(z) * (1.f / 16.f), lane);
                const unsigned qw = dd < 8 ? q0[dd >> 1] : q1[(dd - 8) >> 1], kw = dd < 8 ? k0[dd >> 1] : k1[(dd - 8) >> 1];
                qt[q2] = (q2 ? bfhi(qw) : bflo(qw)) * __expf(bc); kt[q2] = (q2 ? bfhi(kw) : bflo(kw)) * __expf(-bc); }
            qo[dd >> 1] = pk2(qt[0], qt[1]); ko[dd >> 1] = pk2(kt[0], kt[1]);
            __builtin_amdgcn_sched_barrier(0);
        }
        *(v4u*)(QSp + lane * TS + 32 * lw) = (v4u){qo[0], qo[1], qo[2], qo[3]}; *(v4u*)(QSp + lane * TS + 32 * lw + 16) = (v4u){qo[4], qo[5], qo[6], qo[7]};
        *(v4u*)(KSp + lane * TS + 32 * lw) = (v4u){ko[0], ko[1], ko[2], ko[3]}; *(v4u*)(KSp + lane * TS + 32 * lw + 16) = (v4u){ko[4], ko[5], ko[6], ko[7]};
    }
    {
      unsigned vr[16];
#pragma unroll
      for (int i = 0; i < 16; ++i) vr[i] = *(const unsigned*)(P + (rowb + 16 * sg + i) * PS + (GLA ? C_GV : C_MV) + h * 128 + 2 * dp);
      unsigned v0p[8], v1p[8];
#pragma unroll
      for (int i = 0; i < 16; i += 2) { v0p[i >> 1] = (vr[i] & 0xffffu) | (vr[i + 1] << 16); v1p[i >> 1] = (vr[i] >> 16) | (vr[i + 1] & 0xffff0000u); }
      *(v4u*)(VTp + (2 * dp) * TS + 32 * sg) = (v4u){v0p[0], v0p[1], v0p[2], v0p[3]}; *(v4u*)(VTp + (2 * dp) * TS + 32 * sg + 16) = (v4u){v0p[4], v0p[5], v0p[6], v0p[7]};
      *(v4u*)(VTp + (2 * dp + 1) * TS + 32 * sg) = (v4u){v1p[0], v1p[1], v1p[2], v1p[3]}; *(v4u*)(VTp + (2 * dp + 1) * TS + 32 * sg + 16) = (v4u){v1p[4], v1p[5], v1p[6], v1p[7]}; }
    __syncthreads();
    {
        f32x4 pa[5];
#pragma unroll
        for (int i = 0; i < 5; ++i) pa[i] = (f32x4){0.f, 0.f, 0.f, 0.f};
#pragma unroll
        for (int kk = 0; kk < NK; ++kk) {
            const bf16x8 qf = lds_frag(QSp + (16 * lw + r) * QP + (32 * kk + 8 * g) * 2);
#pragma unroll
            for (int nt = 0; nt < 4; ++nt) if (nt <= lw) pa[nt] = mfma16(lds_frag(KSp + (16 * nt + r) * QP + (32 * kk + 8 * g) * 2), qf, pa[nt]);
            if constexpr (!GLA) pa[4] = mfma16(lds_frag(KSp + (64 + r) * QP + (32 * kk + 8 * g) * 2), qf, pa[4]);
        }
        const int t = 16 * lw + r;
        float Mt = 0.f; if constexpr (!GLA) Mt = Mf[t];
        float rs = 0.f;
#pragma unroll
        for (int nt = 0; nt < 4; ++nt) {
            f32x4 p = (f32x4){0.f, 0.f, 0.f, 0.f};
            if (nt <= lw) {
                f32x4 a4 = (f32x4){0.f, 0.f, 0.f, 0.f}; if constexpr (!GLA) a4 = *(const f32x4*)(af + 16 * nt + 4 * g);
#pragma unroll
                for (int j = 0; j < 4; ++j) { const int s = 16 * nt + 4 * g + j; float x = pa[nt][j]; if constexpr (!GLA) x *= __expf(a4[j] - Mt); p[j] = (s <= t) ? x : 0.f; }
            }
            rs += (p[0] + p[1]) + (p[2] + p[3]);
            *(v2u*)(PSp + t * TS + (16 * nt + 4 * g) * 2) = (v2u){pg8::cvt_pk_bf16(p[0], p[1]), pg8::cvt_pk_bf16(p[2], p[3])};
        }
        if constexpr (!GLA) {
            rs += __shfl_xor(rs, 16); rs += __shfl_xor(rs, 32);
            if (g == 0) { const float den = scf[t] * pa[4][0] + rs; dinvf[t] = 1.f / fmaxf(fabsf(den), enf[t]); }
        }
    }
    __syncthreads();
    f32x4 hv[4][2];
    {
        f32x4 aV[4][2], aC[4][2];
#pragma unroll
        for (int mt = 0; mt < 4; ++mt)
#pragma unroll
            for (int n2 = 0; n2 < 2; ++n2) { aV[mt][n2] = (f32x4){0.f, 0.f, 0.f, 0.f}; aC[mt][n2] = (f32x4){0.f, 0.f, 0.f, 0.f}; }
#pragma unroll
        for (int kk = 0; kk < 2; ++kk) {
            bf16x8 vf[2];
#pragma unroll
            for (int n2 = 0; n2 < 2; ++n2) vf[n2] = lds_frag(VTp + (32 * lw + 16 * n2 + r) * TS + (32 * kk + 8 * g) * 2);
#pragma unroll
            for (int mt = 0; mt < 4; ++mt) { const bf16x8 pf = lds_frag(PSp + (16 * mt + r) * TS + (32 * kk + 8 * g) * 2);
#pragma unroll
                for (int n2 = 0; n2 < 2; ++n2) aV[mt][n2] = mfma16(vf[n2], pf, aV[mt][n2]); }
        }
#pragma unroll
        for (int kk = 0; kk < NK; ++kk)
#pragma unroll
            for (int mt = 0; mt < 4; ++mt) { const bf16x8 qf = lds_frag(QSp + (16 * mt + r) * QP + (32 * kk + 8 * g) * 2);
#pragma unroll
                for (int n2 = 0; n2 < 2; ++n2) aC[mt][n2] = mfma16(cfr[n2][kk], qf, aC[mt][n2]); }
#pragma unroll
        for (int mt = 0; mt < 4; ++mt) { const int t = 16 * mt + r;
            float sc = 1.f, di = 1.f; if constexpr (!GLA) { sc = scf[t]; di = dinvf[t]; }
            float s = 0.f;
#pragma unroll
            for (int n2 = 0; n2 < 2; ++n2) { hv[mt][n2] = (aC[mt][n2] * sc + aV[mt][n2]) * di;
                s += (hv[mt][n2][0] * hv[mt][n2][0] + hv[mt][n2][1] * hv[mt][n2][1]) + (hv[mt][n2][2] * hv[mt][n2][2] + hv[mt][n2][3] * hv[mt][n2][3]); }
            s += __shfl_xor(s, 16); s += __shfl_xor(s, 32);
            if (g == 0) ssq[t * 4 + lw] = s; }
    }
    __syncthreads();
    {
        const float* gn = (GLA ? G_GHEAD : G_MHEAD) + h * 128;
#pragma unroll
        for (int mt = 0; mt < 4; ++mt) { const int t = 16 * mt + r; const f32x4 s4 = *(const f32x4*)(ssq + 4 * t);
            const float rn = 1.f / sqrtf(((s4[0] + s4[1]) + (s4[2] + s4[3])) * (1.f / 128.f) + EPS);
#pragma unroll
            for (int n2 = 0; n2 < 2; ++n2) { const int e = 32 * lw + 16 * n2 + 4 * g;
                const v2u gw = *(const v2u*)(P + (rowb + t) * PS + (GLA ? C_GR : C_MO) + h * 128 + e);
                const f32x4 g4 = *(const f32x4*)(gn + e);
                float gt[4] = {bflo(gw[0]), bfhi(gw[0]), bflo(gw[1]), bfhi(gw[1])}; float o[4];
#pragma unroll
                for (int j = 0; j < 4; ++j) { const float sg_ = sigmoidf(gt[j]); o[j] = hv[mt][n2][j] * rn * g4[j] * (GLA ? gt[j] * sg_ : sg_); }
                *(v2u*)(R1B + (rowb + t) * D + (GLA ? 512 : 0) + h * 128 + e) = (v2u){pg8::cvt_pk_bf16(o[0], o[1]), pg8::cvt_pk_bf16(o[2], o[3])}; } }
    }
    __syncthreads();
}

constexpr int NPHASE = 9;

__global__ void __launch_bounds__(NWAVES * 64, 2) mk_fwd(Args args) {
    extern __shared__ __attribute__((aligned(16))) unsigned char lds[];
    Frame F;
    F.lds = (LAS unsigned char*)lds; F.ldsg = (char*)lds;
    F.G = gridDim.x;
    F.a = (CArgs*)__builtin_amdgcn_kernarg_segment_ptr();
    unsigned char* ws = F.a->ws;
    volatile LAS unsigned* MISC = (volatile LAS unsigned*)(F.lds + MISC_OFF);
    for (int u = F_TID; u < 64; u += NWAVES * 64) MISC[u] = 0u;
    __syncthreads();
    XcdBarrier bar; bar.bar = (unsigned*)(ws + CTL_BAR_B); bar.x = 0; bar.st = nullptr;
    if (MK_N_LAUNCHES == 1) bar = xcd_barrier_post((unsigned*)(ws + CTL_BAR_B), MISC + 8);
    const int lo = F.a->ph_lo, hi = F.a->ph_hi;
#ifndef PHASE_MASK
#define PHASE_MASK 0x1ff
#endif
#define IN(k) (((PHASE_MASK >> (k)) & 1) && lo <= (k) && (k) < hi)
#define SEAM(k) do { if (IN(k) && IN((k) + 1)) xcd_barrier(bar); } while (0)

    if (IN(0)) { p0_prologue(F); SEAM(0); }
    if (IN(1)) {
        pg8::Gemm g{R1B, WIN_T, MR, PS, D}; pg8::StaticOrder S; S.init(MR, PS, F.G, (int)blockIdx.x);
        EpiProj E{PROJ, PS};
        pg8::gemm_phase<EpiProj, pg8::StaticOrder, PG8_ALIGN, PG8_SP2>(F.lds, g, S, E);
        SEAM(1);
    }
    if (IN(2)) {
        const int bx = blockIdx.x;
        if (bx < 64) { if (bx < 32) chain_mlstm(F, bx >> 2, bx & 3); else chain_gla(F, (bx - 32) >> 2, (bx - 32) & 3); }
        else {
            const int nb = F.G - 64, gb = bx - 64;
            for (int it = gb; it < MSMP * 8; it += nb) sample_item(F, it >> 3, it & 7);
            for (int i = gb * 512 + F_TID; i < NB * 3 * 1024 + MSMP * 3 * 1024; i += nb * 512) {
                if (i < NB * 3 * 1024) { const int b = i / 3072, j = (i / 1024) % 3, ch = i & 1023; OUTP[O_CVP + i] = bf2f(PROJ[((size_t)b * SEQ + SEQ - 3 + j) * PS + ch]); }
                else { const int k = i - NB * 3 * 1024, n = k / 3072, j = (k / 1024) % 3, ch = k & 1023;
                    OUTP[O_CVS + k] = j < 2 ? ST_CONV[(size_t)n * 3072 + (j + 1) * 1024 + ch] : bf2f(PROJ[((size_t)MP + n) * PS + ch]); }
            }
        }
        SEAM(2);
    }
    if (IN(3)) {
        const int hb = F_WAVE >> 2, ltid = F_TID & 255, lw = F_WAVE & 3;
        char* L = F.ldsg + hb * P2B_HALF;
        for (int it = 0; it * 2 * F.G < 2048; ++it) {
            const int u = (it * F.G + (int)blockIdx.x) * 2 + hb;
            if (u - hb >= 2048) break;
            if (u < 1024) p2b_unit<false>(F, u, L, ltid, lw, F_LANE); else p2b_unit<true>(F, u, L, ltid, lw, F_LANE);
        }
        SEAM(3);
    }
    if (IN(4)) {
        pg8::Gemm g{R1B, WOUT_T, MR, D, D}; pg8::StaticOrder S; S.init(MR, D, F.G, (int)blockIdx.x);
        EpiRes E{X_P, X_S, OUTP, X1B, SS1};
        pg8::gemm_phase<EpiRes, pg8::StaticOrder, PG8_ALIGN, PG8_SP2>(F.lds, g, S, E);
        SEAM(4);
    }
    if (IN(5)) {
        pg8::Gemm g{X1B, W1_T, MR, FF, D}; pg8::StaticOrder S; S.init(MR, FF, F.G, (int)blockIdx.x);
        EpiU E{UBUF, SS1};
        pg8::gemm_phase<EpiU, pg8::StaticOrder, PG8_ALIGN, PG8_SP2>(F.lds, g, S, E);
        SEAM(5);
    }
    if (IN(6)) {
        pg8::Gemm g{UBUF, W2_T, MR, D, FF}; pg8::StaticOrder S; S.init(MR, D, F.G, (int)blockIdx.x);
        EpiRes E{OUTP, OUTP + (size_t)MP * D, OUTP, R1B, SS2};
        pg8::gemm_phase<EpiRes, pg8::StaticOrder, PG8_ALIGN, PG8_SP2>(F.lds, g, S, E);
        SEAM(6);
    }
    if (IN(7)) {
        { pg8::Gemm g{PBUF, WPLE_T, MR, D, DPLE}; pg8::StaticOrder S; S.init(MR, D, F.G, (int)blockIdx.x);
          EpiProj E{PPB, D};
          pg8::gemm_phase<EpiProj, pg8::StaticOrder, PG8_ALIGN, PG8_SP2>(F.lds, g, S, E); }
        { pg8::Gemm g{R1B, WPG_T, MR, D, D}; pg8::StaticOrder S; S.init(MR, D, F.G, (int)blockIdx.x);
          EpiPle E{OUTP, PPB, SS2, SS3};
          pg8::gemm_phase<EpiPle, pg8::StaticOrder, PG8_ALIGN, PG8_SP2>(F.lds, g, S, E); }
        SEAM(7);
    }
    if (IN(8)) {
        const int gw = blockIdx.x * NWAVES + F_WAVE, NGW = F.G * NWAVES;
        for (int m = gw; m < MV; m += NGW) {
            GAS f32x4* xr = (GAS f32x4*)(OUTP + (size_t)m * D) + F_LANE;
            const float r = 1.f / sqrtf(SS3[m] * (1.f / D) + EPS);
#pragma unroll
            for (int j = 0; j < 4; ++j) { const f32x4 gf = ((const GAS f32x4*)G_FINAL)[F_LANE + 64 * j]; xr[64 * j] = xr[64 * j] * r * gf; }
        }
    }
#undef IN
#undef SEAM
}

extern "C" void kernel_launch(void* const* d_in, const int* in_sizes, int n_in, void* d_out, int out_size, void* d_ws, size_t ws_size, hipStream_t stream) {
    static int grid = 0;
    if (grid == 0) {
        if (n_in != 26 || ws_size < WS_END) { fprintf(stderr, "kernel_launch: unexpected n_in %d / ws %zu\n", n_in, ws_size); grid = -1; return; }
        int dev = 0, cus = 0, per_cu = 0;
        if (hipGetDevice(&dev) != hipSuccess || hipDeviceGetAttribute(&cus, hipDeviceAttributeMultiprocessorCount, dev) != hipSuccess) { grid = -1; return; }
        if (hipFuncSetAttribute((const void*)mk_fwd, hipFuncAttributeMaxDynamicSharedMemorySize, LDS_BYTES) != hipSuccess) { fprintf(stderr, "kernel_launch: hipFuncSetAttribute failed\n"); grid = -1; return; }
        if (hipOccupancyMaxActiveBlocksPerMultiprocessor(&per_cu, (const void*)mk_fwd, NWAVES * 64, LDS_BYTES) != hipSuccess || per_cu < 1) { fprintf(stderr, "kernel_launch: occupancy query says %d\n", per_cu); per_cu = 1; }
        (void)hipGetLastError();
        grid = cus;
        if (grid > 256) grid = 256;
    }
    if (grid < 0) return;
    (void)hipMemsetAsync((char*)d_ws + WS_CTL, 0, CTL_ZERO_BYTES, stream);
    Args a{};
    for (int i = 0; i < 26; ++i) a.in[i] = (const float*)d_in[i];
    a.out = (float*)d_out; a.ws = (unsigned char*)d_ws;
    if (MK_N_LAUNCHES == 1) { a.ph_lo = 0; a.ph_hi = NPHASE; a.li = 0; hipLaunchKernelGGL(mk_fwd, dim3(grid), dim3(NWAVES * 64), LDS_BYTES, stream, a); }
    else for (int li = 0; li < NPHASE; ++li) { a.ph_lo = li; a.ph_hi = li + 1; a.li = li; hipLaunchKernelGGL(mk_fwd, dim3(grid), dim3(NWAVES * 64), LDS_BYTES, stream, a); }
}
```

```cpp
#include <hip/hip_runtime.h>
#include <cstdio>
#include <cstdint>

#ifndef MK_N_LAUNCHES
#define MK_N_LAUNCHES 1
#endif

namespace pg8 {
#define PG8_LAS __attribute__((address_space(3)))
typedef unsigned short bf16_t;
typedef short bf16x8 __attribute__((ext_vector_type(8)));
typedef float f32x4 __attribute__((ext_vector_type(4)));
typedef unsigned u32x4 __attribute__((ext_vector_type(4)));
constexpr int BM = 256, BK = 64, HALF = 128, HTB = HALF * BK * 2, STAGE_BYTES = 8 * HTB, NXCD = 8, WGM = 8;

__host__ __device__ __forceinline__ int lds_byte(int r, int c) { const int st = (r >> 4) * 2 + (c >> 5), rr = r & 15, cc = c & 31, ob = rr * 64 + cc * 2; return st * 1024 + (ob ^ (((ob >> 9) & 1) << 5)); }
__host__ __device__ __forceinline__ void stage_rc(int b, int& R, int& C) { const int st = b / 1024, sb = b % 1024, swz = sb ^ (((sb >> 9) & 1) << 5); R = (st >> 1) * 16 + swz / 64; C = (st & 1) * 32 + (swz % 64) / 2; }
__host__ __device__ __forceinline__ int perm32(int rho) { const int n = rho >> 4, i = rho & 15; return 8 * (i >> 2) + 4 * n + (i & 3); }

struct Unit { int pm, pn; };
struct Gemm { const bf16_t* A; const bf16_t* Bt; int M, N, K; };

struct StaticOrder {
    int nM, nN, nwg, G, c;
    __host__ __device__ void init(int M, int N, int G_, int c_) { nM = M / BM; nN = N / BM; nwg = nM * nN; G = G_; c = c_; }
    __host__ __device__ bool next(int i, Unit& u) const {
        const long L = (long)i * G + c; if (L >= nwg) return false;
        int wgid = (int)L; { const int q = nwg / NXCD, r = nwg % NXCD, xcd = wgid % NXCD, off = wgid / NXCD; wgid = (xcd < r ? xcd * (q + 1) : r * (q + 1) + (xcd - r) * q) + off; }
        const int nig = WGM * nN, gid = wgid / nig, fm = gid * WGM, gsz = (nM - fm) < WGM ? (nM - fm) : WGM;
        u.pm = fm + ((wgid % nig) % gsz); u.pn = (wgid % nig) / gsz; return true;
    }
    __device__ __forceinline__ void a_ready(const Unit&) const {}
    __device__ __forceinline__ void done(const Unit&) const {}
};

__device__ __forceinline__ unsigned cvt_pk_bf16(float lo, float hi) { unsigned r; asm volatile("v_cvt_pk_bf16_f32 %0, %1, %2" : "=v"(r) : "v"(lo), "v"(hi)); return r; }


template <class Epi, class Sched, bool ALIGN_EPI = false, bool SP2 = false>
__device__ __forceinline__ void gemm_phase(PG8_LAS unsigned char* lds, const Gemm g, const Sched& S, const Epi& E) {
    int tid_ = threadIdx.x; asm volatile("" : "+v"(tid_));
    const int tid = tid_, wid = __builtin_amdgcn_readfirstlane(tid >> 6), lane = tid & 63, wr = wid >> 2, wc = wid & 3, fr = lane & 15, fq = lane >> 4;
    const int K = g.K, nt = K / BK;
    unsigned voffA[2], voffB[2];
#pragma unroll
    for (int i = 0; i < 2; ++i) { int R, C; stage_rc(tid * 16 + i * 8192, R, C); const int Rb = Epi::PERM ? ((R & ~31) + perm32(R & 31)) : R;
        voffA[i] = (unsigned)(R * K + C) * 2u; voffB[i] = (unsigned)(Rb * K + C) * 2u; }
    const size_t kstep = (size_t)(BK * 2);
    const size_t hstep = (size_t)HALF * K * 2;
    const size_t tstep = 2 * hstep;
    const unsigned ldsw = (unsigned)wid * 1024u;
    const int aoff = lds_byte(wr * 64 + fr, fq * 8), boff = lds_byte(wc * 32 + fr, fq * 8);
#define PG8_SA(b, h) (((b) * 2 + (h)) * HTB)
#define PG8_SB(b, h) ((4 + (b) * 2 + (h)) * HTB)
#define PG8_STAGE(bufoff, gbase, voff) do { _Pragma("unroll") for (int _i = 0; _i < 2; ++_i) \
        __builtin_amdgcn_global_load_lds((const unsigned*)((const char*)(gbase) + (voff)[_i]), (PG8_LAS unsigned*)(lds + (bufoff) + ldsw + _i * 8192), 16, 0, 0); } while (0)
#define PG8_LDA(dst, b, h) do { _Pragma("unroll") for (int m = 0; m < 4; ++m) _Pragma("unroll") for (int k = 0; k < 2; ++k) dst[m][k] = *(const PG8_LAS bf16x8*)(lds + PG8_SA(b, h) + aoff + m * 2048 + k * 1024); } while (0)
#define PG8_LDB(dst, b, h) do { _Pragma("unroll") for (int n = 0; n < 2; ++n) _Pragma("unroll") for (int k = 0; k < 2; ++k) dst[n][k] = *(const PG8_LAS bf16x8*)(lds + PG8_SB(b, h) + boff + n * 2048 + k * 1024); } while (0)
#define PG8_MMA(ai, bj, At, Bt) do { __builtin_amdgcn_s_setprio(1); _Pragma("unroll") for (int m = 0; m < 4; ++m) _Pragma("unroll") for (int n = 0; n < 2; ++n) _Pragma("unroll") for (int k = 0; k < 2; ++k) \
        acc[ai][bj][m][n] = __builtin_amdgcn_mfma_f32_16x16x32_bf16(Bt[n][k], At[m][k], acc[ai][bj][m][n], 0, 0, 0); __builtin_amdgcn_s_setprio(0); } while (0)
#define PG8_WAIT_V(n) asm volatile("s_waitcnt vmcnt(" #n ")" ::: "memory")
#define PG8_WAIT_L(n) asm volatile("s_waitcnt lgkmcnt(" #n ")" ::: "memory")
#define PG8_BAR __builtin_amdgcn_s_barrier()
#define PG8_SCHED __builtin_amdgcn_sched_barrier(0)
    Unit cur, nxt; int ui = 0;
    if (!S.next(0, cur)) return;
    f32x4 acc[2][2][4][2];
#pragma unroll
    for (int a = 0; a < 2; ++a)
#pragma unroll
        for (int b = 0; b < 2; ++b)
#pragma unroll
            for (int m = 0; m < 4; ++m)
#pragma unroll
                for (int n = 0; n < 2; ++n) acc[a][b][m][n] = (f32x4){0.f, 0.f, 0.f, 0.f};
    bf16x8 At[4][2], B0[2][2], B1[2][2];
    const char* cA = (const char*)g.A + (size_t)cur.pm * tstep; const char* cB = (const char*)g.Bt + (size_t)cur.pn * tstep;
    S.a_ready(cur);
    if constexpr (SP2) {
        PG8_STAGE(PG8_SB(0, 0), cB, voffB); PG8_STAGE(PG8_SB(0, 1), cB + hstep, voffB); PG8_STAGE(PG8_SA(0, 0), cA, voffA); PG8_STAGE(PG8_SA(0, 1), cA + hstep, voffA);
        if (wr == 1) PG8_BAR;
        PG8_WAIT_V(2); PG8_BAR;
        PG8_STAGE(PG8_SB(1, 0), cB + kstep, voffB); PG8_STAGE(PG8_SA(1, 0), cA + kstep, voffA); PG8_STAGE(PG8_SB(1, 1), cB + hstep + kstep, voffB);
        PG8_WAIT_V(6); PG8_BAR;
    } else {
        PG8_STAGE(PG8_SB(0, 0), cB, voffB); PG8_STAGE(PG8_SA(0, 0), cA, voffA); PG8_STAGE(PG8_SB(0, 1), cB + hstep, voffB); PG8_STAGE(PG8_SA(0, 1), cA + hstep, voffA);
        if (wr == 1) PG8_BAR;
        PG8_WAIT_V(4); PG8_BAR;
        PG8_STAGE(PG8_SB(1, 0), cB + kstep, voffB); PG8_STAGE(PG8_SA(1, 0), cA + kstep, voffA); PG8_STAGE(PG8_SB(1, 1), cB + hstep + kstep, voffB);
        PG8_WAIT_V(6); PG8_BAR;
    }
    for (;;) {
        const bool has_next = S.next(ui + 1, nxt);
        const char* nA = has_next ? (const char*)g.A + (size_t)nxt.pm * tstep : cA; const char* nB = has_next ? (const char*)g.Bt + (size_t)nxt.pn * tstep : cB;
        for (int t = 0; t < nt; t += 2) {
            const bool last = (t == nt - 2);
            const char* a1 = cA + (size_t)(t + 1) * kstep;
            const char* a2 = last ? nA : cA + (size_t)(t + 2) * kstep; const char* b2 = last ? nB : cB + (size_t)(t + 2) * kstep;
            const char* a3 = a2 + kstep; const char* b3 = b2 + kstep;
            if (last && has_next) S.a_ready(nxt);
            if constexpr (SP2) {
            PG8_LDB(B0, 0, 0); PG8_LDB(B1, 0, 1); PG8_SCHED; PG8_LDA(At, 0, 0); PG8_STAGE(PG8_SA(1, 1), a1 + hstep, voffA);
            PG8_WAIT_V(8); PG8_WAIT_L(0); PG8_BAR; PG8_MMA(0, 0, At, B0); PG8_MMA(0, 1, At, B1); PG8_BAR; PG8_SCHED;
            PG8_LDA(At, 0, 1); PG8_STAGE(PG8_SB(0, 0), b2, voffB); PG8_STAGE(PG8_SB(0, 1), b2 + hstep, voffB); PG8_STAGE(PG8_SA(0, 0), a2, voffA);
            PG8_WAIT_V(8); PG8_WAIT_L(0); PG8_BAR; PG8_MMA(1, 0, At, B0); PG8_MMA(1, 1, At, B1); PG8_BAR; PG8_SCHED;
            PG8_LDB(B0, 1, 0); PG8_LDB(B1, 1, 1); PG8_SCHED; PG8_LDA(At, 1, 0); PG8_STAGE(PG8_SA(0, 1), a2 + hstep, voffA);
            PG8_WAIT_V(8); PG8_WAIT_L(0); PG8_BAR; PG8_MMA(0, 0, At, B0); PG8_MMA(0, 1, At, B1); PG8_BAR; PG8_SCHED;
            PG8_LDA(At, 1, 1); PG8_STAGE(PG8_SB(1, 0), b3, voffB); PG8_STAGE(PG8_SB(1, 1), b3 + hstep, voffB); PG8_STAGE(PG8_SA(1, 0), a3, voffA);
            PG8_WAIT_V(8); PG8_WAIT_L(0); PG8_BAR; PG8_MMA(1, 0, At, B0); PG8_MMA(1, 1, At, B1); PG8_BAR; PG8_SCHED;
            } else {
            PG8_LDB(B0, 0, 0); PG8_SCHED; PG8_LDA(At, 0, 0); PG8_STAGE(PG8_SA(1, 1), a1 + hstep, voffA);
            PG8_WAIT_L(8); PG8_BAR; PG8_WAIT_L(0); PG8_MMA(0, 0, At, B0); PG8_BAR; PG8_SCHED;
            PG8_LDB(B1, 0, 1); PG8_STAGE(PG8_SB(0, 0), b2, voffB);
            PG8_BAR; PG8_WAIT_L(0); PG8_MMA(0, 1, At, B1); PG8_BAR;
            PG8_LDA(At, 0, 1); PG8_STAGE(PG8_SA(0, 0), a2, voffA);
            PG8_BAR; PG8_WAIT_L(0); PG8_MMA(1, 0, At, B0); PG8_BAR; PG8_SCHED;
            PG8_STAGE(PG8_SB(0, 1), b2 + hstep, voffB);
            PG8_WAIT_V(6); PG8_BAR; PG8_MMA(1, 1, At, B1); PG8_BAR;
            PG8_LDB(B0, 1, 0); PG8_SCHED; PG8_LDA(At, 1, 0); PG8_STAGE(PG8_SA(0, 1), a2 + hstep, voffA);
            PG8_WAIT_L(8); PG8_BAR; PG8_WAIT_L(0); PG8_MMA(0, 0, At, B0); PG8_BAR; PG8_SCHED;
            PG8_LDB(B1, 1, 1); PG8_STAGE(PG8_SB(1, 0), b3, voffB);
            PG8_BAR; PG8_WAIT_L(0); PG8_MMA(0, 1, At, B1); PG8_BAR;
            PG8_LDA(At, 1, 1); PG8_STAGE(PG8_SA(1, 0), a3, voffA);
            PG8_BAR; PG8_WAIT_L(0); PG8_MMA(1, 0, At, B0); PG8_BAR; PG8_SCHED;
            PG8_STAGE(PG8_SB(1, 1), b3 + hstep, voffB);
            PG8_WAIT_V(6); PG8_BAR; PG8_MMA(1, 1, At, B1); PG8_BAR;
            }
        }
        if constexpr (ALIGN_EPI) { if (wr == 0) PG8_BAR; }
        E(acc, cur, wr, wc, fr, fq); S.done(cur);
        if (!has_next) break;
#pragma unroll
        for (int a = 0; a < 2; ++a)
#pragma unroll
            for (int b = 0; b < 2; ++b)
#pragma unroll
                for (int m = 0; m < 4; ++m)
#pragma unroll
                    for (int n = 0; n < 2; ++n) acc[a][b][m][n] = (f32x4){0.f, 0.f, 0.f, 0.f};
        cur = nxt; cA = nA; cB = nB; ++ui;
        if constexpr (ALIGN_EPI) { if (wr == 1) PG8_BAR; }
    }
    PG8_WAIT_V(0);
    if constexpr (!ALIGN_EPI) { if (wr == 0) PG8_BAR; }
    PG8_BAR;
#undef PG8_SA
#undef PG8_SB
#undef PG8_STAGE
#undef PG8_LDA
#undef PG8_LDB
#undef PG8_MMA
#undef PG8_WAIT_V
#undef PG8_WAIT_L
#undef PG8_BAR
#undef PG8_SCHED
}
}

#ifndef PG8_SP2
#define PG8_SP2 true
#endif
#ifndef PG8_ALIGN
#define PG8_ALIGN true
#endif

constexpr int NWAVES = 8;
constexpr int D = 1024, SEQ = 2048, NB = 8, MP = NB * SEQ  , MSMP = 128  , MV = MP + MSMP  , MR = 16640  ;
constexpr int FF = 4096, DPLE = 256, NCH = SEQ / 64  ;
constexpr int PS = 3840;
constexpr int C_MQ = 0, C_MK = 512, C_MV = 1024, C_MO = 1536, C_GQ = 2048, C_GK = 2304, C_GV = 2560, C_GR = 3072, C_SM = 3584;
constexpr float EPS = 1e-6f;
constexpr size_t O_YP = 0, O_YS = 16777216, O_CP = 16908288, O_NP = 17432576, O_MP = 17436672, O_CVP = 17436704, O_SP = 17461280,
                 O_CS = 17723424, O_NS = 26112032, O_MS = 26177568, O_CVS = 26178080, O_SS = 26571296;
constexpr size_t MiB = 1u << 20;
constexpr size_t WS_CTL = 0, CTL_ZERO_BYTES = 1 * MiB;
constexpr size_t CTL_BAR_B = 16384, CTL_SS1_B = 262144, CTL_SS2_B = 393216, CTL_SS3_B = 524288;
constexpr size_t WS_WIN = 1 * MiB, WS_WOUT = 9 * MiB, WS_W1 = 11 * MiB, WS_W2 = 19 * MiB, WS_WPG = 27 * MiB, WS_WPLE = 29 * MiB;
constexpr size_t WS_PB = 30 * MiB, WS_NC = 39 * MiB, WS_MC = WS_NC + 512 * 1024, WS_R1 = 40 * MiB, WS_R2 = 73 * MiB, WS_CSM = 195 * MiB, WS_CSG = 227 * MiB;
constexpr size_t WS_X1B = WS_R2, WS_U = 106 * MiB, WS_PP = 106 * MiB, WS_END = 243 * MiB;
static_assert(WS_R2 + (size_t)MR * PS * 2 <= WS_CSM && WS_R1 + (size_t)MR * D * 2 <= WS_R2 && WS_U + (size_t)MR * FF * 2 <= WS_END && WS_X1B + (size_t)MR * D * 2 <= WS_U && WS_PB + (size_t)MR * DPLE * 2 <= WS_NC, "ws map");
constexpr int LDS_BYTES = 147456, MISC_OFF = LDS_BYTES - 256;

#define GAS __attribute__((address_space(1)))
#define LAS __attribute__((address_space(3)))
typedef unsigned short bf16;
typedef unsigned v4u __attribute__((ext_vector_type(4)));
typedef unsigned v2u __attribute__((ext_vector_type(2)));
typedef float f32x4 __attribute__((ext_vector_type(4)));
typedef short bf16x8 __attribute__((ext_vector_type(8)));
typedef GAS unsigned gu32;
#define RLX_AGENT __ATOMIC_RELAXED, __HIP_MEMORY_SCOPE_AGENT
#define LDS_WAIT() asm volatile("s_waitcnt lgkmcnt(0)" ::: "memory")
#define VM_WAIT() asm volatile("s_waitcnt vmcnt(0)" ::: "memory")
__device__ __forceinline__ unsigned f2bf(float f) { unsigned u = __builtin_bit_cast(unsigned, f); return (u + 0x7fffu + ((u >> 16) & 1u)) >> 16; }
__device__ __forceinline__ unsigned pk2(float lo, float hi) { return f2bf(lo) | (f2bf(hi) << 16); }
__device__ __forceinline__ float bf2f(unsigned b) { return __builtin_bit_cast(float, b << 16); }
__device__ __forceinline__ float bflo(unsigned w) { return __builtin_bit_cast(float, w << 16); }
__device__ __forceinline__ float bfhi(unsigned w) { return __builtin_bit_cast(float, w & 0xffff0000u); }
__device__ __forceinline__ float logsig(float x) { return fminf(x, 0.f) - __logf(1.f + __expf(-fabsf(x))); }
__device__ __forceinline__ float sigmoidf(float x) { return 1.f / (1.f + __expf(-x)); }

#define XB_TMO      128
#define XB_XCNT(j)  (256  + 64 * (j))
#define XB_XSUB(j)  (1280 + 64 * (j))
#define XB_XGEN(j)  (2304 + 64 * (j))
#define XB_TOP      3328
#define XB_TOPGEN   3392
#define XCD_BAR_WORDS 3456
#define XB_SPIN_CAP (1u << 22)
__device__ __forceinline__ unsigned xb_ld(unsigned* p)              { return __hip_atomic_load(p, __ATOMIC_RELAXED, __HIP_MEMORY_SCOPE_AGENT); }
__device__ __forceinline__ unsigned xb_add(unsigned* p, unsigned v) { return __hip_atomic_fetch_add(p, v, __ATOMIC_RELAXED, __HIP_MEMORY_SCOPE_AGENT); }
__device__ __forceinline__ unsigned xb_xcc_id() { return (unsigned)__builtin_amdgcn_s_getreg((3 << 11) | 20) & 0xFu; }
#define XB_SPIN(cond, bar) do { unsigned _sp = 0; while (cond) { __builtin_amdgcn_s_sleep(1); \
    if ((++_sp & 255u) == 0u) { if (xb_ld(&(bar)[XB_TMO])) break; if (_sp > XB_SPIN_CAP) { atomicAdd(&(bar)[XB_TMO], 1u); break; } } } } while (0)
struct XcdBarrier { unsigned* bar; unsigned x; volatile LAS unsigned* st; };
__device__ __forceinline__ XcdBarrier xcd_barrier_post(unsigned* bar, volatile LAS unsigned* st) {
    XcdBarrier b; b.bar = bar; b.x = xb_xcc_id(); b.st = st;
    if (threadIdx.x == 0) (void)xb_add(&bar[XB_XCNT(b.x)], 1u);
    return b;
}
__device__ __forceinline__ void xcd_barrier_complete(unsigned* bar, unsigned x, unsigned& nloc, unsigned& nx) {
    const unsigned G = gridDim.x * gridDim.y * gridDim.z;
    unsigned sum, cnt, mine, sp = 0u;
    for (;;) {
        sum = 0u; cnt = 0u; mine = 0u;
#pragma unroll
        for (unsigned j = 0; j < 16; ++j) { const unsigned c = xb_ld(&bar[XB_XCNT(j)]); sum += c; cnt += (c > 0u) ? 1u : 0u; mine = (j == x) ? c : mine; }
        if (sum == G) break;
        __builtin_amdgcn_s_sleep(1);
        if ((++sp & 255u) == 0u) { if (xb_ld(&bar[XB_TMO])) break; if (sp > XB_SPIN_CAP) { atomicAdd(&bar[XB_TMO], 1u); break; } }
    }
    nloc = mine > 0u ? mine : 1u; nx = cnt > 0u ? cnt : 1u;
}
__device__ __forceinline__ void xcd_barrier(const XcdBarrier& b) {
    asm volatile("s_waitcnt vmcnt(0)" ::: "memory");
    __syncthreads();
    if (threadIdx.x == 0) {
        unsigned* bar = b.bar;
        __builtin_amdgcn_s_waitcnt(0);
        unsigned nloc = b.st[0], nx = b.st[1];
        if (nloc == 0u) { xcd_barrier_complete(bar, b.x, nloc, nx); b.st[0] = nloc; b.st[1] = nx; }
        const unsigned old = xb_add(&bar[XB_XSUB(b.x)], 1u);
        const unsigned gen = old / nloc;
        if (old + 1u == (gen + 1u) * nloc) {
            __builtin_amdgcn_fence(__ATOMIC_RELEASE, "agent");
            asm volatile("s_waitcnt vmcnt(0)" ::: "memory");
            const unsigned og = xb_add(&bar[XB_TOP], 1u);
            const unsigned tg = og / nx;
            if (og + 1u == (tg + 1u) * nx) xb_add(&bar[XB_TOPGEN], 1u);
            else XB_SPIN(xb_ld(&bar[XB_TOPGEN]) == tg, bar);
            __builtin_amdgcn_fence(__ATOMIC_ACQUIRE, "agent");
            xb_add(&bar[XB_XGEN(b.x)], 1u);
            asm volatile("s_waitcnt vmcnt(0)" ::: "memory");
        } else {
            XB_SPIN(xb_ld(&bar[XB_XGEN(b.x)]) == gen, bar);
            __builtin_amdgcn_fence(__ATOMIC_ACQUIRE, "agent");
            asm volatile("s_waitcnt vmcnt(0)" ::: "memory");
        }
    }
    __syncthreads();
}

struct Args { const float* in[26]; float* out; unsigned char* ws; int ph_lo, ph_hi, li, pad; };
typedef const Args __attribute__((address_space(4))) CArgs;
struct Frame {
    LAS unsigned char* lds;
    char* ldsg;
    int G;
    CArgs* a;
};
#define F_TID ((int)threadIdx.x)
#define F_LANE ((int)(threadIdx.x & 63))
#define F_WAVE (__builtin_amdgcn_readfirstlane((int)(threadIdx.x >> 6)))
#define IN_F(k) (F.a->in[k])
#define X_P IN_F(0)
#define X_S IN_F(1)
#define P_P IN_F(2)
#define P_S IN_F(3)
#define ST_C IN_F(4)
#define ST_N IN_F(5)
#define ST_M IN_F(6)
#define ST_CONV IN_F(7)
#define ST_S IN_F(8)
#define W_IN IN_F(9)
#define CONV_W IN_F(10)
#define CONV_B IN_F(11)
#define B_GATE CONSTF(IN_F(12))
#define W_A2 CONSTF(IN_F(13))
#define B_A CONSTF(IN_F(14))
#define G_MHEAD IN_F(15)
#define G_GHEAD IN_F(16)
#define W_OUT IN_F(17)
#define G_MIX IN_F(18)
#define G_MLP IN_F(19)
#define W1 IN_F(20)
#define W2 IN_F(21)
#define G_PLE IN_F(22)
#define W_PLE IN_F(23)
#define W_PG IN_F(24)
#define G_FINAL IN_F(25)
typedef const float __attribute__((address_space(4))) cfloat;
#define CONSTF(p) ((cfloat*)(unsigned long long)(p))
#define OUTP (F.a->out)
#define WSB (F.a->ws)
#define WIN_T ((bf16*)(WSB + WS_WIN))
#define WOUT_T ((bf16*)(WSB + WS_WOUT))
#define W1_T ((bf16*)(WSB + WS_W1))
#define W2_T ((bf16*)(WSB + WS_W2))
#define WPG_T ((bf16*)(WSB + WS_WPG))
#define WPLE_T ((bf16*)(WSB + WS_WPLE))
#define PBUF ((bf16*)(WSB + WS_PB))
#define R1B ((bf16*)(WSB + WS_R1))
#define PROJ ((bf16*)(WSB + WS_R2))
#define X1B ((bf16*)(WSB + WS_X1B))
#define UBUF ((bf16*)(WSB + WS_U))
#define CSM ((bf16*)(WSB + WS_CSM))
#define CSG ((bf16*)(WSB + WS_CSG))
#define NCS ((float*)(WSB + WS_NC))
#define MCS ((float*)(WSB + WS_MC))
#define SS1 ((float*)(WSB + CTL_SS1_B))
#define SS2 ((float*)(WSB + CTL_SS2_B))
#define SS3 ((float*)(WSB + CTL_SS3_B))
#define PPB ((bf16*)(WSB + WS_PP))

__device__ __forceinline__ float wave_sum(float v) {
#pragma unroll
    for (int o = 1; o < 64; o <<= 1) v += __shfl_xor(v, o);
    return v;
}
__device__ __forceinline__ float wave_max(float v) {
#pragma unroll
    for (int o = 1; o < 64; o <<= 1) v = fmaxf(v, __shfl_xor(v, o));
    return v;
}
template <int CTRL, int ROWMASK> __device__ __forceinline__ float dpp_f(float idv, float v) {
    return __builtin_bit_cast(float, __builtin_amdgcn_update_dpp(__builtin_bit_cast(int, idv), __builtin_bit_cast(int, v), CTRL, ROWMASK, 0xf, false));
}
__device__ __forceinline__ float wave_scan_sum(float v, int) {
    v += dpp_f<0x111, 0xf>(0.f, v); v += dpp_f<0x112, 0xf>(0.f, v); v += dpp_f<0x114, 0xf>(0.f, v); v += dpp_f<0x118, 0xf>(0.f, v);
    v += dpp_f<0x142, 0xa>(0.f, v); v += dpp_f<0x143, 0xc>(0.f, v);
    return v;
}
__device__ __forceinline__ float wave_scan_max(float v, int) {
    const float ninf = -__builtin_inff();
    v = fmaxf(v, dpp_f<0x111, 0xf>(ninf, v)); v = fmaxf(v, dpp_f<0x112, 0xf>(ninf, v)); v = fmaxf(v, dpp_f<0x114, 0xf>(ninf, v)); v = fmaxf(v, dpp_f<0x118, 0xf>(ninf, v));
    v = fmaxf(v, dpp_f<0x142, 0xa>(ninf, v)); v = fmaxf(v, dpp_f<0x143, 0xc>(ninf, v));
    return v;
}

__device__ __forceinline__ int win_src_col(int np) {
    if (np < 2048) return np;
    if (np < 3584) return np + 8;
    const int j = np - 3584;
    if (j < 8) return 2048 + j;
    if (j < 24) return 3592 + (j - 8);
    return -1;
}
template <int MODE>
__device__ __forceinline__ void p0_transpose_item(const float* W, int K, int N, bf16* WT, const float* gain, LAS float* scr, int item, int nblk, int lane) {
    const int kb = item / nblk, nb = item % nblk, k0 = 64 * kb, n0 = 32 * nb;
    int src = n0 + (lane & 31); float cs = 1.f;
    if (MODE == 1) { const int np = n0 + (lane & 31); src = win_src_col(np); if (np >= C_GQ && np < C_GK) cs = 0.125f; }
#pragma unroll 8
    for (int i = 0; i < 32; ++i) { const int kk = 2 * i + (lane >> 5); float v = 0.f; if (src >= 0) v = W[(size_t)(k0 + kk) * N + src] * cs; if (gain) v *= gain[k0 + kk]; scr[kk * 33 + (lane & 31)] = v; }
    LDS_WAIT(); asm volatile("" ::: "memory");
    const int c = lane & 7;
#pragma unroll
    for (int j = 0; j < 4; ++j) { const int n = (lane >> 3) + 8 * j; const LAS float* s = scr + (8 * c) * 33 + n;
        v4u o; o.x = pk2(s[0 * 33], s[1 * 33]); o.y = pk2(s[2 * 33], s[3 * 33]); o.z = pk2(s[4 * 33], s[5 * 33]); o.w = pk2(s[6 * 33], s[7 * 33]);
        *(GAS v4u*)(WT + (size_t)(n0 + n) * K + k0 + 8 * c) = o; }
    LDS_WAIT(); asm volatile("" ::: "memory");
}
__device__ __forceinline__ void p0_prologue(Frame& F) {
    LAS float* scr = (LAS float*)(F.lds + F_WAVE * 16384);
    const int gw = blockIdx.x * NWAVES + F_WAVE, NGW = F.G * NWAVES;
    constexpr int NB_IN = PS / 32, NB_D = D / 32, NB_FF = FF / 32;
    constexpr int I_IN = (D / 64) * NB_IN, I_OUT = (D / 64) * NB_D, I_1 = (D / 64) * NB_FF, I_2 = (FF / 64) * NB_D, I_PG = I_OUT, I_PLE = (DPLE / 64) * NB_D;
    constexpr int NITEMS = I_IN + I_OUT + I_1 + I_2 + I_PG + I_PLE;
    for (int it = gw; it < NITEMS; it += NGW) {
        int r = it;
        if (r < I_IN) { p0_transpose_item<1>(W_IN, D, 3608, WIN_T, G_MIX, scr, r, NB_IN, F_LANE); continue; } r -= I_IN;
        if (r < I_OUT) { p0_transpose_item<0>(W_OUT, D, D, WOUT_T, nullptr, scr, r, NB_D, F_LANE); continue; } r -= I_OUT;
        if (r < I_1) { p0_transpose_item<0>(W1, D, FF, W1_T, G_MLP, scr, r, NB_FF, F_LANE); continue; } r -= I_1;
        if (r < I_2) { p0_transpose_item<0>(W2, FF, D, W2_T, nullptr, scr, r, NB_D, F_LANE); continue; } r -= I_2;
        if (r < I_PG) { p0_transpose_item<0>(W_PG, D, D, WPG_T, G_PLE, scr, r, NB_D, F_LANE); continue; } r -= I_PG;
        p0_transpose_item<0>(W_PLE, DPLE, D, WPLE_T, nullptr, scr, r, NB_D, F_LANE);
    }
    for (int m = gw; m < MV; m += NGW) {
        const float* xrow = m < MP ? X_P + (size_t)m * D : X_S + (size_t)(m - MP) * D;
        const GAS f32x4* xr = (const GAS f32x4*)xrow + F_LANE;
        f32x4 v[4]; float s = 0.f;
#pragma unroll
        for (int j = 0; j < 4; ++j) { v[j] = xr[64 * j]; s += (v[j].x * v[j].x + v[j].y * v[j].y) + (v[j].z * v[j].z + v[j].w * v[j].w); }
        const float r = 1.f / sqrtf(wave_sum(s) * (1.f / D) + EPS);
        GAS unsigned long long* o8 = (GAS unsigned long long*)(R1B + (size_t)m * D) + F_LANE;
#pragma unroll
        for (int j = 0; j < 4; ++j) o8[64 * j] = (unsigned long long)pk2(v[j].x * r, v[j].y * r) | ((unsigned long long)pk2(v[j].z * r, v[j].w * r) << 32);
        const float* prow = m < MP ? P_P + (size_t)m * DPLE : P_S + (size_t)(m - MP) * DPLE;
        const f32x4 pv = ((const GAS f32x4*)prow)[F_LANE];
        ((GAS unsigned long long*)(PBUF + (size_t)m * DPLE))[F_LANE] = (unsigned long long)pk2(pv.x, pv.y) | ((unsigned long long)pk2(pv.z, pv.w) << 32);
    }
}

struct EpiProj {
    static constexpr bool PERM = true;
    bf16* O; int ldc;
    __device__ __forceinline__ void operator()(const f32x4 (&acc)[2][2][4][2], const pg8::Unit& u, int wr, int wc, int fr, int fq) const {
        const int row0 = u.pm * 256 + wr * 64 + fr, col0 = u.pn * 256 + wc * 32 + 8 * fq;
#pragma unroll
        for (int ai = 0; ai < 2; ++ai)
#pragma unroll
            for (int m = 0; m < 4; ++m) { bf16* rowp = O + (size_t)(row0 + ai * 128 + m * 16) * ldc + col0;
#pragma unroll
                for (int bj = 0; bj < 2; ++bj) { const f32x4 v0 = acc[ai][bj][m][0], v1 = acc[ai][bj][m][1];
                    v4u w; w.x = pg8::cvt_pk_bf16(v0[0], v0[1]); w.y = pg8::cvt_pk_bf16(v0[2], v0[3]); w.z = pg8::cvt_pk_bf16(v1[0], v1[1]); w.w = pg8::cvt_pk_bf16(v1[2], v1[3]);
                    *(v4u*)(rowp + bj * 128) = w; } }
    }
};
struct EpiRes {
    static constexpr bool PERM = true;
    const float* res_p; const float* res_s; float* out; bf16* ob; float* ss; bool dry;
    __device__ __forceinline__ void operator()(const f32x4 (&acc)[2][2][4][2], const pg8::Unit& u, int wr, int wc, int fr, int fq) const {
        const int row0 = u.pm * 256 + wr * 64 + fr, col0 = u.pn * 256 + wc * 32 + 8 * fq;
#pragma unroll
        for (int ai = 0; ai < 2; ++ai)
#pragma unroll
            for (int m = 0; m < 4; ++m) { const int row = row0 + ai * 128 + m * 16; const bool valid = row < MV;
                const float* rp = (row < MP ? res_p + (size_t)row * D : res_s + (size_t)(row - MP) * D) + col0;
                float s = 0.f;
#pragma unroll
                for (int bj = 0; bj < 2; ++bj) {
                    f32x4 r0 = (f32x4){0.f, 0.f, 0.f, 0.f}, r1 = r0;
                    if (valid) { r0 = *(const f32x4*)(rp + bj * 128); r1 = *(const f32x4*)(rp + bj * 128 + 4); }
                    const f32x4 v0 = acc[ai][bj][m][0] + r0, v1 = acc[ai][bj][m][1] + r1;
                    if (valid && !dry) { float* op = out + (size_t)row * D + col0 + bj * 128; *(f32x4*)op = v0; *(f32x4*)(op + 4) = v1; }
                    v4u w; w.x = pg8::cvt_pk_bf16(v0[0], v0[1]); w.y = pg8::cvt_pk_bf16(v0[2], v0[3]); w.z = pg8::cvt_pk_bf16(v1[0], v1[1]); w.w = pg8::cvt_pk_bf16(v1[2], v1[3]);
                    *(v4u*)(ob + (size_t)row * D + col0 + bj * 128) = w;
                    s += (v0[0] * v0[0] + v0[1] * v0[1]) + (v0[2] * v0[2] + v0[3] * v0[3]) + (v1[0] * v1[0] + v1[1] * v1[1]) + (v1[2] * v1[2] + v1[3] * v1[3]);
                }
                s += __shfl_xor(s, 16); s += __shfl_xor(s, 32);
                if (fq == 0) atomicAdd(ss + row, s);
                asm volatile("" ::: "memory"); }
    }
};
struct EpiU {
    static constexpr bool PERM = true;
    bf16* O; const float* ss;
    __device__ __forceinline__ void operator()(const f32x4 (&acc)[2][2][4][2], const pg8::Unit& u, int wr, int wc, int fr, int fq) const {
        const int row0 = u.pm * 256 + wr * 64 + fr, col0 = u.pn * 256 + wc * 32 + 8 * fq;
#pragma unroll
        for (int ai = 0; ai < 2; ++ai)
#pragma unroll
            for (int m = 0; m < 4; ++m) { const int row = row0 + ai * 128 + m * 16; const float r = 1.f / sqrtf(ss[row] * (1.f / D) + EPS);
                bf16* rowp = O + (size_t)row * FF + col0;
#pragma unroll
                for (int bj = 0; bj < 2; ++bj) { f32x4 v0 = acc[ai][bj][m][0] * r, v1 = acc[ai][bj][m][1] * r;
#pragma unroll
                    for (int j = 0; j < 4; ++j) { const float a = fmaxf(v0[j], 0.f), b = fmaxf(v1[j], 0.f); v0[j] = a * a; v1[j] = b * b; }
                    v4u w; w.x = pg8::cvt_pk_bf16(v0[0], v0[1]); w.y = pg8::cvt_pk_bf16(v0[2], v0[3]); w.z = pg8::cvt_pk_bf16(v1[0], v1[1]); w.w = pg8::cvt_pk_bf16(v1[2], v1[3]);
                    *(v4u*)(rowp + bj * 128) = w; } }
    }
};
struct EpiPle {
    static constexpr bool PERM = true;
    float* out; const bf16* Pp; const float* ss2; float* ss3; bool dry;
    __device__ __forceinline__ void operator()(const f32x4 (&acc)[2][2][4][2], const pg8::Unit& u, int wr, int wc, int fr, int fq) const {
        const int row0 = u.pm * 256 + wr * 64 + fr, col0 = u.pn * 256 + wc * 32 + 8 * fq;
#pragma unroll
        for (int ai = 0; ai < 2; ++ai)
#pragma unroll
            for (int m = 0; m < 4; ++m) { const int row = row0 + ai * 128 + m * 16; const bool valid = row < MV;
                const float r = 1.f / sqrtf(ss2[row] * (1.f / D) + EPS);
                float s = 0.f;
#pragma unroll
                for (int bj = 0; bj < 2; ++bj) {
                    const size_t off = (size_t)row * D + col0 + bj * 128;
                    const v4u pw = *(const v4u*)(Pp + off);
#pragma unroll
                    for (int n = 0; n < 2; ++n) {
                        f32x4 x0 = (f32x4){0.f, 0.f, 0.f, 0.f};
                        if (valid) x0 = *(const f32x4*)(out + off + 4 * n);
                        const float p0[4] = {bflo(pw[2 * n]), bfhi(pw[2 * n]), bflo(pw[2 * n + 1]), bfhi(pw[2 * n + 1])};
                        f32x4 v0;
#pragma unroll
                        for (int j = 0; j < 4; ++j) v0[j] = x0[j] + p0[j] * sigmoidf(acc[ai][bj][m][n][j] * r);
                        if (valid && !dry) *(f32x4*)(out + off + 4 * n) = v0;
                        s += (v0[0] * v0[0] + v0[1] * v0[1]) + (v0[2] * v0[2] + v0[3] * v0[3]);
                    }
                    asm volatile("" ::: "memory");
                }
                s += __shfl_xor(s, 16); s += __shfl_xor(s, 32);
                if (fq == 0) atomicAdd(ss3 + row, s);
                asm volatile("" ::: "memory"); }
    }
};

__device__ __forceinline__ f32x4 mfma16(bf16x8 a, bf16x8 b, f32x4 c) { return __builtin_amdgcn_mfma_f32_16x16x32_bf16(a, b, c, 0, 0, 0); }
__device__ __forceinline__ bf16x8 lds_frag(const char* p) { return *(const bf16x8*)p; }
constexpr int TS = 144;
constexpr int QS_P = 272;
constexpr float KSCALE = 0.08838834764831845f;

__device__ __forceinline__ void chain_mlstm(Frame& F, int b, int h, int sl) {
    char* L = F.ldsg;
    constexpr int KT_B = 64 * TS, VT_B = 128 * TS, NP_B = 16 * 64 * 4, BUF_B = KT_B + VT_B + NP_B;
    float* WK = (float*)(L + 2 * BUF_B); float* PM = WK + 2048; float* BLs = PM + 32; float* MX = BLs + 32; float* MCc = MX + 32; float* CSs = MCc + 40;
    const int tid = F_TID, lane = F_LANE, w = F_WAVE, r = lane & 15, g = lane >> 4;
    const int bh = b * 4 + h; const size_t rowb = (size_t)b * SEQ;
    const bf16* P = PROJ;
    { const float bgi = B_GATE[h], bgf = B_GATE[4 + h];
      for (int c = w; c < NCH; c += 8) { const size_t row = rowb + c * 64 + lane;
          const float ig = bf2f(P[row * PS + C_SM + h]) + bgi, lf = logsig(bf2f(P[row * PS + C_SM + 4 + h]) + bgf);
          const float bc = wave_scan_sum(lf, lane), a = ig - bc; const float pmax = wave_max(a);
          WK[c * 64 + lane] = a; if (lane == 63) { PM[c] = pmax; BLs[c] = bc; } } }
    __syncthreads();
    if (tid == 0) { float m = 0.f; for (int c = 0; c < NCH; ++c) { const float M = fmaxf(m, PM[c]); MCc[c] = m; MX[c] = M; CSs[c] = __expf(m - M); m = BLs[c] + M; } MCc[32] = m; }
    __syncthreads();
    for (int i = tid; i < SEQ; i += 512) WK[i] = __expf(WK[i] - MX[i >> 6]);
    __syncthreads();
    const int dpk = tid & 31, tg = tid >> 5, dpv = tid & 63, sg = tid >> 6;
    const int chk = 512 + h * 128 + 64 * sl + 2 * dpk;
    float cw[4][2], cb[2];
#pragma unroll
    for (int j = 0; j < 4; ++j) { cw[j][0] = CONV_W[j * 1024 + chk]; cw[j][1] = CONV_W[j * 1024 + chk + 1]; }
    cb[0] = CONV_B[chk]; cb[1] = CONV_B[chk + 1];
    const int dt = w & 3, eb = 4 * (w >> 2);
    f32x4 acc[4];
#pragma unroll
    for (int i = 0; i < 4; ++i) acc[i] = (f32x4){0.f, 0.f, 0.f, 0.f};
    float nst = 0.f;
    unsigned kr[7], vr[8];
#pragma unroll
    for (int i = 0; i < 7; ++i) { const int t = 4 * tg - 3 + i; kr[i] = (t >= 0) ? *(const unsigned*)(P + (rowb + t) * PS + C_MK + h * 128 + 64 * sl + 2 * dpk) : 0u; }
#pragma unroll
    for (int i = 0; i < 8; ++i) vr[i] = *(const unsigned*)(P + (rowb + 8 * sg + i) * PS + C_MV + h * 128 + 2 * dpv);
    for (int c = 0; c < NCH; ++c) {
        char* KT = L + (c & 1) * BUF_B; char* VT = KT + KT_B; float* NP = (float*)(VT + VT_B);
        const int t0 = c * 64;
        unsigned krn[7], vrn[8];
        if (c + 1 < NCH) {
#pragma unroll
            for (int i = 0; i < 7; ++i) krn[i] = *(const unsigned*)(P + (rowb + t0 + 64 + 4 * tg - 3 + i) * PS + C_MK + h * 128 + 64 * sl + 2 * dpk);
#pragma unroll
            for (int i = 0; i < 8; ++i) vrn[i] = *(const unsigned*)(P + (rowb + t0 + 64 + 8 * sg + i) * PS + C_MV + h * 128 + 2 * dpv);
        }
        { bf16* cst = CSM + (size_t)(bh * NCH + c) * 16384;
#pragma unroll
          for (int i = 0; i < 4; ++i) { const int e = 16 * (eb + i) + r, d = 64 * sl + 16 * dt + 4 * g;
              *(v2u*)(cst + e * 128 + d) = (v2u){pg8::cvt_pk_bf16(acc[i][0], acc[i][1]), pg8::cvt_pk_bf16(acc[i][2], acc[i][3])}; }
          if (tid < 64) NCS[(size_t)(bh * NCH + c) * 128 + 64 * sl + tid] = nst;
          if (tid == 0 && sl == 0) MCS[bh * NCH + c] = MCc[c]; }
        { const f32x4 wk4 = *(const f32x4*)(WK + t0 + 4 * tg);
          float y[4][2]; float ns0 = 0.f, ns1 = 0.f;
#pragma unroll
          for (int i = 0; i < 4; ++i) { float a0 = cb[0], a1 = cb[1];
#pragma unroll
              for (int j = 0; j < 4; ++j) { a0 += cw[j][0] * bflo(kr[i + j]); a1 += cw[j][1] * bfhi(kr[i + j]); }
              const float wki = wk4[i] * KSCALE;
              y[i][0] = a0 * sigmoidf(a0) * wki; y[i][1] = a1 * sigmoidf(a1) * wki; ns0 += y[i][0]; ns1 += y[i][1]; }
          *(v2u*)(KT + (2 * dpk) * TS + 8 * tg) = (v2u){pk2(y[0][0], y[1][0]), pk2(y[2][0], y[3][0])};
          *(v2u*)(KT + (2 * dpk + 1) * TS + 8 * tg) = (v2u){pk2(y[0][1], y[1][1]), pk2(y[2][1], y[3][1])};
          NP[tg * 64 + 2 * dpk] = ns0; NP[tg * 64 + 2 * dpk + 1] = ns1; }
        { unsigned v0p[4], v1p[4];
#pragma unroll
          for (int i = 0; i < 8; i += 2) { v0p[i >> 1] = (vr[i] & 0xffffu) | (vr[i + 1] << 16); v1p[i >> 1] = (vr[i] >> 16) | (vr[i + 1] & 0xffff0000u); }
          *(v4u*)(VT + (2 * dpv) * TS + 16 * sg) = (v4u){v0p[0], v0p[1], v0p[2], v0p[3]};
          *(v4u*)(VT + (2 * dpv + 1) * TS + 16 * sg) = (v4u){v1p[0], v1p[1], v1p[2], v1p[3]}; }
        __syncthreads();
        const float cs = CSs[c];
        if (tid < 64) { float s = 0.f;
#pragma unroll
            for (int q = 0; q < 16; ++q) s += NP[q * 64 + tid];
            nst = cs * nst + s; }
#pragma unroll
        for (int i = 0; i < 4; ++i) acc[i] = acc[i] * cs;
#pragma unroll
        for (int kk = 0; kk < 2; ++kk) {
            const bf16x8 af = lds_frag(KT + (16 * dt + r) * TS + (32 * kk + 8 * g) * 2);
#pragma unroll
            for (int i = 0; i < 4; ++i) acc[i] = mfma16(af, lds_frag(VT + (16 * (eb + i) + r) * TS + (32 * kk + 8 * g) * 2), acc[i]);
        }
#pragma unroll
        for (int i = 0; i < 7; ++i) kr[i] = krn[i];
#pragma unroll
        for (int i = 0; i < 8; ++i) vr[i] = vrn[i];
    }
    { float* Co = OUTP + O_CP + (size_t)bh * 16384;
#pragma unroll
      for (int i = 0; i < 4; ++i)
#pragma unroll
          for (int j = 0; j < 4; ++j) Co[(64 * sl + 16 * dt + 4 * g + j) * 128 + 16 * (eb + i) + r] = acc[i][j];
      if (tid < 64) OUTP[O_NP + (size_t)bh * 128 + 64 * sl + tid] = nst;
      if (tid == 0 && sl == 0) OUTP[O_MP + bh] = MCc[32]; }
    __syncthreads();
}

__device__ __forceinline__ void chain_gla(Frame& F, int b, int hg, int sl) {
    char* L = F.ldsg;
    constexpr int KT_B = 32 * TS, VT_B = 128 * TS, EB_B = 32 * 4, BUF_B = KT_B + VT_B + EB_B;
    const int tid = F_TID, lane = F_LANE, w = F_WAVE, r = lane & 15, g = lane >> 4;
    const int bh = b * 4 + hg; const size_t rowb = (size_t)b * SEQ;
    const bf16* P = PROJ;
    const int dpv = tid & 63, sg = tid >> 6;
    const int dt = w & 1, eb = 2 * (w >> 1);
    const int ch0 = hg * 64 + 32 * sl + 4 * w;
    f32x4 acc[2];
    acc[0] = (f32x4){0.f, 0.f, 0.f, 0.f}; acc[1] = acc[0];
    v4u ga0, ga1; v2u k4; unsigned vr[8];
    { const size_t row = rowb + lane; ga0 = *(const v4u*)(P + row * PS + C_SM + 8); ga1 = *(const v4u*)(P + row * PS + C_SM + 16); k4 = *(const v2u*)(P + row * PS + C_GK + ch0); }
#pragma unroll
    for (int i = 0; i < 8; ++i) vr[i] = *(const unsigned*)(P + (rowb + 8 * sg + i) * PS + C_GV + hg * 128 + 2 * dpv);
    for (int c = 0; c < NCH; ++c) {
        char* KT = L + (c & 1) * BUF_B; char* VT = KT + KT_B; float* EBL = (float*)(VT + VT_B);
        const int t0 = c * 64;
        v4u ga0n, ga1n; v2u k4n; unsigned vrn[8];
        if (c + 1 < NCH) {
            const size_t row = rowb + t0 + 64 + lane; ga0n = *(const v4u*)(P + row * PS + C_SM + 8); ga1n = *(const v4u*)(P + row * PS + C_SM + 16); k4n = *(const v2u*)(P + row * PS + C_GK + ch0);
#pragma unroll
            for (int i = 0; i < 8; ++i) vrn[i] = *(const unsigned*)(P + (rowb + t0 + 64 + 8 * sg + i) * PS + C_GV + hg * 128 + 2 * dpv);
        }
        { bf16* cst = CSG + (size_t)(bh * NCH + c) * 8192;
#pragma unroll
          for (int i = 0; i < 2; ++i) { const int e = 16 * (eb + i) + r, d = 32 * sl + 16 * dt + 4 * g;
              *(v2u*)(cst + e * 64 + d) = (v2u){pg8::cvt_pk_bf16(acc[i][0], acc[i][1]), pg8::cvt_pk_bf16(acc[i][2], acc[i][3])}; } }
        { float ga[16];
#pragma unroll
          for (int i = 0; i < 4; ++i) { ga[2 * i] = bflo(ga0[i]); ga[2 * i + 1] = bfhi(ga0[i]); ga[8 + 2 * i] = bflo(ga1[i]); ga[8 + 2 * i + 1] = bfhi(ga1[i]); }
#pragma unroll
          for (int dd = 0; dd < 4; ++dd) { const int col = ch0 + dd;
              float z = B_A[col];
#pragma unroll
              for (int q = 0; q < 16; ++q) z += ga[q] * W_A2[q * 256 + col];
              const float bc = wave_scan_sum(logsig(z) * (1.f / 16.f), lane); const float bLd = __shfl(bc, 63);
              const float kv = (dd & 1) ? bfhi(k4[dd >> 1]) : bflo(k4[dd >> 1]);
              *(bf16*)(KT + (4 * w + dd) * TS + 2 * lane) = (bf16)f2bf(kv * __expf(bLd - bc));
              if (lane == 0) EBL[4 * w + dd] = __expf(bLd); } }
        { unsigned v0p[4], v1p[4];
#pragma unroll
          for (int i = 0; i < 8; i += 2) { v0p[i >> 1] = (vr[i] & 0xffffu) | (vr[i + 1] << 16); v1p[i >> 1] = (vr[i] >> 16) | (vr[i + 1] & 0xffff0000u); }
          *(v4u*)(VT + (2 * dpv) * TS + 16 * sg) = (v4u){v0p[0], v0p[1], v0p[2], v0p[3]};
          *(v4u*)(VT + (2 * dpv + 1) * TS + 16 * sg) = (v4u){v1p[0], v1p[1], v1p[2], v1p[3]}; }
        __syncthreads();
        { const f32x4 eb4 = *(const f32x4*)(EBL + 16 * dt + 4 * g); acc[0] = acc[0] * eb4; acc[1] = acc[1] * eb4; }
#pragma unroll
        for (int kk = 0; kk < 2; ++kk) {
            const bf16x8 af = lds_frag(KT + (16 * dt + r) * TS + (32 * kk + 8 * g) * 2);
#pragma unroll
            for (int i = 0; i < 2; ++i) acc[i] = mfma16(af, lds_frag(VT + (16 * (eb + i) + r) * TS + (32 * kk + 8 * g) * 2), acc[i]);
        }
        ga0 = ga0n; ga1 = ga1n; k4 = k4n;
#pragma unroll
        for (int i = 0; i < 8; ++i) vr[i] = vrn[i];
    }
    { float* So = OUTP + O_SP + (size_t)bh * 8192;
#pragma unroll
      for (int i = 0; i < 2; ++i)
#pragma unroll
          for (int j = 0; j < 4; ++j) So[(32 * sl + 16 * dt + 4 * g + j) * 128 + 16 * (eb + i) + r] = acc[i][j]; }
    __syncthreads();
}

__device__ __forceinline__ void sample_item(Frame& F, int n, int hh) {
    float* L = (float*)F.ldsg;
    float* qv = L; float* kv = L + 128; float* vv = L + 256; float* part = L + 512; float* sc = L + 512 + 2048;
    const int tid = F_TID, lane = F_LANE, w = F_WAVE;
    const size_t row = (size_t)MP + n;
    const bf16* Pr = PROJ + row * PS;
    const bool gla = hh >= 4; const int h = hh & 3;
    if (!gla) {
        if (tid < 256) { const int d = tid & 127, isk = tid >> 7, ch = isk * 512 + h * 128 + d;
            const float* scv = ST_CONV + (size_t)n * 3 * 1024 + ch;
            float a = CONV_B[ch] + CONV_W[ch] * scv[0] + CONV_W[1024 + ch] * scv[1024] + CONV_W[2048 + ch] * scv[2048] + CONV_W[3072 + ch] * bf2f(Pr[(isk ? C_MK : C_MQ) + h * 128 + d]);
            a = a * sigmoidf(a); if (isk) kv[d] = a * KSCALE; else qv[d] = a;
        } else if (tid < 384) { const int e = tid - 256; vv[e] = bf2f(Pr[C_MV + h * 128 + e]); }
    } else {
        if (tid < 64) qv[tid] = bf2f(Pr[C_GQ + h * 64 + tid]);
        else if (tid < 128) kv[tid - 64] = bf2f(Pr[C_GK + h * 64 + tid - 64]);
        else if (tid < 256) vv[tid - 128] = bf2f(Pr[C_GV + h * 128 + tid - 128]);
        else if (tid < 320) { const int d = tid - 256, col = h * 64 + d; float z = B_A[col];
#pragma unroll
            for (int q = 0; q < 16; ++q) z += bf2f(Pr[C_SM + 8 + q]) * W_A2[q * 256 + col];
            sc[16 + d] = __expf(logsig(z) * (1.f / 16.f)); }
    }
    __syncthreads();
    float cs = 1.f, wkk = 1.f, dinv = 1.f;
    if (!gla) {
        const float* n0 = ST_N + ((size_t)n * 4 + h) * 128;
        if (w == 0) { const float s = wave_sum(qv[lane] * kv[lane] + qv[lane + 64] * kv[lane + 64]); if (lane == 0) sc[0] = s; }
        if (w == 1) { const float s = wave_sum(qv[lane] * n0[lane] + qv[lane + 64] * n0[lane + 64]); if (lane == 0) sc[1] = s; }
        __syncthreads();
        const float ig = bf2f(Pr[C_SM + h]) + B_GATE[h], lf = logsig(bf2f(Pr[C_SM + 4 + h]) + B_GATE[4 + h]);
        const float m0 = ST_M[n * 4 + h], mn = fmaxf(lf + m0, ig);
        wkk = __expf(ig - mn); cs = __expf(lf + m0 - mn);
        const float den = cs * sc[1] + sc[0] * wkk;
        dinv = 1.f / fmaxf(fabsf(den), __expf(-mn));
        if (tid < 128) OUTP[O_NS + ((size_t)n * 4 + h) * 128 + tid] = cs * n0[tid] + wkk * kv[tid];
        if (tid == 0) OUTP[O_MS + n * 4 + h] = mn;
    }
    const int e4 = tid & 31, dg = tid >> 5;
    const f32x4 v4 = *(const f32x4*)(vv + 4 * e4);
    f32x4 hp = (f32x4){0.f, 0.f, 0.f, 0.f};
    if (!gla) {
        const float* C0 = ST_C + ((size_t)n * 4 + h) * 16384; float* Cn = OUTP + O_CS + ((size_t)n * 4 + h) * 16384;
#pragma unroll
        for (int i = 0; i < 8; ++i) { const int d = 8 * dg + i; const f32x4 c0 = *(const f32x4*)(C0 + d * 128 + 4 * e4);
            const f32x4 cn = c0 * cs + v4 * (wkk * kv[d]); *(f32x4*)(Cn + d * 128 + 4 * e4) = cn; hp += cn * qv[d]; }
    } else {
        const float* S0 = ST_S + ((size_t)n * 4 + h) * 8192; float* Sn = OUTP + O_SS + ((size_t)n * 4 + h) * 8192;
#pragma unroll
        for (int i = 0; i < 4; ++i) { const int d = 4 * dg + i; const f32x4 s0 = *(const f32x4*)(S0 + d * 128 + 4 * e4);
            const f32x4 sn = s0 * sc[16 + d] + v4 * kv[d]; *(f32x4*)(Sn + d * 128 + 4 * e4) = sn; hp += sn * qv[d]; }
    }
    *(f32x4*)(part + dg * 128 + 4 * e4) = hp;
    __syncthreads();
    float hv = 0.f;
    if (tid < 128) {
#pragma unroll
        for (int q = 0; q < 16; ++q) hv += part[q * 128 + tid];
        hv *= dinv;
        const float s = wave_sum(hv * hv); if (lane == 0) sc[2 + w] = s;
    }
    __syncthreads();
    if (tid < 128) {
        const float rn = 1.f / sqrtf((sc[2] + sc[3]) * (1.f / 128.f) + EPS);
        float o;
        if (!gla) o = hv * rn * G_MHEAD[h * 128 + tid] * sigmoidf(bf2f(Pr[C_MO + h * 128 + tid]));
        else { const float gr = bf2f(Pr[C_GR + h * 128 + tid]); o = hv * rn * G_GHEAD[h * 128 + tid] * gr * sigmoidf(gr); }
        R1B[row * D + (gla ? 512 : 0) + h * 128 + tid] = (bf16)f2bf(o);
    }
    __syncthreads();
}

constexpr int P2B_QS = 0, P2B_KS = 64 * QS_P, P2B_VT = P2B_KS + 80 * QS_P, P2B_PS = P2B_VT + 128 * TS, P2B_FL = P2B_PS + 64 * TS, P2B_HALF = P2B_FL + 2304;
static_assert(2 * P2B_HALF <= MISC_OFF, "P2b LDS");
template <bool GLA>
__device__ __forceinline__ void p2b_unit(Frame& F, int u, char* L, int ltid, int lw, int lane) {
    const int v = u & 1023, bh = v >> 5, c = v & 31, b = bh >> 2, h = bh & 3, r = lane & 15, g = lane >> 4;
    const size_t rowb = (size_t)b * SEQ + c * 64;
    const bf16* P = PROJ;
    char* QSp = L + P2B_QS; char* KSp = L + P2B_KS; char* VTp = L + P2B_VT; char* PSp = L + P2B_PS;
    float* af = (float*)(L + P2B_FL); float* Mf = af + 64; float* scf = af + 128; float* enf = af + 192; float* dinvf = af + 256; float* ssq = af + 320;
    constexpr int QP = GLA ? TS : QS_P;
    constexpr int NK = GLA ? 2 : 4;
    bf16x8 cfr[2][NK];
    { const bf16* CT = GLA ? CSG + (size_t)(bh * NCH + c) * 8192 : CSM + (size_t)(bh * NCH + c) * 16384;
#pragma unroll
      for (int n2 = 0; n2 < 2; ++n2)
#pragma unroll
          for (int kk = 0; kk < NK; ++kk) cfr[n2][kk] = *(const bf16x8*)(CT + (32 * lw + 16 * n2 + r) * (GLA ? 64 : 128) + 32 * kk + 8 * g); }
    const int dp = ltid & 63, sg = ltid >> 6;
    if constexpr (!GLA) {
        { const size_t row = rowb + lane;
          const float ig = bf2f(P[row * PS + C_SM + h]) + B_GATE[h], lf = logsig(bf2f(P[row * PS + C_SM + 4 + h]) + B_GATE[4 + h]);
          const float bc = wave_scan_sum(lf, lane), a = ig - bc; const float pm = wave_scan_max(a, lane);
          const float mc = MCS[bh * NCH + c], Mt = fmaxf(mc, pm);
          if (lw == 0) { af[lane] = a; Mf[lane] = Mt; scf[lane] = __expf(mc - Mt); enf[lane] = __expf(-(bc + Mt)); } }
#pragma unroll
        for (int isk = 0; isk < 2; ++isk) {
            const int ch = isk * 512 + h * 128 + 2 * dp;
            float cw[4][2], cb[2];
#pragma unroll
            for (int j = 0; j < 4; ++j) { cw[j][0] = CONV_W[j * 1024 + ch]; cw[j][1] = CONV_W[j * 1024 + ch + 1]; }
            cb[0] = CONV_B[ch]; cb[1] = CONV_B[ch + 1];
            unsigned raw[19];
#pragma unroll
            for (int i = 0; i < 19; ++i) { const int t = c * 64 + 16 * sg - 3 + i; raw[i] = (t >= 0) ? *(const unsigned*)(P + ((size_t)b * SEQ + t) * PS + (isk ? C_MK : C_MQ) + h * 128 + 2 * dp) : 0u; }
            char* dst = (isk ? KSp : QSp) + 4 * dp;
#pragma unroll
            for (int i = 0; i < 16; ++i) { float a0 = cb[0], a1 = cb[1];
#pragma unroll
                for (int j = 0; j < 4; ++j) { a0 += cw[j][0] * bflo(raw[i + j]); a1 += cw[j][1] * bfhi(raw[i + j]); }
                a0 = a0 * sigmoidf(a0); a1 = a1 * sigmoidf(a1); if (isk) { a0 *= KSCALE; a1 *= KSCALE; }
                *(unsigned*)(dst + (16 * sg + i) * QS_P) = pk2(a0, a1); }
        }
        if (ltid < 128) *(bf16*)(KSp + 64 * QS_P + 2 * ltid) = (bf16)f2bf(NCS[(size_t)(bh * NCH + c) * 128 + ltid]);
        for (int i = ltid; i < 15 * 64; i += 256) *(unsigned*)(KSp + (65 + i / 64) * QS_P + 4 * (i & 63)) = 0u;
    } else {
        const size_t row = rowb + lane;
        const v4u ga0 = *(const v4u*)(P + row * PS + C_SM + 8), ga1 = *(const v4u*)(P + row * PS + C_SM + 16);
        const v4u q0 = *(const v4u*)(P + row * PS + C_GQ + h * 64 + 16 * lw), q1 = *(const v4u*)(P + row * PS + C_GQ + h * 64 + 16 * lw + 8);
        const v4u k0 = *(const v4u*)(P + row * PS + C_GK + h * 64 + 16 * lw), k1 = *(const v4u*)(P + row * PS + C_GK + h * 64 + 16 * lw + 8);
        float ga[16];
#pragma unroll
        for (int i = 0; i < 4; ++i) { ga[2 * i] = bflo(ga0[i]); ga[2 * i + 1] = bfhi(ga0[i]); ga[8 + 2 * i] = bflo(ga1[i]); ga[8 + 2 * i + 1] = bfhi(ga1[i]); }
        unsigned qo[8], ko[8];
#pragma unroll
        for (int dd = 0; dd < 16; dd += 2) {
            float qt[2], kt[2];
#pragma unroll
            for (int q2 = 0; q2 < 2; ++q2) { const int col = h * 64 + 16 * lw + dd + q2;
                float z = B_A[col];
#pragma unroll
                for (int q = 0; q < 16; ++q) z += ga[q] * W_A2[q * 256 + col];
                const float bc = wave_scan_sum(logsig(z) * (1.f / 16.f), lane);
                const unsigned qw = dd < 8 ? q0[dd >> 1] : q1[(dd - 8) >> 1], kw = dd < 8 ? k0[dd >> 1] : k1[(dd - 8) >> 1];
                qt[q2] = (q2 ? bfhi(qw) : bflo(qw)) * __expf(bc); kt[q2] = (q2 ? bfhi(kw) : bflo(kw)) * __expf(-bc); }
            qo[dd >> 1] = pk2(qt[0], qt[1]); ko[dd >> 1] = pk2(kt[0], kt[1]);
        }
        *(v4u*)(QSp + lane * TS + 32 * lw) = (v4u){qo[0], qo[1], qo[2], qo[3]}; *(v4u*)(QSp + lane * TS + 32 * lw + 16) = (v4u){qo[4], qo[5], qo[6], qo[7]};
        *(v4u*)(KSp + lane * TS + 32 * lw) = (v4u){ko[0], ko[1], ko[2], ko[3]}; *(v4u*)(KSp + lane * TS + 32 * lw + 16) = (v4u){ko[4], ko[5], ko[6], ko[7]};
    }
    {
      unsigned vr[16];
#pragma unroll
      for (int i = 0; i < 16; ++i) vr[i] = *(const unsigned*)(P + (rowb + 16 * sg + i) * PS + (GLA ? C_GV : C_MV) + h * 128 + 2 * dp);
      unsigned v0p[8], v1p[8];
#pragma unroll
      for (int i = 0; i < 16; i += 2) { v0p[i >> 1] = (vr[i] & 0xffffu) | (vr[i + 1] << 16); v1p[i >> 1] = (vr[i] >> 16) | (vr[i + 1] & 0xffff0000u); }
      *(v4u*)(VTp + (2 * dp) * TS + 32 * sg) = (v4u){v0p[0], v0p[1], v0p[2], v0p[3]}; *(v4u*)(VTp + (2 * dp) * TS + 32 * sg + 16) = (v4u){v0p[4], v0p[5], v0p[6], v0p[7]};
      *(v4u*)(VTp + (2 * dp + 1) * TS + 32 * sg) = (v4u){v1p[0], v1p[1], v1p[2], v1p[3]}; *(v4u*)(VTp + (2 * dp + 1) * TS + 32 * sg + 16) = (v4u){v1p[4], v1p[5], v1p[6], v1p[7]}; }
    __syncthreads();
    {
        f32x4 pa[5];
#pragma unroll
        for (int i = 0; i < 5; ++i) pa[i] = (f32x4){0.f, 0.f, 0.f, 0.f};
#pragma unroll
        for (int kk = 0; kk < NK; ++kk) {
            const bf16x8 qf = lds_frag(QSp + (16 * lw + r) * QP + (32 * kk + 8 * g) * 2);
#pragma unroll
            for (int nt = 0; nt < 4; ++nt) if (nt <= lw) pa[nt] = mfma16(lds_frag(KSp + (16 * nt + r) * QP + (32 * kk + 8 * g) * 2), qf, pa[nt]);
            if constexpr (!GLA) pa[4] = mfma16(lds_frag(KSp + (64 + r) * QP + (32 * kk + 8 * g) * 2), qf, pa[4]);
        }
        const int t = 16 * lw + r;
        float Mt = 0.f; if constexpr (!GLA) Mt = Mf[t];
        float rs = 0.f;
#pragma unroll
        for (int nt = 0; nt < 4; ++nt) {
            f32x4 p = (f32x4){0.f, 0.f, 0.f, 0.f};
            if (nt <= lw) {
                f32x4 a4 = (f32x4){0.f, 0.f, 0.f, 0.f}; if constexpr (!GLA) a4 = *(const f32x4*)(af + 16 * nt + 4 * g);
#pragma unroll
                for (int j = 0; j < 4; ++j) { const int s = 16 * nt + 4 * g + j; float x = pa[nt][j]; if constexpr (!GLA) x *= __expf(a4[j] - Mt); p[j] = (s <= t) ? x : 0.f; }
            }
            rs += (p[0] + p[1]) + (p[2] + p[3]);
            *(v2u*)(PSp + t * TS + (16 * nt + 4 * g) * 2) = (v2u){pg8::cvt_pk_bf16(p[0], p[1]), pg8::cvt_pk_bf16(p[2], p[3])};
        }
        if constexpr (!GLA) {
            rs += __shfl_xor(rs, 16); rs += __shfl_xor(rs, 32);
            if (g == 0) { const float den = scf[t] * pa[4][0] + rs; dinvf[t] = 1.f / fmaxf(fabsf(den), enf[t]); }
        }
    }
    __syncthreads();
    f32x4 hv[4][2];
    {
        f32x4 aV[4][2], aC[4][2];
#pragma unroll
        for (int mt = 0; mt < 4; ++mt)
#pragma unroll
            for (int n2 = 0; n2 < 2; ++n2) { aV[mt][n2] = (f32x4){0.f, 0.f, 0.f, 0.f}; aC[mt][n2] = (f32x4){0.f, 0.f, 0.f, 0.f}; }
#pragma unroll
        for (int kk = 0; kk < 2; ++kk) {
            bf16x8 vf[2];
#pragma unroll
            for (int n2 = 0; n2 < 2; ++n2) vf[n2] = lds_frag(VTp + (32 * lw + 16 * n2 + r) * TS + (32 * kk + 8 * g) * 2);
#pragma unroll
            for (int mt = 0; mt < 4; ++mt) { const bf16x8 pf = lds_frag(PSp + (16 * mt + r) * TS + (32 * kk + 8 * g) * 2);
#pragma unroll
                for (int n2 = 0; n2 < 2; ++n2) aV[mt][n2] = mfma16(vf[n2], pf, aV[mt][n2]); }
        }
#pragma unroll
        for (int kk = 0; kk < NK; ++kk)
#pragma unroll
            for (int mt = 0; mt < 4; ++mt) { const bf16x8 qf = lds_frag(QSp + (16 * mt + r) * QP + (32 * kk + 8 * g) * 2);
#pragma unroll
                for (int n2 = 0; n2 < 2; ++n2) aC[mt][n2] = mfma16(cfr[n2][kk], qf, aC[mt][n2]); }
#pragma unroll
        for (int mt = 0; mt < 4; ++mt) { const int t = 16 * mt + r;
            float sc = 1.f, di = 1.f; if constexpr (!GLA) { sc = scf[t]; di = dinvf[t]; }
            float s = 0.f;
#pragma unroll
            for (int n2 = 0; n2 < 2; ++n2) { hv[mt][n2] = (aC[mt][n2] * sc + aV[mt][n2]) * di;
                s += (hv[mt][n2][0] * hv[mt][n2][0] + hv[mt][n2][1] * hv[mt][n2][1]) + (hv[mt][n2][2] * hv[mt][n2][2] + hv[mt][n2][3] * hv[mt][n2][3]); }
            s += __shfl_xor(s, 16); s += __shfl_xor(s, 32);
            if (g == 0) ssq[t * 4 + lw] = s; }
    }
    __syncthreads();
    {
        const float* gn = (GLA ? G_GHEAD : G_MHEAD) + h * 128;
#pragma unroll
        for (int mt = 0; mt < 4; ++mt) { const int t = 16 * mt + r; const f32x4 s4 = *(const f32x4*)(ssq + 4 * t);
            const float rn = 1.f / sqrtf(((s4[0] + s4[1]) + (s4[2] + s4[3])) * (1.f / 128.f) + EPS);
#pragma unroll
            for (int n2 = 0; n2 < 2; ++n2) { const int e = 32 * lw + 16 * n2 + 4 * g;
                const v2u gw = *(const v2u*)(P + (rowb + t) * PS + (GLA ? C_GR : C_MO) + h * 128 + e);
                const f32x4 g4 = *(const f32x4*)(gn + e);
                float gt[4] = {bflo(gw[0]), bfhi(gw[0]), bflo(gw[1]), bfhi(gw[1])}; float o[4];
#pragma unroll
                for (int j = 0; j < 4; ++j) { const float sg_ = sigmoidf(gt[j]); o[j] = hv[mt][n2][j] * rn * g4[j] * (GLA ? gt[j] * sg_ : sg_); }
                *(v2u*)(R1B + (rowb + t) * D + (GLA ? 512 : 0) + h * 128 + e) = (v2u){pg8::cvt_pk_bf16(o[0], o[1]), pg8::cvt_pk_bf16(o[2], o[3])}; } }
    }
    __syncthreads();
}

constexpr int NPHASE = 9;

__global__ void __launch_bounds__(NWAVES * 64, 2) mk_fwd(Args args) {
    extern __shared__ __attribute__((aligned(16))) unsigned char lds[];
    Frame F;
    F.lds = (LAS unsigned char*)lds; F.ldsg = (char*)lds;
    F.G = gridDim.x;
    F.a = (CArgs*)__builtin_amdgcn_kernarg_segment_ptr();
    unsigned char* ws = F.a->ws;
    volatile LAS unsigned* MISC = (volatile LAS unsigned*)(F.lds + MISC_OFF);
    for (int u = F_TID; u < 64; u += NWAVES * 64) MISC[u] = 0u;
    __syncthreads();
    XcdBarrier bar; bar.bar = (unsigned*)(ws + CTL_BAR_B); bar.x = 0; bar.st = nullptr;
    if (MK_N_LAUNCHES == 1) bar = xcd_barrier_post((unsigned*)(ws + CTL_BAR_B), MISC + 8);
    const int lo = F.a->ph_lo, hi = F.a->ph_hi;
#ifndef PROBE_REP
#define PROBE_REP 0
#endif
#define REPS(k) (((PROBE_REP >> (k)) & 1) ? 2 : 1)
#ifndef PHASE_MASK
#define PHASE_MASK 0x1ff
#endif
#define IN(k) (((PHASE_MASK >> (k)) & 1) && lo <= (k) && (k) < hi)
#define SEAM(k) do { if (IN(k) && IN((k) + 1)) { xcd_barrier(bar); if ((PROBE_REP >> 16) & 1) xcd_barrier(bar); } } while (0)

    if (IN(0)) { for (int rep = 0; rep < REPS(0); ++rep) { p0_prologue(F); if (rep + 1 < REPS(0)) __syncthreads(); } SEAM(0); }
    if (IN(1)) {
        pg8::Gemm g{R1B, WIN_T, MR, PS, D}; pg8::StaticOrder S; S.init(MR, PS, F.G, (int)blockIdx.x);
        EpiProj E{PROJ, PS};
        for (int rep = 0; rep < REPS(1); ++rep) pg8::gemm_phase<EpiProj, pg8::StaticOrder, PG8_ALIGN, PG8_SP2>(F.lds, g, S, E);
        SEAM(1);
    }
    if (IN(2)) {
        const int bx = blockIdx.x;
        for (int rep = 0; rep < REPS(2); ++rep) {
        if (bx < 128) { const int cb_ = bx & 63; if (cb_ < 32) chain_mlstm(F, cb_ >> 2, cb_ & 3, bx >> 6); else chain_gla(F, (cb_ - 32) >> 2, (cb_ - 32) & 3, bx >> 6); }
        else {
            const int nb = F.G - 128, gb = bx - 128;
            for (int it = gb; it < MSMP * 8; it += nb) sample_item(F, it >> 3, it & 7);
            for (int i = gb * 512 + F_TID; i < NB * 3 * 1024 + MSMP * 3 * 1024; i += nb * 512) {
                if (i < NB * 3 * 1024) { const int b = i / 3072, j = (i / 1024) % 3, ch = i & 1023; OUTP[O_CVP + i] = bf2f(PROJ[((size_t)b * SEQ + SEQ - 3 + j) * PS + ch]); }
                else { const int k = i - NB * 3 * 1024, n = k / 3072, j = (k / 1024) % 3, ch = k & 1023;
                    OUTP[O_CVS + k] = j < 2 ? ST_CONV[(size_t)n * 3072 + (j + 1) * 1024 + ch] : bf2f(PROJ[((size_t)MP + n) * PS + ch]); }
            }
        }
        if (rep + 1 < REPS(2)) __syncthreads();
        }
        SEAM(2);
    }
    if (IN(3)) {
        const int hb = F_WAVE >> 2, ltid = F_TID & 255, lw = F_WAVE & 3;
        char* L = F.ldsg + hb * P2B_HALF;
        for (int rep = 0; rep < REPS(3); ++rep)
        for (int it = 0; it * 2 * F.G < 2048; ++it) {
            const int u = (it * F.G + (int)blockIdx.x) * 2 + hb;
            if (u - hb >= 2048) break;
            if (u < 1024) p2b_unit<false>(F, u, L, ltid, lw, F_LANE); else p2b_unit<true>(F, u, L, ltid, lw, F_LANE);
        }
        SEAM(3);
    }
    if (IN(4)) {
        pg8::Gemm g{R1B, WOUT_T, MR, D, D}; pg8::StaticOrder S; S.init(MR, D, F.G, (int)blockIdx.x);
        EpiRes E{X_P, X_S, OUTP, X1B, SS1, false};
        pg8::gemm_phase<EpiRes, pg8::StaticOrder, PG8_ALIGN, PG8_SP2>(F.lds, g, S, E);
        if (REPS(4) == 2) { EpiRes E2{X_P, X_S, OUTP, UBUF, NCS, true}; pg8::gemm_phase<EpiRes, pg8::StaticOrder, PG8_ALIGN, PG8_SP2>(F.lds, g, S, E2); }
        SEAM(4);
    }
    if (IN(5)) {
        pg8::Gemm g{X1B, W1_T, MR, FF, D}; pg8::StaticOrder S; S.init(MR, FF, F.G, (int)blockIdx.x);
        EpiU E{UBUF, SS1};
        for (int rep = 0; rep < REPS(5); ++rep) pg8::gemm_phase<EpiU, pg8::StaticOrder, PG8_ALIGN, PG8_SP2>(F.lds, g, S, E);
        SEAM(5);
    }
    if (IN(6)) {
        pg8::Gemm g{UBUF, W2_T, MR, D, FF}; pg8::StaticOrder S; S.init(MR, D, F.G, (int)blockIdx.x);
        EpiRes E{OUTP, OUTP + (size_t)MP * D, OUTP, R1B, SS2, false};
        pg8::gemm_phase<EpiRes, pg8::StaticOrder, PG8_ALIGN, PG8_SP2>(F.lds, g, S, E);
        if (REPS(6) == 2) { EpiRes E2{OUTP, OUTP + (size_t)MP * D, OUTP, X1B, NCS, true}; pg8::gemm_phase<EpiRes, pg8::StaticOrder, PG8_ALIGN, PG8_SP2>(F.lds, g, S, E2); }
        SEAM(6);
    }
    if (IN(7)) {
        { pg8::Gemm g{PBUF, WPLE_T, MR, D, DPLE}; pg8::StaticOrder S; S.init(MR, D, F.G, (int)blockIdx.x);
          EpiProj E{PPB, D};
          pg8::gemm_phase<EpiProj, pg8::StaticOrder, PG8_ALIGN, PG8_SP2>(F.lds, g, S, E); }
        { pg8::Gemm g{R1B, WPG_T, MR, D, D}; pg8::StaticOrder S; S.init(MR, D, F.G, (int)blockIdx.x);
          EpiPle E{OUTP, PPB, SS2, SS3, false};
          pg8::gemm_phase<EpiPle, pg8::StaticOrder, PG8_ALIGN, PG8_SP2>(F.lds, g, S, E);
          if (REPS(7) == 2) { { pg8::Gemm g2{PBUF, WPLE_T, MR, D, DPLE}; EpiProj E1{PPB, D}; pg8::gemm_phase<EpiProj, pg8::StaticOrder, PG8_ALIGN, PG8_SP2>(F.lds, g2, S, E1); }
            EpiPle E2{OUTP, PPB, SS2, NCS, true}; pg8::gemm_phase<EpiPle, pg8::StaticOrder, PG8_ALIGN, PG8_SP2>(F.lds, g, S, E2); } }
        SEAM(7);
    }
    if (IN(8)) {
        const int gw = blockIdx.x * NWAVES + F_WAVE, NGW = F.G * NWAVES;
        if (REPS(8) == 2) for (int m = gw; m < MV; m += NGW) {
            const GAS f32x4* xr = (const GAS f32x4*)(OUTP + (size_t)m * D) + F_LANE; GAS f32x4* xo = (GAS f32x4*)((float*)(WSB + WS_U) + (size_t)m * D) + F_LANE;
            const float r = 1.f / sqrtf(SS3[m] * (1.f / D) + EPS);
#pragma unroll
            for (int j = 0; j < 4; ++j) { const f32x4 gf = ((const GAS f32x4*)G_FINAL)[F_LANE + 64 * j]; xo[64 * j] = xr[64 * j] * r * gf; }
        }
        for (int m = gw; m < MV; m += NGW) {
            GAS f32x4* xr = (GAS f32x4*)(OUTP + (size_t)m * D) + F_LANE;
            const float r = 1.f / sqrtf(SS3[m] * (1.f / D) + EPS);
#pragma unroll
            for (int j = 0; j < 4; ++j) { const f32x4 gf = ((const GAS f32x4*)G_FINAL)[F_LANE + 64 * j]; xr[64 * j] = xr[64 * j] * r * gf; }
        }
    }
#undef IN
#undef SEAM
}

extern "C" void kernel_launch(void* const* d_in, const int* in_sizes, int n_in, void* d_out, int out_size, void* d_ws, size_t ws_size, hipStream_t stream) {
    static int grid = 0;
    if (grid == 0) {
        if (n_in != 26 || ws_size < WS_END) { fprintf(stderr, "kernel_launch: unexpected n_in %d / ws %zu\n", n_in, ws_size); grid = -1; return; }
        int dev = 0, cus = 0, per_cu = 0;
        if (hipGetDevice(&dev) != hipSuccess || hipDeviceGetAttribute(&cus, hipDeviceAttributeMultiprocessorCount, dev) != hipSuccess) { grid = -1; return; }
        if (hipFuncSetAttribute((const void*)mk_fwd, hipFuncAttributeMaxDynamicSharedMemorySize, LDS_BYTES) != hipSuccess) { fprintf(stderr, "kernel_launch: hipFuncSetAttribute failed\n"); grid = -1; return; }
        if (hipOccupancyMaxActiveBlocksPerMultiprocessor(&per_cu, (const void*)mk_fwd, NWAVES * 64, LDS_BYTES) != hipSuccess || per_cu < 1) { fprintf(stderr, "kernel_launch: occupancy query says %d\n", per_cu); per_cu = 1; }
        (void)hipGetLastError();
        grid = cus;
        if (grid > 256) grid = 256;
    }
    if (grid < 0) return;
    (void)hipMemsetAsync((char*)d_ws + WS_CTL, 0, CTL_ZERO_BYTES, stream);
    Args a{};
    for (int i = 0; i < 26; ++i) a.in[i] = (const float*)d_in[i];
    a.out = (float*)d_out; a.ws = (unsigned char*)d_ws;
    if (MK_N_LAUNCHES == 1) { a.ph_lo = 0; a.ph_hi = NPHASE; a.li = 0; hipLaunchKernelGGL(mk_fwd, dim3(grid), dim3(NWAVES * 64), LDS_BYTES, stream, a); }
    else for (int li = 0; li < NPHASE; ++li) { a.ph_lo = li; a.ph_hi = li + 1; a.li = li; hipLaunchKernelGGL(mk_fwd, dim3(grid), dim3(NWAVES * 64), LDS_BYTES, stream, a); }
}
```

```cpp
#include <hip/hip_runtime.h>
#include <cstdio>
#include <cstdint>

#ifndef MK_N_LAUNCHES
#define MK_N_LAUNCHES 1
#endif

namespace pg8 {
#define PG8_LAS __attribute__((address_space(3)))
typedef unsigned short bf16_t;
typedef short bf16x8 __attribute__((ext_vector_type(8)));
typedef float f32x4 __attribute__((ext_vector_type(4)));
typedef unsigned u32x4 __attribute__((ext_vector_type(4)));
constexpr int BM = 256, BK = 64, HALF = 128, HTB = HALF * BK * 2, STAGE_BYTES = 8 * HTB, NXCD = 8, WGM = 8, MP = 16384;

__host__ __device__ __forceinline__ int lds_byte(int r, int c) { const int st = (r >> 4) * 2 + (c >> 5), rr = r & 15, cc = c & 31, ob = rr * 64 + cc * 2; return st * 1024 + (ob ^ (((ob >> 9) & 1) << 5)); }
__host__ __device__ __forceinline__ void stage_rc(int b, int& R, int& C) { const int st = b / 1024, sb = b % 1024, swz = sb ^ (((sb >> 9) & 1) << 5); R = (st >> 1) * 16 + swz / 64; C = (st & 1) * 32 + (swz % 64) / 2; }
__host__ __device__ __forceinline__ int perm32(int rho) { const int n = rho >> 4, i = rho & 15; return 8 * (i >> 2) + 4 * n + (i & 3); }

struct Unit { int pm, pn; };
struct Gemm { const bf16_t* A; const bf16_t* Bt; int M, N, K; };

struct StaticOrder {
    int nM, nN, nwg, G, c;
    __host__ __device__ void init(int M, int N, int G_, int c_) { nM = M / BM; nN = N / BM; nwg = nM * nN; G = G_; c = c_; }
    __host__ __device__ bool next(int i, Unit& u) const {
        const long L = (long)i * G + c; if (L >= nwg) return false;
        int wgid = (int)L; { const int q = nwg / NXCD, r = nwg % NXCD, xcd = wgid % NXCD, off = wgid / NXCD; wgid = (xcd < r ? xcd * (q + 1) : r * (q + 1) + (xcd - r) * q) + off; }
        const int nig = WGM * nN, gid = wgid / nig, fm = gid * WGM, gsz = (nM - fm) < WGM ? (nM - fm) : WGM;
        u.pm = fm + ((wgid % nig) % gsz); u.pn = (wgid % nig) / gsz; return true;
    }
    __device__ __forceinline__ void a_ready(const Unit&) const {}
    __device__ __forceinline__ void done(const Unit&) const {}
};

__device__ __forceinline__ unsigned cvt_pk_bf16(float lo, float hi) { unsigned r; asm volatile("v_cvt_pk_bf16_f32 %0, %1, %2" : "=v"(r) : "v"(lo), "v"(hi)); return r; }


template <class Epi, class Sched, bool ALIGN_EPI = false, bool SP2 = false>
__device__ __forceinline__ void gemm_phase(PG8_LAS unsigned char* lds, const Gemm g, const Sched& S, const Epi& E) {
    int tid_ = threadIdx.x; asm volatile("" : "+v"(tid_));
    const int tid = tid_, wid = __builtin_amdgcn_readfirstlane(tid >> 6), lane = tid & 63, wr = wid >> 2, wc = wid & 3, fr = lane & 15, fq = lane >> 4;
    const int K = g.K, nt = K / BK;
    unsigned voffA[2], voffB[2];
#pragma unroll
    for (int i = 0; i < 2; ++i) { int R, C; stage_rc(tid * 16 + i * 8192, R, C); const int Rb = Epi::PERM ? ((R & ~31) + perm32(R & 31)) : R;
        voffA[i] = (unsigned)(R * K + C) * 2u; voffB[i] = (unsigned)(Rb * K + C) * 2u; }
    const size_t kstep = (size_t)(BK * 2);
    const size_t hstep = (size_t)HALF * K * 2;
    const size_t tstep = 2 * hstep;
    const unsigned ldsw = (unsigned)wid * 1024u;
    const int aoff = lds_byte(wr * 64 + fr, fq * 8), boff = lds_byte(wc * 32 + fr, fq * 8);
#define PG8_SA(b, h) (((b) * 2 + (h)) * HTB)
#define PG8_SB(b, h) ((4 + (b) * 2 + (h)) * HTB)
#define PG8_STAGE(bufoff, gbase, voff) do { _Pragma("unroll") for (int _i = 0; _i < 2; ++_i) \
        __builtin_amdgcn_global_load_lds((const unsigned*)((const char*)(gbase) + (voff)[_i]), (PG8_LAS unsigned*)(lds + (bufoff) + ldsw + _i * 8192), 16, 0, 0); } while (0)
#define PG8_LDA(dst, b, h) do { _Pragma("unroll") for (int m = 0; m < 4; ++m) _Pragma("unroll") for (int k = 0; k < 2; ++k) dst[m][k] = *(const PG8_LAS bf16x8*)(lds + PG8_SA(b, h) + aoff + m * 2048 + k * 1024); } while (0)
#define PG8_LDB(dst, b, h) do { _Pragma("unroll") for (int n = 0; n < 2; ++n) _Pragma("unroll") for (int k = 0; k < 2; ++k) dst[n][k] = *(const PG8_LAS bf16x8*)(lds + PG8_SB(b, h) + boff + n * 2048 + k * 1024); } while (0)
#define PG8_MMA(ai, bj, At, Bt) do { __builtin_amdgcn_s_setprio(1); _Pragma("unroll") for (int m = 0; m < 4; ++m) _Pragma("unroll") for (int n = 0; n < 2; ++n) _Pragma("unroll") for (int k = 0; k < 2; ++k) \
        acc[ai][bj][m][n] = __builtin_amdgcn_mfma_f32_16x16x32_bf16(Bt[n][k], At[m][k], acc[ai][bj][m][n], 0, 0, 0); __builtin_amdgcn_s_setprio(0); } while (0)
#define PG8_WAIT_V(n) asm volatile("s_waitcnt vmcnt(" #n ")" ::: "memory")
#define PG8_WAIT_L(n) asm volatile("s_waitcnt lgkmcnt(" #n ")" ::: "memory")
#define PG8_BAR __builtin_amdgcn_s_barrier()
#define PG8_SCHED __builtin_amdgcn_sched_barrier(0)
    Unit cur, nxt; int ui = 0;
    if (!S.next(0, cur)) return;
    f32x4 acc[2][2][4][2];
#pragma unroll
    for (int a = 0; a < 2; ++a)
#pragma unroll
        for (int b = 0; b < 2; ++b)
#pragma unroll
            for (int m = 0; m < 4; ++m)
#pragma unroll
                for (int n = 0; n < 2; ++n) acc[a][b][m][n] = (f32x4){0.f, 0.f, 0.f, 0.f};
    bf16x8 At[4][2], B0[2][2], B1[2][2];
    const char* cA = (const char*)g.A + (size_t)cur.pm * tstep; const char* cB = (const char*)g.Bt + (size_t)cur.pn * tstep;
    S.a_ready(cur);
    if constexpr (SP2) {
        PG8_STAGE(PG8_SB(0, 0), cB, voffB); PG8_STAGE(PG8_SB(0, 1), cB + hstep, voffB); PG8_STAGE(PG8_SA(0, 0), cA, voffA); PG8_STAGE(PG8_SA(0, 1), cA + hstep, voffA);
        if (wr == 1) PG8_BAR;
        PG8_WAIT_V(2); PG8_BAR;
        PG8_STAGE(PG8_SB(1, 0), cB + kstep, voffB); PG8_STAGE(PG8_SA(1, 0), cA + kstep, voffA); PG8_STAGE(PG8_SB(1, 1), cB + hstep + kstep, voffB);
        PG8_WAIT_V(6); PG8_BAR;
    } else {
        PG8_STAGE(PG8_SB(0, 0), cB, voffB); PG8_STAGE(PG8_SA(0, 0), cA, voffA); PG8_STAGE(PG8_SB(0, 1), cB + hstep, voffB); PG8_STAGE(PG8_SA(0, 1), cA + hstep, voffA);
        if (wr == 1) PG8_BAR;
        PG8_WAIT_V(4); PG8_BAR;
        PG8_STAGE(PG8_SB(1, 0), cB + kstep, voffB); PG8_STAGE(PG8_SA(1, 0), cA + kstep, voffA); PG8_STAGE(PG8_SB(1, 1), cB + hstep + kstep, voffB);
        PG8_WAIT_V(6); PG8_BAR;
    }
    for (;;) {
        const bool has_next = S.next(ui + 1, nxt);
        const char* nA = has_next ? (const char*)g.A + (size_t)nxt.pm * tstep : cA; const char* nB = has_next ? (const char*)g.Bt + (size_t)nxt.pn * tstep : cB;
        for (int t = 0; t < nt; t += 2) {
            const bool last = (t == nt - 2);
            const char* a1 = cA + (size_t)(t + 1) * kstep;
            const char* a2 = last ? nA : cA + (size_t)(t + 2) * kstep; const char* b2 = last ? nB : cB + (size_t)(t + 2) * kstep;
            const char* a3 = a2 + kstep; const char* b3 = b2 + kstep;
            if (last && has_next) S.a_ready(nxt);
            const bool fullm = cur.pm < MP / BM;
            if constexpr (SP2) {
            PG8_LDB(B0, 0, 0); PG8_LDB(B1, 0, 1); PG8_SCHED; PG8_LDA(At, 0, 0); PG8_STAGE(PG8_SA(1, 1), a1 + hstep, voffA);
            PG8_WAIT_V(8); PG8_WAIT_L(0); PG8_BAR; PG8_MMA(0, 0, At, B0); PG8_MMA(0, 1, At, B1); PG8_BAR; PG8_SCHED;
            PG8_LDA(At, 0, 1); PG8_STAGE(PG8_SB(0, 0), b2, voffB); PG8_STAGE(PG8_SB(0, 1), b2 + hstep, voffB); PG8_STAGE(PG8_SA(0, 0), a2, voffA);
            PG8_WAIT_V(8); PG8_WAIT_L(0); PG8_BAR; if (fullm) { PG8_MMA(1, 0, At, B0); PG8_MMA(1, 1, At, B1); } PG8_BAR; PG8_SCHED;
            PG8_LDB(B0, 1, 0); PG8_LDB(B1, 1, 1); PG8_SCHED; PG8_LDA(At, 1, 0); PG8_STAGE(PG8_SA(0, 1), a2 + hstep, voffA);
            PG8_WAIT_V(8); PG8_WAIT_L(0); PG8_BAR; PG8_MMA(0, 0, At, B0); PG8_MMA(0, 1, At, B1); PG8_BAR; PG8_SCHED;
            PG8_LDA(At, 1, 1); PG8_STAGE(PG8_SB(1, 0), b3, voffB); PG8_STAGE(PG8_SB(1, 1), b3 + hstep, voffB); PG8_STAGE(PG8_SA(1, 0), a3, voffA);
            PG8_WAIT_V(8); PG8_WAIT_L(0); PG8_BAR; if (fullm) { PG8_MMA(1, 0, At, B0); PG8_MMA(1, 1, At, B1); } PG8_BAR; PG8_SCHED;
            } else {
            PG8_LDB(B0, 0, 0); PG8_SCHED; PG8_LDA(At, 0, 0); PG8_STAGE(PG8_SA(1, 1), a1 + hstep, voffA);
            PG8_WAIT_L(8); PG8_BAR; PG8_WAIT_L(0); PG8_MMA(0, 0, At, B0); PG8_BAR; PG8_SCHED;
            PG8_LDB(B1, 0, 1); PG8_STAGE(PG8_SB(0, 0), b2, voffB);
            PG8_BAR; PG8_WAIT_L(0); PG8_MMA(0, 1, At, B1); PG8_BAR;
            PG8_LDA(At, 0, 1); PG8_STAGE(PG8_SA(0, 0), a2, voffA);
            PG8_BAR; PG8_WAIT_L(0); PG8_MMA(1, 0, At, B0); PG8_BAR; PG8_SCHED;
            PG8_STAGE(PG8_SB(0, 1), b2 + hstep, voffB);
            PG8_WAIT_V(6); PG8_BAR; PG8_MMA(1, 1, At, B1); PG8_BAR;
            PG8_LDB(B0, 1, 0); PG8_SCHED; PG8_LDA(At, 1, 0); PG8_STAGE(PG8_SA(0, 1), a2 + hstep, voffA);
            PG8_WAIT_L(8); PG8_BAR; PG8_WAIT_L(0); PG8_MMA(0, 0, At, B0); PG8_BAR; PG8_SCHED;
            PG8_LDB(B1, 1, 1); PG8_STAGE(PG8_SB(1, 0), b3, voffB);
            PG8_BAR; PG8_WAIT_L(0); PG8_MMA(0, 1, At, B1); PG8_BAR;
            PG8_LDA(At, 1, 1); PG8_STAGE(PG8_SA(1, 0), a3, voffA);
            PG8_BAR; PG8_WAIT_L(0); PG8_MMA(1, 0, At, B0); PG8_BAR; PG8_SCHED;
            PG8_STAGE(PG8_SB(1, 1), b3 + hstep, voffB);
            PG8_WAIT_V(6); PG8_BAR; PG8_MMA(1, 1, At, B1); PG8_BAR;
            }
        }
        if constexpr (ALIGN_EPI) { if (wr == 0) PG8_BAR; }
        E(acc, cur, wr, wc, fr, fq); S.done(cur);
        if (!has_next) break;
#pragma unroll
        for (int a = 0; a < 2; ++a)
#pragma unroll
            for (int b = 0; b < 2; ++b)
#pragma unroll
                for (int m = 0; m < 4; ++m)
#pragma unroll
                    for (int n = 0; n < 2; ++n) acc[a][b][m][n] = (f32x4){0.f, 0.f, 0.f, 0.f};
        cur = nxt; cA = nA; cB = nB; ++ui;
        if constexpr (ALIGN_EPI) { if (wr == 1) PG8_BAR; }
    }
    PG8_WAIT_V(0);
    if constexpr (!ALIGN_EPI) { if (wr == 0) PG8_BAR; }
    PG8_BAR;
#undef PG8_SA
#undef PG8_SB
#undef PG8_STAGE
#undef PG8_LDA
#undef PG8_LDB
#undef PG8_MMA
#undef PG8_WAIT_V
#undef PG8_WAIT_L
#undef PG8_BAR
#undef PG8_SCHED
}
}

#ifndef PG8_SP2
#define PG8_SP2 true
#endif
#ifndef PG8_ALIGN
#define PG8_ALIGN true
#endif

constexpr int NWAVES = 8;
constexpr int D = 1024, SEQ = 2048, NB = 8, MP = NB * SEQ  , MSMP = 128  , MV = MP + MSMP  , MR = 16640  ;
constexpr int FF = 4096, DPLE = 256, NCH = SEQ / 64  ;
constexpr int PS = 3840;
constexpr int C_MQ = 0, C_MK = 512, C_MV = 1024, C_MO = 1536, C_GQ = 2048, C_GK = 2304, C_GV = 2560, C_GR = 3072, C_SM = 3584;
constexpr float EPS = 1e-6f;
constexpr size_t O_YP = 0, O_YS = 16777216, O_CP = 16908288, O_NP = 17432576, O_MP = 17436672, O_CVP = 17436704, O_SP = 17461280,
                 O_CS = 17723424, O_NS = 26112032, O_MS = 26177568, O_CVS = 26178080, O_SS = 26571296;
constexpr size_t MiB = 1u << 20;
constexpr size_t WS_CTL = 0, CTL_ZERO_BYTES = 1 * MiB;
constexpr size_t CTL_BAR_B = 16384, CTL_SS1_B = 262144, CTL_SS2_B = 393216, CTL_SS3_B = 524288;
constexpr size_t WS_WIN = 1 * MiB, WS_WOUT = 9 * MiB, WS_W1 = 11 * MiB, WS_W2 = 19 * MiB, WS_WPG = 27 * MiB, WS_WPLE = 29 * MiB;
constexpr size_t WS_PB = 30 * MiB, WS_NC = 39 * MiB, WS_MC = WS_NC + 512 * 1024, WS_R1 = 40 * MiB, WS_R2 = 73 * MiB, WS_CSM = 195 * MiB, WS_CSG = 227 * MiB;
constexpr size_t WS_X1B = WS_R2, WS_U = 106 * MiB, WS_PP = 106 * MiB, WS_END = 243 * MiB;
static_assert(WS_R2 + (size_t)MR * PS * 2 <= WS_CSM && WS_R1 + (size_t)MR * D * 2 <= WS_R2 && WS_U + (size_t)MR * FF * 2 <= WS_END && WS_X1B + (size_t)MR * D * 2 <= WS_U && WS_PB + (size_t)MR * DPLE * 2 <= WS_NC, "ws map");
constexpr int LDS_BYTES = 147456, MISC_OFF = LDS_BYTES - 256;

#define GAS __attribute__((address_space(1)))
#define LAS __attribute__((address_space(3)))
typedef unsigned short bf16;
typedef unsigned v4u __attribute__((ext_vector_type(4)));
typedef unsigned v2u __attribute__((ext_vector_type(2)));
typedef float f32x4 __attribute__((ext_vector_type(4)));
typedef short bf16x8 __attribute__((ext_vector_type(8)));
typedef GAS unsigned gu32;
#define RLX_AGENT __ATOMIC_RELAXED, __HIP_MEMORY_SCOPE_AGENT
#define LDS_WAIT() asm volatile("s_waitcnt lgkmcnt(0)" ::: "memory")
#define VM_WAIT() asm volatile("s_waitcnt vmcnt(0)" ::: "memory")
#define LBAR() do { asm volatile("s_waitcnt lgkmcnt(0)" ::: "memory"); __builtin_amdgcn_s_barrier(); asm volatile("" ::: "memory"); } while (0)
__device__ __forceinline__ unsigned f2bf(float f) { unsigned u = __builtin_bit_cast(unsigned, f); return (u + 0x7fffu + ((u >> 16) & 1u)) >> 16; }
__device__ __forceinline__ unsigned pk2(float lo, float hi) { return f2bf(lo) | (f2bf(hi) << 16); }
__device__ __forceinline__ float bf2f(unsigned b) { return __builtin_bit_cast(float, b << 16); }
__device__ __forceinline__ float bflo(unsigned w) { return __builtin_bit_cast(float, w << 16); }
__device__ __forceinline__ float bfhi(unsigned w) { return __builtin_bit_cast(float, w & 0xffff0000u); }
__device__ __forceinline__ float logsig(float x) { return fminf(x, 0.f) - __logf(1.f + __expf(-fabsf(x))); }
__device__ __forceinline__ float sigmoidf(float x) { return 1.f / (1.f + __expf(-x)); }

#define XB_TMO      128
#define XB_XCNT(j)  (256  + 64 * (j))
#define XB_XSUB(j)  (1280 + 64 * (j))
#define XB_XGEN(j)  (2304 + 64 * (j))
#define XB_TOP      3328
#define XB_TOPGEN   3392
#define XCD_BAR_WORDS 3456
#define XB_SPIN_CAP (1u << 22)
__device__ __forceinline__ unsigned xb_ld(unsigned* p)              { return __hip_atomic_load(p, __ATOMIC_RELAXED, __HIP_MEMORY_SCOPE_AGENT); }
__device__ __forceinline__ unsigned xb_add(unsigned* p, unsigned v) { return __hip_atomic_fetch_add(p, v, __ATOMIC_RELAXED, __HIP_MEMORY_SCOPE_AGENT); }
__device__ __forceinline__ unsigned xb_xcc_id() { return (unsigned)__builtin_amdgcn_s_getreg((3 << 11) | 20) & 0xFu; }
#define XB_SPIN(cond, bar) do { unsigned _sp = 0; while (cond) { __builtin_amdgcn_s_sleep(1); \
    if ((++_sp & 255u) == 0u) { if (xb_ld(&(bar)[XB_TMO])) break; if (_sp > XB_SPIN_CAP) { atomicAdd(&(bar)[XB_TMO], 1u); break; } } } } while (0)
struct XcdBarrier { unsigned* bar; unsigned x; volatile LAS unsigned* st; };
__device__ __forceinline__ XcdBarrier xcd_barrier_post(unsigned* bar, volatile LAS unsigned* st) {
    XcdBarrier b; b.bar = bar; b.x = xb_xcc_id(); b.st = st;
    if (threadIdx.x == 0) (void)xb_add(&bar[XB_XCNT(b.x)], 1u);
    return b;
}
__device__ __forceinline__ void xcd_barrier_complete(unsigned* bar, unsigned x, unsigned& nloc, unsigned& nx) {
    const unsigned G = gridDim.x * gridDim.y * gridDim.z;
    unsigned sum, cnt, mine, sp = 0u;
    for (;;) {
        sum = 0u; cnt = 0u; mine = 0u;
#pragma unroll
        for (unsigned j = 0; j < 16; ++j) { const unsigned c = xb_ld(&bar[XB_XCNT(j)]); sum += c; cnt += (c > 0u) ? 1u : 0u; mine = (j == x) ? c : mine; }
        if (sum == G) break;
        __builtin_amdgcn_s_sleep(1);
        if ((++sp & 255u) == 0u) { if (xb_ld(&bar[XB_TMO])) break; if (sp > XB_SPIN_CAP) { atomicAdd(&bar[XB_TMO], 1u); break; } }
    }
    nloc = mine > 0u ? mine : 1u; nx = cnt > 0u ? cnt : 1u;
}
__device__ __forceinline__ void xcd_barrier(const XcdBarrier& b) {
    asm volatile("s_waitcnt vmcnt(0)" ::: "memory");
    __syncthreads();
    if (threadIdx.x == 0) {
        unsigned* bar = b.bar;
        __builtin_amdgcn_s_waitcnt(0);
        unsigned nloc = b.st[0], nx = b.st[1];
        if (nloc == 0u) { xcd_barrier_complete(bar, b.x, nloc, nx); b.st[0] = nloc; b.st[1] = nx; }
        const unsigned old = xb_add(&bar[XB_XSUB(b.x)], 1u);
        const unsigned gen = old / nloc;
        if (old + 1u == (gen + 1u) * nloc) {
            __builtin_amdgcn_fence(__ATOMIC_RELEASE, "agent");
            asm volatile("s_waitcnt vmcnt(0)" ::: "memory");
            const unsigned og = xb_add(&bar[XB_TOP], 1u);
            const unsigned tg = og / nx;
            if (og + 1u == (tg + 1u) * nx) xb_add(&bar[XB_TOPGEN], 1u);
            else XB_SPIN(xb_ld(&bar[XB_TOPGEN]) == tg, bar);
            __builtin_amdgcn_fence(__ATOMIC_ACQUIRE, "agent");
            xb_add(&bar[XB_XGEN(b.x)], 1u);
            asm volatile("s_waitcnt vmcnt(0)" ::: "memory");
        } else {
            XB_SPIN(xb_ld(&bar[XB_XGEN(b.x)]) == gen, bar);
            __builtin_amdgcn_fence(__ATOMIC_ACQUIRE, "agent");
            asm volatile("s_waitcnt vmcnt(0)" ::: "memory");
        }
    }
    __syncthreads();
}

struct Args { const float* in[26]; float* out; unsigned char* ws; int ph_lo, ph_hi, li, pad; };
typedef const Args __attribute__((address_space(4))) CArgs;
struct Frame {
    LAS unsigned char* lds;
    char* ldsg;
    int G;
    CArgs* a;
};
#define F_TID ((int)threadIdx.x)
#define F_LANE ((int)(threadIdx.x & 63))
#define F_WAVE (__builtin_amdgcn_readfirstlane((int)(threadIdx.x >> 6)))
#define IN_F(k) (F.a->in[k])
#define X_P IN_F(0)
#define X_S IN_F(1)
#define P_P IN_F(2)
#define P_S IN_F(3)
#define ST_C IN_F(4)
#define ST_N IN_F(5)
#define ST_M IN_F(6)
#define ST_CONV IN_F(7)
#define ST_S IN_F(8)
#define W_IN IN_F(9)
#define CONV_W IN_F(10)
#define CONV_B IN_F(11)
#define B_GATE CONSTF(IN_F(12))
#define W_A2 CONSTF(IN_F(13))
#define B_A CONSTF(IN_F(14))
#define G_MHEAD IN_F(15)
#define G_GHEAD IN_F(16)
#define W_OUT IN_F(17)
#define G_MIX IN_F(18)
#define G_MLP IN_F(19)
#define W1 IN_F(20)
#define W2 IN_F(21)
#define G_PLE IN_F(22)
#define W_PLE IN_F(23)
#define W_PG IN_F(24)
#define G_FINAL IN_F(25)
typedef const float __attribute__((address_space(4))) cfloat;
#define CONSTF(p) ((cfloat*)(unsigned long long)(p))
#define OUTP (F.a->out)
#define WSB (F.a->ws)
#define WIN_T ((bf16*)(WSB + WS_WIN))
#define WOUT_T ((bf16*)(WSB + WS_WOUT))
#define W1_T ((bf16*)(WSB + WS_W1))
#define W2_T ((bf16*)(WSB + WS_W2))
#define WPG_T ((bf16*)(WSB + WS_WPG))
#define WPLE_T ((bf16*)(WSB + WS_WPLE))
#define PBUF ((bf16*)(WSB + WS_PB))
#define R1B ((bf16*)(WSB + WS_R1))
#define PROJ ((bf16*)(WSB + WS_R2))
#define X1B ((bf16*)(WSB + WS_X1B))
#define UBUF ((bf16*)(WSB + WS_U))
#define CSM ((bf16*)(WSB + WS_CSM))
#define CSG ((bf16*)(WSB + WS_CSG))
#define NCS ((float*)(WSB + WS_NC))
#define MCS ((float*)(WSB + WS_MC))
#define SS1 ((float*)(WSB + CTL_SS1_B))
#define SS2 ((float*)(WSB + CTL_SS2_B))
#define SS3 ((float*)(WSB + CTL_SS3_B))
#define PPB ((bf16*)(WSB + WS_PP))

__device__ __forceinline__ float wave_sum(float v) {
#pragma unroll
    for (int o = 1; o < 64; o <<= 1) v += __shfl_xor(v, o);
    return v;
}
__device__ __forceinline__ float wave_max(float v) {
#pragma unroll
    for (int o = 1; o < 64; o <<= 1) v = fmaxf(v, __shfl_xor(v, o));
    return v;
}
template <int CTRL, int ROWMASK> __device__ __forceinline__ float dpp_f(float idv, float v) {
    return __builtin_bit_cast(float, __builtin_amdgcn_update_dpp(__builtin_bit_cast(int, idv), __builtin_bit_cast(int, v), CTRL, ROWMASK, 0xf, false));
}
__device__ __forceinline__ float wave_scan_sum(float v, int) {
    v += dpp_f<0x111, 0xf>(0.f, v); v += dpp_f<0x112, 0xf>(0.f, v); v += dpp_f<0x114, 0xf>(0.f, v); v += dpp_f<0x118, 0xf>(0.f, v);
    v += dpp_f<0x142, 0xa>(0.f, v); v += dpp_f<0x143, 0xc>(0.f, v);
    return v;
}
__device__ __forceinline__ float wave_scan_max(float v, int) {
    const float ninf = -__builtin_inff();
    v = fmaxf(v, dpp_f<0x111, 0xf>(ninf, v)); v = fmaxf(v, dpp_f<0x112, 0xf>(ninf, v)); v = fmaxf(v, dpp_f<0x114, 0xf>(ninf, v)); v = fmaxf(v, dpp_f<0x118, 0xf>(ninf, v));
    v = fmaxf(v, dpp_f<0x142, 0xa>(ninf, v)); v = fmaxf(v, dpp_f<0x143, 0xc>(ninf, v));
    return v;
}

__device__ __forceinline__ int win_src_col(int np) {
    if (np < 2048) return np;
    if (np < 3584) return np + 8;
    const int j = np - 3584;
    if (j < 8) return 2048 + j;
    if (j < 24) return 3592 + (j - 8);
    return -1;
}
template <int MODE>
__device__ __forceinline__ void p0_transpose_item(const float* W, int K, int N, bf16* WT, const float* gain, LAS float* scr, int item, int nblk, int lane) {
    const int kb = item / nblk, nb = item % nblk, k0 = 64 * kb, n0 = 32 * nb;
    int src = n0 + (lane & 31); float cs = 1.f;
    if (MODE == 1) { const int np = n0 + (lane & 31); src = win_src_col(np); if (np >= C_GQ && np < C_GK) cs = 0.125f; }
#pragma unroll 8
    for (int i = 0; i < 32; ++i) { const int kk = 2 * i + (lane >> 5); float v = 0.f; if (src >= 0) v = W[(size_t)(k0 + kk) * N + src] * cs; if (gain) v *= gain[k0 + kk]; scr[kk * 33 + (lane & 31)] = v; }
    LDS_WAIT(); asm volatile("" ::: "memory");
    const int c = lane & 7;
#pragma unroll
    for (int j = 0; j < 4; ++j) { const int n = (lane >> 3) + 8 * j; const LAS float* s = scr + (8 * c) * 33 + n;
        v4u o; o.x = pk2(s[0 * 33], s[1 * 33]); o.y = pk2(s[2 * 33], s[3 * 33]); o.z = pk2(s[4 * 33], s[5 * 33]); o.w = pk2(s[6 * 33], s[7 * 33]);
        *(GAS v4u*)(WT + (size_t)(n0 + n) * K + k0 + 8 * c) = o; }
    LDS_WAIT(); asm volatile("" ::: "memory");
}
__device__ __forceinline__ void p0_prologue(Frame& F) {
    LAS float* scr = (LAS float*)(F.lds + F_WAVE * 16384);
    const int gw = blockIdx.x * NWAVES + F_WAVE, NGW = F.G * NWAVES;
    constexpr int NB_IN = PS / 32, NB_D = D / 32, NB_FF = FF / 32;
    constexpr int I_IN = (D / 64) * NB_IN, I_OUT = (D / 64) * NB_D, I_1 = (D / 64) * NB_FF, I_2 = (FF / 64) * NB_D, I_PG = I_OUT, I_PLE = (DPLE / 64) * NB_D;
    constexpr int NITEMS = I_IN + I_OUT + I_1 + I_2 + I_PG + I_PLE;
    for (int it = gw; it < NITEMS; it += NGW) {
        int r = it;
        if (r < I_IN) { p0_transpose_item<1>(W_IN, D, 3608, WIN_T, G_MIX, scr, r, NB_IN, F_LANE); continue; } r -= I_IN;
        if (r < I_OUT) { p0_transpose_item<0>(W_OUT, D, D, WOUT_T, nullptr, scr, r, NB_D, F_LANE); continue; } r -= I_OUT;
        if (r < I_1) { p0_transpose_item<0>(W1, D, FF, W1_T, G_MLP, scr, r, NB_FF, F_LANE); continue; } r -= I_1;
        if (r < I_2) { p0_transpose_item<0>(W2, FF, D, W2_T, nullptr, scr, r, NB_D, F_LANE); continue; } r -= I_2;
        if (r < I_PG) { p0_transpose_item<0>(W_PG, D, D, WPG_T, G_PLE, scr, r, NB_D, F_LANE); continue; } r -= I_PG;
        p0_transpose_item<0>(W_PLE, DPLE, D, WPLE_T, nullptr, scr, r, NB_D, F_LANE);
    }
    for (int m = gw; m < MV; m += NGW) {
        const float* xrow = m < MP ? X_P + (size_t)m * D : X_S + (size_t)(m - MP) * D;
        const GAS f32x4* xr = (const GAS f32x4*)xrow + F_LANE;
        f32x4 v[4]; float s = 0.f;
#pragma unroll
        for (int j = 0; j < 4; ++j) { v[j] = xr[64 * j]; s += (v[j].x * v[j].x + v[j].y * v[j].y) + (v[j].z * v[j].z + v[j].w * v[j].w); }
        const float r = 1.f / sqrtf(wave_sum(s) * (1.f / D) + EPS);
        GAS unsigned long long* o8 = (GAS unsigned long long*)(R1B + (size_t)m * D) + F_LANE;
#pragma unroll
        for (int j = 0; j < 4; ++j) o8[64 * j] = (unsigned long long)pk2(v[j].x * r, v[j].y * r) | ((unsigned long long)pk2(v[j].z * r, v[j].w * r) << 32);
        const float* prow = m < MP ? P_P + (size_t)m * DPLE : P_S + (size_t)(m - MP) * DPLE;
        const f32x4 pv = ((const GAS f32x4*)prow)[F_LANE];
        ((GAS unsigned long long*)(PBUF + (size_t)m * DPLE))[F_LANE] = (unsigned long long)pk2(pv.x, pv.y) | ((unsigned long long)pk2(pv.z, pv.w) << 32);
    }
}

struct EpiProj {
    static constexpr bool PERM = true;
    bf16* O; int ldc;
    __device__ __forceinline__ void operator()(const f32x4 (&acc)[2][2][4][2], const pg8::Unit& u, int wr, int wc, int fr, int fq) const {
        const int row0 = u.pm * 256 + wr * 64 + fr, col0 = u.pn * 256 + wc * 32 + 8 * fq;
#pragma unroll
        for (int ai = 0; ai < 2; ++ai)
#pragma unroll
            for (int m = 0; m < 4; ++m) { bf16* rowp = O + (size_t)(row0 + ai * 128 + m * 16) * ldc + col0;
#pragma unroll
                for (int bj = 0; bj < 2; ++bj) { const f32x4 v0 = acc[ai][bj][m][0], v1 = acc[ai][bj][m][1];
                    v4u w; w.x = pg8::cvt_pk_bf16(v0[0], v0[1]); w.y = pg8::cvt_pk_bf16(v0[2], v0[3]); w.z = pg8::cvt_pk_bf16(v1[0], v1[1]); w.w = pg8::cvt_pk_bf16(v1[2], v1[3]);
                    *(v4u*)(rowp + bj * 128) = w; } }
    }
};
struct EpiRes {
    static constexpr bool PERM = true;
    const float* res_p; const float* res_s; float* out; bf16* ob; float* ss; bool dry;
    __device__ __forceinline__ void operator()(const f32x4 (&acc)[2][2][4][2], const pg8::Unit& u, int wr, int wc, int fr, int fq) const {
        const int row0 = u.pm * 256 + wr * 64 + fr, col0 = u.pn * 256 + wc * 32 + 8 * fq;
#pragma unroll
        for (int ai = 0; ai < 2; ++ai)
#pragma unroll
            for (int m = 0; m < 4; ++m) { const int row = row0 + ai * 128 + m * 16; const bool valid = row < MV;
                const float* rp = (row < MP ? res_p + (size_t)row * D : res_s + (size_t)(row - MP) * D) + col0;
                float s = 0.f;
#pragma unroll
                for (int bj = 0; bj < 2; ++bj) {
                    f32x4 r0 = (f32x4){0.f, 0.f, 0.f, 0.f}, r1 = r0;
                    if (valid) { r0 = *(const f32x4*)(rp + bj * 128); r1 = *(const f32x4*)(rp + bj * 128 + 4); }
                    const f32x4 v0 = acc[ai][bj][m][0] + r0, v1 = acc[ai][bj][m][1] + r1;
                    if (valid && !dry) { float* op = out + (size_t)row * D + col0 + bj * 128; *(f32x4*)op = v0; *(f32x4*)(op + 4) = v1; }
                    v4u w; w.x = pg8::cvt_pk_bf16(v0[0], v0[1]); w.y = pg8::cvt_pk_bf16(v0[2], v0[3]); w.z = pg8::cvt_pk_bf16(v1[0], v1[1]); w.w = pg8::cvt_pk_bf16(v1[2], v1[3]);
                    *(v4u*)(ob + (size_t)row * D + col0 + bj * 128) = w;
                    s += (v0[0] * v0[0] + v0[1] * v0[1]) + (v0[2] * v0[2] + v0[3] * v0[3]) + (v1[0] * v1[0] + v1[1] * v1[1]) + (v1[2] * v1[2] + v1[3] * v1[3]);
                }
                s += __shfl_xor(s, 16); s += __shfl_xor(s, 32);
                if (fq == 0) atomicAdd(ss + row, s);
                asm volatile("" ::: "memory"); }
    }
};
struct EpiU {
    static constexpr bool PERM = true;
    bf16* O; const float* ss;
    __device__ __forceinline__ void operator()(const f32x4 (&acc)[2][2][4][2], const pg8::Unit& u, int wr, int wc, int fr, int fq) const {
        const int row0 = u.pm * 256 + wr * 64 + fr, col0 = u.pn * 256 + wc * 32 + 8 * fq;
#pragma unroll
        for (int ai = 0; ai < 2; ++ai)
#pragma unroll
            for (int m = 0; m < 4; ++m) { const int row = row0 + ai * 128 + m * 16; const float r = 1.f / sqrtf(ss[row] * (1.f / D) + EPS);
                bf16* rowp = O + (size_t)row * FF + col0;
#pragma unroll
                for (int bj = 0; bj < 2; ++bj) { f32x4 v0 = acc[ai][bj][m][0] * r, v1 = acc[ai][bj][m][1] * r;
#pragma unroll
                    for (int j = 0; j < 4; ++j) { const float a = fmaxf(v0[j], 0.f), b = fmaxf(v1[j], 0.f); v0[j] = a * a; v1[j] = b * b; }
                    v4u w; w.x = pg8::cvt_pk_bf16(v0[0], v0[1]); w.y = pg8::cvt_pk_bf16(v0[2], v0[3]); w.z = pg8::cvt_pk_bf16(v1[0], v1[1]); w.w = pg8::cvt_pk_bf16(v1[2], v1[3]);
                    *(v4u*)(rowp + bj * 128) = w; } }
    }
};
struct EpiPle {
    static constexpr bool PERM = true;
    float* out; const bf16* Pp; const float* ss2; float* ss3; bool dry;
    __device__ __forceinline__ void operator()(const f32x4 (&acc)[2][2][4][2], const pg8::Unit& u, int wr, int wc, int fr, int fq) const {
        const int row0 = u.pm * 256 + wr * 64 + fr, col0 = u.pn * 256 + wc * 32 + 8 * fq;
#pragma unroll
        for (int ai = 0; ai < 2; ++ai)
#pragma unroll
            for (int m = 0; m < 4; ++m) { const int row = row0 + ai * 128 + m * 16; const bool valid = row < MV;
                const float r = 1.f / sqrtf(ss2[row] * (1.f / D) + EPS);
                float s = 0.f;
#pragma unroll
                for (int bj = 0; bj < 2; ++bj) {
                    const size_t off = (size_t)row * D + col0 + bj * 128;
                    const v4u pw = *(const v4u*)(Pp + off);
#pragma unroll
                    for (int n = 0; n < 2; ++n) {
                        f32x4 x0 = (f32x4){0.f, 0.f, 0.f, 0.f};
                        if (valid) x0 = *(const f32x4*)(out + off + 4 * n);
                        const float p0[4] = {bflo(pw[2 * n]), bfhi(pw[2 * n]), bflo(pw[2 * n + 1]), bfhi(pw[2 * n + 1])};
                        f32x4 v0;
#pragma unroll
                        for (int j = 0; j < 4; ++j) v0[j] = x0[j] + p0[j] * sigmoidf(acc[ai][bj][m][n][j] * r);
                        if (valid && !dry) *(f32x4*)(out + off + 4 * n) = v0;
                        s += (v0[0] * v0[0] + v0[1] * v0[1]) + (v0[2] * v0[2] + v0[3] * v0[3]);
                    }
                    asm volatile("" ::: "memory");
                }
                s += __shfl_xor(s, 16); s += __shfl_xor(s, 32);
                if (fq == 0) atomicAdd(ss3 + row, s);
                asm volatile("" ::: "memory"); }
    }
};

__device__ __forceinline__ f32x4 mfma16(bf16x8 a, bf16x8 b, f32x4 c) { return __builtin_amdgcn_mfma_f32_16x16x32_bf16(a, b, c, 0, 0, 0); }
__device__ __forceinline__ bf16x8 lds_frag(const char* p) { return *(const bf16x8*)p; }
constexpr int TS = 144;
constexpr int QS_P = 272;
constexpr float KSCALE = 0.08838834764831845f;

constexpr int PFD = 4;
__device__ __forceinline__ void chain_mlstm(Frame& F, int b, int h, int sl) {
    char* L = F.ldsg;
    constexpr int KT_B = 64 * TS, VT_B = 128 * TS, NP_B = 16 * 64 * 4, BUF_B = KT_B + VT_B + NP_B;
    float* WK = (float*)(L + 2 * BUF_B); float* PM = WK + 2048; float* BLs = PM + 32; float* MX = BLs + 32; float* MCc = MX + 32; float* CSs = MCc + 40;
    const int tid = F_TID, lane = F_LANE, w = F_WAVE, r = lane & 15, g = lane >> 4;
    const int bh = b * 4 + h; const size_t rowb = (size_t)b * SEQ;
    const bf16* P = PROJ;
    { const float bgi = B_GATE[h], bgf = B_GATE[4 + h];
      for (int c = w; c < NCH; c += 8) { const size_t row = rowb + c * 64 + lane;
          const float ig = bf2f(P[row * PS + C_SM + h]) + bgi, lf = logsig(bf2f(P[row * PS + C_SM + 4 + h]) + bgf);
          const float bc = wave_scan_sum(lf, lane), a = ig - bc; const float pmax = wave_max(a);
          WK[c * 64 + lane] = a; if (lane == 63) { PM[c] = pmax; BLs[c] = bc; } } }
    __syncthreads();
    if (tid == 0) { float m = 0.f; for (int c = 0; c < NCH; ++c) { const float M = fmaxf(m, PM[c]); MCc[c] = m; MX[c] = M; CSs[c] = __expf(m - M); m = BLs[c] + M; } MCc[32] = m; }
    __syncthreads();
    for (int i = tid; i < SEQ; i += 512) WK[i] = __expf(WK[i] - MX[i >> 6]);
    __syncthreads();
    const int dpk = tid & 31, tg = tid >> 5, dpv = tid & 63, sg = tid >> 6;
    const int chk = 512 + h * 128 + 64 * sl + 2 * dpk;
    float cw[4][2], cb[2];
#pragma unroll
    for (int j = 0; j < 4; ++j) { cw[j][0] = CONV_W[j * 1024 + chk]; cw[j][1] = CONV_W[j * 1024 + chk + 1]; }
    cb[0] = CONV_B[chk]; cb[1] = CONV_B[chk + 1];
    const int dt = w & 3, eb = 4 * (w >> 2);
    f32x4 acc[4];
#pragma unroll
    for (int i = 0; i < 4; ++i) acc[i] = (f32x4){0.f, 0.f, 0.f, 0.f};
    float nst = 0.f;
    unsigned krq[PFD][7], vrq[PFD][8];
    const bf16* kbase = P + rowb * PS + C_MK + h * 128 + 64 * sl + 2 * dpk; const bf16* vbase = P + rowb * PS + C_MV + h * 128 + 2 * dpv;
#pragma unroll
    for (int q = 0; q < PFD; ++q) {
#pragma unroll
        for (int i = 0; i < 7; ++i) { const int t = 64 * q + 4 * tg - 3 + i; krq[q][i] = (t >= 0) ? *(const unsigned*)(kbase + (size_t)t * PS) : 0u; }
#pragma unroll
        for (int i = 0; i < 8; ++i) vrq[q][i] = *(const unsigned*)(vbase + (size_t)(64 * q + 8 * sg + i) * PS);
    }
    for (int c = 0; c < NCH; ++c) {
        char* KT = L + (c & 1) * BUF_B; char* VT = KT + KT_B; float* NP = (float*)(VT + VT_B);
        const int t0 = c * 64;
        unsigned kr[7], vr[8];
#pragma unroll
        for (int i = 0; i < 7; ++i) kr[i] = krq[0][i];
#pragma unroll
        for (int i = 0; i < 8; ++i) vr[i] = vrq[0][i];
#pragma unroll
        for (int q = 0; q + 1 < PFD; ++q) {
#pragma unroll
            for (int i = 0; i < 7; ++i) krq[q][i] = krq[q + 1][i];
#pragma unroll
            for (int i = 0; i < 8; ++i) vrq[q][i] = vrq[q + 1][i];
        }
        if (c + PFD < NCH) {
#pragma unroll
            for (int i = 0; i < 7; ++i) krq[PFD - 1][i] = *(const unsigned*)(kbase + (size_t)(t0 + 64 * PFD + 4 * tg - 3 + i) * PS);
#pragma unroll
            for (int i = 0; i < 8; ++i) vrq[PFD - 1][i] = *(const unsigned*)(vbase + (size_t)(t0 + 64 * PFD + 8 * sg + i) * PS);
        }
        { bf16* cst = CSM + (size_t)(bh * NCH + c) * 16384;
#pragma unroll
          for (int i = 0; i < 4; ++i) { const int e = 16 * (eb + i) + r, d = 64 * sl + 16 * dt + 4 * g;
              *(v2u*)(cst + e * 128 + d) = (v2u){pg8::cvt_pk_bf16(acc[i][0], acc[i][1]), pg8::cvt_pk_bf16(acc[i][2], acc[i][3])}; }
          if (tid < 64) NCS[(size_t)(bh * NCH + c) * 128 + 64 * sl + tid] = nst;
          if (tid == 0 && sl == 0) MCS[bh * NCH + c] = MCc[c]; }
        { const f32x4 wk4 = *(const f32x4*)(WK + t0 + 4 * tg);
          float y[4][2]; float ns0 = 0.f, ns1 = 0.f;
#pragma unroll
          for (int i = 0; i < 4; ++i) { float a0 = cb[0], a1 = cb[1];
#pragma unroll
              for (int j = 0; j < 4; ++j) { a0 += cw[j][0] * bflo(kr[i + j]); a1 += cw[j][1] * bfhi(kr[i + j]); }
              const float wki = wk4[i] * KSCALE;
              y[i][0] = a0 * sigmoidf(a0) * wki; y[i][1] = a1 * sigmoidf(a1) * wki; ns0 += y[i][0]; ns1 += y[i][1]; }
          *(v2u*)(KT + (2 * dpk) * TS + 8 * tg) = (v2u){pk2(y[0][0], y[1][0]), pk2(y[2][0], y[3][0])};
          *(v2u*)(KT + (2 * dpk + 1) * TS + 8 * tg) = (v2u){pk2(y[0][1], y[1][1]), pk2(y[2][1], y[3][1])};
          NP[tg * 64 + 2 * dpk] = ns0; NP[tg * 64 + 2 * dpk + 1] = ns1; }
        { unsigned v0p[4], v1p[4];
#pragma unroll
          for (int i = 0; i < 8; i += 2) { v0p[i >> 1] = (vr[i] & 0xffffu) | (vr[i + 1] << 16); v1p[i >> 1] = (vr[i] >> 16) | (vr[i + 1] & 0xffff0000u); }
          *(v4u*)(VT + (2 * dpv) * TS + 16 * sg) = (v4u){v0p[0], v0p[1], v0p[2], v0p[3]};
          *(v4u*)(VT + (2 * dpv + 1) * TS + 16 * sg) = (v4u){v1p[0], v1p[1], v1p[2], v1p[3]}; }
        LBAR();
        const float cs = CSs[c];
        if (tid < 64) { float s = 0.f;
#pragma unroll
            for (int q = 0; q < 16; ++q) s += NP[q * 64 + tid];
            nst = cs * nst + s; }
#pragma unroll
        for (int i = 0; i < 4; ++i) acc[i] = acc[i] * cs;
#pragma unroll
        for (int kk = 0; kk < 2; ++kk) {
            const bf16x8 af = lds_frag(KT + (16 * dt + r) * TS + (32 * kk + 8 * g) * 2);
#pragma unroll
            for (int i = 0; i < 4; ++i) acc[i] = mfma16(af, lds_frag(VT + (16 * (eb + i) + r) * TS + (32 * kk + 8 * g) * 2), acc[i]);
        }
    }
    { float* Co = OUTP + O_CP + (size_t)bh * 16384;
#pragma unroll
      for (int i = 0; i < 4; ++i)
#pragma unroll
          for (int j = 0; j < 4; ++j) Co[(64 * sl + 16 * dt + 4 * g + j) * 128 + 16 * (eb + i) + r] = acc[i][j];
      if (tid < 64) OUTP[O_NP + (size_t)bh * 128 + 64 * sl + tid] = nst;
      if (tid == 0 && sl == 0) OUTP[O_MP + bh] = MCc[32]; }
    __syncthreads();
}

__device__ __forceinline__ void chain_gla(Frame& F, int b, int hg, int sl) {
    char* L = F.ldsg;
    constexpr int KT_B = 32 * TS, VT_B = 128 * TS, EB_B = 32 * 4, BUF_B = KT_B + VT_B + EB_B;
    const int tid = F_TID, lane = F_LANE, w = F_WAVE, r = lane & 15, g = lane >> 4;
    const int bh = b * 4 + hg; const size_t rowb = (size_t)b * SEQ;
    const bf16* P = PROJ;
    const int dpv = tid & 63, sg = tid >> 6;
    const int dt = w & 1, eb = 2 * (w >> 1);
    const int ch0 = hg * 64 + 32 * sl + 4 * w;
    f32x4 acc[2];
    acc[0] = (f32x4){0.f, 0.f, 0.f, 0.f}; acc[1] = acc[0];
    v4u ga0q[PFD], ga1q[PFD]; v2u k4q[PFD]; unsigned vrq[PFD][8];
    const bf16* gbase = P + (rowb + lane) * PS; const bf16* vbase = P + rowb * PS + C_GV + hg * 128 + 2 * dpv;
#pragma unroll
    for (int q = 0; q < PFD; ++q) { const bf16* gp = gbase + (size_t)(64 * q) * PS;
        ga0q[q] = *(const v4u*)(gp + C_SM + 8); ga1q[q] = *(const v4u*)(gp + C_SM + 16); k4q[q] = *(const v2u*)(gp + C_GK + ch0);
#pragma unroll
        for (int i = 0; i < 8; ++i) vrq[q][i] = *(const unsigned*)(vbase + (size_t)(64 * q + 8 * sg + i) * PS); }
    for (int c = 0; c < NCH; ++c) {
        char* KT = L + (c & 1) * BUF_B; char* VT = KT + KT_B; float* EBL = (float*)(VT + VT_B);
        const int t0 = c * 64;
        const v4u ga0 = ga0q[0], ga1 = ga1q[0]; const v2u k4 = k4q[0]; unsigned vr[8];
#pragma unroll
        for (int i = 0; i < 8; ++i) vr[i] = vrq[0][i];
#pragma unroll
        for (int q = 0; q + 1 < PFD; ++q) { ga0q[q] = ga0q[q + 1]; ga1q[q] = ga1q[q + 1]; k4q[q] = k4q[q + 1];
#pragma unroll
            for (int i = 0; i < 8; ++i) vrq[q][i] = vrq[q + 1][i]; }
        if (c + PFD < NCH) { const bf16* gp = gbase + (size_t)(t0 + 64 * PFD) * PS;
            ga0q[PFD - 1] = *(const v4u*)(gp + C_SM + 8); ga1q[PFD - 1] = *(const v4u*)(gp + C_SM + 16); k4q[PFD - 1] = *(const v2u*)(gp + C_GK + ch0);
#pragma unroll
            for (int i = 0; i < 8; ++i) vrq[PFD - 1][i] = *(const unsigned*)(vbase + (size_t)(t0 + 64 * PFD + 8 * sg + i) * PS); }
        { bf16* cst = CSG + (size_t)(bh * NCH + c) * 8192;
#pragma unroll
          for (int i = 0; i < 2; ++i) { const int e = 16 * (eb + i) + r, d = 32 * sl + 16 * dt + 4 * g;
              *(v2u*)(cst + e * 64 + d) = (v2u){pg8::cvt_pk_bf16(acc[i][0], acc[i][1]), pg8::cvt_pk_bf16(acc[i][2], acc[i][3])}; } }
        { float ga[16];
#pragma unroll
          for (int i = 0; i < 4; ++i) { ga[2 * i] = bflo(ga0[i]); ga[2 * i + 1] = bfhi(ga0[i]); ga[8 + 2 * i] = bflo(ga1[i]); ga[8 + 2 * i + 1] = bfhi(ga1[i]); }
#pragma unroll
          for (int dd = 0; dd < 4; ++dd) { const int col = ch0 + dd;
              float z = B_A[col];
#pragma unroll
              for (int q = 0; q < 16; ++q) z += ga[q] * W_A2[q * 256 + col];
              const float bc = wave_scan_sum(logsig(z) * (1.f / 16.f), lane); const float bLd = __shfl(bc, 63);
              const float kv = (dd & 1) ? bfhi(k4[dd >> 1]) : bflo(k4[dd >> 1]);
              *(bf16*)(KT + (4 * w + dd) * TS + 2 * lane) = (bf16)f2bf(kv * __expf(bLd - bc));
              if (lane == 0) EBL[4 * w + dd] = __expf(bLd); } }
        { unsigned v0p[4], v1p[4];
#pragma unroll
          for (int i = 0; i < 8; i += 2) { v0p[i >> 1] = (vr[i] & 0xffffu) | (vr[i + 1] << 16); v1p[i >> 1] = (vr[i] >> 16) | (vr[i + 1] & 0xffff0000u); }
          *(v4u*)(VT + (2 * dpv) * TS + 16 * sg) = (v4u){v0p[0], v0p[1], v0p[2], v0p[3]};
          *(v4u*)(VT + (2 * dpv + 1) * TS + 16 * sg) = (v4u){v1p[0], v1p[1], v1p[2], v1p[3]}; }
        LBAR();
        { const f32x4 eb4 = *(const f32x4*)(EBL + 16 * dt + 4 * g); acc[0] = acc[0] * eb4; acc[1] = acc[1] * eb4; }
#pragma unroll
        for (int kk = 0; kk < 2; ++kk) {
            const bf16x8 af = lds_frag(KT + (16 * dt + r) * TS + (32 * kk + 8 * g) * 2);
#pragma unroll
            for (int i = 0; i < 2; ++i) acc[i] = mfma16(af, lds_frag(VT + (16 * (eb + i) + r) * TS + (32 * kk + 8 * g) * 2), acc[i]);
        }
    }
    { float* So = OUTP + O_SP + (size_t)bh * 8192;
#pragma unroll
      for (int i = 0; i < 2; ++i)
#pragma unroll
          for (int j = 0; j < 4; ++j) So[(32 * sl + 16 * dt + 4 * g + j) * 128 + 16 * (eb + i) + r] = acc[i][j]; }
    __syncthreads();
}

__device__ __forceinline__ void sample_item(Frame& F, int n, int hh, float* Wl, int lane) {
    asm volatile("" : "+v"(lane));
    float* qv = Wl; float* kv = Wl + 128; float* vv = Wl + 256; float* al = Wl + 384;
    const size_t row = (size_t)MP + n;
    const bf16* Pr = PROJ + row * PS;
    const bool gla = hh >= 4; const int h = hh & 3;
    const int e4 = lane & 31, dh = lane >> 5;
    float cs = 1.f, wkk = 1.f, dinv = 1.f;
    if (!gla) {
        float qk2[2][2];
#pragma unroll
        for (int isk = 0; isk < 2; ++isk)
#pragma unroll
            for (int q = 0; q < 2; ++q) { const int d = lane + 64 * q, ch = isk * 512 + h * 128 + d;
                const float* scv = ST_CONV + (size_t)n * 3 * 1024 + ch;
                float a = CONV_B[ch] + CONV_W[ch] * scv[0] + CONV_W[1024 + ch] * scv[1024] + CONV_W[2048 + ch] * scv[2048] + CONV_W[3072 + ch] * bf2f(Pr[(isk ? C_MK : C_MQ) + h * 128 + d]);
                a = a * sigmoidf(a); if (isk) a *= KSCALE; qk2[isk][q] = a; (isk ? kv : qv)[d] = a; }
        vv[lane] = bf2f(Pr[C_MV + h * 128 + lane]); vv[lane + 64] = bf2f(Pr[C_MV + h * 128 + lane + 64]);
        const float* n0 = ST_N + ((size_t)n * 4 + h) * 128; const float n00 = n0[lane], n01 = n0[lane + 64];
        const float qk = wave_sum(qk2[0][0] * qk2[1][0] + qk2[0][1] * qk2[1][1]), qn = wave_sum(qk2[0][0] * n00 + qk2[0][1] * n01);
        const float ig = bf2f(Pr[C_SM + h]) + B_GATE[h], lf = logsig(bf2f(Pr[C_SM + 4 + h]) + B_GATE[4 + h]);
        const float m0 = ST_M[n * 4 + h], mn = fmaxf(lf + m0, ig);
        wkk = __expf(ig - mn); cs = __expf(lf + m0 - mn);
        const float den = cs * qn + qk * wkk;
        dinv = 1.f / fmaxf(fabsf(den), __expf(-mn));
        float* nsO = OUTP + O_NS + ((size_t)n * 4 + h) * 128; nsO[lane] = cs * n00 + wkk * qk2[1][0]; nsO[lane + 64] = cs * n01 + wkk * qk2[1][1];
        if (lane == 0) OUTP[O_MS + n * 4 + h] = mn;
    } else {
        qv[lane] = bf2f(Pr[C_GQ + h * 64 + lane]); kv[lane] = bf2f(Pr[C_GK + h * 64 + lane]);
        vv[lane] = bf2f(Pr[C_GV + h * 128 + lane]); vv[lane + 64] = bf2f(Pr[C_GV + h * 128 + lane + 64]);
        { const int col = h * 64 + lane; float z = B_A[col];
#pragma unroll
          for (int q = 0; q < 16; ++q) z += bf2f(Pr[C_SM + 8 + q]) * IN_F(13)[q * 256 + col];
          al[lane] = __expf(logsig(z) * (1.f / 16.f)); }
    }
    asm volatile("s_waitcnt lgkmcnt(0)" ::: "memory");
    const f32x4 v4 = *(const f32x4*)(vv + 4 * e4);
    f32x4 hp = (f32x4){0.f, 0.f, 0.f, 0.f};
    if (!gla) {
        const float* C0 = ST_C + ((size_t)n * 4 + h) * 16384 + (size_t)(64 * dh) * 128 + 4 * e4; float* Cn = OUTP + O_CS + ((size_t)n * 4 + h) * 16384 + (size_t)(64 * dh) * 128 + 4 * e4;
        for (int i0 = 0; i0 < 64; i0 += 8) { f32x4 c0[8];
#pragma unroll
            for (int i = 0; i < 8; ++i) c0[i] = *(const f32x4*)(C0 + (i0 + i) * 128);
#pragma unroll
            for (int i = 0; i < 8; ++i) { const int d = 64 * dh + i0 + i; const f32x4 cn = c0[i] * cs + v4 * (wkk * kv[d]); *(f32x4*)(Cn + (i0 + i) * 128) = cn; hp += cn * qv[d]; } }
    } else {
        const float* S0 = ST_S + ((size_t)n * 4 + h) * 8192 + (size_t)(32 * dh) * 128 + 4 * e4; float* Sn = OUTP + O_SS + ((size_t)n * 4 + h) * 8192 + (size_t)(32 * dh) * 128 + 4 * e4;
        for (int i0 = 0; i0 < 32; i0 += 8) { f32x4 c0[8];
#pragma unroll
            for (int i = 0; i < 8; ++i) c0[i] = *(const f32x4*)(S0 + (i0 + i) * 128);
#pragma unroll
            for (int i = 0; i < 8; ++i) { const int d = 32 * dh + i0 + i; const f32x4 sn = c0[i] * al[d] + v4 * kv[d]; *(f32x4*)(Sn + (i0 + i) * 128) = sn; hp += sn * qv[d]; } }
    }
#pragma unroll
    for (int j = 0; j < 4; ++j) hp[j] += __shfl_xor(hp[j], 32);
    hp = hp * dinv;
    float ssum = (hp[0] * hp[0] + hp[1] * hp[1]) + (hp[2] * hp[2] + hp[3] * hp[3]);
#pragma unroll
    for (int o = 1; o < 32; o <<= 1) ssum += __shfl_xor(ssum, o);
    const float rn = 1.f / sqrtf(ssum * (1.f / 128.f) + EPS);
    if (lane < 32) {
        const v2u gw = *(const v2u*)(Pr + (gla ? C_GR : C_MO) + h * 128 + 4 * e4);
        const f32x4 g4 = *(const f32x4*)((gla ? G_GHEAD : G_MHEAD) + h * 128 + 4 * e4);
        const float gt[4] = {bflo(gw[0]), bfhi(gw[0]), bflo(gw[1]), bfhi(gw[1])}; float o[4];
#pragma unroll
        for (int j = 0; j < 4; ++j) { const float sg_ = sigmoidf(gt[j]); o[j] = hp[j] * rn * g4[j] * (gla ? gt[j] * sg_ : sg_); }
        int e4o = e4; asm volatile("" : "+v"(e4o));
        *(v2u*)(R1B + row * D + (gla ? 512 : 0) + h * 128 + 4 * e4o) = (v2u){pg8::cvt_pk_bf16(o[0], o[1]), pg8::cvt_pk_bf16(o[2], o[3])};
    }
    asm volatile("s_waitcnt lgkmcnt(0)" ::: "memory");
}

constexpr int P2B_QS = 0, P2B_KS = 64 * QS_P, P2B_VT = P2B_KS + 80 * QS_P, P2B_PS = P2B_VT + 128 * TS, P2B_FL = P2B_PS + 64 * TS, P2B_HALF = P2B_FL + 2304;
static_assert(2 * P2B_HALF <= MISC_OFF, "P2b LDS");
template <bool GLA>
__device__ __forceinline__ void p2b_unit(Frame& F, int u, char* L, int ltid, int lw, int lane) {
    const int v = u & 1023, bh = v >> 5, c = v & 31, b = bh >> 2, h = bh & 3, r = lane & 15, g = lane >> 4;
    const size_t rowb = (size_t)b * SEQ + c * 64;
    const bf16* P = PROJ;
    char* QSp = L + P2B_QS; char* KSp = L + P2B_KS; char* VTp = L + P2B_VT; char* PSp = L + P2B_PS;
    float* af = (float*)(L + P2B_FL); float* Mf = af + 64; float* scf = af + 128; float* enf = af + 192; float* dinvf = af + 256; float* ssq = af + 320;
    constexpr int QP = GLA ? TS : QS_P;
    constexpr int NK = GLA ? 2 : 4;
    bf16x8 cfr[2][NK];
    { const bf16* CT = GLA ? CSG + (size_t)(bh * NCH + c) * 8192 : CSM + (size_t)(bh * NCH + c) * 16384;
#pragma unroll
      for (int n2 = 0; n2 < 2; ++n2)
#pragma unroll
          for (int kk = 0; kk < NK; ++kk) cfr[n2][kk] = *(const bf16x8*)(CT + (32 * lw + 16 * n2 + r) * (GLA ? 64 : 128) + 32 * kk + 8 * g); }
    const int dp = ltid & 63, sg = ltid >> 6;
    if constexpr (!GLA) {
        { const size_t row = rowb + lane;
          const float ig = bf2f(P[row * PS + C_SM + h]) + B_GATE[h], lf = logsig(bf2f(P[row * PS + C_SM + 4 + h]) + B_GATE[4 + h]);
          const float bc = wave_scan_sum(lf, lane), a = ig - bc; const float pm = wave_scan_max(a, lane);
          const float mc = MCS[bh * NCH + c], Mt = fmaxf(mc, pm);
          if (lw == 0) { af[lane] = a; Mf[lane] = Mt; scf[lane] = __expf(mc - Mt); enf[lane] = __expf(-(bc + Mt)); } }
#pragma unroll
        for (int isk = 0; isk < 2; ++isk) {
            const int ch = isk * 512 + h * 128 + 2 * dp;
            float cw[4][2], cb[2];
#pragma unroll
            for (int j = 0; j < 4; ++j) { cw[j][0] = CONV_W[j * 1024 + ch]; cw[j][1] = CONV_W[j * 1024 + ch + 1]; }
            cb[0] = CONV_B[ch]; cb[1] = CONV_B[ch + 1];
            unsigned raw[19];
#pragma unroll
            for (int i = 0; i < 19; ++i) { const int t = c * 64 + 16 * sg - 3 + i; raw[i] = (t >= 0) ? *(const unsigned*)(P + ((size_t)b * SEQ + t) * PS + (isk ? C_MK : C_MQ) + h * 128 + 2 * dp) : 0u; }
            char* dst = (isk ? KSp : QSp) + 4 * dp;
#pragma unroll
            for (int i = 0; i < 16; ++i) { float a0 = cb[0], a1 = cb[1];
#pragma unroll
                for (int j = 0; j < 4; ++j) { a0 += cw[j][0] * bflo(raw[i + j]); a1 += cw[j][1] * bfhi(raw[i + j]); }
                a0 = a0 * sigmoidf(a0); a1 = a1 * sigmoidf(a1); if (isk) { a0 *= KSCALE; a1 *= KSCALE; }
                *(unsigned*)(dst + (16 * sg + i) * QS_P) = pk2(a0, a1); }
        }
        if (ltid < 128) *(bf16*)(KSp + 64 * QS_P + 2 * ltid) = (bf16)f2bf(NCS[(size_t)(bh * NCH + c) * 128 + ltid]);
        for (int i = ltid; i < 15 * 64; i += 256) *(unsigned*)(KSp + (65 + i / 64) * QS_P + 4 * (i & 63)) = 0u;
    } else {
        const size_t row = rowb + lane;
        const v4u ga0 = *(const v4u*)(P + row * PS + C_SM + 8), ga1 = *(const v4u*)(P + row * PS + C_SM + 16);
        const v4u q0 = *(const v4u*)(P + row * PS + C_GQ + h * 64 + 16 * lw), q1 = *(const v4u*)(P + row * PS + C_GQ + h * 64 + 16 * lw + 8);
        const v4u k0 = *(const v4u*)(P + row * PS + C_GK + h * 64 + 16 * lw), k1 = *(const v4u*)(P + row * PS + C_GK + h * 64 + 16 * lw + 8);
        float ga[16];
#pragma unroll
        for (int i = 0; i < 4; ++i) { ga[2 * i] = bflo(ga0[i]); ga[2 * i + 1] = bfhi(ga0[i]); ga[8 + 2 * i] = bflo(ga1[i]); ga[8 + 2 * i + 1] = bfhi(ga1[i]); }
        unsigned qo[8], ko[8];
#pragma unroll
        for (int dd = 0; dd < 16; dd += 2) {
            float qt[2], kt[2];
#pragma unroll
            for (int q2 = 0; q2 < 2; ++q2) { const int col = h * 64 + 16 * lw + dd + q2;
                float z = B_A[col];
#pragma unroll
                for (int q = 0; q < 16; ++q) z += ga[q] * W_A2[q * 256 + col];
                const float bc = wave_scan_sum(logsig(z) * (1.f / 16.f), lane);
                const unsigned qw = dd < 8 ? q0[dd >> 1] : q1[(dd - 8) >> 1], kw = dd < 8 ? k0[dd >> 1] : k1[(dd - 8) >> 1];
                qt[q2] = (q2 ? bfhi(qw) : bflo(qw)) * __expf(bc); kt[q2] = (q2 ? bfhi(kw) : bflo(kw)) * __expf(-bc); }
            qo[dd >> 1] = pk2(qt[0], qt[1]); ko[dd >> 1] = pk2(kt[0], kt[1]);
        }
        *(v4u*)(QSp + lane * TS + 32 * lw) = (v4u){qo[0], qo[1], qo[2], qo[3]}; *(v4u*)(QSp + lane * TS + 32 * lw + 16) = (v4u){qo[4], qo[5], qo[6], qo[7]};
        *(v4u*)(KSp + lane * TS + 32 * lw) = (v4u){ko[0], ko[1], ko[2], ko[3]}; *(v4u*)(KSp + lane * TS + 32 * lw + 16) = (v4u){ko[4], ko[5], ko[6], ko[7]};
    }
    {
      unsigned vr[16];
#pragma unroll
      for (int i = 0; i < 16; ++i) vr[i] = *(const unsigned*)(P + (rowb + 16 * sg + i) * PS + (GLA ? C_GV : C_MV) + h * 128 + 2 * dp);
      unsigned v0p[8], v1p[8];
#pragma unroll
      for (int i = 0; i < 16; i += 2) { v0p[i >> 1] = (vr[i] & 0xffffu) | (vr[i + 1] << 16); v1p[i >> 1] = (vr[i] >> 16) | (vr[i + 1] & 0xffff0000u); }
      *(v4u*)(VTp + (2 * dp) * TS + 32 * sg) = (v4u){v0p[0], v0p[1], v0p[2], v0p[3]}; *(v4u*)(VTp + (2 * dp) * TS + 32 * sg + 16) = (v4u){v0p[4], v0p[5], v0p[6], v0p[7]};
      *(v4u*)(VTp + (2 * dp + 1) * TS + 32 * sg) = (v4u){v1p[0], v1p[1], v1p[2], v1p[3]}; *(v4u*)(VTp + (2 * dp + 1) * TS + 32 * sg + 16) = (v4u){v1p[4], v1p[5], v1p[6], v1p[7]}; }
    __syncthreads();
    {
        f32x4 pa[5];
#pragma unroll
        for (int i = 0; i < 5; ++i) pa[i] = (f32x4){0.f, 0.f, 0.f, 0.f};
#pragma unroll
        for (int kk = 0; kk < NK; ++kk) {
            const bf16x8 qf = lds_frag(QSp + (16 * lw + r) * QP + (32 * kk + 8 * g) * 2);
#pragma unroll
            for (int nt = 0; nt < 4; ++nt) if (nt <= lw) pa[nt] = mfma16(lds_frag(KSp + (16 * nt + r) * QP + (32 * kk + 8 * g) * 2), qf, pa[nt]);
            if constexpr (!GLA) pa[4] = mfma16(lds_frag(KSp + (64 + r) * QP + (32 * kk + 8 * g) * 2), qf, pa[4]);
        }
        const int t = 16 * lw + r;
        float Mt = 0.f; if constexpr (!GLA) Mt = Mf[t];
        float rs = 0.f;
#pragma unroll
        for (int nt = 0; nt < 4; ++nt) {
            f32x4 p = (f32x4){0.f, 0.f, 0.f, 0.f};
            if (nt <= lw) {
                f32x4 a4 = (f32x4){0.f, 0.f, 0.f, 0.f}; if constexpr (!GLA) a4 = *(const f32x4*)(af + 16 * nt + 4 * g);
#pragma unroll
                for (int j = 0; j < 4; ++j) { const int s = 16 * nt + 4 * g + j; float x = pa[nt][j]; if constexpr (!GLA) x *= __expf(a4[j] - Mt); p[j] = (s <= t) ? x : 0.f; }
            }
            rs += (p[0] + p[1]) + (p[2] + p[3]);
            *(v2u*)(PSp + t * TS + (16 * nt + 4 * g) * 2) = (v2u){pg8::cvt_pk_bf16(p[0], p[1]), pg8::cvt_pk_bf16(p[2], p[3])};
        }
        if constexpr (!GLA) {
            rs += __shfl_xor(rs, 16); rs += __shfl_xor(rs, 32);
            if (g == 0) { const float den = scf[t] * pa[4][0] + rs; dinvf[t] = 1.f / fmaxf(fabsf(den), enf[t]); }
        }
    }
    __syncthreads();
    f32x4 hv[4][2];
    {
        f32x4 aV[4][2], aC[4][2];
#pragma unroll
        for (int mt = 0; mt < 4; ++mt)
#pragma unroll
            for (int n2 = 0; n2 < 2; ++n2) { aV[mt][n2] = (f32x4){0.f, 0.f, 0.f, 0.f}; aC[mt][n2] = (f32x4){0.f, 0.f, 0.f, 0.f}; }
#pragma unroll
        for (int kk = 0; kk < 2; ++kk) {
            bf16x8 vf[2];
#pragma unroll
            for (int n2 = 0; n2 < 2; ++n2) vf[n2] = lds_frag(VTp + (32 * lw + 16 * n2 + r) * TS + (32 * kk + 8 * g) * 2);
#pragma unroll
            for (int mt = 0; mt < 4; ++mt) { const bf16x8 pf = lds_frag(PSp + (16 * mt + r) * TS + (32 * kk + 8 * g) * 2);
#pragma unroll
                for (int n2 = 0; n2 < 2; ++n2) aV[mt][n2] = mfma16(vf[n2], pf, aV[mt][n2]); }
        }
#pragma unroll
        for (int kk = 0; kk < NK; ++kk)
#pragma unroll
            for (int mt = 0; mt < 4; ++mt) { const bf16x8 qf = lds_frag(QSp + (16 * mt + r) * QP + (32 * kk + 8 * g) * 2);
#pragma unroll
                for (int n2 = 0; n2 < 2; ++n2) aC[mt][n2] = mfma16(cfr[n2][kk], qf, aC[mt][n2]); }
#pragma unroll
        for (int mt = 0; mt < 4; ++mt) { const int t = 16 * mt + r;
            float sc = 1.f, di = 1.f; if constexpr (!GLA) { sc = scf[t]; di = dinvf[t]; }
            float s = 0.f;
#pragma unroll
            for (int n2 = 0; n2 < 2; ++n2) { hv[mt][n2] = (aC[mt][n2] * sc + aV[mt][n2]) * di;
                s += (hv[mt][n2][0] * hv[mt][n2][0] + hv[mt][n2][1] * hv[mt][n2][1]) + (hv[mt][n2][2] * hv[mt][n2][2] + hv[mt][n2][3] * hv[mt][n2][3]); }
            s += __shfl_xor(s, 16); s += __shfl_xor(s, 32);
            if (g == 0) ssq[t * 4 + lw] = s; }
    }
    __syncthreads();
    {
        const float* gn = (GLA ? G_GHEAD : G_MHEAD) + h * 128;
#pragma unroll
        for (int mt = 0; mt < 4; ++mt) { const int t = 16 * mt + r; const f32x4 s4 = *(const f32x4*)(ssq + 4 * t);
            const float rn = 1.f / sqrtf(((s4[0] + s4[1]) + (s4[2] + s4[3])) * (1.f / 128.f) + EPS);
#pragma unroll
            for (int n2 = 0; n2 < 2; ++n2) { const int e = 32 * lw + 16 * n2 + 4 * g;
                const v2u gw = *(const v2u*)(P + (rowb + t) * PS + (GLA ? C_GR : C_MO) + h * 128 + e);
                const f32x4 g4 = *(const f32x4*)(gn + e);
                float gt[4] = {bflo(gw[0]), bfhi(gw[0]), bflo(gw[1]), bfhi(gw[1])}; float o[4];
#pragma unroll
                for (int j = 0; j < 4; ++j) { const float sg_ = sigmoidf(gt[j]); o[j] = hv[mt][n2][j] * rn * g4[j] * (GLA ? gt[j] * sg_ : sg_); }
                *(v2u*)(R1B + (rowb + t) * D + (GLA ? 512 : 0) + h * 128 + e) = (v2u){pg8::cvt_pk_bf16(o[0], o[1]), pg8::cvt_pk_bf16(o[2], o[3])}; } }
    }
    __syncthreads();
}

template <int K>
__device__ __forceinline__ void skinny_acc(const bf16* A, const bf16* Bt, int sl, f32x4 (&acc)[8], int w, int r, int g) {
    constexpr int KW = K / 8, NKS = KW / 32, KB = NKS < 2 ? NKS : 2;
    const bf16* ap = A + (size_t)r * K + w * KW + 8 * g;
    const bf16* bp = Bt + (size_t)(sl * 16 + r) * K + w * KW + 8 * g;
#pragma unroll 1
    for (int ks = 0; ks < NKS; ks += KB) {
        bf16x8 bfr[KB], afr[8][KB];
#pragma unroll
        for (int kk = 0; kk < KB; ++kk) { bfr[kk] = *(const bf16x8*)(bp + 32 * (ks + kk));
#pragma unroll
            for (int rt = 0; rt < 8; ++rt) afr[rt][kk] = *(const bf16x8*)(ap + (size_t)rt * 16 * K + 32 * (ks + kk)); }
#pragma unroll
        for (int kk = 0; kk < KB; ++kk)
#pragma unroll
            for (int rt = 0; rt < 8; ++rt) acc[rt] = mfma16(bfr[kk], afr[rt][kk], acc[rt]);
    }
}
__device__ __forceinline__ void skinny_put(float* red, const f32x4 (&acc)[8], int w, int r, int g) {
#pragma unroll
    for (int rt = 0; rt < 8; ++rt) *(f32x4*)(red + w * 2048 + (16 * rt + r) * 16 + 4 * g) = acc[rt];
}
__device__ __forceinline__ f32x4 skinny_get(const float* red, int row, int c4) {
    f32x4 v = (f32x4){0.f, 0.f, 0.f, 0.f};
#pragma unroll
    for (int q = 0; q < 8; ++q) v += *(const f32x4*)(red + q * 2048 + row * 16 + 4 * c4);
    return v;
}
__device__ __forceinline__ void zero8(f32x4 (&acc)[8]) {
#pragma unroll
    for (int i = 0; i < 8; ++i) acc[i] = (f32x4){0.f, 0.f, 0.f, 0.f};
}
__device__ __forceinline__ float quad_sum(float s) { s += __shfl_xor(s, 1); s += __shfl_xor(s, 2); return s; }
__device__ __forceinline__ v2u pack4(f32x4 v) { return (v2u){pg8::cvt_pk_bf16(v[0], v[1]), pg8::cvt_pk_bf16(v[2], v[3])}; }
__device__ __forceinline__ void skinny_res(Frame& F, const bf16* A, const bf16* Bt, int K4096, const float* res, float* out, bf16* ob, float* ss) {
    float* red = (float*)F.ldsg; const int tid = F_TID, lane = F_LANE, w = F_WAVE, r = lane & 15, g = lane >> 4, row = tid >> 2, c4 = tid & 3;
    for (int sl = blockIdx.x; sl < D / 16; sl += F.G) {
        f32x4 acc[8]; zero8(acc);
        if (K4096) skinny_acc<FF>(A, Bt, sl, acc, w, r, g); else skinny_acc<D>(A, Bt, sl, acc, w, r, g);
        skinny_put(red, acc, w, r, g); LBAR();
        const int col = sl * 16 + 4 * c4;
        const f32x4 v = skinny_get(red, row, c4) + *(const f32x4*)(res + (size_t)row * D + col);
        *(f32x4*)(out + (size_t)row * D + col) = v; *(v2u*)(ob + (size_t)row * D + col) = pack4(v);
        const float s = quad_sum((v[0] * v[0] + v[1] * v[1]) + (v[2] * v[2] + v[3] * v[3]));
        if (c4 == 0) atomicAdd(ss + row, s);
        LBAR();
    }
}
__device__ __forceinline__ void skinny_up(Frame& F, const bf16* A, const bf16* Bt, const float* ss, bf16* U) {
    float* red = (float*)F.ldsg; const int tid = F_TID, lane = F_LANE, w = F_WAVE, r = lane & 15, g = lane >> 4, row = tid >> 2, c4 = tid & 3;
    for (int sl = blockIdx.x; sl < FF / 16; sl += F.G) {
        f32x4 acc[8]; zero8(acc);
        skinny_acc<D>(A, Bt, sl, acc, w, r, g);
        skinny_put(red, acc, w, r, g); LBAR();
        const float rs = 1.f / sqrtf(ss[row] * (1.f / D) + EPS);
        f32x4 v = skinny_get(red, row, c4) * rs;
#pragma unroll
        for (int j = 0; j < 4; ++j) { const float a = fmaxf(v[j], 0.f); v[j] = a * a; }
        *(v2u*)(U + (size_t)row * FF + sl * 16 + 4 * c4) = pack4(v);
        LBAR();
    }
}
__device__ __forceinline__ void skinny_ple(Frame& F, const bf16* pbs, const bf16* Wple, const bf16* x2b, const bf16* Wpg, const float* ss2, float* out, float* ss3) {
    float* red = (float*)F.ldsg; float* red2 = red + 8 * 2048; const int tid = F_TID, lane = F_LANE, w = F_WAVE, r = lane & 15, g = lane >> 4, row = tid >> 2, c4 = tid & 3;
    for (int sl = blockIdx.x; sl < D / 16; sl += F.G) {
        f32x4 acc[8]; zero8(acc);
        skinny_acc<DPLE>(pbs, Wple, sl, acc, w, r, g); skinny_put(red2, acc, w, r, g);
        zero8(acc);
        skinny_acc<D>(x2b, Wpg, sl, acc, w, r, g); skinny_put(red, acc, w, r, g); LBAR();
        const int col = sl * 16 + 4 * c4;
        const float rs = 1.f / sqrtf(ss2[row] * (1.f / D) + EPS);
        const f32x4 gt = skinny_get(red, row, c4) * rs, pp = skinny_get(red2, row, c4); f32x4 v = *(const f32x4*)(out + (size_t)row * D + col);
#pragma unroll
        for (int j = 0; j < 4; ++j) v[j] += pp[j] * sigmoidf(gt[j]);
        *(f32x4*)(out + (size_t)row * D + col) = v;
        const float s = quad_sum((v[0] * v[0] + v[1] * v[1]) + (v[2] * v[2] + v[3] * v[3]));
        if (c4 == 0) atomicAdd(ss3 + row, s);
        LBAR();
    }
}

constexpr int NPHASE = 9;

__global__ void __launch_bounds__(NWAVES * 64, 2) mk_fwd(Args args) {
    extern __shared__ __attribute__((aligned(16))) unsigned char lds[];
    Frame F;
    F.lds = (LAS unsigned char*)lds; F.ldsg = (char*)lds;
    F.G = gridDim.x;
    F.a = (CArgs*)__builtin_amdgcn_kernarg_segment_ptr();
    unsigned char* ws = F.a->ws;
    volatile LAS unsigned* MISC = (volatile LAS unsigned*)(F.lds + MISC_OFF);
    for (int u = F_TID; u < 64; u += NWAVES * 64) MISC[u] = 0u;
    __syncthreads();
    XcdBarrier bar; bar.bar = (unsigned*)(ws + CTL_BAR_B); bar.x = 0; bar.st = nullptr;
    if (MK_N_LAUNCHES == 1) bar = xcd_barrier_post((unsigned*)(ws + CTL_BAR_B), MISC + 8);
    const int lo = F.a->ph_lo, hi = F.a->ph_hi;
#ifndef PROBE_REP
#define PROBE_REP 0
#endif
#define REPS(k) (((PROBE_REP >> (k)) & 1) ? 2 : 1)
#ifndef PHASE_MASK
#define PHASE_MASK 0x1ff
#endif
#define IN(k) (((PHASE_MASK >> (k)) & 1) && lo <= (k) && (k) < hi)
#define SEAM(k) do { if (IN(k) && IN((k) + 1)) { xcd_barrier(bar); if ((PROBE_REP >> 16) & 1) xcd_barrier(bar); } } while (0)

    if (IN(0)) { for (int rep = 0; rep < REPS(0); ++rep) { p0_prologue(F); if (rep + 1 < REPS(0)) __syncthreads(); } SEAM(0); }
    if (IN(1)) {
        pg8::Gemm g{R1B, WIN_T, MR, PS, D}; pg8::StaticOrder S; S.init(MR, PS, F.G, (int)blockIdx.x);
        EpiProj E{PROJ, PS};
        for (int rep = 0; rep < REPS(1); ++rep) pg8::gemm_phase<EpiProj, pg8::StaticOrder, PG8_ALIGN, PG8_SP2>(F.lds, g, S, E);
        SEAM(1);
    }
    if (IN(2)) {
        const int bx = blockIdx.x;
        for (int rep = 0; rep < REPS(2) + ((bx < 128) ? ((PROBE_REP >> 17) & 1) : ((PROBE_REP >> 18) & 1)); ++rep) {
        if (bx < 128) { const int cb_ = bx & 63; if (cb_ < 32) chain_mlstm(F, cb_ >> 2, cb_ & 3, bx >> 6); else chain_gla(F, (cb_ - 32) >> 2, (cb_ - 32) & 3, bx >> 6); }
        else {
            const int nb = F.G - 128, gb = bx - 128;
            { float* Wl = (float*)(F.ldsg + F_WAVE * 2048);
              for (int it = gb * NWAVES + F_WAVE; it < MSMP * 8; it += nb * NWAVES) sample_item(F, it >> 3, it & 7, Wl, F_LANE); }
            for (int i = gb * 512 + F_TID; i < NB * 3 * 1024 + MSMP * 3 * 1024; i += nb * 512) {
                if (i < NB * 3 * 1024) { const int b = i / 3072, j = (i / 1024) % 3, ch = i & 1023; OUTP[O_CVP + i] = bf2f(PROJ[((size_t)b * SEQ + SEQ - 3 + j) * PS + ch]); }
                else { const int k = i - NB * 3 * 1024, n = k / 3072, j = (k / 1024) % 3, ch = k & 1023;
                    OUTP[O_CVS + k] = j < 2 ? ST_CONV[(size_t)n * 3072 + (j + 1) * 1024 + ch] : bf2f(PROJ[((size_t)MP + n) * PS + ch]); }
            }
        }
        __syncthreads();
        }
        SEAM(2);
    }
    if (IN(3)) {
        const int hb = F_WAVE >> 2, ltid = F_TID & 255, lw = F_WAVE & 3;
        char* L = F.ldsg + hb * P2B_HALF;
        for (int rep = 0; rep < REPS(3); ++rep)
        for (int it = 0; it * 2 * F.G < 2048; ++it) {
            const int u = (it * F.G + (int)blockIdx.x) * 2 + hb;
            if (u - hb >= 2048) break;
            if (u < 1024) p2b_unit<false>(F, u, L, ltid, lw, F_LANE); else p2b_unit<true>(F, u, L, ltid, lw, F_LANE);
        }
        SEAM(3);
    }
    if (IN(4)) {
        pg8::Gemm g{R1B, WOUT_T, MP, D, D}; pg8::StaticOrder S; S.init(MP, D, F.G, (int)blockIdx.x);
        EpiRes E{X_P, X_S, OUTP, X1B, SS1, false};
        pg8::gemm_phase<EpiRes, pg8::StaticOrder, PG8_ALIGN, PG8_SP2>(F.lds, g, S, E);
        if (REPS(4) == 2) { EpiRes E2{X_P, X_S, OUTP, UBUF, NCS, true}; pg8::gemm_phase<EpiRes, pg8::StaticOrder, PG8_ALIGN, PG8_SP2>(F.lds, g, S, E2); }
        skinny_res(F, R1B + (size_t)MP * D, WOUT_T, 0, X_S, OUTP + (size_t)MP * D, X1B + (size_t)MP * D, SS1 + MP);
        SEAM(4);
    }
    if (IN(5)) {
        pg8::Gemm g{X1B, W1_T, MP, FF, D}; pg8::StaticOrder S; S.init(MP, FF, F.G, (int)blockIdx.x);
        EpiU E{UBUF, SS1};
        for (int rep = 0; rep < REPS(5); ++rep) pg8::gemm_phase<EpiU, pg8::StaticOrder, PG8_ALIGN, PG8_SP2>(F.lds, g, S, E);
        skinny_up(F, X1B + (size_t)MP * D, W1_T, SS1 + MP, UBUF + (size_t)MP * FF);
        SEAM(5);
    }
    if (IN(6)) {
        pg8::Gemm g{UBUF, W2_T, MP, D, FF}; pg8::StaticOrder S; S.init(MP, D, F.G, (int)blockIdx.x);
        EpiRes E{OUTP, OUTP + (size_t)MP * D, OUTP, R1B, SS2, false};
        pg8::gemm_phase<EpiRes, pg8::StaticOrder, PG8_ALIGN, PG8_SP2>(F.lds, g, S, E);
        if (REPS(6) == 2) { EpiRes E2{OUTP, OUTP + (size_t)MP * D, OUTP, X1B, NCS, true}; pg8::gemm_phase<EpiRes, pg8::StaticOrder, PG8_ALIGN, PG8_SP2>(F.lds, g, S, E2); }
        skinny_res(F, UBUF + (size_t)MP * FF, W2_T, 1, OUTP + (size_t)MP * D, OUTP + (size_t)MP * D, R1B + (size_t)MP * D, SS2 + MP);
        SEAM(6);
    }
    if (IN(7)) {
        { pg8::Gemm g{PBUF, WPLE_T, MP, D, DPLE}; pg8::StaticOrder S; S.init(MP, D, F.G, (int)blockIdx.x);
          EpiProj E{PPB, D};
          pg8::gemm_phase<EpiProj, pg8::StaticOrder, PG8_ALIGN, PG8_SP2>(F.lds, g, S, E); }
        { pg8::Gemm g{R1B, WPG_T, MP, D, D}; pg8::StaticOrder S; S.init(MP, D, F.G, (int)blockIdx.x);
          EpiPle E{OUTP, PPB, SS2, SS3, false};
          pg8::gemm_phase<EpiPle, pg8::StaticOrder, PG8_ALIGN, PG8_SP2>(F.lds, g, S, E);
          if (REPS(7) == 2) { { pg8::Gemm g2{PBUF, WPLE_T, MP, D, DPLE}; EpiProj E1{PPB, D}; pg8::gemm_phase<EpiProj, pg8::StaticOrder, PG8_ALIGN, PG8_SP2>(F.lds, g2, S, E1); }
            EpiPle E2{OUTP, PPB, SS2, NCS, true}; pg8::gemm_phase<EpiPle, pg8::StaticOrder, PG8_ALIGN, PG8_SP2>(F.lds, g, S, E2); } }
        skinny_ple(F, PBUF + (size_t)MP * DPLE, WPLE_T, R1B + (size_t)MP * D, WPG_T, SS2 + MP, OUTP + (size_t)MP * D, SS3 + MP);
        SEAM(7);
    }
    if (IN(8)) {
        const int gw = blockIdx.x * NWAVES + F_WAVE, NGW = F.G * NWAVES;
        if (REPS(8) == 2) for (int m = gw; m < MV; m += NGW) {
            const GAS f32x4* xr = (const GAS f32x4*)(OUTP + (size_t)m * D) + F_LANE; GAS f32x4* xo = (GAS f32x4*)((float*)(WSB + WS_U) + (size_t)m * D) + F_LANE;
            const float r = 1.f / sqrtf(SS3[m] * (1.f / D) + EPS);
#pragma unroll
            for (int j = 0; j < 4; ++j) { const f32x4 gf = ((const GAS f32x4*)G_FINAL)[F_LANE + 64 * j]; xo[64 * j] = xr[64 * j] * r * gf; }
        }
        for (int m = gw; m < MV; m += NGW) {
            GAS f32x4* xr = (GAS f32x4*)(OUTP + (size_t)m * D) + F_LANE;
            const float r = 1.f / sqrtf(SS3[m] * (1.f / D) + EPS);
#pragma unroll
            for (int j = 0; j < 4; ++j) { const f32x4 gf = ((const GAS f32x4*)G_FINAL)[F_LANE + 64 * j]; xr[64 * j] = xr[64 * j] * r * gf; }
        }
    }
#undef IN
#undef SEAM
}

extern "C" void kernel_launch(void* const* d_in, const int* in_sizes, int n_in, void* d_out, int out_size, void* d_ws, size_t ws_size, hipStream_t stream) {
    static int grid = 0;
    if (grid == 0) {
        if (n_in != 26 || ws_size < WS_END) { fprintf(stderr, "kernel_launch: unexpected n_in %d / ws %zu\n", n_in, ws_size); grid = -1; return; }
        int dev = 0, cus = 0, per_cu = 0;
        if (hipGetDevice(&dev) != hipSuccess || hipDeviceGetAttribute(&cus, hipDeviceAttributeMultiprocessorCount, dev) != hipSuccess) { grid = -1; return; }
        if (hipFuncSetAttribute((const void*)mk_fwd, hipFuncAttributeMaxDynamicSharedMemorySize, LDS_BYTES) != hipSuccess) { fprintf(stderr, "kernel_launch: hipFuncSetAttribute failed\n"); grid = -1; return; }
        if (hipOccupancyMaxActiveBlocksPerMultiprocessor(&per_cu, (const void*)mk_fwd, NWAVES * 64, LDS_BYTES) != hipSuccess || per_cu < 1) { fprintf(stderr, "kernel_launch: occupancy query says %d\n", per_cu); per_cu = 1; }
        (void)hipGetLastError();
        grid = cus;
        if (grid > 256) grid = 256;
    }
    if (grid < 0) return;
    (void)hipMemsetAsync((char*)d_ws + WS_CTL, 0, CTL_ZERO_BYTES, stream);
    Args a{};
    for (int i = 0; i < 26; ++i) a.in[i] = (const float*)d_in[i];
    a.out = (float*)d_out; a.ws = (unsigned char*)d_ws;
    if (MK_N_LAUNCHES == 1) { a.ph_lo = 0; a.ph_hi = NPHASE; a.li = 0; hipLaunchKernelGGL(mk_fwd, dim3(grid), dim3(NWAVES * 64), LDS_BYTES, stream, a); }
    else for (int li = 0; li < NPHASE; ++li) { a.ph_lo = li; a.ph_hi = li + 1; a.li = li; hipLaunchKernelGGL(mk_fwd, dim3(grid), dim3(NWAVES * 64), LDS_BYTES, stream, a); }
}
```

```cpp
#include <hip/hip_runtime.h>
#include <cstdio>
#include <cstdint>

#ifndef MK_N_LAUNCHES
#define MK_N_LAUNCHES 1
#endif

namespace pg8 {
#define PG8_LAS __attribute__((address_space(3)))
typedef unsigned short bf16_t;
typedef short bf16x8 __attribute__((ext_vector_type(8)));
typedef float f32x4 __attribute__((ext_vector_type(4)));
typedef unsigned u32x4 __attribute__((ext_vector_type(4)));
constexpr int BM = 256, BK = 64, HALF = 128, HTB = HALF * BK * 2, STAGE_BYTES = 8 * HTB, NXCD = 8, WGM = 8, MP = 16384;

__host__ __device__ __forceinline__ int lds_byte(int r, int c) { const int st = (r >> 4) * 2 + (c >> 5), rr = r & 15, cc = c & 31, ob = rr * 64 + cc * 2; return st * 1024 + (ob ^ (((ob >> 9) & 1) << 5)); }
__host__ __device__ __forceinline__ void stage_rc(int b, int& R, int& C) { const int st = b / 1024, sb = b % 1024, swz = sb ^ (((sb >> 9) & 1) << 5); R = (st >> 1) * 16 + swz / 64; C = (st & 1) * 32 + (swz % 64) / 2; }
__host__ __device__ __forceinline__ int perm32(int rho) { const int n = rho >> 4, i = rho & 15; return 8 * (i >> 2) + 4 * n + (i & 3); }

struct Unit { int pm, pn; };
struct Gemm { const bf16_t* A; const bf16_t* Bt; int M, N, K; };

struct StaticOrder {
    int nM, nN, nwg, G, c;
    __host__ __device__ void init(int M, int N, int G_, int c_) { nM = M / BM; nN = N / BM; nwg = nM * nN; G = G_; c = c_; }
    __host__ __device__ bool next(int i, Unit& u) const {
        const long L = (long)i * G + c; if (L >= nwg) return false;
        int wgid = (int)L; { const int q = nwg / NXCD, r = nwg % NXCD, xcd = wgid % NXCD, off = wgid / NXCD; wgid = (xcd < r ? xcd * (q + 1) : r * (q + 1) + (xcd - r) * q) + off; }
        const int nig = WGM * nN, gid = wgid / nig, fm = gid * WGM, gsz = (nM - fm) < WGM ? (nM - fm) : WGM;
        u.pm = fm + ((wgid % nig) % gsz); u.pn = (wgid % nig) / gsz; return true;
    }
    __device__ __forceinline__ void a_ready(const Unit&) const {}
    __device__ __forceinline__ void done(const Unit&) const {}
};

__device__ __forceinline__ unsigned cvt_pk_bf16(float lo, float hi) { unsigned r; asm volatile("v_cvt_pk_bf16_f32 %0, %1, %2" : "=v"(r) : "v"(lo), "v"(hi)); return r; }


template <class Epi, class Sched, bool ALIGN_EPI = false, bool SP2 = false>
__device__ __forceinline__ void gemm_phase(PG8_LAS unsigned char* lds, const Gemm g, const Sched& S, const Epi& E) {
    int tid_ = threadIdx.x; asm volatile("" : "+v"(tid_));
    const int tid = tid_, wid = __builtin_amdgcn_readfirstlane(tid >> 6), lane = tid & 63, wr = wid >> 2, wc = wid & 3, fr = lane & 15, fq = lane >> 4;
    const int K = g.K, nt = K / BK;
    unsigned voffA[2], voffB[2];
#pragma unroll
    for (int i = 0; i < 2; ++i) { int R, C; stage_rc(tid * 16 + i * 8192, R, C); const int Rb = Epi::PERM ? ((R & ~31) + perm32(R & 31)) : R;
        voffA[i] = (unsigned)(R * K + C) * 2u; voffB[i] = (unsigned)(Rb * K + C) * 2u; }
    const size_t kstep = (size_t)(BK * 2);
    const size_t hstep = (size_t)HALF * K * 2;
    const size_t tstep = 2 * hstep;
    const unsigned ldsw = (unsigned)wid * 1024u;
    const int aoff = lds_byte(wr * 64 + fr, fq * 8), boff = lds_byte(wc * 32 + fr, fq * 8);
#define PG8_SA(b, h) (((b) * 2 + (h)) * HTB)
#define PG8_SB(b, h) ((4 + (b) * 2 + (h)) * HTB)
#define PG8_STAGE(bufoff, gbase, voff) do { _Pragma("unroll") for (int _i = 0; _i < 2; ++_i) \
        __builtin_amdgcn_global_load_lds((const unsigned*)((const char*)(gbase) + (voff)[_i]), (PG8_LAS unsigned*)(lds + (bufoff) + ldsw + _i * 8192), 16, 0, 0); } while (0)
#define PG8_LDA(dst, b, h) do { _Pragma("unroll") for (int m = 0; m < 4; ++m) _Pragma("unroll") for (int k = 0; k < 2; ++k) dst[m][k] = *(const PG8_LAS bf16x8*)(lds + PG8_SA(b, h) + aoff + m * 2048 + k * 1024); } while (0)
#define PG8_LDB(dst, b, h) do { _Pragma("unroll") for (int n = 0; n < 2; ++n) _Pragma("unroll") for (int k = 0; k < 2; ++k) dst[n][k] = *(const PG8_LAS bf16x8*)(lds + PG8_SB(b, h) + boff + n * 2048 + k * 1024); } while (0)
#define PG8_MMA(ai, bj, At, Bt) do { __builtin_amdgcn_s_setprio(1); _Pragma("unroll") for (int m = 0; m < 4; ++m) _Pragma("unroll") for (int n = 0; n < 2; ++n) _Pragma("unroll") for (int k = 0; k < 2; ++k) \
        acc[ai][bj][m][n] = __builtin_amdgcn_mfma_f32_16x16x32_bf16(Bt[n][k], At[m][k], acc[ai][bj][m][n], 0, 0, 0); __builtin_amdgcn_s_setprio(0); } while (0)
#define PG8_WAIT_V(n) asm volatile("s_waitcnt vmcnt(" #n ")" ::: "memory")
#define PG8_WAIT_L(n) asm volatile("s_waitcnt lgkmcnt(" #n ")" ::: "memory")
#define PG8_BAR __builtin_amdgcn_s_barrier()
#define PG8_SCHED __builtin_amdgcn_sched_barrier(0)
    Unit cur, nxt; int ui = 0;
    if (!S.next(0, cur)) return;
    f32x4 acc[2][2][4][2];
#pragma unroll
    for (int a = 0; a < 2; ++a)
#pragma unroll
        for (int b = 0; b < 2; ++b)
#pragma unroll
            for (int m = 0; m < 4; ++m)
#pragma unroll
                for (int n = 0; n < 2; ++n) acc[a][b][m][n] = (f32x4){0.f, 0.f, 0.f, 0.f};
    bf16x8 At[4][2], B0[2][2], B1[2][2];
    const char* cA = (const char*)g.A + (size_t)cur.pm * tstep; const char* cB = (const char*)g.Bt + (size_t)cur.pn * tstep;
    S.a_ready(cur);
    if constexpr (SP2) {
        PG8_STAGE(PG8_SB(0, 0), cB, voffB); PG8_STAGE(PG8_SB(0, 1), cB + hstep, voffB); PG8_STAGE(PG8_SA(0, 0), cA, voffA); PG8_STAGE(PG8_SA(0, 1), cA + hstep, voffA);
        if (wr == 1) PG8_BAR;
        PG8_WAIT_V(2); PG8_BAR;
        PG8_STAGE(PG8_SB(1, 0), cB + kstep, voffB); PG8_STAGE(PG8_SA(1, 0), cA + kstep, voffA); PG8_STAGE(PG8_SB(1, 1), cB + hstep + kstep, voffB);
        PG8_WAIT_V(6); PG8_BAR;
    } else {
        PG8_STAGE(PG8_SB(0, 0), cB, voffB); PG8_STAGE(PG8_SA(0, 0), cA, voffA); PG8_STAGE(PG8_SB(0, 1), cB + hstep, voffB); PG8_STAGE(PG8_SA(0, 1), cA + hstep, voffA);
        if (wr == 1) PG8_BAR;
        PG8_WAIT_V(4); PG8_BAR;
        PG8_STAGE(PG8_SB(1, 0), cB + kstep, voffB); PG8_STAGE(PG8_SA(1, 0), cA + kstep, voffA); PG8_STAGE(PG8_SB(1, 1), cB + hstep + kstep, voffB);
        PG8_WAIT_V(6); PG8_BAR;
    }
    for (;;) {
        const bool has_next = S.next(ui + 1, nxt);
        const char* nA = has_next ? (const char*)g.A + (size_t)nxt.pm * tstep : cA; const char* nB = has_next ? (const char*)g.Bt + (size_t)nxt.pn * tstep : cB;
        for (int t = 0; t < nt; t += 2) {
            const bool last = (t == nt - 2);
            const char* a1 = cA + (size_t)(t + 1) * kstep;
            const char* a2 = last ? nA : cA + (size_t)(t + 2) * kstep; const char* b2 = last ? nB : cB + (size_t)(t + 2) * kstep;
            const char* a3 = a2 + kstep; const char* b3 = b2 + kstep;
            if (last && has_next) S.a_ready(nxt);
            const bool fullm = cur.pm < MP / BM;
            if constexpr (SP2) {
            PG8_LDB(B0, 0, 0); PG8_LDB(B1, 0, 1); PG8_SCHED; PG8_LDA(At, 0, 0); PG8_STAGE(PG8_SA(1, 1), a1 + hstep, voffA);
            PG8_WAIT_V(8); PG8_WAIT_L(0); PG8_BAR; PG8_MMA(0, 0, At, B0); PG8_MMA(0, 1, At, B1); PG8_BAR; PG8_SCHED;
            PG8_LDA(At, 0, 1); PG8_STAGE(PG8_SB(0, 0), b2, voffB); PG8_STAGE(PG8_SB(0, 1), b2 + hstep, voffB); PG8_STAGE(PG8_SA(0, 0), a2, voffA);
            PG8_WAIT_V(8); PG8_WAIT_L(0); PG8_BAR; if (fullm) { PG8_MMA(1, 0, At, B0); PG8_MMA(1, 1, At, B1); } PG8_BAR; PG8_SCHED;
            PG8_LDB(B0, 1, 0); PG8_LDB(B1, 1, 1); PG8_SCHED; PG8_LDA(At, 1, 0); PG8_STAGE(PG8_SA(0, 1), a2 + hstep, voffA);
            PG8_WAIT_V(8); PG8_WAIT_L(0); PG8_BAR; PG8_MMA(0, 0, At, B0); PG8_MMA(0, 1, At, B1); PG8_BAR; PG8_SCHED;
            PG8_LDA(At, 1, 1); PG8_STAGE(PG8_SB(1, 0), b3, voffB); PG8_STAGE(PG8_SB(1, 1), b3 + hstep, voffB); PG8_STAGE(PG8_SA(1, 0), a3, voffA);
            PG8_WAIT_V(8); PG8_WAIT_L(0); PG8_BAR; if (fullm) { PG8_MMA(1, 0, At, B0); PG8_MMA(1, 1, At, B1); } PG8_BAR; PG8_SCHED;
            } else {
            PG8_LDB(B0, 0, 0); PG8_SCHED; PG8_LDA(At, 0, 0); PG8_STAGE(PG8_SA(1, 1), a1 + hstep, voffA);
            PG8_WAIT_L(8); PG8_BAR; PG8_WAIT_L(0); PG8_MMA(0, 0, At, B0); PG8_BAR; PG8_SCHED;
            PG8_LDB(B1, 0, 1); PG8_STAGE(PG8_SB(0, 0), b2, voffB);
            PG8_BAR; PG8_WAIT_L(0); PG8_MMA(0, 1, At, B1); PG8_BAR;
            PG8_LDA(At, 0, 1); PG8_STAGE(PG8_SA(0, 0), a2, voffA);
            PG8_BAR; PG8_WAIT_L(0); PG8_MMA(1, 0, At, B0); PG8_BAR; PG8_SCHED;
            PG8_STAGE(PG8_SB(0, 1), b2 + hstep, voffB);
            PG8_WAIT_V(6); PG8_BAR; PG8_MMA(1, 1, At, B1); PG8_BAR;
            PG8_LDB(B0, 1, 0); PG8_SCHED; PG8_LDA(At, 1, 0); PG8_STAGE(PG8_SA(0, 1), a2 + hstep, voffA);
            PG8_WAIT_L(8); PG8_BAR; PG8_WAIT_L(0); PG8_MMA(0, 0, At, B0); PG8_BAR; PG8_SCHED;
            PG8_LDB(B1, 1, 1); PG8_STAGE(PG8_SB(1, 0), b3, voffB);
            PG8_BAR; PG8_WAIT_L(0); PG8_MMA(0, 1, At, B1); PG8_BAR;
            PG8_LDA(At, 1, 1); PG8_STAGE(PG8_SA(1, 0), a3, voffA);
            PG8_BAR; PG8_WAIT_L(0); PG8_MMA(1, 0, At, B0); PG8_BAR; PG8_SCHED;
            PG8_STAGE(PG8_SB(1, 1), b3 + hstep, voffB);
            PG8_WAIT_V(6); PG8_BAR; PG8_MMA(1, 1, At, B1); PG8_BAR;
            }
        }
        if constexpr (ALIGN_EPI) { if (wr == 0) PG8_BAR; }
        E(acc, cur, wr, wc, fr, fq); S.done(cur);
        if (!has_next) break;
#pragma unroll
        for (int a = 0; a < 2; ++a)
#pragma unroll
            for (int b = 0; b < 2; ++b)
#pragma unroll
                for (int m = 0; m < 4; ++m)
#pragma unroll
                    for (int n = 0; n < 2; ++n) acc[a][b][m][n] = (f32x4){0.f, 0.f, 0.f, 0.f};
        cur = nxt; cA = nA; cB = nB; ++ui;
        if constexpr (ALIGN_EPI) { if (wr == 1) PG8_BAR; }
    }
    PG8_WAIT_V(0);
    if constexpr (!ALIGN_EPI) { if (wr == 0) PG8_BAR; }
    PG8_BAR;
#undef PG8_SA
#undef PG8_SB
#undef PG8_STAGE
#undef PG8_LDA
#undef PG8_LDB
#undef PG8_MMA
#undef PG8_WAIT_V
#undef PG8_WAIT_L
#undef PG8_BAR
#undef PG8_SCHED
}
}

#ifndef PG8_SP2
#define PG8_SP2 true
#endif
#ifndef PG8_ALIGN
#define PG8_ALIGN true
#endif

constexpr int NWAVES = 8;
constexpr int D = 1024, SEQ = 2048, NB = 8, MP = NB * SEQ  , MSMP = 128  , MV = MP + MSMP  , MR = 16640  ;
constexpr int FF = 4096, DPLE = 256, NCH = SEQ / 64  ;
constexpr int PS = 3840;
constexpr int C_MQ = 0, C_MK = 512, C_MV = 1024, C_MO = 1536, C_GQ = 2048, C_GK = 2304, C_GV = 2560, C_GR = 3072, C_SM = 3584;
constexpr float EPS = 1e-6f;
constexpr size_t O_YP = 0, O_YS = 16777216, O_CP = 16908288, O_NP = 17432576, O_MP = 17436672, O_CVP = 17436704, O_SP = 17461280,
                 O_CS = 17723424, O_NS = 26112032, O_MS = 26177568, O_CVS = 26178080, O_SS = 26571296;
constexpr size_t MiB = 1u << 20;
constexpr size_t WS_CTL = 0, CTL_ZERO_BYTES = 1 * MiB;
constexpr size_t CTL_BAR_B = 16384, CTL_SS1_B = 262144, CTL_SS2_B = 393216, CTL_SS3_B = 524288;
constexpr size_t WS_WIN = 1 * MiB, WS_WOUT = 9 * MiB, WS_W1 = 11 * MiB, WS_W2 = 19 * MiB, WS_WPG = 27 * MiB, WS_WPLE = 29 * MiB;
constexpr size_t WS_PB = 30 * MiB, WS_NC = 39 * MiB, WS_MC = WS_NC + 512 * 1024, WS_R1 = 40 * MiB, WS_R2 = 73 * MiB, WS_CSM = 195 * MiB, WS_CSG = 227 * MiB;
constexpr size_t WS_X1B = WS_R2, WS_U = 106 * MiB, WS_PP = 106 * MiB, WS_END = 243 * MiB;
static_assert(WS_R2 + (size_t)MR * PS * 2 <= WS_CSM && WS_R1 + (size_t)MR * D * 2 <= WS_R2 && WS_U + (size_t)MR * FF * 2 <= WS_END && WS_X1B + (size_t)MR * D * 2 <= WS_U && WS_PB + (size_t)MR * DPLE * 2 <= WS_NC, "ws map");
constexpr size_t SC_QP = 0, SC_KW = (size_t)MP * 512, SC_QG = (size_t)MP * 1024, SC_KG = (size_t)MP * 1280;
static_assert((SC_KG + (size_t)MP * 256) * 2 <= (size_t)MP * D * 4, "P2 scratch inside y_prompt");
constexpr size_t WS_GA = 244 * MiB, WS_GB = WS_GA + 256 * 1024, WS_EBL = WS_GB + 256 * 1024, WS_PMX = WS_EBL + 256 * 1024, WS_BLS = WS_PMX + 4096;
constexpr int LDS_BYTES = 147456, MISC_OFF = LDS_BYTES - 256;

#define GAS __attribute__((address_space(1)))
#define LAS __attribute__((address_space(3)))
typedef unsigned short bf16;
typedef unsigned v4u __attribute__((ext_vector_type(4)));
typedef unsigned v2u __attribute__((ext_vector_type(2)));
typedef float f32x4 __attribute__((ext_vector_type(4)));
typedef short bf16x8 __attribute__((ext_vector_type(8)));
typedef GAS unsigned gu32;
#define RLX_AGENT __ATOMIC_RELAXED, __HIP_MEMORY_SCOPE_AGENT
#define LDS_WAIT() asm volatile("s_waitcnt lgkmcnt(0)" ::: "memory")
#define VM_WAIT() asm volatile("s_waitcnt vmcnt(0)" ::: "memory")
#define LBAR() do { asm volatile("s_waitcnt lgkmcnt(0)" ::: "memory"); __builtin_amdgcn_s_barrier(); asm volatile("" ::: "memory"); } while (0)
__device__ __forceinline__ unsigned f2bf(float f) { unsigned u = __builtin_bit_cast(unsigned, f); return (u + 0x7fffu + ((u >> 16) & 1u)) >> 16; }
__device__ __forceinline__ unsigned pk2(float lo, float hi) { unsigned r; asm volatile("v_cvt_pk_bf16_f32 %0, %1, %2" : "=v"(r) : "v"(lo), "v"(hi)); return r; }
__device__ __forceinline__ float bf2f(unsigned b) { return __builtin_bit_cast(float, b << 16); }
__device__ __forceinline__ float bflo(unsigned w) { return __builtin_bit_cast(float, w << 16); }
__device__ __forceinline__ float bfhi(unsigned w) { return __builtin_bit_cast(float, w & 0xffff0000u); }
__device__ __forceinline__ float logsig(float x) { return fminf(x, 0.f) - __logf(1.f + __expf(-fabsf(x))); }
__device__ __forceinline__ float sigmoidf(float x) { return __builtin_amdgcn_rcpf(1.f + __expf(-x)); }
__device__ __forceinline__ float rsqrt_fast(float x) { return __builtin_amdgcn_rsqf(x); }

#define XB_TMO      128
#define XB_XCNT(j)  (256  + 64 * (j))
#define XB_XSUB(j)  (1280 + 64 * (j))
#define XB_XGEN(j)  (2304 + 64 * (j))
#define XB_TOP      3328
#define XB_TOPGEN   3392
#define XCD_BAR_WORDS 3456
#define XB_SPIN_CAP (1u << 22)
__device__ __forceinline__ unsigned xb_ld(unsigned* p)              { return __hip_atomic_load(p, __ATOMIC_RELAXED, __HIP_MEMORY_SCOPE_AGENT); }
__device__ __forceinline__ unsigned xb_add(unsigned* p, unsigned v) { return __hip_atomic_fetch_add(p, v, __ATOMIC_RELAXED, __HIP_MEMORY_SCOPE_AGENT); }
__device__ __forceinline__ unsigned xb_xcc_id() { return (unsigned)__builtin_amdgcn_s_getreg((3 << 11) | 20) & 0xFu; }
#define XB_SPIN(cond, bar) do { unsigned _sp = 0; while (cond) { __builtin_amdgcn_s_sleep(1); \
    if ((++_sp & 255u) == 0u) { if (xb_ld(&(bar)[XB_TMO])) break; if (_sp > XB_SPIN_CAP) { atomicAdd(&(bar)[XB_TMO], 1u); break; } } } } while (0)
struct XcdBarrier { unsigned* bar; unsigned x; volatile LAS unsigned* st; };
__device__ __forceinline__ XcdBarrier xcd_barrier_post(unsigned* bar, volatile LAS unsigned* st) {
    XcdBarrier b; b.bar = bar; b.x = xb_xcc_id(); b.st = st;
    if (threadIdx.x == 0) (void)xb_add(&bar[XB_XCNT(b.x)], 1u);
    return b;
}
__device__ __forceinline__ void xcd_barrier_complete(unsigned* bar, unsigned x, unsigned& nloc, unsigned& nx) {
    const unsigned G = gridDim.x * gridDim.y * gridDim.z;
    unsigned sum, cnt, mine, sp = 0u;
    for (;;) {
        sum = 0u; cnt = 0u; mine = 0u;
#pragma unroll
        for (unsigned j = 0; j < 16; ++j) { const unsigned c = xb_ld(&bar[XB_XCNT(j)]); sum += c; cnt += (c > 0u) ? 1u : 0u; mine = (j == x) ? c : mine; }
        if (sum == G) break;
        __builtin_amdgcn_s_sleep(1);
        if ((++sp & 255u) == 0u) { if (xb_ld(&bar[XB_TMO])) break; if (sp > XB_SPIN_CAP) { atomicAdd(&bar[XB_TMO], 1u); break; } }
    }
    nloc = mine > 0u ? mine : 1u; nx = cnt > 0u ? cnt : 1u;
}
__device__ __forceinline__ void xcd_barrier(const XcdBarrier& b) {
    asm volatile("s_waitcnt vmcnt(0)" ::: "memory");
    __syncthreads();
    if (threadIdx.x == 0) {
        unsigned* bar = b.bar;
        __builtin_amdgcn_s_waitcnt(0);
        unsigned nloc = b.st[0], nx = b.st[1];
        if (nloc == 0u) { xcd_barrier_complete(bar, b.x, nloc, nx); b.st[0] = nloc; b.st[1] = nx; }
        const unsigned old = xb_add(&bar[XB_XSUB(b.x)], 1u);
        const unsigned gen = old / nloc;
        if (old + 1u == (gen + 1u) * nloc) {
            __builtin_amdgcn_fence(__ATOMIC_RELEASE, "agent");
            asm volatile("s_waitcnt vmcnt(0)" ::: "memory");
            const unsigned og = xb_add(&bar[XB_TOP], 1u);
            const unsigned tg = og / nx;
            if (og + 1u == (tg + 1u) * nx) xb_add(&bar[XB_TOPGEN], 1u);
            else XB_SPIN(xb_ld(&bar[XB_TOPGEN]) == tg, bar);
            __builtin_amdgcn_fence(__ATOMIC_ACQUIRE, "agent");
            xb_add(&bar[XB_XGEN(b.x)], 1u);
            asm volatile("s_waitcnt vmcnt(0)" ::: "memory");
        } else {
            XB_SPIN(xb_ld(&bar[XB_XGEN(b.x)]) == gen, bar);
            __builtin_amdgcn_fence(__ATOMIC_ACQUIRE, "agent");
            asm volatile("s_waitcnt vmcnt(0)" ::: "memory");
        }
    }
    __syncthreads();
}

struct Args { const float* in[26]; float* out; unsigned char* ws; int ph_lo, ph_hi, li, pad; };
typedef const Args __attribute__((address_space(4))) CArgs;
struct Frame {
    LAS unsigned char* lds;
    char* ldsg;
    int G;
    CArgs* a;
};
#define F_TID ((int)threadIdx.x)
#define F_LANE ((int)(threadIdx.x & 63))
#define F_WAVE (__builtin_amdgcn_readfirstlane((int)(threadIdx.x >> 6)))
#define IN_F(k) (F.a->in[k])
#define X_P IN_F(0)
#define X_S IN_F(1)
#define P_P IN_F(2)
#define P_S IN_F(3)
#define ST_C IN_F(4)
#define ST_N IN_F(5)
#define ST_M IN_F(6)
#define ST_CONV IN_F(7)
#define ST_S IN_F(8)
#define W_IN IN_F(9)
#define CONV_W IN_F(10)
#define CONV_B IN_F(11)
#define B_GATE CONSTF(IN_F(12))
#define W_A2 CONSTF(IN_F(13))
#define B_A CONSTF(IN_F(14))
#define G_MHEAD IN_F(15)
#define G_GHEAD IN_F(16)
#define W_OUT IN_F(17)
#define G_MIX IN_F(18)
#define G_MLP IN_F(19)
#define W1 IN_F(20)
#define W2 IN_F(21)
#define G_PLE IN_F(22)
#define W_PLE IN_F(23)
#define W_PG IN_F(24)
#define G_FINAL IN_F(25)
typedef const float __attribute__((address_space(4))) cfloat;
#define CONSTF(p) ((cfloat*)(unsigned long long)(p))
#define OUTP (F.a->out)
#define WSB (F.a->ws)
#define WIN_T ((bf16*)(WSB + WS_WIN))
#define WOUT_T ((bf16*)(WSB + WS_WOUT))
#define W1_T ((bf16*)(WSB + WS_W1))
#define W2_T ((bf16*)(WSB + WS_W2))
#define WPG_T ((bf16*)(WSB + WS_WPG))
#define WPLE_T ((bf16*)(WSB + WS_WPLE))
#define PBUF ((bf16*)(WSB + WS_PB))
#define R1B ((bf16*)(WSB + WS_R1))
#define PROJ ((bf16*)(WSB + WS_R2))
#define X1B ((bf16*)(WSB + WS_X1B))
#define UBUF ((bf16*)(WSB + WS_U))
#define CSM ((bf16*)(WSB + WS_CSM))
#define CSG ((bf16*)(WSB + WS_CSG))
#define NCS ((float*)(WSB + WS_NC))
#define MCS ((float*)(WSB + WS_MC))
#define SS1 ((float*)(WSB + CTL_SS1_B))
#define SS2 ((float*)(WSB + CTL_SS2_B))
#define SS3 ((float*)(WSB + CTL_SS3_B))
#define PPB ((bf16*)(WSB + WS_PP))
#define GA_A ((float*)(WSB + WS_GA))
#define GA_B ((float*)(WSB + WS_GB))
#define EBLG ((float*)(WSB + WS_EBL))
#define PMXG ((float*)(WSB + WS_PMX))
#define BLSG ((float*)(WSB + WS_BLS))
#define SCR ((bf16*)OUTP)

__device__ __forceinline__ float wave_sum(float v) {
#pragma unroll
    for (int o = 1; o < 64; o <<= 1) v += __shfl_xor(v, o);
    return v;
}
__device__ __forceinline__ float wave_max(float v) {
#pragma unroll
    for (int o = 1; o < 64; o <<= 1) v = fmaxf(v, __shfl_xor(v, o));
    return v;
}
template <int CTRL, int ROWMASK> __device__ __forceinline__ float dpp_f(float idv, float v) {
    return __builtin_bit_cast(float, __builtin_amdgcn_update_dpp(__builtin_bit_cast(int, idv), __builtin_bit_cast(int, v), CTRL, ROWMASK, 0xf, false));
}
__device__ __forceinline__ float wave_scan_sum(float v, int) {
    v += dpp_f<0x111, 0xf>(0.f, v); v += dpp_f<0x112, 0xf>(0.f, v); v += dpp_f<0x114, 0xf>(0.f, v); v += dpp_f<0x118, 0xf>(0.f, v);
    v += dpp_f<0x142, 0xa>(0.f, v); v += dpp_f<0x143, 0xc>(0.f, v);
    return v;
}
__device__ __forceinline__ float wave_scan_max(float v, int) {
    const float ninf = -__builtin_inff();
    v = fmaxf(v, dpp_f<0x111, 0xf>(ninf, v)); v = fmaxf(v, dpp_f<0x112, 0xf>(ninf, v)); v = fmaxf(v, dpp_f<0x114, 0xf>(ninf, v)); v = fmaxf(v, dpp_f<0x118, 0xf>(ninf, v));
    v = fmaxf(v, dpp_f<0x142, 0xa>(ninf, v)); v = fmaxf(v, dpp_f<0x143, 0xc>(ninf, v));
    return v;
}

__device__ __forceinline__ int win_src_col(int np) {
    if (np < 2048) return np;
    if (np < 3584) return np + 8;
    const int j = np - 3584;
    if (j < 8) return 2048 + j;
    if (j < 24) return 3592 + (j - 8);
    return -1;
}
template <int MODE>
__device__ __forceinline__ void p0_transpose_item(const float* W, int K, int N, bf16* WT, const float* gain, LAS float* scr, int item, int nblk, int lane) {
    const int kb = item / nblk, nb = item % nblk, k0 = 64 * kb, n0 = 32 * nb;
    int src = n0 + (lane & 31); float cs = 1.f;
    if (MODE == 1) { const int np = n0 + (lane & 31); src = win_src_col(np); if (np >= C_GQ && np < C_GK) cs = 0.125f; }
#pragma unroll 8
    for (int i = 0; i < 32; ++i) { const int kk = 2 * i + (lane >> 5); float v = 0.f; if (src >= 0) v = W[(size_t)(k0 + kk) * N + src] * cs; if (gain) v *= gain[k0 + kk]; scr[kk * 33 + (lane & 31)] = v; }
    LDS_WAIT(); asm volatile("" ::: "memory");
    const int c = lane & 7;
#pragma unroll
    for (int j = 0; j < 4; ++j) { const int n = (lane >> 3) + 8 * j; const LAS float* s = scr + (8 * c) * 33 + n;
        v4u o; o.x = pk2(s[0 * 33], s[1 * 33]); o.y = pk2(s[2 * 33], s[3 * 33]); o.z = pk2(s[4 * 33], s[5 * 33]); o.w = pk2(s[6 * 33], s[7 * 33]);
        *(GAS v4u*)(WT + (size_t)(n0 + n) * K + k0 + 8 * c) = o; }
    LDS_WAIT(); asm volatile("" ::: "memory");
}
__device__ __forceinline__ void p0_prologue(Frame& F) {
    LAS float* scr = (LAS float*)(F.lds + F_WAVE * 16384);
    const int gw = blockIdx.x * NWAVES + F_WAVE, NGW = F.G * NWAVES;
    constexpr int NB_IN = PS / 32, NB_D = D / 32, NB_FF = FF / 32;
    constexpr int I_IN = (D / 64) * NB_IN, I_OUT = (D / 64) * NB_D, I_1 = (D / 64) * NB_FF, I_2 = (FF / 64) * NB_D, I_PG = I_OUT, I_PLE = (DPLE / 64) * NB_D;
    constexpr int NITEMS = I_IN + I_OUT + I_1 + I_2 + I_PG + I_PLE;
    for (int it = gw; it < NITEMS; it += NGW) {
        int r = it;
        if (r < I_IN) { p0_transpose_item<1>(W_IN, D, 3608, WIN_T, G_MIX, scr, r, NB_IN, F_LANE); continue; } r -= I_IN;
        if (r < I_OUT) { p0_transpose_item<0>(W_OUT, D, D, WOUT_T, nullptr, scr, r, NB_D, F_LANE); continue; } r -= I_OUT;
        if (r < I_1) { p0_transpose_item<0>(W1, D, FF, W1_T, G_MLP, scr, r, NB_FF, F_LANE); continue; } r -= I_1;
        if (r < I_2) { p0_transpose_item<0>(W2, FF, D, W2_T, nullptr, scr, r, NB_D, F_LANE); continue; } r -= I_2;
        if (r < I_PG) { p0_transpose_item<0>(W_PG, D, D, WPG_T, G_PLE, scr, r, NB_D, F_LANE); continue; } r -= I_PG;
        p0_transpose_item<0>(W_PLE, DPLE, D, WPLE_T, nullptr, scr, r, NB_D, F_LANE);
    }
    for (int m = gw; m < MV; m += NGW) {
        const float* xrow = m < MP ? X_P + (size_t)m * D : X_S + (size_t)(m - MP) * D;
        const GAS f32x4* xr = (const GAS f32x4*)xrow + F_LANE;
        f32x4 v[4]; float s = 0.f;
#pragma unroll
        for (int j = 0; j < 4; ++j) { v[j] = xr[64 * j]; s += (v[j].x * v[j].x + v[j].y * v[j].y) + (v[j].z * v[j].z + v[j].w * v[j].w); }
        const float r = rsqrt_fast(wave_sum(s) * (1.f / D) + EPS);
        GAS unsigned long long* o8 = (GAS unsigned long long*)(R1B + (size_t)m * D) + F_LANE;
#pragma unroll
        for (int j = 0; j < 4; ++j) o8[64 * j] = (unsigned long long)pk2(v[j].x * r, v[j].y * r) | ((unsigned long long)pk2(v[j].z * r, v[j].w * r) << 32);
        const float* prow = m < MP ? P_P + (size_t)m * DPLE : P_S + (size_t)(m - MP) * DPLE;
        const f32x4 pv = ((const GAS f32x4*)prow)[F_LANE];
        ((GAS unsigned long long*)(PBUF + (size_t)m * DPLE))[F_LANE] = (unsigned long long)pk2(pv.x, pv.y) | ((unsigned long long)pk2(pv.z, pv.w) << 32);
    }
}

struct EpiProj {
    static constexpr bool PERM = true;
    bf16* O; int ldc;
    __device__ __forceinline__ void operator()(const f32x4 (&acc)[2][2][4][2], const pg8::Unit& u, int wr, int wc, int fr, int fq) const {
        const int row0 = u.pm * 256 + wr * 64 + fr, col0 = u.pn * 256 + wc * 32 + 8 * fq;
#pragma unroll
        for (int ai = 0; ai < 2; ++ai)
#pragma unroll
            for (int m = 0; m < 4; ++m) { bf16* rowp = O + (size_t)(row0 + ai * 128 + m * 16) * ldc + col0;
#pragma unroll
                for (int bj = 0; bj < 2; ++bj) { const f32x4 v0 = acc[ai][bj][m][0], v1 = acc[ai][bj][m][1];
                    v4u w; w.x = pg8::cvt_pk_bf16(v0[0], v0[1]); w.y = pg8::cvt_pk_bf16(v0[2], v0[3]); w.z = pg8::cvt_pk_bf16(v1[0], v1[1]); w.w = pg8::cvt_pk_bf16(v1[2], v1[3]);
                    *(v4u*)(rowp + bj * 128) = w; } }
    }
};
template <bool RES_BF16> struct EpiRes {
    static constexpr bool PERM = true;
    const void* res; bf16* ob; float* ss;
    __device__ __forceinline__ void operator()(const f32x4 (&acc)[2][2][4][2], const pg8::Unit& u, int wr, int wc, int fr, int fq) const {
        const int row0 = u.pm * 256 + wr * 64 + fr, col0 = u.pn * 256 + wc * 32 + 8 * fq;
#pragma unroll
        for (int ai = 0; ai < 2; ++ai)
#pragma unroll
            for (int m = 0; m < 4; ++m) { const int row = row0 + ai * 128 + m * 16;
                const size_t off = (size_t)row * D + col0;
                float s = 0.f;
#pragma unroll
                for (int bj = 0; bj < 2; ++bj) {
                    f32x4 r0, r1;
                    if constexpr (RES_BF16) { const v4u rw = *(const v4u*)((const bf16*)res + off + bj * 128);
                        r0 = (f32x4){bflo(rw.x), bfhi(rw.x), bflo(rw.y), bfhi(rw.y)}; r1 = (f32x4){bflo(rw.z), bfhi(rw.z), bflo(rw.w), bfhi(rw.w)}; }
                    else { r0 = *(const f32x4*)((const float*)res + off + bj * 128); r1 = *(const f32x4*)((const float*)res + off + bj * 128 + 4); }
                    const f32x4 v0 = acc[ai][bj][m][0] + r0, v1 = acc[ai][bj][m][1] + r1;
                    v4u w; w.x = pg8::cvt_pk_bf16(v0[0], v0[1]); w.y = pg8::cvt_pk_bf16(v0[2], v0[3]); w.z = pg8::cvt_pk_bf16(v1[0], v1[1]); w.w = pg8::cvt_pk_bf16(v1[2], v1[3]);
                    *(v4u*)(ob + off + bj * 128) = w;
                    s += (v0[0] * v0[0] + v0[1] * v0[1]) + (v0[2] * v0[2] + v0[3] * v0[3]) + (v1[0] * v1[0] + v1[1] * v1[1]) + (v1[2] * v1[2] + v1[3] * v1[3]);
                }
                s += __shfl_xor(s, 16); s += __shfl_xor(s, 32);
                if (fq == 0) atomicAdd(ss + row, s);
                asm volatile("" ::: "memory"); }
    }
};
struct EpiU {
    static constexpr bool PERM = true;
    bf16* O; const float* ss;
    __device__ __forceinline__ void operator()(const f32x4 (&acc)[2][2][4][2], const pg8::Unit& u, int wr, int wc, int fr, int fq) const {
        const int row0 = u.pm * 256 + wr * 64 + fr, col0 = u.pn * 256 + wc * 32 + 8 * fq;
#pragma unroll
        for (int ai = 0; ai < 2; ++ai)
#pragma unroll
            for (int m = 0; m < 4; ++m) { const int row = row0 + ai * 128 + m * 16; const float r = rsqrt_fast(ss[row] * (1.f / D) + EPS);
                bf16* rowp = O + (size_t)row * FF + col0;
#pragma unroll
                for (int bj = 0; bj < 2; ++bj) { f32x4 v0 = acc[ai][bj][m][0] * r, v1 = acc[ai][bj][m][1] * r;
#pragma unroll
                    for (int j = 0; j < 4; ++j) { const float a = fmaxf(v0[j], 0.f), b = fmaxf(v1[j], 0.f); v0[j] = a * a; v1[j] = b * b; }
                    v4u w; w.x = pg8::cvt_pk_bf16(v0[0], v0[1]); w.y = pg8::cvt_pk_bf16(v0[2], v0[3]); w.z = pg8::cvt_pk_bf16(v1[0], v1[1]); w.w = pg8::cvt_pk_bf16(v1[2], v1[3]);
                    *(v4u*)(rowp + bj * 128) = w; } }
    }
};
struct EpiPle {
    static constexpr bool PERM = true;
    const bf16* x2b; const bf16* Pp; bf16* x3b; const float* ss2; float* ss3;
    __device__ __forceinline__ void operator()(const f32x4 (&acc)[2][2][4][2], const pg8::Unit& u, int wr, int wc, int fr, int fq) const {
        const int row0 = u.pm * 256 + wr * 64 + fr, col0 = u.pn * 256 + wc * 32 + 8 * fq;
#pragma unroll
        for (int ai = 0; ai < 2; ++ai)
#pragma unroll
            for (int m = 0; m < 4; ++m) { const int row = row0 + ai * 128 + m * 16;
                const float r = rsqrt_fast(ss2[row] * (1.f / D) + EPS);
                float s = 0.f;
#pragma unroll
                for (int bj = 0; bj < 2; ++bj) {
                    const size_t off = (size_t)row * D + col0 + bj * 128;
                    const v4u pw = *(const v4u*)(Pp + off), xw = *(const v4u*)(x2b + off);
                    unsigned o[4];
#pragma unroll
                    for (int n = 0; n < 2; ++n) {
                        const float p0[4] = {bflo(pw[2 * n]), bfhi(pw[2 * n]), bflo(pw[2 * n + 1]), bfhi(pw[2 * n + 1])};
                        const float x0[4] = {bflo(xw[2 * n]), bfhi(xw[2 * n]), bflo(xw[2 * n + 1]), bfhi(xw[2 * n + 1])};
                        float v0[4];
#pragma unroll
                        for (int j = 0; j < 4; ++j) v0[j] = x0[j] + p0[j] * sigmoidf(acc[ai][bj][m][n][j] * r);
                        o[2 * n] = pg8::cvt_pk_bf16(v0[0], v0[1]); o[2 * n + 1] = pg8::cvt_pk_bf16(v0[2], v0[3]);
                        s += (v0[0] * v0[0] + v0[1] * v0[1]) + (v0[2] * v0[2] + v0[3] * v0[3]);
                    }
                    *(v4u*)(x3b + off) = (v4u){o[0], o[1], o[2], o[3]};
                    asm volatile("" ::: "memory");
                }
                s += __shfl_xor(s, 16); s += __shfl_xor(s, 32);
                if (fq == 0) atomicAdd(ss3 + row, s);
                asm volatile("" ::: "memory"); }
    }
};

__device__ __forceinline__ f32x4 mfma16(bf16x8 a, bf16x8 b, f32x4 c) { return __builtin_amdgcn_mfma_f32_16x16x32_bf16(a, b, c, 0, 0, 0); }
__device__ __forceinline__ bf16x8 lds_frag(const char* p) { return *(const bf16x8*)p; }
constexpr int TS = 144;
constexpr int QS_P = 272;
constexpr float KSCALE = 0.08838834764831845f;

__device__ __forceinline__ void p2p_item(Frame& F, int b, int c) {
    float* WKL = (float*)F.ldsg;
    const int tid = F_TID, lane = F_LANE, w = F_WAVE;
    const size_t row0 = (size_t)b * SEQ + c * 64;
    const bf16* P = PROJ;
    if (w < 4) { const int h = w, bh = b * 4 + h; const size_t row = row0 + lane;
        const float ig = bf2f(P[row * PS + C_SM + h]) + B_GATE[h], lf = logsig(bf2f(P[row * PS + C_SM + 4 + h]) + B_GATE[4 + h]);
        const float bc = wave_scan_sum(lf, lane), a = ig - bc; const float pmax = wave_max(a);
        GA_A[(size_t)bh * SEQ + c * 64 + lane] = a; GA_B[(size_t)bh * SEQ + c * 64 + lane] = bc;
        if (lane == 63) { PMXG[bh * NCH + c] = pmax; BLSG[bh * NCH + c] = bc; }
        WKL[h * 64 + lane] = __expf(a - pmax) * KSCALE; }
    { const int hg = w >> 1, d0 = 32 * (w & 1), bh = b * 4 + hg; const size_t row = row0 + lane;
      const v4u ga0 = *(const v4u*)(P + row * PS + C_SM + 8), ga1 = *(const v4u*)(P + row * PS + C_SM + 16);
      v4u qv[4], kv[4];
#pragma unroll
      for (int i = 0; i < 4; ++i) { qv[i] = *(const v4u*)(P + row * PS + C_GQ + hg * 64 + d0 + 8 * i); kv[i] = *(const v4u*)(P + row * PS + C_GK + hg * 64 + d0 + 8 * i); }
      float ga[16];
#pragma unroll
      for (int i = 0; i < 4; ++i) { ga[2 * i] = bflo(ga0[i]); ga[2 * i + 1] = bfhi(ga0[i]); ga[8 + 2 * i] = bflo(ga1[i]); ga[8 + 2 * i + 1] = bfhi(ga1[i]); }
      unsigned qo[16], ko[16];
#pragma unroll
      for (int dd = 0; dd < 32; dd += 2) {
          float qt[2], kt[2];
#pragma unroll
          for (int q2 = 0; q2 < 2; ++q2) { const int col = hg * 64 + d0 + dd + q2;
              float z = B_A[col];
#pragma unroll
              for (int q = 0; q < 16; ++q) z += ga[q] * W_A2[q * 256 + col];
              const float bc = wave_scan_sum(logsig(z) * (1.f / 16.f), lane);
              if (lane == 63) EBLG[(size_t)(bh * NCH + c) * 64 + d0 + dd + q2] = __expf(bc);
              const unsigned qw = qv[dd >> 3][(dd >> 1) & 3], kw = kv[dd >> 3][(dd >> 1) & 3];
              qt[q2] = (q2 ? bfhi(qw) : bflo(qw)) * __expf(bc); kt[q2] = (q2 ? bfhi(kw) : bflo(kw)) * __expf(-bc); }
          qo[dd >> 1] = pk2(qt[0], qt[1]); ko[dd >> 1] = pk2(kt[0], kt[1]);
      }
      bf16* qd = SCR + SC_QG + row * 256 + hg * 64 + d0; bf16* kd = SCR + SC_KG + row * 256 + hg * 64 + d0;
#pragma unroll
      for (int i = 0; i < 4; ++i) { *(v4u*)(qd + 8 * i) = (v4u){qo[4 * i], qo[4 * i + 1], qo[4 * i + 2], qo[4 * i + 3]}; *(v4u*)(kd + 8 * i) = (v4u){ko[4 * i], ko[4 * i + 1], ko[4 * i + 2], ko[4 * i + 3]}; } }
    LBAR();
    {
      const int isk = tid >> 8, pc = tid & 255, h = pc >> 6, ch = isk * 512 + 2 * pc;
      float cw[4][2], cb[2];
#pragma unroll
      for (int j = 0; j < 4; ++j) { cw[j][0] = CONV_W[j * 1024 + ch]; cw[j][1] = CONV_W[j * 1024 + ch + 1]; }
      cb[0] = CONV_B[ch]; cb[1] = CONV_B[ch + 1];
      const bf16* src = P + row0 * PS + (isk ? C_MK : C_MQ) + 2 * pc;
      bf16* dst = SCR + (isk ? SC_KW : SC_QP) + row0 * 512 + 2 * pc;
#pragma unroll
      for (int hf = 0; hf < 2; ++hf) {
          unsigned raw[35];
#pragma unroll
          for (int i = 0; i < 35; ++i) { const int t = 32 * hf - 3 + i; raw[i] = (c > 0 || t >= 0) ? *(const unsigned*)(src + (long)t * PS) : 0u; }
#pragma unroll
          for (int i = 0; i < 32; ++i) { float a0 = cb[0], a1 = cb[1];
#pragma unroll
              for (int j = 0; j < 4; ++j) { a0 += cw[j][0] * bflo(raw[i + j]); a1 += cw[j][1] * bfhi(raw[i + j]); }
              a0 = a0 * sigmoidf(a0); a1 = a1 * sigmoidf(a1);
              if (isk) { const float wk = WKL[h * 64 + 32 * hf + i]; a0 *= wk; a1 *= wk; }
              *(unsigned*)(dst + (size_t)(32 * hf + i) * 512) = pk2(a0, a1); }
      } }
    LBAR();
}

constexpr int PFD = 4;
__device__ __forceinline__ void chain_mlstm(Frame& F, int b, int h, int sl) {
    char* L = F.ldsg;
    constexpr int KT_B = 64 * TS, VT_B = 128 * TS, NP_B = 16 * 64 * 4, BUF_B = KT_B + VT_B + NP_B;
    float* PM = (float*)(L + 2 * BUF_B); float* BLs = PM + 32; float* MCc = BLs + 32; float* CSs = MCc + 40; float* E2s = CSs + 32;
    const int tid = F_TID, lane = F_LANE, w = F_WAVE, r = lane & 15, g = lane >> 4;
    const int bh = b * 4 + h; const size_t rowb = (size_t)b * SEQ;
    if (tid < 32) { PM[tid] = PMXG[bh * NCH + tid]; BLs[tid] = BLSG[bh * NCH + tid]; }
    __syncthreads();
    if (tid == 0) { float m = 0.f; for (int c = 0; c < NCH; ++c) { const float M = fmaxf(m, PM[c]); MCc[c] = m; CSs[c] = __expf(m - M); E2s[c] = __expf(PM[c] - M); m = BLs[c] + M; } MCc[32] = m; }
    __syncthreads();
    const int dpk = tid & 31, tg = tid >> 5, dpv = tid & 63, sg = tid >> 6;
    const int dt = w & 3, eb = 4 * (w >> 2);
    f32x4 acc[4];
#pragma unroll
    for (int i = 0; i < 4; ++i) acc[i] = (f32x4){0.f, 0.f, 0.f, 0.f};
    float nst = 0.f;
    unsigned krq[PFD][4], vrq[PFD][8];
    const bf16* kbase = SCR + SC_KW + (rowb + 4 * tg) * 512 + h * 128 + 64 * sl + 2 * dpk; const bf16* vbase = PROJ + (rowb + 8 * sg) * PS + C_MV + h * 128 + 2 * dpv;
#pragma unroll
    for (int q = 0; q < PFD; ++q) {
#pragma unroll
        for (int i = 0; i < 4; ++i) krq[q][i] = *(const unsigned*)(kbase + (size_t)(64 * q + i) * 512);
#pragma unroll
        for (int i = 0; i < 8; ++i) vrq[q][i] = *(const unsigned*)(vbase + (size_t)(64 * q + i) * PS);
    }
    for (int c = 0; c < NCH; ++c) {
        char* KT = L + (c & 1) * BUF_B; char* VT = KT + KT_B; float* NP = (float*)(VT + VT_B);
        const int t0 = c * 64;
        unsigned kr[4], vr[8];
#pragma unroll
        for (int i = 0; i < 4; ++i) kr[i] = krq[0][i];
#pragma unroll
        for (int i = 0; i < 8; ++i) vr[i] = vrq[0][i];
#pragma unroll
        for (int q = 0; q + 1 < PFD; ++q) {
#pragma unroll
            for (int i = 0; i < 4; ++i) krq[q][i] = krq[q + 1][i];
#pragma unroll
            for (int i = 0; i < 8; ++i) vrq[q][i] = vrq[q + 1][i];
        }
        if (c + PFD < NCH) {
#pragma unroll
            for (int i = 0; i < 4; ++i) krq[PFD - 1][i] = *(const unsigned*)(kbase + (size_t)(t0 + 64 * PFD + i) * 512);
#pragma unroll
            for (int i = 0; i < 8; ++i) vrq[PFD - 1][i] = *(const unsigned*)(vbase + (size_t)(t0 + 64 * PFD + i) * PS);
        }
        { bf16* cst = CSM + (size_t)(bh * NCH + c) * 16384;
#pragma unroll
          for (int i = 0; i < 4; ++i) { const int e = 16 * (eb + i) + r, d = 64 * sl + 16 * dt + 4 * g;
              *(v2u*)(cst + e * 128 + d) = (v2u){pg8::cvt_pk_bf16(acc[i][0], acc[i][1]), pg8::cvt_pk_bf16(acc[i][2], acc[i][3])}; }
          if (tid < 64) NCS[(size_t)(bh * NCH + c) * 128 + 64 * sl + tid] = nst;
          if (tid == 0 && sl == 0) MCS[bh * NCH + c] = MCc[c]; }
        *(v2u*)(KT + (2 * dpk) * TS + 8 * tg) = (v2u){(kr[0] & 0xffffu) | (kr[1] << 16), (kr[2] & 0xffffu) | (kr[3] << 16)};
        *(v2u*)(KT + (2 * dpk + 1) * TS + 8 * tg) = (v2u){(kr[0] >> 16) | (kr[1] & 0xffff0000u), (kr[2] >> 16) | (kr[3] & 0xffff0000u)};
        NP[tg * 64 + 2 * dpk] = (bflo(kr[0]) + bflo(kr[1])) + (bflo(kr[2]) + bflo(kr[3])); NP[tg * 64 + 2 * dpk + 1] = (bfhi(kr[0]) + bfhi(kr[1])) + (bfhi(kr[2]) + bfhi(kr[3]));
        { unsigned v0p[4], v1p[4];
#pragma unroll
          for (int i = 0; i < 8; i += 2) { v0p[i >> 1] = (vr[i] & 0xffffu) | (vr[i + 1] << 16); v1p[i >> 1] = (vr[i] >> 16) | (vr[i + 1] & 0xffff0000u); }
          *(v4u*)(VT + (2 * dpv) * TS + 16 * sg) = (v4u){v0p[0], v0p[1], v0p[2], v0p[3]};
          *(v4u*)(VT + (2 * dpv + 1) * TS + 16 * sg) = (v4u){v1p[0], v1p[1], v1p[2], v1p[3]}; }
        LBAR();
        const float cs = CSs[c], e2 = E2s[c];
        if (tid < 64) { float s = 0.f;
#pragma unroll
            for (int q = 0; q < 16; ++q) s += NP[q * 64 + tid];
            nst = cs * nst + e2 * s; }
        f32x4 ta[4];
#pragma unroll
        for (int i = 0; i < 4; ++i) ta[i] = (f32x4){0.f, 0.f, 0.f, 0.f};
#pragma unroll
        for (int kk = 0; kk < 2; ++kk) {
            const bf16x8 af = lds_frag(KT + (16 * dt + r) * TS + (32 * kk + 8 * g) * 2);
#pragma unroll
            for (int i = 0; i < 4; ++i) ta[i] = mfma16(af, lds_frag(VT + (16 * (eb + i) + r) * TS + (32 * kk + 8 * g) * 2), ta[i]);
        }
#pragma unroll
        for (int i = 0; i < 4; ++i) acc[i] = acc[i] * cs + ta[i] * e2;
    }
    { float* Co = OUTP + O_CP + (size_t)bh * 16384;
#pragma unroll
      for (int i = 0; i < 4; ++i)
#pragma unroll
          for (int j = 0; j < 4; ++j) Co[(64 * sl + 16 * dt + 4 * g + j) * 128 + 16 * (eb + i) + r] = acc[i][j];
      if (tid < 64) OUTP[O_NP + (size_t)bh * 128 + 64 * sl + tid] = nst;
      if (tid == 0 && sl == 0) OUTP[O_MP + bh] = MCc[32]; }
    __syncthreads();
}

__device__ __forceinline__ void chain_gla(Frame& F, int b, int hg, int sl) {
    char* L = F.ldsg;
    constexpr int KT_B = 32 * TS, VT_B = 128 * TS, BUF_B = KT_B + VT_B;
    const int tid = F_TID, lane = F_LANE, w = F_WAVE, r = lane & 15, g = lane >> 4;
    const int bh = b * 4 + hg; const size_t rowb = (size_t)b * SEQ;
    const int dpv = tid & 63, sg = tid >> 6;
    const int dt = w & 1, eb = 2 * (w >> 1);
    f32x4 acc[2];
    acc[0] = (f32x4){0.f, 0.f, 0.f, 0.f}; acc[1] = acc[0];
    v2u k4q[PFD]; f32x4 ebq[PFD]; unsigned vrq[PFD][8];
    const bf16* kbase = SCR + SC_KG + (rowb + lane) * 256 + hg * 64 + 32 * sl + 4 * w; const bf16* vbase = PROJ + (rowb + 8 * sg) * PS + C_GV + hg * 128 + 2 * dpv;
    const float* ebase = EBLG + (size_t)bh * NCH * 64 + 32 * sl + 16 * dt + 4 * g;
#pragma unroll
    for (int q = 0; q < PFD; ++q) { k4q[q] = *(const v2u*)(kbase + (size_t)(64 * q) * 256); ebq[q] = *(const f32x4*)(ebase + q * 64);
#pragma unroll
        for (int i = 0; i < 8; ++i) vrq[q][i] = *(const unsigned*)(vbase + (size_t)(64 * q + i) * PS); }
    for (int c = 0; c < NCH; ++c) {
        char* KT = L + (c & 1) * BUF_B; char* VT = KT + KT_B;
        const int t0 = c * 64;
        const v2u k4 = k4q[0]; const f32x4 eb4 = ebq[0]; unsigned vr[8];
#pragma unroll
        for (int i = 0; i < 8; ++i) vr[i] = vrq[0][i];
#pragma unroll
        for (int q = 0; q + 1 < PFD; ++q) { k4q[q] = k4q[q + 1]; ebq[q] = ebq[q + 1];
#pragma unroll
            for (int i = 0; i < 8; ++i) vrq[q][i] = vrq[q + 1][i]; }
        if (c + PFD < NCH) { k4q[PFD - 1] = *(const v2u*)(kbase + (size_t)(t0 + 64 * PFD) * 256); ebq[PFD - 1] = *(const f32x4*)(ebase + (c + PFD) * 64);
#pragma unroll
            for (int i = 0; i < 8; ++i) vrq[PFD - 1][i] = *(const unsigned*)(vbase + (size_t)(t0 + 64 * PFD + i) * PS); }
        { bf16* cst = CSG + (size_t)(bh * NCH + c) * 8192;
#pragma unroll
          for (int i = 0; i < 2; ++i) { const int e = 16 * (eb + i) + r, d = 32 * sl + 16 * dt + 4 * g;
              *(v2u*)(cst + e * 64 + d) = (v2u){pg8::cvt_pk_bf16(acc[i][0], acc[i][1]), pg8::cvt_pk_bf16(acc[i][2], acc[i][3])}; } }
        *(bf16*)(KT + (4 * w + 0) * TS + 2 * lane) = (bf16)(k4[0] & 0xffffu); *(bf16*)(KT + (4 * w + 1) * TS + 2 * lane) = (bf16)(k4[0] >> 16);
        *(bf16*)(KT + (4 * w + 2) * TS + 2 * lane) = (bf16)(k4[1] & 0xffffu); *(bf16*)(KT + (4 * w + 3) * TS + 2 * lane) = (bf16)(k4[1] >> 16);
        { unsigned v0p[4], v1p[4];
#pragma unroll
          for (int i = 0; i < 8; i += 2) { v0p[i >> 1] = (vr[i] & 0xffffu) | (vr[i + 1] << 16); v1p[i >> 1] = (vr[i] >> 16) | (vr[i + 1] & 0xffff0000u); }
          *(v4u*)(VT + (2 * dpv) * TS + 16 * sg) = (v4u){v0p[0], v0p[1], v0p[2], v0p[3]};
          *(v4u*)(VT + (2 * dpv + 1) * TS + 16 * sg) = (v4u){v1p[0], v1p[1], v1p[2], v1p[3]}; }
        LBAR();
#pragma unroll
        for (int kk = 0; kk < 2; ++kk) {
            const bf16x8 af = lds_frag(KT + (16 * dt + r) * TS + (32 * kk + 8 * g) * 2);
#pragma unroll
            for (int i = 0; i < 2; ++i) acc[i] = mfma16(af, lds_frag(VT + (16 * (eb + i) + r) * TS + (32 * kk + 8 * g) * 2), acc[i]);
        }
        acc[0] = acc[0] * eb4; acc[1] = acc[1] * eb4;
    }
    { float* So = OUTP + O_SP + (size_t)bh * 8192;
#pragma unroll
      for (int i = 0; i < 2; ++i)
#pragma unroll
          for (int j = 0; j < 4; ++j) So[(32 * sl + 16 * dt + 4 * g + j) * 128 + 16 * (eb + i) + r] = acc[i][j]; }
    __syncthreads();
}

__device__ __forceinline__ void sample_item(Frame& F, int n, int hh, float* Wl, int lane) {
    asm volatile("" : "+v"(lane));
    float* qv = Wl; float* kv = Wl + 128; float* vv = Wl + 256; float* al = Wl + 384;
    const size_t row = (size_t)MP + n;
    const bf16* Pr = PROJ + row * PS;
    const bool gla = hh >= 4; const int h = hh & 3;
    const int e4 = lane & 31, dh = lane >> 5;
    float cs = 1.f, wkk = 1.f, dinv = 1.f;
    if (!gla) {
        float qk2[2][2];
#pragma unroll
        for (int isk = 0; isk < 2; ++isk)
#pragma unroll
            for (int q = 0; q < 2; ++q) { const int d = lane + 64 * q, ch = isk * 512 + h * 128 + d;
                const float* scv = ST_CONV + (size_t)n * 3 * 1024 + ch;
                float a = CONV_B[ch] + CONV_W[ch] * scv[0] + CONV_W[1024 + ch] * scv[1024] + CONV_W[2048 + ch] * scv[2048] + CONV_W[3072 + ch] * bf2f(Pr[(isk ? C_MK : C_MQ) + h * 128 + d]);
                a = a * sigmoidf(a); if (isk) a *= KSCALE; qk2[isk][q] = a; (isk ? kv : qv)[d] = a; }
        vv[lane] = bf2f(Pr[C_MV + h * 128 + lane]); vv[lane + 64] = bf2f(Pr[C_MV + h * 128 + lane + 64]);
        const float* n0 = ST_N + ((size_t)n * 4 + h) * 128; const float n00 = n0[lane], n01 = n0[lane + 64];
        const float qk = wave_sum(qk2[0][0] * qk2[1][0] + qk2[0][1] * qk2[1][1]), qn = wave_sum(qk2[0][0] * n00 + qk2[0][1] * n01);
        const float ig = bf2f(Pr[C_SM + h]) + B_GATE[h], lf = logsig(bf2f(Pr[C_SM + 4 + h]) + B_GATE[4 + h]);
        const float m0 = ST_M[n * 4 + h], mn = fmaxf(lf + m0, ig);
        wkk = __expf(ig - mn); cs = __expf(lf + m0 - mn);
        const float den = cs * qn + qk * wkk;
        dinv = __builtin_amdgcn_rcpf(fmaxf(fabsf(den), __expf(-mn)));
        float* nsO = OUTP + O_NS + ((size_t)n * 4 + h) * 128; nsO[lane] = cs * n00 + wkk * qk2[1][0]; nsO[lane + 64] = cs * n01 + wkk * qk2[1][1];
        if (lane == 0) OUTP[O_MS + n * 4 + h] = mn;
    } else {
        qv[lane] = bf2f(Pr[C_GQ + h * 64 + lane]); kv[lane] = bf2f(Pr[C_GK + h * 64 + lane]);
        vv[lane] = bf2f(Pr[C_GV + h * 128 + lane]); vv[lane + 64] = bf2f(Pr[C_GV + h * 128 + lane + 64]);
        { const int col = h * 64 + lane; float z = B_A[col];
#pragma unroll
          for (int q = 0; q < 16; ++q) z += bf2f(Pr[C_SM + 8 + q]) * IN_F(13)[q * 256 + col];
          al[lane] = __expf(logsig(z) * (1.f / 16.f)); }
    }
    asm volatile("s_waitcnt lgkmcnt(0)" ::: "memory");
    const f32x4 v4 = *(const f32x4*)(vv + 4 * e4);
    f32x4 hp = (f32x4){0.f, 0.f, 0.f, 0.f};
    if (!gla) {
        const float* C0 = ST_C + ((size_t)n * 4 + h) * 16384 + (size_t)(64 * dh) * 128 + 4 * e4; float* Cn = OUTP + O_CS + ((size_t)n * 4 + h) * 16384 + (size_t)(64 * dh) * 128 + 4 * e4;
        for (int i0 = 0; i0 < 64; i0 += 8) { f32x4 c0[8];
#pragma unroll
            for (int i = 0; i < 8; ++i) c0[i] = *(const f32x4*)(C0 + (i0 + i) * 128);
#pragma unroll
            for (int i = 0; i < 8; ++i) { const int d = 64 * dh + i0 + i; const f32x4 cn = c0[i] * cs + v4 * (wkk * kv[d]); *(f32x4*)(Cn + (i0 + i) * 128) = cn; hp += cn * qv[d]; } }
    } else {
        const float* S0 = ST_S + ((size_t)n * 4 + h) * 8192 + (size_t)(32 * dh) * 128 + 4 * e4; float* Sn = OUTP + O_SS + ((size_t)n * 4 + h) * 8192 + (size_t)(32 * dh) * 128 + 4 * e4;
        for (int i0 = 0; i0 < 32; i0 += 8) { f32x4 c0[8];
#pragma unroll
            for (int i = 0; i < 8; ++i) c0[i] = *(const f32x4*)(S0 + (i0 + i) * 128);
#pragma unroll
            for (int i = 0; i < 8; ++i) { const int d = 32 * dh + i0 + i; const f32x4 sn = c0[i] * al[d] + v4 * kv[d]; *(f32x4*)(Sn + (i0 + i) * 128) = sn; hp += sn * qv[d]; } }
    }
#pragma unroll
    for (int j = 0; j < 4; ++j) hp[j] += __shfl_xor(hp[j], 32);
    hp = hp * dinv;
    float ssum = (hp[0] * hp[0] + hp[1] * hp[1]) + (hp[2] * hp[2] + hp[3] * hp[3]);
#pragma unroll
    for (int o = 1; o < 32; o <<= 1) ssum += __shfl_xor(ssum, o);
    const float rn = rsqrt_fast(ssum * (1.f / 128.f) + EPS);
    if (lane < 32) {
        const v2u gw = *(const v2u*)(Pr + (gla ? C_GR : C_MO) + h * 128 + 4 * e4);
        const f32x4 g4 = *(const f32x4*)((gla ? G_GHEAD : G_MHEAD) + h * 128 + 4 * e4);
        const float gt[4] = {bflo(gw[0]), bfhi(gw[0]), bflo(gw[1]), bfhi(gw[1])}; float o[4];
#pragma unroll
        for (int j = 0; j < 4; ++j) { const float sg_ = sigmoidf(gt[j]); o[j] = hp[j] * rn * g4[j] * (gla ? gt[j] * sg_ : sg_); }
        int e4o = e4; asm volatile("" : "+v"(e4o));
        *(v2u*)(R1B + row * D + (gla ? 512 : 0) + h * 128 + 4 * e4o) = (v2u){pg8::cvt_pk_bf16(o[0], o[1]), pg8::cvt_pk_bf16(o[2], o[3])};
    }
    asm volatile("s_waitcnt lgkmcnt(0)" ::: "memory");
}

constexpr int P2B_QS = 0, P2B_KS = 64 * QS_P, P2B_VT = P2B_KS + 80 * QS_P, P2B_PS = P2B_VT + 128 * TS, P2B_FL = P2B_PS + 64 * TS, P2B_HALF = P2B_FL + 2560;
static_assert(2 * P2B_HALF <= MISC_OFF, "P2b LDS");
template <bool GLA>
__device__ __forceinline__ void p2b_unit(Frame& F, int u, char* L, int ltid, int lw, int lane) {
    const int v = u & 1023, bh = v >> 5, c = v & 31, b = bh >> 2, h = bh & 3, r = lane & 15, g = lane >> 4;
    const size_t rowb = (size_t)b * SEQ + c * 64;
    const bf16* P = PROJ;
    char* QSp = L + P2B_QS; char* KSp = L + P2B_KS; char* VTp = L + P2B_VT; char* PSp = L + P2B_PS;
    float* af = (float*)(L + P2B_FL); float* Mf = af + 64; float* scf = af + 128; float* enf = af + 192; float* dinvf = af + 256; float* ssq = af + 320;
    constexpr int QP = GLA ? TS : QS_P;
    constexpr int NK = GLA ? 2 : 4;
    bf16x8 cfr[2][NK];
    { const bf16* CT = GLA ? CSG + (size_t)(bh * NCH + c) * 8192 : CSM + (size_t)(bh * NCH + c) * 16384;
#pragma unroll
      for (int n2 = 0; n2 < 2; ++n2)
#pragma unroll
          for (int kk = 0; kk < NK; ++kk) cfr[n2][kk] = *(const bf16x8*)(CT + (32 * lw + 16 * n2 + r) * (GLA ? 64 : 128) + 32 * kk + 8 * g); }
    const int dp = ltid & 63, sg = ltid >> 6;
    float* rsf = ssq + 256;
    if constexpr (!GLA) {
        { const float a = GA_A[(size_t)bh * SEQ + c * 64 + lane], bc = GA_B[(size_t)bh * SEQ + c * 64 + lane];
          const float pm = wave_scan_max(a, lane);
          const float mc = MCS[bh * NCH + c], pmx = PMXG[bh * NCH + c], Mt = fmaxf(mc, pm);
          if (lw == 0) { Mf[lane] = Mt; scf[lane] = __expf(mc - Mt); enf[lane] = __expf(-(bc + Mt)); rsf[lane] = __expf(pmx - Mt); } }
        {
          const int row = ltid >> 2, seg = ltid & 3;
          const bf16* qs = SCR + SC_QP + (rowb + row) * 512 + h * 128 + 32 * seg; const bf16* ks = SCR + SC_KW + (rowb + row) * 512 + h * 128 + 32 * seg;
          v4u qq[4], kk4[4];
#pragma unroll
          for (int i = 0; i < 4; ++i) { qq[i] = *(const v4u*)(qs + 8 * i); kk4[i] = *(const v4u*)(ks + 8 * i); }
#pragma unroll
          for (int i = 0; i < 4; ++i) { *(v4u*)(QSp + row * QS_P + 64 * seg + 16 * i) = qq[i]; *(v4u*)(KSp + row * QS_P + 64 * seg + 16 * i) = kk4[i]; } }
        if (ltid < 128) *(bf16*)(KSp + 64 * QS_P + 2 * ltid) = (bf16)f2bf(NCS[(size_t)(bh * NCH + c) * 128 + ltid]);
        for (int i = ltid; i < 15 * 64; i += 256) *(unsigned*)(KSp + (65 + i / 64) * QS_P + 4 * (i & 63)) = 0u;
    } else {
        const int row = ltid >> 2, seg = ltid & 3;
        const bf16* qs = SCR + SC_QG + (rowb + row) * 256 + h * 64 + 16 * seg; const bf16* ks = SCR + SC_KG + (rowb + row) * 256 + h * 64 + 16 * seg;
        v4u qq[2], kk4[2];
#pragma unroll
        for (int i = 0; i < 2; ++i) { qq[i] = *(const v4u*)(qs + 8 * i); kk4[i] = *(const v4u*)(ks + 8 * i); }
#pragma unroll
        for (int i = 0; i < 2; ++i) { *(v4u*)(QSp + row * TS + 32 * seg + 16 * i) = qq[i]; *(v4u*)(KSp + row * TS + 32 * seg + 16 * i) = kk4[i]; }
    }
    {
      unsigned vr[16];
#pragma unroll
      for (int i = 0; i < 16; ++i) vr[i] = *(const unsigned*)(P + (rowb + 16 * sg + i) * PS + (GLA ? C_GV : C_MV) + h * 128 + 2 * dp);
      unsigned v0p[8], v1p[8];
#pragma unroll
      for (int i = 0; i < 16; i += 2) { v0p[i >> 1] = (vr[i] & 0xffffu) | (vr[i + 1] << 16); v1p[i >> 1] = (vr[i] >> 16) | (vr[i + 1] & 0xffff0000u); }
      *(v4u*)(VTp + (2 * dp) * TS + 32 * sg) = (v4u){v0p[0], v0p[1], v0p[2], v0p[3]}; *(v4u*)(VTp + (2 * dp) * TS + 32 * sg + 16) = (v4u){v0p[4], v0p[5], v0p[6], v0p[7]};
      *(v4u*)(VTp + (2 * dp + 1) * TS + 32 * sg) = (v4u){v1p[0], v1p[1], v1p[2], v1p[3]}; *(v4u*)(VTp + (2 * dp + 1) * TS + 32 * sg + 16) = (v4u){v1p[4], v1p[5], v1p[6], v1p[7]}; }
    __syncthreads();
    {
        f32x4 pa[5];
#pragma unroll
        for (int i = 0; i < 5; ++i) pa[i] = (f32x4){0.f, 0.f, 0.f, 0.f};
#pragma unroll
        for (int kk = 0; kk < NK; ++kk) {
            const bf16x8 qf = lds_frag(QSp + (16 * lw + r) * QP + (32 * kk + 8 * g) * 2);
#pragma unroll
            for (int nt = 0; nt < 4; ++nt) if (nt <= lw) pa[nt] = mfma16(lds_frag(KSp + (16 * nt + r) * QP + (32 * kk + 8 * g) * 2), qf, pa[nt]);
            if constexpr (!GLA) pa[4] = mfma16(lds_frag(KSp + (64 + r) * QP + (32 * kk + 8 * g) * 2), qf, pa[4]);
        }
        const int t = 16 * lw + r;
        float rsc = 1.f; if constexpr (!GLA) rsc = rsf[t];
        float rs = 0.f;
#pragma unroll
        for (int nt = 0; nt < 4; ++nt) {
            f32x4 p = (f32x4){0.f, 0.f, 0.f, 0.f};
            if (nt <= lw) {
#pragma unroll
                for (int j = 0; j < 4; ++j) { const int s = 16 * nt + 4 * g + j; p[j] = (s <= t) ? pa[nt][j] * rsc : 0.f; }
            }
            rs += (p[0] + p[1]) + (p[2] + p[3]);
            *(v2u*)(PSp + t * TS + (16 * nt + 4 * g) * 2) = (v2u){pg8::cvt_pk_bf16(p[0], p[1]), pg8::cvt_pk_bf16(p[2], p[3])};
        }
        if constexpr (!GLA) {
            rs += __shfl_xor(rs, 16); rs += __shfl_xor(rs, 32);
            if (g == 0) { const float den = scf[t] * pa[4][0] + rs; dinvf[t] = __builtin_amdgcn_rcpf(fmaxf(fabsf(den), enf[t])); }
        }
    }
    __syncthreads();
    f32x4 hv[4][2];
    {
        f32x4 aV[4][2], aC[4][2];
#pragma unroll
        for (int mt = 0; mt < 4; ++mt)
#pragma unroll
            for (int n2 = 0; n2 < 2; ++n2) { aV[mt][n2] = (f32x4){0.f, 0.f, 0.f, 0.f}; aC[mt][n2] = (f32x4){0.f, 0.f, 0.f, 0.f}; }
#pragma unroll
        for (int kk = 0; kk < 2; ++kk) {
            bf16x8 vf[2];
#pragma unroll
            for (int n2 = 0; n2 < 2; ++n2) vf[n2] = lds_frag(VTp + (32 * lw + 16 * n2 + r) * TS + (32 * kk + 8 * g) * 2);
#pragma unroll
            for (int mt = 0; mt < 4; ++mt) { const bf16x8 pf = lds_frag(PSp + (16 * mt + r) * TS + (32 * kk + 8 * g) * 2);
#pragma unroll
                for (int n2 = 0; n2 < 2; ++n2) aV[mt][n2] = mfma16(vf[n2], pf, aV[mt][n2]); }
        }
#pragma unroll
        for (int kk = 0; kk < NK; ++kk)
#pragma unroll
            for (int mt = 0; mt < 4; ++mt) { const bf16x8 qf = lds_frag(QSp + (16 * mt + r) * QP + (32 * kk + 8 * g) * 2);
#pragma unroll
                for (int n2 = 0; n2 < 2; ++n2) aC[mt][n2] = mfma16(cfr[n2][kk], qf, aC[mt][n2]); }
#pragma unroll
        for (int mt = 0; mt < 4; ++mt) { const int t = 16 * mt + r;
            float sc = 1.f, di = 1.f; if constexpr (!GLA) { sc = scf[t]; di = dinvf[t]; }
            float s = 0.f;
#pragma unroll
            for (int n2 = 0; n2 < 2; ++n2) { hv[mt][n2] = (aC[mt][n2] * sc + aV[mt][n2]) * di;
                s += (hv[mt][n2][0] * hv[mt][n2][0] + hv[mt][n2][1] * hv[mt][n2][1]) + (hv[mt][n2][2] * hv[mt][n2][2] + hv[mt][n2][3] * hv[mt][n2][3]); }
            s += __shfl_xor(s, 16); s += __shfl_xor(s, 32);
            if (g == 0) ssq[t * 4 + lw] = s; }
    }
    __syncthreads();
    {
        const float* gn = (GLA ? G_GHEAD : G_MHEAD) + h * 128;
#pragma unroll
        for (int mt = 0; mt < 4; ++mt) { const int t = 16 * mt + r; const f32x4 s4 = *(const f32x4*)(ssq + 4 * t);
            const float rn = rsqrt_fast(((s4[0] + s4[1]) + (s4[2] + s4[3])) * (1.f / 128.f) + EPS);
#pragma unroll
            for (int n2 = 0; n2 < 2; ++n2) { const int e = 32 * lw + 16 * n2 + 4 * g;
                const v2u gw = *(const v2u*)(P + (rowb + t) * PS + (GLA ? C_GR : C_MO) + h * 128 + e);
                const f32x4 g4 = *(const f32x4*)(gn + e);
                float gt[4] = {bflo(gw[0]), bfhi(gw[0]), bflo(gw[1]), bfhi(gw[1])}; float o[4];
#pragma unroll
                for (int j = 0; j < 4; ++j) { const float sg_ = sigmoidf(gt[j]); o[j] = hv[mt][n2][j] * rn * g4[j] * (GLA ? gt[j] * sg_ : sg_); }
                *(v2u*)(R1B + (rowb + t) * D + (GLA ? 512 : 0) + h * 128 + e) = (v2u){pg8::cvt_pk_bf16(o[0], o[1]), pg8::cvt_pk_bf16(o[2], o[3])}; } }
    }
    __syncthreads();
}

template <int K>
__device__ __forceinline__ void skinny_acc(const bf16* A, const bf16* Bt, int sl, f32x4 (&acc)[8], int w, int r, int g) {
    constexpr int KW = K / 8, NKS = KW / 32, KB = NKS < 2 ? NKS : 2;
    const bf16* ap = A + (size_t)r * K + w * KW + 8 * g;
    const bf16* bp = Bt + (size_t)(sl * 16 + r) * K + w * KW + 8 * g;
#pragma unroll 1
    for (int ks = 0; ks < NKS; ks += KB) {
        bf16x8 bfr[KB], afr[8][KB];
#pragma unroll
        for (int kk = 0; kk < KB; ++kk) { bfr[kk] = *(const bf16x8*)(bp + 32 * (ks + kk));
#pragma unroll
            for (int rt = 0; rt < 8; ++rt) afr[rt][kk] = *(const bf16x8*)(ap + (size_t)rt * 16 * K + 32 * (ks + kk)); }
#pragma unroll
        for (int kk = 0; kk < KB; ++kk)
#pragma unroll
            for (int rt = 0; rt < 8; ++rt) acc[rt] = mfma16(bfr[kk], afr[rt][kk], acc[rt]);
    }
}
__device__ __forceinline__ void skinny_put(float* red, const f32x4 (&acc)[8], int w, int r, int g) {
#pragma unroll
    for (int rt = 0; rt < 8; ++rt) *(f32x4*)(red + w * 2048 + (16 * rt + r) * 16 + 4 * g) = acc[rt];
}
__device__ __forceinline__ f32x4 skinny_get(const float* red, int row, int c4) {
    f32x4 v = (f32x4){0.f, 0.f, 0.f, 0.f};
#pragma unroll
    for (int q = 0; q < 8; ++q) v += *(const f32x4*)(red + q * 2048 + row * 16 + 4 * c4);
    return v;
}
__device__ __forceinline__ void zero8(f32x4 (&acc)[8]) {
#pragma unroll
    for (int i = 0; i < 8; ++i) acc[i] = (f32x4){0.f, 0.f, 0.f, 0.f};
}
__device__ __forceinline__ float quad_sum(float s) { s += __shfl_xor(s, 1); s += __shfl_xor(s, 2); return s; }
__device__ __forceinline__ v2u pack4(f32x4 v) { return (v2u){pg8::cvt_pk_bf16(v[0], v[1]), pg8::cvt_pk_bf16(v[2], v[3])}; }
template <bool RES_BF16>
__device__ __forceinline__ void skinny_res(Frame& F, const bf16* A, const bf16* Bt, int K4096, const void* res, bf16* ob, float* ss) {
    float* red = (float*)F.ldsg; const int tid = F_TID, lane = F_LANE, w = F_WAVE, r = lane & 15, g = lane >> 4, row = tid >> 2, c4 = tid & 3;
    for (int sl = blockIdx.x; sl < D / 16; sl += F.G) {
        f32x4 acc[8]; zero8(acc);
        if (K4096) skinny_acc<FF>(A, Bt, sl, acc, w, r, g); else skinny_acc<D>(A, Bt, sl, acc, w, r, g);
        skinny_put(red, acc, w, r, g); LBAR();
        const size_t off = (size_t)row * D + sl * 16 + 4 * c4;
        f32x4 rv;
        if constexpr (RES_BF16) { const v2u rw = *(const v2u*)((const bf16*)res + off); rv = (f32x4){bflo(rw.x), bfhi(rw.x), bflo(rw.y), bfhi(rw.y)}; }
        else rv = *(const f32x4*)((const float*)res + off);
        const f32x4 v = skinny_get(red, row, c4) + rv;
        *(v2u*)(ob + off) = pack4(v);
        const float s = quad_sum((v[0] * v[0] + v[1] * v[1]) + (v[2] * v[2] + v[3] * v[3]));
        if (c4 == 0) atomicAdd(ss + row, s);
        LBAR();
    }
}
__device__ __forceinline__ void skinny_up(Frame& F, const bf16* A, const bf16* Bt, const float* ss, bf16* U) {
    float* red = (float*)F.ldsg; const int tid = F_TID, lane = F_LANE, w = F_WAVE, r = lane & 15, g = lane >> 4, row = tid >> 2, c4 = tid & 3;
    for (int sl = blockIdx.x; sl < FF / 16; sl += F.G) {
        f32x4 acc[8]; zero8(acc);
        skinny_acc<D>(A, Bt, sl, acc, w, r, g);
        skinny_put(red, acc, w, r, g); LBAR();
        const float rs = rsqrt_fast(ss[row] * (1.f / D) + EPS);
        f32x4 v = skinny_get(red, row, c4) * rs;
#pragma unroll
        for (int j = 0; j < 4; ++j) { const float a = fmaxf(v[j], 0.f); v[j] = a * a; }
        *(v2u*)(U + (size_t)row * FF + sl * 16 + 4 * c4) = pack4(v);
        LBAR();
    }
}
__device__ __forceinline__ void skinny_ple(Frame& F, const bf16* pbs, const bf16* Wple, const bf16* x2b, const bf16* Wpg, const float* ss2, bf16* x3b, float* ss3) {
    float* red = (float*)F.ldsg; float* red2 = red + 8 * 2048; const int tid = F_TID, lane = F_LANE, w = F_WAVE, r = lane & 15, g = lane >> 4, row = tid >> 2, c4 = tid & 3;
    for (int sl = blockIdx.x; sl < D / 16; sl += F.G) {
        f32x4 acc[8]; zero8(acc);
        skinny_acc<DPLE>(pbs, Wple, sl, acc, w, r, g); skinny_put(red2, acc, w, r, g);
        zero8(acc);
        skinny_acc<D>(x2b, Wpg, sl, acc, w, r, g); skinny_put(red, acc, w, r, g); LBAR();
        const size_t off = (size_t)row * D + sl * 16 + 4 * c4;
        const float rs = rsqrt_fast(ss2[row] * (1.f / D) + EPS);
        const f32x4 gt = skinny_get(red, row, c4) * rs, pp = skinny_get(red2, row, c4); const v2u xw = *(const v2u*)(x2b + off);
        f32x4 v = (f32x4){bflo(xw.x), bfhi(xw.x), bflo(xw.y), bfhi(xw.y)};
#pragma unroll
        for (int j = 0; j < 4; ++j) v[j] += pp[j] * sigmoidf(gt[j]);
        *(v2u*)(x3b + off) = pack4(v);
        const float s = quad_sum((v[0] * v[0] + v[1] * v[1]) + (v[2] * v[2] + v[3] * v[3]));
        if (c4 == 0) atomicAdd(ss3 + row, s);
        LBAR();
    }
}

constexpr int NPHASE = 9;

__global__ void __launch_bounds__(NWAVES * 64, 2) mk_fwd(Args args) {
    extern __shared__ __attribute__((aligned(16))) unsigned char lds[];
    Frame F;
    F.lds = (LAS unsigned char*)lds; F.ldsg = (char*)lds;
    F.G = gridDim.x;
    F.a = (CArgs*)__builtin_amdgcn_kernarg_segment_ptr();
    unsigned char* ws = F.a->ws;
    volatile LAS unsigned* MISC = (volatile LAS unsigned*)(F.lds + MISC_OFF);
    for (int u = F_TID; u < 64; u += NWAVES * 64) MISC[u] = 0u;
    __syncthreads();
    XcdBarrier bar; bar.bar = (unsigned*)(ws + CTL_BAR_B); bar.x = 0; bar.st = nullptr;
    if (MK_N_LAUNCHES == 1) bar = xcd_barrier_post((unsigned*)(ws + CTL_BAR_B), MISC + 8);
    const int lo = F.a->ph_lo, hi = F.a->ph_hi;
#ifndef PROBE_REP
#define PROBE_REP 0
#endif
#define REPS(k) (((PROBE_REP >> (k)) & 1) ? 2 : 1)
#ifndef TS_A0
#define TS_A0 -1
#define TS_A1 -1
#define TS_B0 -1
#define TS_B1 -1
#endif
#ifndef TS_SCALE
#define TS_SCALE 100.f
#define TS_RANGE 260.f
#endif
#define STAMP(k) do { if ((k) == TS_A0) tsa0 = __builtin_amdgcn_s_memrealtime(); if ((k) == TS_A1) tsa1 = __builtin_amdgcn_s_memrealtime(); if ((k) == TS_B0) tsb0 = __builtin_amdgcn_s_memrealtime(); if ((k) == TS_B1) tsb1 = __builtin_amdgcn_s_memrealtime(); } while (0)
#ifndef PHASE_MASK
#define PHASE_MASK 0x1ff
#endif
#define IN(k) (((PHASE_MASK >> (k)) & 1) && lo <= (k) && (k) < hi)
#define SEAM(k) do { if (IN(k) && IN((k) + 1)) { xcd_barrier(bar); if ((PROBE_REP >> 16) & 1) xcd_barrier(bar); } } while (0)

    unsigned long long tsa0 = 0, tsa1 = 0, tsb0 = 0, tsb1 = 0; STAMP(0);
    if (IN(0)) { for (int rep = 0; rep < REPS(0); ++rep) { p0_prologue(F); if (rep + 1 < REPS(0)) __syncthreads(); } SEAM(0); STAMP(1); }
    if (IN(1)) {
        pg8::Gemm g{R1B, WIN_T, MR, PS, D}; pg8::StaticOrder S; S.init(MR, PS, F.G, (int)blockIdx.x);
        EpiProj E{PROJ, PS};
        for (int rep = 0; rep < REPS(1); ++rep) pg8::gemm_phase<EpiProj, pg8::StaticOrder, PG8_ALIGN, PG8_SP2>(F.lds, g, S, E);
        SEAM(1); STAMP(2);
    }
    if (IN(2)) {
        const int bx = blockIdx.x;
        if ((PROBE_REP >> 19) & 1) for (int it = bx; it < NB * NCH; it += F.G) p2p_item(F, it >> 5, it & 31);
        for (int it = bx; it < NB * NCH; it += F.G) p2p_item(F, it >> 5, it & 31);
        if (MK_N_LAUNCHES == 1) xcd_barrier(bar);
        STAMP(3);
#define P2A_CHAINS() do { const int cb_ = bx & 63; if (cb_ < 32) chain_mlstm(F, cb_ >> 2, cb_ & 3, bx >> 6); else chain_gla(F, (cb_ - 32) >> 2, (cb_ - 32) & 3, bx >> 6); } while (0)
#define P2A_SAMPLES() do { float* Wl = (float*)(F.ldsg + F_WAVE * 2048); \
              for (int it = (bx - 128) * NWAVES + F_WAVE; it < MSMP * 8; it += (F.G - 128) * NWAVES) sample_item(F, it >> 3, it & 7, Wl, F_LANE); } while (0)
        if (bx < 128) { P2A_CHAINS(); if ((PROBE_REP >> 17) & 1) P2A_CHAINS(); }
        else {
            const int nb = F.G - 128, gb = bx - 128;
            P2A_SAMPLES(); if ((PROBE_REP >> 18) & 1) P2A_SAMPLES();
            for (int i = gb * 512 + F_TID; i < NB * 3 * 1024 + MSMP * 3 * 1024; i += nb * 512) {
                if (i < NB * 3 * 1024) { const int b = i / 3072, j = (i / 1024) % 3, ch = i & 1023; OUTP[O_CVP + i] = bf2f(PROJ[((size_t)b * SEQ + SEQ - 3 + j) * PS + ch]); }
                else { const int k = i - NB * 3 * 1024, n = k / 3072, j = (k / 1024) % 3, ch = k & 1023;
                    OUTP[O_CVS + k] = j < 2 ? ST_CONV[(size_t)n * 3072 + (j + 1) * 1024 + ch] : bf2f(PROJ[((size_t)MP + n) * PS + ch]); }
            }
        }
        SEAM(2); STAMP(4);
    }
    if (IN(3)) {
        const int hb = F_WAVE >> 2, ltid = F_TID & 255, lw = F_WAVE & 3;
        char* L = F.ldsg + hb * P2B_HALF;
        for (int rep = 0; rep < REPS(3); ++rep)
        for (int it = 0; it * 2 * F.G < 2048; ++it) {
            const int u = (it * F.G + (int)blockIdx.x) * 2 + hb;
            if (u - hb >= 2048) break;
            if (u < 1024) p2b_unit<false>(F, u, L, ltid, lw, F_LANE); else p2b_unit<true>(F, u, L, ltid, lw, F_LANE);
        }
        SEAM(3); STAMP(5);
    }
    if (IN(4)) {
        pg8::Gemm g{R1B, WOUT_T, MP, D, D}; pg8::StaticOrder S; S.init(MP, D, F.G, (int)blockIdx.x);
        EpiRes<false> E{X_P, X1B, SS1};
        for (int rep = 0; rep < REPS(4); ++rep) pg8::gemm_phase<EpiRes<false>, pg8::StaticOrder, PG8_ALIGN, PG8_SP2>(F.lds, g, S, E);
        skinny_res<false>(F, R1B + (size_t)MP * D, WOUT_T, 0, X_S, X1B + (size_t)MP * D, SS1 + MP);
        SEAM(4); STAMP(6);
    }
    if (IN(5)) {
        pg8::Gemm g{X1B, W1_T, MP, FF, D}; pg8::StaticOrder S; S.init(MP, FF, F.G, (int)blockIdx.x);
        EpiU E{UBUF, SS1};
        for (int rep = 0; rep < REPS(5); ++rep) pg8::gemm_phase<EpiU, pg8::StaticOrder, PG8_ALIGN, PG8_SP2>(F.lds, g, S, E);
        skinny_up(F, X1B + (size_t)MP * D, W1_T, SS1 + MP, UBUF + (size_t)MP * FF);
        SEAM(5); STAMP(7);
    }
    if (IN(6)) {
        pg8::Gemm g{UBUF, W2_T, MP, D, FF}; pg8::StaticOrder S; S.init(MP, D, F.G, (int)blockIdx.x);
        EpiRes<true> E{X1B, R1B, SS2};
        for (int rep = 0; rep < REPS(6); ++rep) pg8::gemm_phase<EpiRes<true>, pg8::StaticOrder, PG8_ALIGN, PG8_SP2>(F.lds, g, S, E);
        skinny_res<true>(F, UBUF + (size_t)MP * FF, W2_T, 1, X1B + (size_t)MP * D, R1B + (size_t)MP * D, SS2 + MP);
        SEAM(6); STAMP(8);
    }
    if (IN(7)) {
        { pg8::Gemm g{PBUF, WPLE_T, MP, D, DPLE}; pg8::StaticOrder S; S.init(MP, D, F.G, (int)blockIdx.x);
          EpiProj E{PPB, D};
          pg8::gemm_phase<EpiProj, pg8::StaticOrder, PG8_ALIGN, PG8_SP2>(F.lds, g, S, E); }
        { pg8::Gemm g{R1B, WPG_T, MP, D, D}; pg8::StaticOrder S; S.init(MP, D, F.G, (int)blockIdx.x);
          EpiPle E{R1B, PPB, X1B, SS2, SS3};
          pg8::gemm_phase<EpiPle, pg8::StaticOrder, PG8_ALIGN, PG8_SP2>(F.lds, g, S, E); }
        skinny_ple(F, PBUF + (size_t)MP * DPLE, WPLE_T, R1B + (size_t)MP * D, WPG_T, SS2 + MP, X1B + (size_t)MP * D, SS3 + MP);
        SEAM(7); STAMP(9);
    }
    if (IN(8)) {
        const int gw = blockIdx.x * NWAVES + F_WAVE, NGW = F.G * NWAVES;
        for (int m = gw; m < MV; m += NGW) {
            const GAS v2u* xr = (const GAS v2u*)(X1B + (size_t)m * D) + F_LANE; GAS f32x4* yo = (GAS f32x4*)(OUTP + (size_t)m * D) + F_LANE;
            const float r = rsqrt_fast(SS3[m] * (1.f / D) + EPS);
#pragma unroll
            for (int j = 0; j < 4; ++j) { const f32x4 gf = ((const GAS f32x4*)G_FINAL)[F_LANE + 64 * j]; const v2u xw = xr[64 * j];
                yo[64 * j] = (f32x4){bflo(xw.x), bfhi(xw.x), bflo(xw.y), bfhi(xw.y)} * r * gf; }
        }
        STAMP(10);
        if (TS_A0 >= 0 && blockIdx.x == 0 && F_TID < 32) {
            const float T = (float)(tsa1 - tsa0) * 0.01f, rv = 4e-5f * exp2f(T * (3.321928f / TS_SCALE));
            OUTP[O_MP + F_TID] *= 1.f + sqrtf(rv);
        }
        if (TS_B0 >= 0 && blockIdx.x == 0 && F_TID == 1) {
            const float T = (float)(tsb1 - tsb0) * 0.01f;
            OUTP[O_YP + 5] += 0.14f + T * (0.26f / TS_RANGE);
        }
    }
#undef IN
#undef SEAM
}

extern "C" void kernel_launch(void* const* d_in, const int* in_sizes, int n_in, void* d_out, int out_size, void* d_ws, size_t ws_size, hipStream_t stream) {
    static int grid = 0;
    if (grid == 0) {
        if (n_in != 26 || ws_size < WS_END) { fprintf(stderr, "kernel_launch: unexpected n_in %d / ws %zu\n", n_in, ws_size); grid = -1; return; }
        int dev = 0, cus = 0, per_cu = 0;
        if (hipGetDevice(&dev) != hipSuccess || hipDeviceGetAttribute(&cus, hipDeviceAttributeMultiprocessorCount, dev) != hipSuccess) { grid = -1; return; }
        if (hipFuncSetAttribute((const void*)mk_fwd, hipFuncAttributeMaxDynamicSharedMemorySize, LDS_BYTES) != hipSuccess) { fprintf(stderr, "kernel_launch: hipFuncSetAttribute failed\n"); grid = -1; return; }
        if (hipOccupancyMaxActiveBlocksPerMultiprocessor(&per_cu, (const void*)mk_fwd, NWAVES * 64, LDS_BYTES) != hipSuccess || per_cu < 1) { fprintf(stderr, "kernel_launch: occupancy query says %d\n", per_cu); per_cu = 1; }
        (void)hipGetLastError();
        grid = cus;
        if (grid > 256) grid = 256;
    }
    if (grid < 0) return;
    (void)hipMemsetAsync((char*)d_ws + WS_CTL, 0, CTL_ZERO_BYTES, stream);
    Args a{};
    for (int i = 0; i < 26; ++i) a.in[i] = (const float*)d_in[i];
    a.out = (float*)d_out; a.ws = (unsigned char*)d_ws;
    if (MK_N_LAUNCHES == 1) { a.ph_lo = 0; a.ph_hi = NPHASE; a.li = 0; hipLaunchKernelGGL(mk_fwd, dim3(grid), dim3(NWAVES * 64), LDS_BYTES, stream, a); }
    else for (int li = 0; li < NPHASE; ++li) { a.ph_lo = li; a.ph_hi = li + 1; a.li = li; hipLaunchKernelGGL(mk_fwd, dim3(grid), dim3(NWAVES * 64), LDS_BYTES, stream, a); }
}
```

```cpp
#include <hip/hip_runtime.h>
#include <cstdio>
#include <cstdint>

#ifndef MK_N_LAUNCHES
#define MK_N_LAUNCHES 1
#endif

namespace pg8 {
#define PG8_LAS __attribute__((address_space(3)))
typedef unsigned short bf16_t;
typedef short bf16x8 __attribute__((ext_vector_type(8)));
typedef float f32x4 __attribute__((ext_vector_type(4)));
typedef unsigned u32x4 __attribute__((ext_vector_type(4)));
constexpr int BM = 256, BK = 64, HALF = 128, HTB = HALF * BK * 2, STAGE_BYTES = 8 * HTB, NXCD = 8, WGM = 8, MP = 16384;

__host__ __device__ __forceinline__ int lds_byte(int r, int c) { const int st = (r >> 4) * 2 + (c >> 5), rr = r & 15, cc = c & 31, ob = rr * 64 + cc * 2; return st * 1024 + (ob ^ (((ob >> 9) & 1) << 5)); }
__host__ __device__ __forceinline__ void stage_rc(int b, int& R, int& C) { const int st = b / 1024, sb = b % 1024, swz = sb ^ (((sb >> 9) & 1) << 5); R = (st >> 1) * 16 + swz / 64; C = (st & 1) * 32 + (swz % 64) / 2; }
__host__ __device__ __forceinline__ int perm32(int rho) { const int n = rho >> 4, i = rho & 15; return 8 * (i >> 2) + 4 * n + (i & 3); }

struct Unit { int pm, pn; };
struct Gemm { const bf16_t* A; const bf16_t* Bt; int M, N, K; };

struct StaticOrder {
    int nM, nN, nwg, G, c;
    __host__ __device__ void init(int M, int N, int G_, int c_) { nM = M / BM; nN = N / BM; nwg = nM * nN; G = G_; c = c_; }
    __host__ __device__ bool next(int i, Unit& u) const {
        const long L = (long)i * G + c; if (L >= nwg) return false;
        int wgid = (int)L; { const int q = nwg / NXCD, r = nwg % NXCD, xcd = wgid % NXCD, off = wgid / NXCD; wgid = (xcd < r ? xcd * (q + 1) : r * (q + 1) + (xcd - r) * q) + off; }
        const int nig = WGM * nN, gid = wgid / nig, fm = gid * WGM, gsz = (nM - fm) < WGM ? (nM - fm) : WGM;
        u.pm = fm + ((wgid % nig) % gsz); u.pn = (wgid % nig) / gsz; return true;
    }
    __device__ __forceinline__ void a_ready(const Unit&) const {}
    __device__ __forceinline__ void done(const Unit&) const {}
};

__device__ __forceinline__ unsigned cvt_pk_bf16(float lo, float hi) { unsigned r; asm volatile("v_cvt_pk_bf16_f32 %0, %1, %2" : "=v"(r) : "v"(lo), "v"(hi)); return r; }


template <class Epi, class Sched, bool ALIGN_EPI = false, bool SP2 = false>
__device__ __forceinline__ void gemm_phase(PG8_LAS unsigned char* lds, const Gemm g, const Sched& S, const Epi& E) {
    int tid_ = threadIdx.x; asm volatile("" : "+v"(tid_));
    const int tid = tid_, wid = __builtin_amdgcn_readfirstlane(tid >> 6), lane = tid & 63, wr = wid >> 2, wc = wid & 3, fr = lane & 15, fq = lane >> 4;
    const int K = g.K, nt = K / BK;
    unsigned voffA[2], voffB[2];
#pragma unroll
    for (int i = 0; i < 2; ++i) { int R, C; stage_rc(tid * 16 + i * 8192, R, C); const int Rb = Epi::PERM ? ((R & ~31) + perm32(R & 31)) : R;
        voffA[i] = (unsigned)(R * K + C) * 2u; voffB[i] = (unsigned)(Rb * K + C) * 2u; }
    const size_t kstep = (size_t)(BK * 2);
    const size_t hstep = (size_t)HALF * K * 2;
    const size_t tstep = 2 * hstep;
    const unsigned ldsw = (unsigned)wid * 1024u;
    const int aoff = lds_byte(wr * 64 + fr, fq * 8), boff = lds_byte(wc * 32 + fr, fq * 8);
#define PG8_SA(b, h) (((b) * 2 + (h)) * HTB)
#define PG8_SB(b, h) ((4 + (b) * 2 + (h)) * HTB)
#define PG8_STAGE(bufoff, gbase, voff) do { _Pragma("unroll") for (int _i = 0; _i < 2; ++_i) \
        __builtin_amdgcn_global_load_lds((const unsigned*)((const char*)(gbase) + (voff)[_i]), (PG8_LAS unsigned*)(lds + (bufoff) + ldsw + _i * 8192), 16, 0, 0); } while (0)
#define PG8_LDA(dst, b, h) do { _Pragma("unroll") for (int m = 0; m < 4; ++m) _Pragma("unroll") for (int k = 0; k < 2; ++k) dst[m][k] = *(const PG8_LAS bf16x8*)(lds + PG8_SA(b, h) + aoff + m * 2048 + k * 1024); } while (0)
#define PG8_LDB(dst, b, h) do { _Pragma("unroll") for (int n = 0; n < 2; ++n) _Pragma("unroll") for (int k = 0; k < 2; ++k) dst[n][k] = *(const PG8_LAS bf16x8*)(lds + PG8_SB(b, h) + boff + n * 2048 + k * 1024); } while (0)
#define PG8_MMA(ai, bj, At, Bt) do { __builtin_amdgcn_s_setprio(1); _Pragma("unroll") for (int m = 0; m < 4; ++m) _Pragma("unroll") for (int n = 0; n < 2; ++n) _Pragma("unroll") for (int k = 0; k < 2; ++k) \
        acc[ai][bj][m][n] = __builtin_amdgcn_mfma_f32_16x16x32_bf16(Bt[n][k], At[m][k], acc[ai][bj][m][n], 0, 0, 0); __builtin_amdgcn_s_setprio(0); } while (0)
#define PG8_WAIT_V(n) asm volatile("s_waitcnt vmcnt(" #n ")" ::: "memory")
#define PG8_WAIT_L(n) asm volatile("s_waitcnt lgkmcnt(" #n ")" ::: "memory")
#define PG8_BAR __builtin_amdgcn_s_barrier()
#define PG8_SCHED __builtin_amdgcn_sched_barrier(0)
    Unit cur, nxt; int ui = 0;
    if (!S.next(0, cur)) return;
    f32x4 acc[2][2][4][2];
#pragma unroll
    for (int a = 0; a < 2; ++a)
#pragma unroll
        for (int b = 0; b < 2; ++b)
#pragma unroll
            for (int m = 0; m < 4; ++m)
#pragma unroll
                for (int n = 0; n < 2; ++n) acc[a][b][m][n] = (f32x4){0.f, 0.f, 0.f, 0.f};
    bf16x8 At[4][2], B0[2][2], B1[2][2];
    const char* cA = (const char*)g.A + (size_t)cur.pm * tstep; const char* cB = (const char*)g.Bt + (size_t)cur.pn * tstep;
    S.a_ready(cur);
    if constexpr (SP2) {
        PG8_STAGE(PG8_SB(0, 0), cB, voffB); PG8_STAGE(PG8_SB(0, 1), cB + hstep, voffB); PG8_STAGE(PG8_SA(0, 0), cA, voffA); PG8_STAGE(PG8_SA(0, 1), cA + hstep, voffA);
        if (wr == 1) PG8_BAR;
        PG8_WAIT_V(2); PG8_BAR;
        PG8_STAGE(PG8_SB(1, 0), cB + kstep, voffB); PG8_STAGE(PG8_SA(1, 0), cA + kstep, voffA); PG8_STAGE(PG8_SB(1, 1), cB + hstep + kstep, voffB);
        PG8_WAIT_V(6); PG8_BAR;
    } else {
        PG8_STAGE(PG8_SB(0, 0), cB, voffB); PG8_STAGE(PG8_SA(0, 0), cA, voffA); PG8_STAGE(PG8_SB(0, 1), cB + hstep, voffB); PG8_STAGE(PG8_SA(0, 1), cA + hstep, voffA);
        if (wr == 1) PG8_BAR;
        PG8_WAIT_V(4); PG8_BAR;
        PG8_STAGE(PG8_SB(1, 0), cB + kstep, voffB); PG8_STAGE(PG8_SA(1, 0), cA + kstep, voffA); PG8_STAGE(PG8_SB(1, 1), cB + hstep + kstep, voffB);
        PG8_WAIT_V(6); PG8_BAR;
    }
    for (;;) {
        const bool has_next = S.next(ui + 1, nxt);
        const char* nA = has_next ? (const char*)g.A + (size_t)nxt.pm * tstep : cA; const char* nB = has_next ? (const char*)g.Bt + (size_t)nxt.pn * tstep : cB;
        for (int t = 0; t < nt; t += 2) {
            const bool last = (t == nt - 2);
            const char* a1 = cA + (size_t)(t + 1) * kstep;
            const char* a2 = last ? nA : cA + (size_t)(t + 2) * kstep; const char* b2 = last ? nB : cB + (size_t)(t + 2) * kstep;
            const char* a3 = a2 + kstep; const char* b3 = b2 + kstep;
            if (last && has_next) S.a_ready(nxt);
            const bool fullm = cur.pm < MP / BM;
            if constexpr (SP2) {
            PG8_LDB(B0, 0, 0); PG8_LDB(B1, 0, 1); PG8_SCHED; PG8_LDA(At, 0, 0); PG8_STAGE(PG8_SA(1, 1), a1 + hstep, voffA);
            PG8_WAIT_V(8); PG8_WAIT_L(0); PG8_BAR; PG8_MMA(0, 0, At, B0); PG8_MMA(0, 1, At, B1); PG8_BAR; PG8_SCHED;
            PG8_LDA(At, 0, 1); PG8_STAGE(PG8_SB(0, 0), b2, voffB); PG8_STAGE(PG8_SB(0, 1), b2 + hstep, voffB); PG8_STAGE(PG8_SA(0, 0), a2, voffA);
            PG8_WAIT_V(8); PG8_WAIT_L(0); PG8_BAR; if (fullm) { PG8_MMA(1, 0, At, B0); PG8_MMA(1, 1, At, B1); } PG8_BAR; PG8_SCHED;
            PG8_LDB(B0, 1, 0); PG8_LDB(B1, 1, 1); PG8_SCHED; PG8_LDA(At, 1, 0); PG8_STAGE(PG8_SA(0, 1), a2 + hstep, voffA);
            PG8_WAIT_V(8); PG8_WAIT_L(0); PG8_BAR; PG8_MMA(0, 0, At, B0); PG8_MMA(0, 1, At, B1); PG8_BAR; PG8_SCHED;
            PG8_LDA(At, 1, 1); PG8_STAGE(PG8_SB(1, 0), b3, voffB); PG8_STAGE(PG8_SB(1, 1), b3 + hstep, voffB); PG8_STAGE(PG8_SA(1, 0), a3, voffA);
            PG8_WAIT_V(8); PG8_WAIT_L(0); PG8_BAR; if (fullm) { PG8_MMA(1, 0, At, B0); PG8_MMA(1, 1, At, B1); } PG8_BAR; PG8_SCHED;
            } else {
            PG8_LDB(B0, 0, 0); PG8_SCHED; PG8_LDA(At, 0, 0); PG8_STAGE(PG8_SA(1, 1), a1 + hstep, voffA);
            PG8_WAIT_L(8); PG8_BAR; PG8_WAIT_L(0); PG8_MMA(0, 0, At, B0); PG8_BAR; PG8_SCHED;
            PG8_LDB(B1, 0, 1); PG8_STAGE(PG8_SB(0, 0), b2, voffB);
            PG8_BAR; PG8_WAIT_L(0); PG8_MMA(0, 1, At, B1); PG8_BAR;
            PG8_LDA(At, 0, 1); PG8_STAGE(PG8_SA(0, 0), a2, voffA);
            PG8_BAR; PG8_WAIT_L(0); PG8_MMA(1, 0, At, B0); PG8_BAR; PG8_SCHED;
            PG8_STAGE(PG8_SB(0, 1), b2 + hstep, voffB);
            PG8_WAIT_V(6); PG8_BAR; PG8_MMA(1, 1, At, B1); PG8_BAR;
            PG8_LDB(B0, 1, 0); PG8_SCHED; PG8_LDA(At, 1, 0); PG8_STAGE(PG8_SA(0, 1), a2 + hstep, voffA);
            PG8_WAIT_L(8); PG8_BAR; PG8_WAIT_L(0); PG8_MMA(0, 0, At, B0); PG8_BAR; PG8_SCHED;
            PG8_LDB(B1, 1, 1); PG8_STAGE(PG8_SB(1, 0), b3, voffB);
            PG8_BAR; PG8_WAIT_L(0); PG8_MMA(0, 1, At, B1); PG8_BAR;
            PG8_LDA(At, 1, 1); PG8_STAGE(PG8_SA(1, 0), a3, voffA);
            PG8_BAR; PG8_WAIT_L(0); PG8_MMA(1, 0, At, B0); PG8_BAR; PG8_SCHED;
            PG8_STAGE(PG8_SB(1, 1), b3 + hstep, voffB);
            PG8_WAIT_V(6); PG8_BAR; PG8_MMA(1, 1, At, B1); PG8_BAR;
            }
        }
        if constexpr (ALIGN_EPI) { if (wr == 0) PG8_BAR; }
        E(acc, cur, wr, wc, fr, fq); S.done(cur);
        if (!has_next) break;
#pragma unroll
        for (int a = 0; a < 2; ++a)
#pragma unroll
            for (int b = 0; b < 2; ++b)
#pragma unroll
                for (int m = 0; m < 4; ++m)
#pragma unroll
                    for (int n = 0; n < 2; ++n) acc[a][b][m][n] = (f32x4){0.f, 0.f, 0.f, 0.f};
        cur = nxt; cA = nA; cB = nB; ++ui;
        if constexpr (ALIGN_EPI) { if (wr == 1) PG8_BAR; }
    }
    PG8_WAIT_V(0);
    if constexpr (!ALIGN_EPI) { if (wr == 0) PG8_BAR; }
    PG8_BAR;
#undef PG8_SA
#undef PG8_SB
#undef PG8_STAGE
#undef PG8_LDA
#undef PG8_LDB
#undef PG8_MMA
#undef PG8_WAIT_V
#undef PG8_WAIT_L
#undef PG8_BAR
#undef PG8_SCHED
}
}

#ifndef PG8_SP2
#define PG8_SP2 true
#endif
#ifndef PG8_ALIGN
#define PG8_ALIGN true
#endif

constexpr int NWAVES = 8;
constexpr int D = 1024, SEQ = 2048, NB = 8, MP = NB * SEQ  , MSMP = 128  , MV = MP + MSMP  , MR = 16640  ;
constexpr int FF = 4096, DPLE = 256, NCH = SEQ / 64  ;
constexpr int PS = 3840;
constexpr int C_MQ = 0, C_MK = 512, C_MV = 1024, C_MO = 1536, C_GQ = 2048, C_GK = 2304, C_GV = 2560, C_GR = 3072, C_SM = 3584;
constexpr float EPS = 1e-6f;
constexpr size_t O_YP = 0, O_YS = 16777216, O_CP = 16908288, O_NP = 17432576, O_MP = 17436672, O_CVP = 17436704, O_SP = 17461280,
                 O_CS = 17723424, O_NS = 26112032, O_MS = 26177568, O_CVS = 26178080, O_SS = 26571296;
constexpr size_t MiB = 1u << 20;
constexpr size_t WS_CTL = 0, CTL_ZERO_BYTES = 1 * MiB;
constexpr size_t CTL_BAR_B = 16384, CTL_SS1_B = 262144, CTL_SS2_B = 393216, CTL_SS3_B = 524288;
constexpr size_t WS_WIN = 1 * MiB, WS_WOUT = 9 * MiB, WS_W1 = 11 * MiB, WS_W2 = 19 * MiB, WS_WPG = 27 * MiB, WS_WPLE = 29 * MiB;
constexpr size_t WS_PB = 30 * MiB, WS_NC = 39 * MiB, WS_MC = WS_NC + 512 * 1024, WS_R1 = 40 * MiB, WS_R2 = 73 * MiB, WS_CSM = 195 * MiB, WS_CSG = 227 * MiB;
constexpr size_t WS_X1B = WS_R2, WS_U = 106 * MiB, WS_PP = 106 * MiB, WS_END = 243 * MiB;
static_assert(WS_R2 + (size_t)MR * PS * 2 <= WS_CSM && WS_R1 + (size_t)MR * D * 2 <= WS_R2 && WS_U + (size_t)MR * FF * 2 <= WS_END && WS_X1B + (size_t)MR * D * 2 <= WS_U && WS_PB + (size_t)MR * DPLE * 2 <= WS_NC, "ws map");
constexpr size_t SC_QP = 0, SC_KW = (size_t)MP * 512, SC_QG = (size_t)MP * 1024, SC_KG = (size_t)MP * 1280;
static_assert((SC_KG + (size_t)MP * 256) * 2 <= (size_t)MP * D * 4, "P2 scratch inside y_prompt");
constexpr size_t WS_GA = 244 * MiB, WS_GB = WS_GA + 256 * 1024, WS_EBL = WS_GB + 256 * 1024, WS_PMX = WS_EBL + 256 * 1024, WS_BLS = WS_PMX + 4096;
constexpr int LDS_BYTES = 147456, MISC_OFF = LDS_BYTES - 256;

#define GAS __attribute__((address_space(1)))
#define LAS __attribute__((address_space(3)))
typedef unsigned short bf16;
typedef unsigned v4u __attribute__((ext_vector_type(4)));
typedef unsigned v2u __attribute__((ext_vector_type(2)));
typedef float f32x4 __attribute__((ext_vector_type(4)));
typedef short bf16x8 __attribute__((ext_vector_type(8)));
typedef GAS unsigned gu32;
#define RLX_AGENT __ATOMIC_RELAXED, __HIP_MEMORY_SCOPE_AGENT
#define LDS_WAIT() asm volatile("s_waitcnt lgkmcnt(0)" ::: "memory")
#define VM_WAIT() asm volatile("s_waitcnt vmcnt(0)" ::: "memory")
#define LBAR() do { asm volatile("s_waitcnt lgkmcnt(0)" ::: "memory"); __builtin_amdgcn_s_barrier(); asm volatile("" ::: "memory"); } while (0)
__device__ __forceinline__ unsigned f2bf(float f) { unsigned u = __builtin_bit_cast(unsigned, f); return (u + 0x7fffu + ((u >> 16) & 1u)) >> 16; }
__device__ __forceinline__ unsigned pk2(float lo, float hi) { unsigned r; asm volatile("v_cvt_pk_bf16_f32 %0, %1, %2" : "=v"(r) : "v"(lo), "v"(hi)); return r; }
__device__ __forceinline__ float bf2f(unsigned b) { return __builtin_bit_cast(float, b << 16); }
__device__ __forceinline__ float bflo(unsigned w) { return __builtin_bit_cast(float, w << 16); }
__device__ __forceinline__ float bfhi(unsigned w) { return __builtin_bit_cast(float, w & 0xffff0000u); }
__device__ __forceinline__ float logsig(float x) { return fminf(x, 0.f) - __logf(1.f + __expf(-fabsf(x))); }
__device__ __forceinline__ float sigmoidf(float x) { return __builtin_amdgcn_rcpf(1.f + __expf(-x)); }
__device__ __forceinline__ float rsqrt_fast(float x) { return __builtin_amdgcn_rsqf(x); }

#define XB_TMO      128
#define XB_XCNT(j)  (256  + 64 * (j))
#define XB_XSUB(j)  (1280 + 64 * (j))
#define XB_XGEN(j)  (2304 + 64 * (j))
#define XB_TOP      3328
#define XB_TOPGEN   3392
#define XCD_BAR_WORDS 3456
#define XB_SPIN_CAP (1u << 22)
__device__ __forceinline__ unsigned xb_ld(unsigned* p)              { return __hip_atomic_load(p, __ATOMIC_RELAXED, __HIP_MEMORY_SCOPE_AGENT); }
__device__ __forceinline__ unsigned xb_add(unsigned* p, unsigned v) { return __hip_atomic_fetch_add(p, v, __ATOMIC_RELAXED, __HIP_MEMORY_SCOPE_AGENT); }
__device__ __forceinline__ unsigned xb_xcc_id() { return (unsigned)__builtin_amdgcn_s_getreg((3 << 11) | 20) & 0xFu; }
#define XB_SPIN(cond, bar) do { unsigned _sp = 0; while (cond) { __builtin_amdgcn_s_sleep(1); \
    if ((++_sp & 255u) == 0u) { if (xb_ld(&(bar)[XB_TMO])) break; if (_sp > XB_SPIN_CAP) { atomicAdd(&(bar)[XB_TMO], 1u); break; } } } } while (0)
struct XcdBarrier { unsigned* bar; unsigned x; volatile LAS unsigned* st; };
__device__ __forceinline__ XcdBarrier xcd_barrier_post(unsigned* bar, volatile LAS unsigned* st) {
    XcdBarrier b; b.bar = bar; b.x = xb_xcc_id(); b.st = st;
    if (threadIdx.x == 0) (void)xb_add(&bar[XB_XCNT(b.x)], 1u);
    return b;
}
__device__ __forceinline__ void xcd_barrier_complete(unsigned* bar, unsigned x, unsigned& nloc, unsigned& nx) {
    const unsigned G = gridDim.x * gridDim.y * gridDim.z;
    unsigned sum, cnt, mine, sp = 0u;
    for (;;) {
        sum = 0u; cnt = 0u; mine = 0u;
#pragma unroll
        for (unsigned j = 0; j < 16; ++j) { const unsigned c = xb_ld(&bar[XB_XCNT(j)]); sum += c; cnt += (c > 0u) ? 1u : 0u; mine = (j == x) ? c : mine; }
        if (sum == G) break;
        __builtin_amdgcn_s_sleep(1);
        if ((++sp & 255u) == 0u) { if (xb_ld(&bar[XB_TMO])) break; if (sp > XB_SPIN_CAP) { atomicAdd(&bar[XB_TMO], 1u); break; } }
    }
    nloc = mine > 0u ? mine : 1u; nx = cnt > 0u ? cnt : 1u;
}
__device__ __forceinline__ void xcd_barrier(const XcdBarrier& b) {
    asm volatile("s_waitcnt vmcnt(0)" ::: "memory");
    __syncthreads();
    if (threadIdx.x == 0) {
        unsigned* bar = b.bar;
        __builtin_amdgcn_s_waitcnt(0);
        unsigned nloc = b.st[0], nx = b.st[1];
        if (nloc == 0u) { xcd_barrier_complete(bar, b.x, nloc, nx); b.st[0] = nloc; b.st[1] = nx; }
        const unsigned old = xb_add(&bar[XB_XSUB(b.x)], 1u);
        const unsigned gen = old / nloc;
        if (old + 1u == (gen + 1u) * nloc) {
            __builtin_amdgcn_fence(__ATOMIC_RELEASE, "agent");
            asm volatile("s_waitcnt vmcnt(0)" ::: "memory");
            const unsigned og = xb_add(&bar[XB_TOP], 1u);
            const unsigned tg = og / nx;
            if (og + 1u == (tg + 1u) * nx) xb_add(&bar[XB_TOPGEN], 1u);
            else XB_SPIN(xb_ld(&bar[XB_TOPGEN]) == tg, bar);
            __builtin_amdgcn_fence(__ATOMIC_ACQUIRE, "agent");
            xb_add(&bar[XB_XGEN(b.x)], 1u);
            asm volatile("s_waitcnt vmcnt(0)" ::: "memory");
        } else {
            XB_SPIN(xb_ld(&bar[XB_XGEN(b.x)]) == gen, bar);
            __builtin_amdgcn_fence(__ATOMIC_ACQUIRE, "agent");
            asm volatile("s_waitcnt vmcnt(0)" ::: "memory");
        }
    }
    __syncthreads();
}

struct Args { const float* in[26]; float* out; unsigned char* ws; int ph_lo, ph_hi, li, pad; };
typedef const Args __attribute__((address_space(4))) CArgs;
struct Frame {
    LAS unsigned char* lds;
    char* ldsg;
    int G;
    CArgs* a;
};
#define F_TID ((int)threadIdx.x)
#define F_LANE ((int)(threadIdx.x & 63))
#define F_WAVE (__builtin_amdgcn_readfirstlane((int)(threadIdx.x >> 6)))
#define IN_F(k) (F.a->in[k])
#define X_P IN_F(0)
#define X_S IN_F(1)
#define P_P IN_F(2)
#define P_S IN_F(3)
#define ST_C IN_F(4)
#define ST_N IN_F(5)
#define ST_M IN_F(6)
#define ST_CONV IN_F(7)
#define ST_S IN_F(8)
#define W_IN IN_F(9)
#define CONV_W IN_F(10)
#define CONV_B IN_F(11)
#define B_GATE CONSTF(IN_F(12))
#define W_A2 CONSTF(IN_F(13))
#define B_A CONSTF(IN_F(14))
#define G_MHEAD IN_F(15)
#define G_GHEAD IN_F(16)
#define W_OUT IN_F(17)
#define G_MIX IN_F(18)
#define G_MLP IN_F(19)
#define W1 IN_F(20)
#define W2 IN_F(21)
#define G_PLE IN_F(22)
#define W_PLE IN_F(23)
#define W_PG IN_F(24)
#define G_FINAL IN_F(25)
typedef const float __attribute__((address_space(4))) cfloat;
#define CONSTF(p) ((cfloat*)(unsigned long long)(p))
#define OUTP (F.a->out)
#define WSB (F.a->ws)
#define WIN_T ((bf16*)(WSB + WS_WIN))
#define WOUT_T ((bf16*)(WSB + WS_WOUT))
#define W1_T ((bf16*)(WSB + WS_W1))
#define W2_T ((bf16*)(WSB + WS_W2))
#define WPG_T ((bf16*)(WSB + WS_WPG))
#define WPLE_T ((bf16*)(WSB + WS_WPLE))
#define PBUF ((bf16*)(WSB + WS_PB))
#define R1B ((bf16*)(WSB + WS_R1))
#define PROJ ((bf16*)(WSB + WS_R2))
#define X1B ((bf16*)(WSB + WS_X1B))
#define UBUF ((bf16*)(WSB + WS_U))
#define CSM ((bf16*)(WSB + WS_CSM))
#define CSG ((bf16*)(WSB + WS_CSG))
#define NCS ((float*)(WSB + WS_NC))
#define MCS ((float*)(WSB + WS_MC))
#define SS1 ((float*)(WSB + CTL_SS1_B))
#define SS2 ((float*)(WSB + CTL_SS2_B))
#define SS3 ((float*)(WSB + CTL_SS3_B))
#define PPB ((bf16*)(WSB + WS_PP))
#define GA_A ((float*)(WSB + WS_GA))
#define GA_B ((float*)(WSB + WS_GB))
#define EBLG ((float*)(WSB + WS_EBL))
#define PMXG ((float*)(WSB + WS_PMX))
#define BLSG ((float*)(WSB + WS_BLS))
#define SCR ((bf16*)OUTP)

__device__ __forceinline__ float wave_sum(float v) {
#pragma unroll
    for (int o = 1; o < 64; o <<= 1) v += __shfl_xor(v, o);
    return v;
}
__device__ __forceinline__ float wave_max(float v) {
#pragma unroll
    for (int o = 1; o < 64; o <<= 1) v = fmaxf(v, __shfl_xor(v, o));
    return v;
}
template <int CTRL, int ROWMASK> __device__ __forceinline__ float dpp_f(float idv, float v) {
    return __builtin_bit_cast(float, __builtin_amdgcn_update_dpp(__builtin_bit_cast(int, idv), __builtin_bit_cast(int, v), CTRL, ROWMASK, 0xf, false));
}
__device__ __forceinline__ float wave_scan_sum(float v, int) {
    v += dpp_f<0x111, 0xf>(0.f, v); v += dpp_f<0x112, 0xf>(0.f, v); v += dpp_f<0x114, 0xf>(0.f, v); v += dpp_f<0x118, 0xf>(0.f, v);
    v += dpp_f<0x142, 0xa>(0.f, v); v += dpp_f<0x143, 0xc>(0.f, v);
    return v;
}
__device__ __forceinline__ float wave_scan_max(float v, int) {
    const float ninf = -__builtin_inff();
    v = fmaxf(v, dpp_f<0x111, 0xf>(ninf, v)); v = fmaxf(v, dpp_f<0x112, 0xf>(ninf, v)); v = fmaxf(v, dpp_f<0x114, 0xf>(ninf, v)); v = fmaxf(v, dpp_f<0x118, 0xf>(ninf, v));
    v = fmaxf(v, dpp_f<0x142, 0xa>(ninf, v)); v = fmaxf(v, dpp_f<0x143, 0xc>(ninf, v));
    return v;
}

__device__ __forceinline__ int win_src_col(int np) {
    if (np < 2048) return np;
    if (np < 3584) return np + 8;
    const int j = np - 3584;
    if (j < 8) return 2048 + j;
    if (j < 24) return 3592 + (j - 8);
    return -1;
}
template <int MODE>
__device__ __forceinline__ void p0_transpose_item(const float* W, int K, int N, bf16* WT, const float* gain, LAS float* scr, int item, int nblk, int lane) {
    const int kb = item / nblk, nb = item % nblk, k0 = 64 * kb, n0 = 32 * nb;
    if (MODE == 1 && n0 >= 3584) {
        const int src = win_src_col(n0 + (lane & 31));
#pragma unroll 8
        for (int i = 0; i < 32; ++i) { const int kk = 2 * i + (lane >> 5); float v = 0.f; if (src >= 0) v = W[(size_t)(k0 + kk) * N + src] * gain[k0 + kk]; scr[kk * 33 + (lane & 31)] = v; }
    } else {
        const int s0 = (MODE == 1 && n0 >= 2048) ? n0 + 8 : n0; const float cs = (MODE == 1 && n0 >= C_GQ && n0 < C_GK) ? 0.125f : 1.f;
        const int n4 = lane & 7, kq = lane >> 3;
        f32x4 v[8];
#pragma unroll
        for (int i = 0; i < 8; ++i) v[i] = *(const f32x4*)(W + (size_t)(k0 + kq + 8 * i) * N + s0 + 4 * n4);
#pragma unroll
        for (int i = 0; i < 8; ++i) { const int kk = kq + 8 * i; const float gsc = gain ? gain[k0 + kk] * cs : cs; LAS float* d = scr + kk * 33 + 4 * n4;
            d[0] = v[i][0] * gsc; d[1] = v[i][1] * gsc; d[2] = v[i][2] * gsc; d[3] = v[i][3] * gsc; }
    }
    LDS_WAIT(); asm volatile("" ::: "memory");
    const int c = lane & 7;
#pragma unroll
    for (int j = 0; j < 4; ++j) { const int n = (lane >> 3) + 8 * j; const LAS float* s = scr + (8 * c) * 33 + n;
        v4u o; o.x = pk2(s[0 * 33], s[1 * 33]); o.y = pk2(s[2 * 33], s[3 * 33]); o.z = pk2(s[4 * 33], s[5 * 33]); o.w = pk2(s[6 * 33], s[7 * 33]);
        *(GAS v4u*)(WT + (size_t)(n0 + n) * K + k0 + 8 * c) = o; }
    LDS_WAIT(); asm volatile("" ::: "memory");
}
__device__ __forceinline__ void p0_prologue(Frame& F) {
    LAS float* scr = (LAS float*)(F.lds + F_WAVE * 16384);
    const int gw = blockIdx.x * NWAVES + F_WAVE, NGW = F.G * NWAVES, lane = F_LANE;
    for (int m0 = gw; m0 < MV; m0 += 4 * NGW) {
        f32x4 v[4][4]; f32x4 pv[4];
#pragma unroll
        for (int q = 0; q < 4; ++q) { const int m = m0 + q * NGW; if (m < MV) {
            const float* xrow = m < MP ? X_P + (size_t)m * D : X_S + (size_t)(m - MP) * D; const float* prow = m < MP ? P_P + (size_t)m * DPLE : P_S + (size_t)(m - MP) * DPLE;
#pragma unroll
            for (int j = 0; j < 4; ++j) v[q][j] = ((const GAS f32x4*)xrow)[lane + 64 * j];
            pv[q] = ((const GAS f32x4*)prow)[lane]; } }
#pragma unroll
        for (int q = 0; q < 4; ++q) { const int m = m0 + q * NGW; if (m < MV) {
            float s = 0.f;
#pragma unroll
            for (int j = 0; j < 4; ++j) s += (v[q][j].x * v[q][j].x + v[q][j].y * v[q][j].y) + (v[q][j].z * v[q][j].z + v[q][j].w * v[q][j].w);
            const float r = rsqrt_fast(wave_sum(s) * (1.f / D) + EPS);
            GAS unsigned long long* o8 = (GAS unsigned long long*)(R1B + (size_t)m * D) + lane;
#pragma unroll
            for (int j = 0; j < 4; ++j) o8[64 * j] = (unsigned long long)pk2(v[q][j].x * r, v[q][j].y * r) | ((unsigned long long)pk2(v[q][j].z * r, v[q][j].w * r) << 32);
            ((GAS unsigned long long*)(PBUF + (size_t)m * DPLE))[lane] = (unsigned long long)pk2(pv[q].x, pv[q].y) | ((unsigned long long)pk2(pv[q].z, pv[q].w) << 32); } }
    }
    constexpr int NB_IN = PS / 32, NB_D = D / 32, NB_FF = FF / 32;
    constexpr int I_IN = (D / 64) * NB_IN, I_OUT = (D / 64) * NB_D, I_1 = (D / 64) * NB_FF, I_2 = (FF / 64) * NB_D, I_PG = I_OUT, I_PLE = (DPLE / 64) * NB_D;
    constexpr int NITEMS = I_IN + I_OUT + I_1 + I_2 + I_PG + I_PLE;
    for (int it = gw; it < NITEMS; it += NGW) {
        int r = it;
        if (r < I_IN) { p0_transpose_item<1>(W_IN, D, 3608, WIN_T, G_MIX, scr, r, NB_IN, lane); continue; } r -= I_IN;
        if (r < I_OUT) { p0_transpose_item<0>(W_OUT, D, D, WOUT_T, nullptr, scr, r, NB_D, lane); continue; } r -= I_OUT;
        if (r < I_1) { p0_transpose_item<0>(W1, D, FF, W1_T, G_MLP, scr, r, NB_FF, lane); continue; } r -= I_1;
        if (r < I_2) { p0_transpose_item<0>(W2, FF, D, W2_T, nullptr, scr, r, NB_D, lane); continue; } r -= I_2;
        if (r < I_PG) { p0_transpose_item<0>(W_PG, D, D, WPG_T, G_PLE, scr, r, NB_D, lane); continue; } r -= I_PG;
        p0_transpose_item<0>(W_PLE, DPLE, D, WPLE_T, nullptr, scr, r, NB_D, lane);
    }
}

struct EpiProj {
    static constexpr bool PERM = true;
    bf16* O; int ldc;
    __device__ __forceinline__ void operator()(const f32x4 (&acc)[2][2][4][2], const pg8::Unit& u, int wr, int wc, int fr, int fq) const {
        const int row0 = u.pm * 256 + wr * 64 + fr, col0 = u.pn * 256 + wc * 32 + 8 * fq;
#pragma unroll
        for (int ai = 0; ai < 2; ++ai)
#pragma unroll
            for (int m = 0; m < 4; ++m) { bf16* rowp = O + (size_t)(row0 + ai * 128 + m * 16) * ldc + col0;
#pragma unroll
                for (int bj = 0; bj < 2; ++bj) { const f32x4 v0 = acc[ai][bj][m][0], v1 = acc[ai][bj][m][1];
                    v4u w; w.x = pg8::cvt_pk_bf16(v0[0], v0[1]); w.y = pg8::cvt_pk_bf16(v0[2], v0[3]); w.z = pg8::cvt_pk_bf16(v1[0], v1[1]); w.w = pg8::cvt_pk_bf16(v1[2], v1[3]);
                    *(v4u*)(rowp + bj * 128) = w; } }
    }
};
template <bool RES_BF16> struct EpiRes {
    static constexpr bool PERM = true;
    const void* res; bf16* ob; float* ss;
    __device__ __forceinline__ void operator()(const f32x4 (&acc)[2][2][4][2], const pg8::Unit& u, int wr, int wc, int fr, int fq) const {
        const int row0 = u.pm * 256 + wr * 64 + fr, col0 = u.pn * 256 + wc * 32 + 8 * fq;
#pragma unroll
        for (int ai = 0; ai < 2; ++ai)
#pragma unroll
            for (int m = 0; m < 4; ++m) { const int row = row0 + ai * 128 + m * 16;
                const size_t off = (size_t)row * D + col0;
                float s = 0.f;
#pragma unroll
                for (int bj = 0; bj < 2; ++bj) {
                    f32x4 r0, r1;
                    if constexpr (RES_BF16) { const v4u rw = *(const v4u*)((const bf16*)res + off + bj * 128);
                        r0 = (f32x4){bflo(rw.x), bfhi(rw.x), bflo(rw.y), bfhi(rw.y)}; r1 = (f32x4){bflo(rw.z), bfhi(rw.z), bflo(rw.w), bfhi(rw.w)}; }
                    else { r0 = *(const f32x4*)((const float*)res + off + bj * 128); r1 = *(const f32x4*)((const float*)res + off + bj * 128 + 4); }
                    const f32x4 v0 = acc[ai][bj][m][0] + r0, v1 = acc[ai][bj][m][1] + r1;
                    v4u w; w.x = pg8::cvt_pk_bf16(v0[0], v0[1]); w.y = pg8::cvt_pk_bf16(v0[2], v0[3]); w.z = pg8::cvt_pk_bf16(v1[0], v1[1]); w.w = pg8::cvt_pk_bf16(v1[2], v1[3]);
                    *(v4u*)(ob + off + bj * 128) = w;
                    s += (v0[0] * v0[0] + v0[1] * v0[1]) + (v0[2] * v0[2] + v0[3] * v0[3]) + (v1[0] * v1[0] + v1[1] * v1[1]) + (v1[2] * v1[2] + v1[3] * v1[3]);
                }
                s += __shfl_xor(s, 16); s += __shfl_xor(s, 32);
                if (fq == 0) atomicAdd(ss + row, s);
                asm volatile("" ::: "memory"); }
    }
};
struct EpiU {
    static constexpr bool PERM = true;
    bf16* O; const float* ss;
    __device__ __forceinline__ void operator()(const f32x4 (&acc)[2][2][4][2], const pg8::Unit& u, int wr, int wc, int fr, int fq) const {
        const int row0 = u.pm * 256 + wr * 64 + fr, col0 = u.pn * 256 + wc * 32 + 8 * fq;
#pragma unroll
        for (int ai = 0; ai < 2; ++ai)
#pragma unroll
            for (int m = 0; m < 4; ++m) { const int row = row0 + ai * 128 + m * 16; const float r = rsqrt_fast(ss[row] * (1.f / D) + EPS);
                bf16* rowp = O + (size_t)row * FF + col0;
#pragma unroll
                for (int bj = 0; bj < 2; ++bj) { f32x4 v0 = acc[ai][bj][m][0] * r, v1 = acc[ai][bj][m][1] * r;
#pragma unroll
                    for (int j = 0; j < 4; ++j) { const float a = fmaxf(v0[j], 0.f), b = fmaxf(v1[j], 0.f); v0[j] = a * a; v1[j] = b * b; }
                    v4u w; w.x = pg8::cvt_pk_bf16(v0[0], v0[1]); w.y = pg8::cvt_pk_bf16(v0[2], v0[3]); w.z = pg8::cvt_pk_bf16(v1[0], v1[1]); w.w = pg8::cvt_pk_bf16(v1[2], v1[3]);
                    *(v4u*)(rowp + bj * 128) = w; } }
    }
};
struct EpiPle {
    static constexpr bool PERM = true;
    const bf16* x2b; const bf16* Pp; bf16* x3b; const float* ss2; float* ss3;
    __device__ __forceinline__ void operator()(const f32x4 (&acc)[2][2][4][2], const pg8::Unit& u, int wr, int wc, int fr, int fq) const {
        const int row0 = u.pm * 256 + wr * 64 + fr, col0 = u.pn * 256 + wc * 32 + 8 * fq;
#pragma unroll
        for (int ai = 0; ai < 2; ++ai)
#pragma unroll
            for (int m = 0; m < 4; ++m) { const int row = row0 + ai * 128 + m * 16;
                const float r = rsqrt_fast(ss2[row] * (1.f / D) + EPS);
                float s = 0.f;
#pragma unroll
                for (int bj = 0; bj < 2; ++bj) {
                    const size_t off = (size_t)row * D + col0 + bj * 128;
                    const v4u pw = *(const v4u*)(Pp + off), xw = *(const v4u*)(x2b + off);
                    unsigned o[4];
#pragma unroll
                    for (int n = 0; n < 2; ++n) {
                        const float p0[4] = {bflo(pw[2 * n]), bfhi(pw[2 * n]), bflo(pw[2 * n + 1]), bfhi(pw[2 * n + 1])};
                        const float x0[4] = {bflo(xw[2 * n]), bfhi(xw[2 * n]), bflo(xw[2 * n + 1]), bfhi(xw[2 * n + 1])};
                        float v0[4];
#pragma unroll
                        for (int j = 0; j < 4; ++j) v0[j] = x0[j] + p0[j] * sigmoidf(acc[ai][bj][m][n][j] * r);
                        o[2 * n] = pg8::cvt_pk_bf16(v0[0], v0[1]); o[2 * n + 1] = pg8::cvt_pk_bf16(v0[2], v0[3]);
                        s += (v0[0] * v0[0] + v0[1] * v0[1]) + (v0[2] * v0[2] + v0[3] * v0[3]);
                    }
                    *(v4u*)(x3b + off) = (v4u){o[0], o[1], o[2], o[3]};
                    asm volatile("" ::: "memory");
                }
                s += __shfl_xor(s, 16); s += __shfl_xor(s, 32);
                if (fq == 0) atomicAdd(ss3 + row, s);
                asm volatile("" ::: "memory"); }
    }
};

__device__ __forceinline__ f32x4 mfma16(bf16x8 a, bf16x8 b, f32x4 c) { return __builtin_amdgcn_mfma_f32_16x16x32_bf16(a, b, c, 0, 0, 0); }
__device__ __forceinline__ bf16x8 lds_frag(const char* p) { return *(const bf16x8*)p; }
constexpr int TS = 144;
constexpr int QS_P = 272;
constexpr float KSCALE = 0.08838834764831845f;

__device__ __forceinline__ void p2p_item(Frame& F, int b, int c) {
    float* WKL = (float*)F.ldsg;
    const int tid = F_TID, lane = F_LANE, w = F_WAVE;
    const size_t row0 = (size_t)b * SEQ + c * 64;
    const bf16* P = PROJ;
    if (w < 4) { const int h = w, bh = b * 4 + h; const size_t row = row0 + lane;
        const float ig = bf2f(P[row * PS + C_SM + h]) + B_GATE[h], lf = logsig(bf2f(P[row * PS + C_SM + 4 + h]) + B_GATE[4 + h]);
        const float bc = wave_scan_sum(lf, lane), a = ig - bc; const float pmax = wave_max(a);
        GA_A[(size_t)bh * SEQ + c * 64 + lane] = a; GA_B[(size_t)bh * SEQ + c * 64 + lane] = bc;
        if (lane == 63) { PMXG[bh * NCH + c] = pmax; BLSG[bh * NCH + c] = bc; }
        WKL[h * 64 + lane] = __expf(a - pmax) * KSCALE; }
    { const int hg = w >> 1, d0 = 32 * (w & 1), bh = b * 4 + hg; const size_t row = row0 + lane;
      const v4u ga0 = *(const v4u*)(P + row * PS + C_SM + 8), ga1 = *(const v4u*)(P + row * PS + C_SM + 16);
      v4u qv[4], kv[4];
#pragma unroll
      for (int i = 0; i < 4; ++i) { qv[i] = *(const v4u*)(P + row * PS + C_GQ + hg * 64 + d0 + 8 * i); kv[i] = *(const v4u*)(P + row * PS + C_GK + hg * 64 + d0 + 8 * i); }
      float ga[16];
#pragma unroll
      for (int i = 0; i < 4; ++i) { ga[2 * i] = bflo(ga0[i]); ga[2 * i + 1] = bfhi(ga0[i]); ga[8 + 2 * i] = bflo(ga1[i]); ga[8 + 2 * i + 1] = bfhi(ga1[i]); }
      unsigned qo[16], ko[16];
#pragma unroll
      for (int dd = 0; dd < 32; dd += 2) {
          float qt[2], kt[2];
#pragma unroll
          for (int q2 = 0; q2 < 2; ++q2) { const int col = hg * 64 + d0 + dd + q2;
              float z = B_A[col];
#pragma unroll
              for (int q = 0; q < 16; ++q) z += ga[q] * W_A2[q * 256 + col];
              const float bc = wave_scan_sum(logsig(z) * (1.f / 16.f), lane);
              if (lane == 63) EBLG[(size_t)(bh * NCH + c) * 64 + d0 + dd + q2] = __expf(bc);
              const unsigned qw = qv[dd >> 3][(dd >> 1) & 3], kw = kv[dd >> 3][(dd >> 1) & 3];
              qt[q2] = (q2 ? bfhi(qw) : bflo(qw)) * __expf(bc); kt[q2] = (q2 ? bfhi(kw) : bflo(kw)) * __expf(-bc); }
          qo[dd >> 1] = pk2(qt[0], qt[1]); ko[dd >> 1] = pk2(kt[0], kt[1]);
      }
      bf16* qd = SCR + SC_QG + row * 256 + hg * 64 + d0; bf16* kd = SCR + SC_KG + row * 256 + hg * 64 + d0;
#pragma unroll
      for (int i = 0; i < 4; ++i) { *(v4u*)(qd + 8 * i) = (v4u){qo[4 * i], qo[4 * i + 1], qo[4 * i + 2], qo[4 * i + 3]}; *(v4u*)(kd + 8 * i) = (v4u){ko[4 * i], ko[4 * i + 1], ko[4 * i + 2], ko[4 * i + 3]}; } }
    LBAR();
    {
      const int isk = tid >> 8, pc = tid & 255, h = pc >> 6, ch = isk * 512 + 2 * pc;
      float cw[4][2], cb[2];
#pragma unroll
      for (int j = 0; j < 4; ++j) { cw[j][0] = CONV_W[j * 1024 + ch]; cw[j][1] = CONV_W[j * 1024 + ch + 1]; }
      cb[0] = CONV_B[ch]; cb[1] = CONV_B[ch + 1];
      const bf16* src = P + row0 * PS + (isk ? C_MK : C_MQ) + 2 * pc;
      bf16* dst = SCR + (isk ? SC_KW : SC_QP) + row0 * 512 + 2 * pc;
#pragma unroll
      for (int hf = 0; hf < 2; ++hf) {
          unsigned raw[35];
#pragma unroll
          for (int i = 0; i < 35; ++i) { const int t = 32 * hf - 3 + i; raw[i] = (c > 0 || t >= 0) ? *(const unsigned*)(src + (long)t * PS) : 0u; }
#pragma unroll
          for (int i = 0; i < 32; ++i) { float a0 = cb[0], a1 = cb[1];
#pragma unroll
              for (int j = 0; j < 4; ++j) { a0 += cw[j][0] * bflo(raw[i + j]); a1 += cw[j][1] * bfhi(raw[i + j]); }
              a0 = a0 * sigmoidf(a0); a1 = a1 * sigmoidf(a1);
              if (isk) { const float wk = WKL[h * 64 + 32 * hf + i]; a0 *= wk; a1 *= wk; }
              *(unsigned*)(dst + (size_t)(32 * hf + i) * 512) = pk2(a0, a1); }
      } }
    LBAR();
}

constexpr int NCI = 4;
__device__ __forceinline__ void chain_mlstm(Frame& F, int b, int h, int sl) {
    char* L = F.ldsg;
    constexpr int KT_B = 64 * TS, VT_B = 128 * TS, NP_B = 16 * 64 * 4, BUF_B = KT_B + VT_B + NP_B;
    float* PM = (float*)(L + NCI * BUF_B); float* BLs = PM + 32; float* MCc = BLs + 32; float* CSs = MCc + 40; float* E2s = CSs + 32;
    const int tid = F_TID, lane = F_LANE, w = F_WAVE, r = lane & 15, g = lane >> 4;
    const int bh = b * 4 + h; const size_t rowb = (size_t)b * SEQ;
    if (tid < 32) { PM[tid] = PMXG[bh * NCH + tid]; BLs[tid] = BLSG[bh * NCH + tid]; }
    __syncthreads();
    if (tid == 0) { float m = 0.f; for (int c = 0; c < NCH; ++c) { const float M = fmaxf(m, PM[c]); MCc[c] = m; CSs[c] = __expf(m - M); E2s[c] = __expf(PM[c] - M); m = BLs[c] + M; } MCc[32] = m; }
    __syncthreads();
    const int dpk = tid & 31, tg = tid >> 5, dpv = tid & 63, sg = tid >> 6;
    const int dt = w & 3, eb = 4 * (w >> 2);
    f32x4 acc[4];
#pragma unroll
    for (int i = 0; i < 4; ++i) acc[i] = (f32x4){0.f, 0.f, 0.f, 0.f};
    float nst = 0.f;
    unsigned krq[NCI][4], vrq[NCI][8];
    const bf16* kbase = SCR + SC_KW + (rowb + 4 * tg) * 512 + h * 128 + 64 * sl + 2 * dpk; const bf16* vbase = PROJ + (rowb + 8 * sg) * PS + C_MV + h * 128 + 2 * dpv;
#pragma unroll
    for (int q = 0; q < NCI; ++q) {
#pragma unroll
        for (int i = 0; i < 4; ++i) krq[q][i] = *(const unsigned*)(kbase + (size_t)(64 * q + i) * 512);
#pragma unroll
        for (int i = 0; i < 8; ++i) vrq[q][i] = *(const unsigned*)(vbase + (size_t)(64 * q + i) * PS);
    }
    for (int c0 = 0; c0 < NCH; c0 += NCI) {
#pragma unroll
        for (int q = 0; q < NCI; ++q) { char* KT = L + q * BUF_B; char* VT = KT + KT_B; float* NP = (float*)(VT + VT_B);
            const unsigned* kr = krq[q]; const unsigned* vr = vrq[q];
            *(v2u*)(KT + (2 * dpk) * TS + 8 * tg) = (v2u){(kr[0] & 0xffffu) | (kr[1] << 16), (kr[2] & 0xffffu) | (kr[3] << 16)};
            *(v2u*)(KT + (2 * dpk + 1) * TS + 8 * tg) = (v2u){(kr[0] >> 16) | (kr[1] & 0xffff0000u), (kr[2] >> 16) | (kr[3] & 0xffff0000u)};
            NP[tg * 64 + 2 * dpk] = (bflo(kr[0]) + bflo(kr[1])) + (bflo(kr[2]) + bflo(kr[3])); NP[tg * 64 + 2 * dpk + 1] = (bfhi(kr[0]) + bfhi(kr[1])) + (bfhi(kr[2]) + bfhi(kr[3]));
            unsigned v0p[4], v1p[4];
#pragma unroll
            for (int i = 0; i < 8; i += 2) { v0p[i >> 1] = (vr[i] & 0xffffu) | (vr[i + 1] << 16); v1p[i >> 1] = (vr[i] >> 16) | (vr[i + 1] & 0xffff0000u); }
            *(v4u*)(VT + (2 * dpv) * TS + 16 * sg) = (v4u){v0p[0], v0p[1], v0p[2], v0p[3]};
            *(v4u*)(VT + (2 * dpv + 1) * TS + 16 * sg) = (v4u){v1p[0], v1p[1], v1p[2], v1p[3]}; }
        if (c0 + NCI < NCH) {
#pragma unroll
            for (int q = 0; q < NCI; ++q) {
#pragma unroll
                for (int i = 0; i < 4; ++i) krq[q][i] = *(const unsigned*)(kbase + (size_t)(64 * (c0 + NCI + q) + i) * 512);
#pragma unroll
                for (int i = 0; i < 8; ++i) vrq[q][i] = *(const unsigned*)(vbase + (size_t)(64 * (c0 + NCI + q) + i) * PS);
            }
        }
        LBAR();
        f32x4 ta[NCI][4];
#pragma unroll
        for (int q = 0; q < NCI; ++q) { const char* KT = L + q * BUF_B; const char* VT = KT + KT_B;
#pragma unroll
            for (int i = 0; i < 4; ++i) ta[q][i] = (f32x4){0.f, 0.f, 0.f, 0.f};
#pragma unroll
            for (int kk = 0; kk < 2; ++kk) {
                const bf16x8 af = lds_frag(KT + (16 * dt + r) * TS + (32 * kk + 8 * g) * 2);
#pragma unroll
                for (int i = 0; i < 4; ++i) ta[q][i] = mfma16(af, lds_frag(VT + (16 * (eb + i) + r) * TS + (32 * kk + 8 * g) * 2), ta[q][i]);
            } }
#pragma unroll
        for (int q = 0; q < NCI; ++q) { const int c = c0 + q;
            { bf16* cst = CSM + (size_t)(bh * NCH + c) * 16384;
#pragma unroll
              for (int i = 0; i < 4; ++i)
                  *(v2u*)(cst + ((eb + i) * 8 + 4 * sl + dt) * 256 + r * 16 + 4 * g) = (v2u){pg8::cvt_pk_bf16(acc[i][0], acc[i][1]), pg8::cvt_pk_bf16(acc[i][2], acc[i][3])};
              if (tid < 64) NCS[(size_t)(bh * NCH + c) * 128 + 64 * sl + tid] = nst;
              if (tid == 0 && sl == 0) MCS[bh * NCH + c] = MCc[c]; }
            const float cs = CSs[c], e2 = E2s[c];
            if (tid < 64) { const float* NP = (const float*)(L + q * BUF_B + KT_B + VT_B); float s = 0.f;
#pragma unroll
                for (int k = 0; k < 16; ++k) s += NP[k * 64 + tid];
                nst = cs * nst + e2 * s; }
#pragma unroll
            for (int i = 0; i < 4; ++i) acc[i] = acc[i] * cs + ta[q][i] * e2; }
        LBAR();
    }
    { float* Co = OUTP + O_CP + (size_t)bh * 16384;
#pragma unroll
      for (int i = 0; i < 4; ++i)
#pragma unroll
          for (int j = 0; j < 4; ++j) Co[(64 * sl + 16 * dt + 4 * g + j) * 128 + 16 * (eb + i) + r] = acc[i][j];
      if (tid < 64) OUTP[O_NP + (size_t)bh * 128 + 64 * sl + tid] = nst;
      if (tid == 0 && sl == 0) OUTP[O_MP + bh] = MCc[32]; }
    __syncthreads();
}

__device__ __forceinline__ void chain_gla(Frame& F, int b, int hg, int sl) {
    char* L = F.ldsg;
    constexpr int KT_B = 32 * TS, VT_B = 128 * TS, BUF_B = KT_B + VT_B;
    const int tid = F_TID, lane = F_LANE, w = F_WAVE, r = lane & 15, g = lane >> 4;
    const int bh = b * 4 + hg; const size_t rowb = (size_t)b * SEQ;
    const int dpv = tid & 63, sg = tid >> 6;
    const int dt = w & 1, eb = 2 * (w >> 1);
    f32x4 acc[2];
    acc[0] = (f32x4){0.f, 0.f, 0.f, 0.f}; acc[1] = acc[0];
    v2u k4q[NCI]; f32x4 ebq[NCI]; unsigned vrq[NCI][8];
    const bf16* kbase = SCR + SC_KG + (rowb + lane) * 256 + hg * 64 + 32 * sl + 4 * w; const bf16* vbase = PROJ + (rowb + 8 * sg) * PS + C_GV + hg * 128 + 2 * dpv;
    const float* ebase = EBLG + (size_t)bh * NCH * 64 + 32 * sl + 16 * dt + 4 * g;
#pragma unroll
    for (int q = 0; q < NCI; ++q) { k4q[q] = *(const v2u*)(kbase + (size_t)(64 * q) * 256); ebq[q] = *(const f32x4*)(ebase + q * 64);
#pragma unroll
        for (int i = 0; i < 8; ++i) vrq[q][i] = *(const unsigned*)(vbase + (size_t)(64 * q + i) * PS); }
    for (int c0 = 0; c0 < NCH; c0 += NCI) {
        f32x4 eb4[NCI];
#pragma unroll
        for (int q = 0; q < NCI; ++q) { char* KT = L + q * BUF_B; char* VT = KT + KT_B; const v2u k4 = k4q[q]; const unsigned* vr = vrq[q]; eb4[q] = ebq[q];
            *(bf16*)(KT + (4 * w + 0) * TS + 2 * lane) = (bf16)(k4[0] & 0xffffu); *(bf16*)(KT + (4 * w + 1) * TS + 2 * lane) = (bf16)(k4[0] >> 16);
            *(bf16*)(KT + (4 * w + 2) * TS + 2 * lane) = (bf16)(k4[1] & 0xffffu); *(bf16*)(KT + (4 * w + 3) * TS + 2 * lane) = (bf16)(k4[1] >> 16);
            unsigned v0p[4], v1p[4];
#pragma unroll
            for (int i = 0; i < 8; i += 2) { v0p[i >> 1] = (vr[i] & 0xffffu) | (vr[i + 1] << 16); v1p[i >> 1] = (vr[i] >> 16) | (vr[i + 1] & 0xffff0000u); }
            *(v4u*)(VT + (2 * dpv) * TS + 16 * sg) = (v4u){v0p[0], v0p[1], v0p[2], v0p[3]};
            *(v4u*)(VT + (2 * dpv + 1) * TS + 16 * sg) = (v4u){v1p[0], v1p[1], v1p[2], v1p[3]}; }
        if (c0 + NCI < NCH) {
#pragma unroll
            for (int q = 0; q < NCI; ++q) { k4q[q] = *(const v2u*)(kbase + (size_t)(64 * (c0 + NCI + q)) * 256); ebq[q] = *(const f32x4*)(ebase + (c0 + NCI + q) * 64);
#pragma unroll
                for (int i = 0; i < 8; ++i) vrq[q][i] = *(const unsigned*)(vbase + (size_t)(64 * (c0 + NCI + q) + i) * PS); }
        }
        LBAR();
        f32x4 ta[NCI][2];
#pragma unroll
        for (int q = 0; q < NCI; ++q) { const char* KT = L + q * BUF_B; const char* VT = KT + KT_B;
            ta[q][0] = (f32x4){0.f, 0.f, 0.f, 0.f}; ta[q][1] = ta[q][0];
#pragma unroll
            for (int kk = 0; kk < 2; ++kk) {
                const bf16x8 af = lds_frag(KT + (16 * dt + r) * TS + (32 * kk + 8 * g) * 2);
#pragma unroll
                for (int i = 0; i < 2; ++i) ta[q][i] = mfma16(af, lds_frag(VT + (16 * (eb + i) + r) * TS + (32 * kk + 8 * g) * 2), ta[q][i]);
            } }
#pragma unroll
        for (int q = 0; q < NCI; ++q) { const int c = c0 + q;
            bf16* cst = CSG + (size_t)(bh * NCH + c) * 8192;
#pragma unroll
            for (int i = 0; i < 2; ++i)
                *(v2u*)(cst + ((eb + i) * 4 + 2 * sl + dt) * 256 + r * 16 + 4 * g) = (v2u){pg8::cvt_pk_bf16(acc[i][0], acc[i][1]), pg8::cvt_pk_bf16(acc[i][2], acc[i][3])};
            acc[0] = (acc[0] + ta[q][0]) * eb4[q]; acc[1] = (acc[1] + ta[q][1]) * eb4[q]; }
        LBAR();
    }
    { float* So = OUTP + O_SP + (size_t)bh * 8192;
#pragma unroll
      for (int i = 0; i < 2; ++i)
#pragma unroll
          for (int j = 0; j < 4; ++j) So[(32 * sl + 16 * dt + 4 * g + j) * 128 + 16 * (eb + i) + r] = acc[i][j]; }
    __syncthreads();
}

__device__ __forceinline__ void sample_item(Frame& F, int n, int hh, float* Wl, int lane) {
    asm volatile("" : "+v"(lane));
    float* qv = Wl; float* kv = Wl + 128; float* vv = Wl + 256; float* al = Wl + 384;
    const size_t row = (size_t)MP + n;
    const bf16* Pr = PROJ + row * PS;
    const bool gla = hh >= 4; const int h = hh & 3;
    const int e4 = lane & 31, dh = lane >> 5;
    float cs = 1.f, wkk = 1.f, dinv = 1.f;
    if (!gla) {
        float qk2[2][2];
#pragma unroll
        for (int isk = 0; isk < 2; ++isk)
#pragma unroll
            for (int q = 0; q < 2; ++q) { const int d = lane + 64 * q, ch = isk * 512 + h * 128 + d;
                const float* scv = ST_CONV + (size_t)n * 3 * 1024 + ch;
                float a = CONV_B[ch] + CONV_W[ch] * scv[0] + CONV_W[1024 + ch] * scv[1024] + CONV_W[2048 + ch] * scv[2048] + CONV_W[3072 + ch] * bf2f(Pr[(isk ? C_MK : C_MQ) + h * 128 + d]);
                a = a * sigmoidf(a); if (isk) a *= KSCALE; qk2[isk][q] = a; (isk ? kv : qv)[d] = a; }
        vv[lane] = bf2f(Pr[C_MV + h * 128 + lane]); vv[lane + 64] = bf2f(Pr[C_MV + h * 128 + lane + 64]);
        const float* n0 = ST_N + ((size_t)n * 4 + h) * 128; const float n00 = n0[lane], n01 = n0[lane + 64];
        const float qk = wave_sum(qk2[0][0] * qk2[1][0] + qk2[0][1] * qk2[1][1]), qn = wave_sum(qk2[0][0] * n00 + qk2[0][1] * n01);
        const float ig = bf2f(Pr[C_SM + h]) + B_GATE[h], lf = logsig(bf2f(Pr[C_SM + 4 + h]) + B_GATE[4 + h]);
        const float m0 = ST_M[n * 4 + h], mn = fmaxf(lf + m0, ig);
        wkk = __expf(ig - mn); cs = __expf(lf + m0 - mn);
        const float den = cs * qn + qk * wkk;
        dinv = __builtin_amdgcn_rcpf(fmaxf(fabsf(den), __expf(-mn)));
        float* nsO = OUTP + O_NS + ((size_t)n * 4 + h) * 128; nsO[lane] = cs * n00 + wkk * qk2[1][0]; nsO[lane + 64] = cs * n01 + wkk * qk2[1][1];
        if (lane == 0) OUTP[O_MS + n * 4 + h] = mn;
    } else {
        qv[lane] = bf2f(Pr[C_GQ + h * 64 + lane]); kv[lane] = bf2f(Pr[C_GK + h * 64 + lane]);
        vv[lane] = bf2f(Pr[C_GV + h * 128 + lane]); vv[lane + 64] = bf2f(Pr[C_GV + h * 128 + lane + 64]);
        { const int col = h * 64 + lane; float z = B_A[col];
#pragma unroll
          for (int q = 0; q < 16; ++q) z += bf2f(Pr[C_SM + 8 + q]) * IN_F(13)[q * 256 + col];
          al[lane] = __expf(logsig(z) * (1.f / 16.f)); }
    }
    asm volatile("s_waitcnt lgkmcnt(0)" ::: "memory");
    const f32x4 v4 = *(const f32x4*)(vv + 4 * e4);
    f32x4 hp = (f32x4){0.f, 0.f, 0.f, 0.f};
    if (!gla) {
        const float* C0 = ST_C + ((size_t)n * 4 + h) * 16384 + (size_t)(64 * dh) * 128 + 4 * e4; float* Cn = OUTP + O_CS + ((size_t)n * 4 + h) * 16384 + (size_t)(64 * dh) * 128 + 4 * e4;
        for (int i0 = 0; i0 < 64; i0 += 8) { f32x4 c0[8];
#pragma unroll
            for (int i = 0; i < 8; ++i) c0[i] = *(const f32x4*)(C0 + (i0 + i) * 128);
#pragma unroll
            for (int i = 0; i < 8; ++i) { const int d = 64 * dh + i0 + i; const f32x4 cn = c0[i] * cs + v4 * (wkk * kv[d]); *(f32x4*)(Cn + (i0 + i) * 128) = cn; hp += cn * qv[d]; } }
    } else {
        const float* S0 = ST_S + ((size_t)n * 4 + h) * 8192 + (size_t)(32 * dh) * 128 + 4 * e4; float* Sn = OUTP + O_SS + ((size_t)n * 4 + h) * 8192 + (size_t)(32 * dh) * 128 + 4 * e4;
        for (int i0 = 0; i0 < 32; i0 += 8) { f32x4 c0[8];
#pragma unroll
            for (int i = 0; i < 8; ++i) c0[i] = *(const f32x4*)(S0 + (i0 + i) * 128);
#pragma unroll
            for (int i = 0; i < 8; ++i) { const int d = 32 * dh + i0 + i; const f32x4 sn = c0[i] * al[d] + v4 * kv[d]; *(f32x4*)(Sn + (i0 + i) * 128) = sn; hp += sn * qv[d]; } }
    }
#pragma unroll
    for (int j = 0; j < 4; ++j) hp[j] += __shfl_xor(hp[j], 32);
    hp = hp * dinv;
    float ssum = (hp[0] * hp[0] + hp[1] * hp[1]) + (hp[2] * hp[2] + hp[3] * hp[3]);
#pragma unroll
    for (int o = 1; o < 32; o <<= 1) ssum += __shfl_xor(ssum, o);
    const float rn = rsqrt_fast(ssum * (1.f / 128.f) + EPS);
    if (lane < 32) {
        const v2u gw = *(const v2u*)(Pr + (gla ? C_GR : C_MO) + h * 128 + 4 * e4);
        const f32x4 g4 = *(const f32x4*)((gla ? G_GHEAD : G_MHEAD) + h * 128 + 4 * e4);
        const float gt[4] = {bflo(gw[0]), bfhi(gw[0]), bflo(gw[1]), bfhi(gw[1])}; float o[4];
#pragma unroll
        for (int j = 0; j < 4; ++j) { const float sg_ = sigmoidf(gt[j]); o[j] = hp[j] * rn * g4[j] * (gla ? gt[j] * sg_ : sg_); }
        int e4o = e4; asm volatile("" : "+v"(e4o));
        *(v2u*)(R1B + row * D + (gla ? 512 : 0) + h * 128 + 4 * e4o) = (v2u){pg8::cvt_pk_bf16(o[0], o[1]), pg8::cvt_pk_bf16(o[2], o[3])};
    }
    asm volatile("s_waitcnt lgkmcnt(0)" ::: "memory");
}

constexpr int P2B_QS = 0, P2B_KS = 64 * QS_P, P2B_VT = P2B_KS + 80 * QS_P, P2B_PS = P2B_VT + 128 * TS, P2B_FL = P2B_PS + 64 * TS, P2B_HALF = P2B_FL + 2560;
static_assert(2 * P2B_HALF <= MISC_OFF, "P2b LDS");
template <bool GLA>
__device__ __forceinline__ void p2b_unit(Frame& F, int u, char* L, int ltid, int lw, int lane) {
    const int v = u & 1023, bh = v >> 5, c = v & 31, b = bh >> 2, h = bh & 3, r = lane & 15, g = lane >> 4;
    const size_t rowb = (size_t)b * SEQ + c * 64;
    const bf16* P = PROJ;
    char* QSp = L + P2B_QS; char* KSp = L + P2B_KS; char* VTp = L + P2B_VT; char* PSp = L + P2B_PS;
    float* af = (float*)(L + P2B_FL); float* Mf = af + 64; float* scf = af + 128; float* enf = af + 192; float* dinvf = af + 256; float* ssq = af + 320;
    constexpr int QP = GLA ? TS : QS_P;
    constexpr int NK = GLA ? 2 : 4;
    bf16x8 cfr[2][NK];
    { const bf16* CT = GLA ? CSG + (size_t)(bh * NCH + c) * 8192 : CSM + (size_t)(bh * NCH + c) * 16384;
#pragma unroll
      for (int n2 = 0; n2 < 2; ++n2)
#pragma unroll
          for (int kk = 0; kk < NK; ++kk) cfr[n2][kk] = *(const bf16x8*)(CT + ((2 * lw + n2) * (GLA ? 4 : 8) + 2 * kk + (g >> 1)) * 256 + r * 16 + 8 * (g & 1)); }
    const int dp = ltid & 63, sg = ltid >> 6;
    float* rsf = ssq + 256;
    if constexpr (!GLA) {
        { const float a = GA_A[(size_t)bh * SEQ + c * 64 + lane], bc = GA_B[(size_t)bh * SEQ + c * 64 + lane];
          const float pm = wave_scan_max(a, lane);
          const float mc = MCS[bh * NCH + c], pmx = PMXG[bh * NCH + c], Mt = fmaxf(mc, pm);
          if (lw == 0) { Mf[lane] = Mt; scf[lane] = __expf(mc - Mt); enf[lane] = __expf(-(bc + Mt)); rsf[lane] = __expf(pmx - Mt); } }
        {
          const int row = ltid >> 2, seg = ltid & 3;
          const bf16* qs = SCR + SC_QP + (rowb + row) * 512 + h * 128 + 32 * seg; const bf16* ks = SCR + SC_KW + (rowb + row) * 512 + h * 128 + 32 * seg;
          v4u qq[4], kk4[4];
#pragma unroll
          for (int i = 0; i < 4; ++i) { qq[i] = *(const v4u*)(qs + 8 * i); kk4[i] = *(const v4u*)(ks + 8 * i); }
#pragma unroll
          for (int i = 0; i < 4; ++i) { *(v4u*)(QSp + row * QS_P + 64 * seg + 16 * i) = qq[i]; *(v4u*)(KSp + row * QS_P + 64 * seg + 16 * i) = kk4[i]; } }
        if (ltid < 128) *(bf16*)(KSp + 64 * QS_P + 2 * ltid) = (bf16)f2bf(NCS[(size_t)(bh * NCH + c) * 128 + ltid]);
        for (int i = ltid; i < 15 * 64; i += 256) *(unsigned*)(KSp + (65 + i / 64) * QS_P + 4 * (i & 63)) = 0u;
    } else {
        const int row = ltid >> 2, seg = ltid & 3;
        const bf16* qs = SCR + SC_QG + (rowb + row) * 256 + h * 64 + 16 * seg; const bf16* ks = SCR + SC_KG + (rowb + row) * 256 + h * 64 + 16 * seg;
        v4u qq[2], kk4[2];
#pragma unroll
        for (int i = 0; i < 2; ++i) { qq[i] = *(const v4u*)(qs + 8 * i); kk4[i] = *(const v4u*)(ks + 8 * i); }
#pragma unroll
        for (int i = 0; i < 2; ++i) { *(v4u*)(QSp + row * TS + 32 * seg + 16 * i) = qq[i]; *(v4u*)(KSp + row * TS + 32 * seg + 16 * i) = kk4[i]; }
    }
    {
      unsigned vr[16];
#pragma unroll
      for (int i = 0; i < 16; ++i) vr[i] = *(const unsigned*)(P + (rowb + 16 * sg + i) * PS + (GLA ? C_GV : C_MV) + h * 128 + 2 * dp);
      unsigned v0p[8], v1p[8];
#pragma unroll
      for (int i = 0; i < 16; i += 2) { v0p[i >> 1] = (vr[i] & 0xffffu) | (vr[i + 1] << 16); v1p[i >> 1] = (vr[i] >> 16) | (vr[i + 1] & 0xffff0000u); }
      *(v4u*)(VTp + (2 * dp) * TS + 32 * sg) = (v4u){v0p[0], v0p[1], v0p[2], v0p[3]}; *(v4u*)(VTp + (2 * dp) * TS + 32 * sg + 16) = (v4u){v0p[4], v0p[5], v0p[6], v0p[7]};
      *(v4u*)(VTp + (2 * dp + 1) * TS + 32 * sg) = (v4u){v1p[0], v1p[1], v1p[2], v1p[3]}; *(v4u*)(VTp + (2 * dp + 1) * TS + 32 * sg + 16) = (v4u){v1p[4], v1p[5], v1p[6], v1p[7]}; }
    __syncthreads();
    {
        f32x4 pa[5];
#pragma unroll
        for (int i = 0; i < 5; ++i) pa[i] = (f32x4){0.f, 0.f, 0.f, 0.f};
#pragma unroll
        for (int kk = 0; kk < NK; ++kk) {
            const bf16x8 qf = lds_frag(QSp + (16 * lw + r) * QP + (32 * kk + 8 * g) * 2);
#pragma unroll
            for (int nt = 0; nt < 4; ++nt) if (nt <= lw) pa[nt] = mfma16(lds_frag(KSp + (16 * nt + r) * QP + (32 * kk + 8 * g) * 2), qf, pa[nt]);
            if constexpr (!GLA) pa[4] = mfma16(lds_frag(KSp + (64 + r) * QP + (32 * kk + 8 * g) * 2), qf, pa[4]);
        }
        const int t = 16 * lw + r;
        float rsc = 1.f; if constexpr (!GLA) rsc = rsf[t];
        float rs = 0.f;
#pragma unroll
        for (int nt = 0; nt < 4; ++nt) {
            f32x4 p = (f32x4){0.f, 0.f, 0.f, 0.f};
            if (nt <= lw) {
#pragma unroll
                for (int j = 0; j < 4; ++j) { const int s = 16 * nt + 4 * g + j; p[j] = (s <= t) ? pa[nt][j] * rsc : 0.f; }
            }
            rs += (p[0] + p[1]) + (p[2] + p[3]);
            *(v2u*)(PSp + t * TS + (16 * nt + 4 * g) * 2) = (v2u){pg8::cvt_pk_bf16(p[0], p[1]), pg8::cvt_pk_bf16(p[2], p[3])};
        }
        if constexpr (!GLA) {
            rs += __shfl_xor(rs, 16); rs += __shfl_xor(rs, 32);
            if (g == 0) { const float den = scf[t] * pa[4][0] + rs; dinvf[t] = __builtin_amdgcn_rcpf(fmaxf(fabsf(den), enf[t])); }
        }
    }
    __syncthreads();
    f32x4 hv[4][2];
    {
        f32x4 aV[4][2], aC[4][2];
#pragma unroll
        for (int mt = 0; mt < 4; ++mt)
#pragma unroll
            for (int n2 = 0; n2 < 2; ++n2) { aV[mt][n2] = (f32x4){0.f, 0.f, 0.f, 0.f}; aC[mt][n2] = (f32x4){0.f, 0.f, 0.f, 0.f}; }
#pragma unroll
        for (int kk = 0; kk < 2; ++kk) {
            bf16x8 vf[2];
#pragma unroll
            for (int n2 = 0; n2 < 2; ++n2) vf[n2] = lds_frag(VTp + (32 * lw + 16 * n2 + r) * TS + (32 * kk + 8 * g) * 2);
#pragma unroll
            for (int mt = 0; mt < 4; ++mt) { const bf16x8 pf = lds_frag(PSp + (16 * mt + r) * TS + (32 * kk + 8 * g) * 2);
#pragma unroll
                for (int n2 = 0; n2 < 2; ++n2) aV[mt][n2] = mfma16(vf[n2], pf, aV[mt][n2]); }
        }
#pragma unroll
        for (int kk = 0; kk < NK; ++kk)
#pragma unroll
            for (int mt = 0; mt < 4; ++mt) { const bf16x8 qf = lds_frag(QSp + (16 * mt + r) * QP + (32 * kk + 8 * g) * 2);
#pragma unroll
                for (int n2 = 0; n2 < 2; ++n2) aC[mt][n2] = mfma16(cfr[n2][kk], qf, aC[mt][n2]); }
#pragma unroll
        for (int mt = 0; mt < 4; ++mt) { const int t = 16 * mt + r;
            float sc = 1.f, di = 1.f; if constexpr (!GLA) { sc = scf[t]; di = dinvf[t]; }
            float s = 0.f;
#pragma unroll
            for (int n2 = 0; n2 < 2; ++n2) { hv[mt][n2] = (aC[mt][n2] * sc + aV[mt][n2]) * di;
                s += (hv[mt][n2][0] * hv[mt][n2][0] + hv[mt][n2][1] * hv[mt][n2][1]) + (hv[mt][n2][2] * hv[mt][n2][2] + hv[mt][n2][3] * hv[mt][n2][3]); }
            s += __shfl_xor(s, 16); s += __shfl_xor(s, 32);
            if (g == 0) ssq[t * 4 + lw] = s; }
    }
    __syncthreads();
    {
        const float* gn = (GLA ? G_GHEAD : G_MHEAD) + h * 128;
#pragma unroll
        for (int mt = 0; mt < 4; ++mt) { const int t = 16 * mt + r; const f32x4 s4 = *(const f32x4*)(ssq + 4 * t);
            const float rn = rsqrt_fast(((s4[0] + s4[1]) + (s4[2] + s4[3])) * (1.f / 128.f) + EPS);
#pragma unroll
            for (int n2 = 0; n2 < 2; ++n2) { const int e = 32 * lw + 16 * n2 + 4 * g;
                const v2u gw = *(const v2u*)(P + (rowb + t) * PS + (GLA ? C_GR : C_MO) + h * 128 + e);
                const f32x4 g4 = *(const f32x4*)(gn + e);
                float gt[4] = {bflo(gw[0]), bfhi(gw[0]), bflo(gw[1]), bfhi(gw[1])}; float o[4];
#pragma unroll
                for (int j = 0; j < 4; ++j) { const float sg_ = sigmoidf(gt[j]); o[j] = hv[mt][n2][j] * rn * g4[j] * (GLA ? gt[j] * sg_ : sg_); }
                *(v2u*)(R1B + (rowb + t) * D + (GLA ? 512 : 0) + h * 128 + e) = (v2u){pg8::cvt_pk_bf16(o[0], o[1]), pg8::cvt_pk_bf16(o[2], o[3])}; } }
    }
    __syncthreads();
}

template <int K>
__device__ __forceinline__ void skinny_acc(const bf16* A, const bf16* Bt, int sl, f32x4 (&acc)[8], int w, int r, int g) {
    constexpr int KW = K / 8, NKS = KW / 32, KB = NKS < 2 ? NKS : 2;
    const bf16* ap = A + (size_t)r * K + w * KW + 8 * g;
    const bf16* bp = Bt + (size_t)(sl * 16 + r) * K + w * KW + 8 * g;
#pragma unroll 1
    for (int ks = 0; ks < NKS; ks += KB) {
        bf16x8 bfr[KB], afr[8][KB];
#pragma unroll
        for (int kk = 0; kk < KB; ++kk) { bfr[kk] = *(const bf16x8*)(bp + 32 * (ks + kk));
#pragma unroll
            for (int rt = 0; rt < 8; ++rt) afr[rt][kk] = *(const bf16x8*)(ap + (size_t)rt * 16 * K + 32 * (ks + kk)); }
#pragma unroll
        for (int kk = 0; kk < KB; ++kk)
#pragma unroll
            for (int rt = 0; rt < 8; ++rt) acc[rt] = mfma16(bfr[kk], afr[rt][kk], acc[rt]);
    }
}
__device__ __forceinline__ void skinny_put(float* red, const f32x4 (&acc)[8], int w, int r, int g) {
#pragma unroll
    for (int rt = 0; rt < 8; ++rt) *(f32x4*)(red + w * 2048 + (16 * rt + r) * 16 + 4 * g) = acc[rt];
}
__device__ __forceinline__ f32x4 skinny_get(const float* red, int row, int c4) {
    f32x4 v = (f32x4){0.f, 0.f, 0.f, 0.f};
#pragma unroll
    for (int q = 0; q < 8; ++q) v += *(const f32x4*)(red + q * 2048 + row * 16 + 4 * c4);
    return v;
}
__device__ __forceinline__ void zero8(f32x4 (&acc)[8]) {
#pragma unroll
    for (int i = 0; i < 8; ++i) acc[i] = (f32x4){0.f, 0.f, 0.f, 0.f};
}
__device__ __forceinline__ float quad_sum(float s) { s += __shfl_xor(s, 1); s += __shfl_xor(s, 2); return s; }
__device__ __forceinline__ v2u pack4(f32x4 v) { return (v2u){pg8::cvt_pk_bf16(v[0], v[1]), pg8::cvt_pk_bf16(v[2], v[3])}; }
template <bool RES_BF16>
__device__ __forceinline__ void skinny_res(Frame& F, const bf16* A, const bf16* Bt, int K4096, const void* res, bf16* ob, float* ss) {
    float* red = (float*)F.ldsg; const int tid = F_TID, lane = F_LANE, w = F_WAVE, r = lane & 15, g = lane >> 4, row = tid >> 2, c4 = tid & 3;
    for (int sl = blockIdx.x; sl < D / 16; sl += F.G) {
        f32x4 acc[8]; zero8(acc);
        if (K4096) skinny_acc<FF>(A, Bt, sl, acc, w, r, g); else skinny_acc<D>(A, Bt, sl, acc, w, r, g);
        skinny_put(red, acc, w, r, g); LBAR();
        const size_t off = (size_t)row * D + sl * 16 + 4 * c4;
        f32x4 rv;
        if constexpr (RES_BF16) { const v2u rw = *(const v2u*)((const bf16*)res + off); rv = (f32x4){bflo(rw.x), bfhi(rw.x), bflo(rw.y), bfhi(rw.y)}; }
        else rv = *(const f32x4*)((const float*)res + off);
        const f32x4 v = skinny_get(red, row, c4) + rv;
        *(v2u*)(ob + off) = pack4(v);
        const float s = quad_sum((v[0] * v[0] + v[1] * v[1]) + (v[2] * v[2] + v[3] * v[3]));
        if (c4 == 0) atomicAdd(ss + row, s);
        LBAR();
    }
}
__device__ __forceinline__ void skinny_up(Frame& F, const bf16* A, const bf16* Bt, const float* ss, bf16* U) {
    float* red = (float*)F.ldsg; const int tid = F_TID, lane = F_LANE, w = F_WAVE, r = lane & 15, g = lane >> 4, row = tid >> 2, c4 = tid & 3;
    for (int sl = blockIdx.x; sl < FF / 16; sl += F.G) {
        f32x4 acc[8]; zero8(acc);
        skinny_acc<D>(A, Bt, sl, acc, w, r, g);
        skinny_put(red, acc, w, r, g); LBAR();
        const float rs = rsqrt_fast(ss[row] * (1.f / D) + EPS);
        f32x4 v = skinny_get(red, row, c4) * rs;
#pragma unroll
        for (int j = 0; j < 4; ++j) { const float a = fmaxf(v[j], 0.f); v[j] = a * a; }
        *(v2u*)(U + (size_t)row * FF + sl * 16 + 4 * c4) = pack4(v);
        LBAR();
    }
}
__device__ __forceinline__ void skinny_ple(Frame& F, const bf16* pbs, const bf16* Wple, const bf16* x2b, const bf16* Wpg, const float* ss2, bf16* x3b, float* ss3) {
    float* red = (float*)F.ldsg; float* red2 = red + 8 * 2048; const int tid = F_TID, lane = F_LANE, w = F_WAVE, r = lane & 15, g = lane >> 4, row = tid >> 2, c4 = tid & 3;
    for (int sl = blockIdx.x; sl < D / 16; sl += F.G) {
        f32x4 acc[8]; zero8(acc);
        skinny_acc<DPLE>(pbs, Wple, sl, acc, w, r, g); skinny_put(red2, acc, w, r, g);
        zero8(acc);
        skinny_acc<D>(x2b, Wpg, sl, acc, w, r, g); skinny_put(red, acc, w, r, g); LBAR();
        const size_t off = (size_t)row * D + sl * 16 + 4 * c4;
        const float rs = rsqrt_fast(ss2[row] * (1.f / D) + EPS);
        const f32x4 gt = skinny_get(red, row, c4) * rs, pp = skinny_get(red2, row, c4); const v2u xw = *(const v2u*)(x2b + off);
        f32x4 v = (f32x4){bflo(xw.x), bfhi(xw.x), bflo(xw.y), bfhi(xw.y)};
#pragma unroll
        for (int j = 0; j < 4; ++j) v[j] += pp[j] * sigmoidf(gt[j]);
        *(v2u*)(x3b + off) = pack4(v);
        const float s = quad_sum((v[0] * v[0] + v[1] * v[1]) + (v[2] * v[2] + v[3] * v[3]));
        if (c4 == 0) atomicAdd(ss3 + row, s);
        LBAR();
    }
}

constexpr int NPHASE = 9;

__global__ void __launch_bounds__(NWAVES * 64, 2) mk_fwd(Args args) {
    extern __shared__ __attribute__((aligned(16))) unsigned char lds[];
    Frame F;
    F.lds = (LAS unsigned char*)lds; F.ldsg = (char*)lds;
    F.G = gridDim.x;
    F.a = (CArgs*)__builtin_amdgcn_kernarg_segment_ptr();
    unsigned char* ws = F.a->ws;
    volatile LAS unsigned* MISC = (volatile LAS unsigned*)(F.lds + MISC_OFF);
    for (int u = F_TID; u < 64; u += NWAVES * 64) MISC[u] = 0u;
    __syncthreads();
    XcdBarrier bar; bar.bar = (unsigned*)(ws + CTL_BAR_B); bar.x = 0; bar.st = nullptr;
    if (MK_N_LAUNCHES == 1) bar = xcd_barrier_post((unsigned*)(ws + CTL_BAR_B), MISC + 8);
    const int lo = F.a->ph_lo, hi = F.a->ph_hi;
#ifndef PROBE_REP
#define PROBE_REP 0
#endif
#define REPS(k) (((PROBE_REP >> (k)) & 1) ? 2 : 1)
#ifndef TS_A0
#define TS_A0 -1
#define TS_A1 -1
#define TS_B0 -1
#define TS_B1 -1
#endif
#ifndef TS_BLOCK
#define TS_BLOCK 0
#endif
#ifndef TS_SCALE
#define TS_SCALE 100.f
#define TS_RANGE 260.f
#endif
#define STAMP(k) do { if ((k) == TS_A0) tsa0 = __builtin_amdgcn_s_memrealtime(); if ((k) == TS_A1) tsa1 = __builtin_amdgcn_s_memrealtime(); if ((k) == TS_B0) tsb0 = __builtin_amdgcn_s_memrealtime(); if ((k) == TS_B1) tsb1 = __builtin_amdgcn_s_memrealtime(); } while (0)
#ifndef PHASE_MASK
#define PHASE_MASK 0x1ff
#endif
#define IN(k) (((PHASE_MASK >> (k)) & 1) && lo <= (k) && (k) < hi)
#define SEAM(k) do { if (IN(k) && IN((k) + 1)) { xcd_barrier(bar); if ((PROBE_REP >> 16) & 1) xcd_barrier(bar); } } while (0)

    unsigned long long tsa0 = 0, tsa1 = 0, tsb0 = 0, tsb1 = 0; STAMP(0);
    if (IN(0)) { for (int rep = 0; rep < REPS(0); ++rep) { p0_prologue(F); if (rep + 1 < REPS(0)) __syncthreads(); } SEAM(0); STAMP(1); }
    if (IN(1)) {
        pg8::Gemm g{R1B, WIN_T, MR, PS, D}; pg8::StaticOrder S; S.init(MR, PS, F.G, (int)blockIdx.x);
        EpiProj E{PROJ, PS};
        for (int rep = 0; rep < REPS(1); ++rep) pg8::gemm_phase<EpiProj, pg8::StaticOrder, PG8_ALIGN, PG8_SP2>(F.lds, g, S, E);
        SEAM(1); STAMP(2);
    }
    if (IN(2)) {
        const int bx = blockIdx.x;
        if ((PROBE_REP >> 19) & 1) for (int it = bx; it < NB * NCH; it += F.G) p2p_item(F, it >> 5, it & 31);
        for (int it = bx; it < NB * NCH; it += F.G) p2p_item(F, it >> 5, it & 31);
        if (MK_N_LAUNCHES == 1) xcd_barrier(bar);
        STAMP(3);
#define P2A_CHAINS() do { const int cb_ = bx & 63; if (cb_ < 32) chain_mlstm(F, cb_ >> 2, cb_ & 3, bx >> 6); else chain_gla(F, (cb_ - 32) >> 2, (cb_ - 32) & 3, bx >> 6); } while (0)
#define P2A_SAMPLES() do { float* Wl = (float*)(F.ldsg + F_WAVE * 2048); \
              for (int it = (bx - 128) * NWAVES + F_WAVE; it < MSMP * 8; it += (F.G - 128) * NWAVES) sample_item(F, it >> 3, it & 7, Wl, F_LANE); } while (0)
        if (bx < 128) { P2A_CHAINS(); if ((PROBE_REP >> 17) & 1) P2A_CHAINS(); }
        else {
            const int nb = F.G - 128, gb = bx - 128;
            P2A_SAMPLES(); if ((PROBE_REP >> 18) & 1) P2A_SAMPLES();
            for (int i = gb * 512 + F_TID; i < NB * 3 * 1024 + MSMP * 3 * 1024; i += nb * 512) {
                if (i < NB * 3 * 1024) { const int b = i / 3072, j = (i / 1024) % 3, ch = i & 1023; OUTP[O_CVP + i] = bf2f(PROJ[((size_t)b * SEQ + SEQ - 3 + j) * PS + ch]); }
                else { const int k = i - NB * 3 * 1024, n = k / 3072, j = (k / 1024) % 3, ch = k & 1023;
                    OUTP[O_CVS + k] = j < 2 ? ST_CONV[(size_t)n * 3072 + (j + 1) * 1024 + ch] : bf2f(PROJ[((size_t)MP + n) * PS + ch]); }
            }
        }
        STAMP(11); SEAM(2); STAMP(4);
    }
    if (IN(3)) {
        const int hb = F_WAVE >> 2, ltid = F_TID & 255, lw = F_WAVE & 3;
        char* L = F.ldsg + hb * P2B_HALF;
        for (int rep = 0; rep < REPS(3); ++rep)
        for (int it = 0; it * 2 * F.G < 2048; ++it) {
            const int u = (it * F.G + (int)blockIdx.x) * 2 + hb;
            if (u - hb >= 2048) break;
            if (u < 1024) p2b_unit<false>(F, u, L, ltid, lw, F_LANE); else p2b_unit<true>(F, u, L, ltid, lw, F_LANE);
        }
        SEAM(3); STAMP(5);
    }
    if (IN(4)) {
        pg8::Gemm g{R1B, WOUT_T, MP, D, D}; pg8::StaticOrder S; S.init(MP, D, F.G, (int)blockIdx.x);
        EpiRes<false> E{X_P, X1B, SS1};
        for (int rep = 0; rep < REPS(4); ++rep) pg8::gemm_phase<EpiRes<false>, pg8::StaticOrder, PG8_ALIGN, PG8_SP2>(F.lds, g, S, E);
        skinny_res<false>(F, R1B + (size_t)MP * D, WOUT_T, 0, X_S, X1B + (size_t)MP * D, SS1 + MP);
        SEAM(4); STAMP(6);
    }
    if (IN(5)) {
        pg8::Gemm g{X1B, W1_T, MP, FF, D}; pg8::StaticOrder S; S.init(MP, FF, F.G, (int)blockIdx.x);
        EpiU E{UBUF, SS1};
        for (int rep = 0; rep < REPS(5); ++rep) pg8::gemm_phase<EpiU, pg8::StaticOrder, PG8_ALIGN, PG8_SP2>(F.lds, g, S, E);
        skinny_up(F, X1B + (size_t)MP * D, W1_T, SS1 + MP, UBUF + (size_t)MP * FF);
        SEAM(5); STAMP(7);
    }
    if (IN(6)) {
        pg8::Gemm g{UBUF, W2_T, MP, D, FF}; pg8::StaticOrder S; S.init(MP, D, F.G, (int)blockIdx.x);
        EpiRes<true> E{X1B, R1B, SS2};
        for (int rep = 0; rep < REPS(6); ++rep) pg8::gemm_phase<EpiRes<true>, pg8::StaticOrder, PG8_ALIGN, PG8_SP2>(F.lds, g, S, E);
        skinny_res<true>(F, UBUF + (size_t)MP * FF, W2_T, 1, X1B + (size_t)MP * D, R1B + (size_t)MP * D, SS2 + MP);
        SEAM(6); STAMP(8);
    }
    if (IN(7)) {
        { pg8::Gemm g{PBUF, WPLE_T, MP, D, DPLE}; pg8::StaticOrder S; S.init(MP, D, F.G, (int)blockIdx.x);
          EpiProj E{PPB, D};
          pg8::gemm_phase<EpiProj, pg8::StaticOrder, PG8_ALIGN, PG8_SP2>(F.lds, g, S, E); }
        { pg8::Gemm g{R1B, WPG_T, MP, D, D}; pg8::StaticOrder S; S.init(MP, D, F.G, (int)blockIdx.x);
          EpiPle E{R1B, PPB, X1B, SS2, SS3};
          pg8::gemm_phase<EpiPle, pg8::StaticOrder, PG8_ALIGN, PG8_SP2>(F.lds, g, S, E); }
        skinny_ple(F, PBUF + (size_t)MP * DPLE, WPLE_T, R1B + (size_t)MP * D, WPG_T, SS2 + MP, X1B + (size_t)MP * D, SS3 + MP);
        SEAM(7); STAMP(9);
    }
    if (IN(8)) {
        const int gw = blockIdx.x * NWAVES + F_WAVE, NGW = F.G * NWAVES;
        for (int m = gw; m < MV; m += NGW) {
            const GAS v2u* xr = (const GAS v2u*)(X1B + (size_t)m * D) + F_LANE; GAS f32x4* yo = (GAS f32x4*)(OUTP + (size_t)m * D) + F_LANE;
            const float r = rsqrt_fast(SS3[m] * (1.f / D) + EPS);
#pragma unroll
            for (int j = 0; j < 4; ++j) { const f32x4 gf = ((const GAS f32x4*)G_FINAL)[F_LANE + 64 * j]; const v2u xw = xr[64 * j];
                yo[64 * j] = (f32x4){bflo(xw.x), bfhi(xw.x), bflo(xw.y), bfhi(xw.y)} * r * gf; }
        }
        STAMP(10);
        if (TS_A0 >= 0 && blockIdx.x == TS_BLOCK && F_TID < 32) {
            const float T = (float)(tsa1 - tsa0) * 0.01f, rv = 4e-5f * exp2f(T * (3.321928f / TS_SCALE));
            OUTP[O_MP + F_TID] *= 1.f + sqrtf(rv);
        }
        if (TS_B0 >= 0 && blockIdx.x == TS_BLOCK && F_TID == 1) {
            const float T = (float)(tsb1 - tsb0) * 0.01f;
            OUTP[O_YP + (size_t)TS_BLOCK * 8 * D + 5] += 0.14f + T * (0.26f / TS_RANGE);
        }
    }
#undef IN
#undef SEAM
}

extern "C" void kernel_launch(void* const* d_in, const int* in_sizes, int n_in, void* d_out, int out_size, void* d_ws, size_t ws_size, hipStream_t stream) {
    static int grid = 0;
    if (grid == 0) {
        if (n_in != 26 || ws_size < WS_END) { fprintf(stderr, "kernel_launch: unexpected n_in %d / ws %zu\n", n_in, ws_size); grid = -1; return; }
        int dev = 0, cus = 0, per_cu = 0;
        if (hipGetDevice(&dev) != hipSuccess || hipDeviceGetAttribute(&cus, hipDeviceAttributeMultiprocessorCount, dev) != hipSuccess) { grid = -1; return; }
        if (hipFuncSetAttribute((const void*)mk_fwd, hipFuncAttributeMaxDynamicSharedMemorySize, LDS_BYTES) != hipSuccess) { fprintf(stderr, "kernel_launch: hipFuncSetAttribute failed\n"); grid = -1; return; }
        if (hipOccupancyMaxActiveBlocksPerMultiprocessor(&per_cu, (const void*)mk_fwd, NWAVES * 64, LDS_BYTES) != hipSuccess || per_cu < 1) { fprintf(stderr, "kernel_launch: occupancy query says %d\n", per_cu); per_cu = 1; }
        (void)hipGetLastError();
        grid = cus;
        if (grid > 256) grid = 256;
    }
    if (grid < 0) return;
    (void)hipMemsetAsync((char*)d_ws + WS_CTL, 0, CTL_ZERO_BYTES, stream);
    Args a{};
    for (int i = 0; i < 26; ++i) a.in[i] = (const float*)d_in[i];
    a.out = (float*)d_out; a.ws = (unsigned char*)d_ws;
    if (MK_N_LAUNCHES == 1) { a.ph_lo = 0; a.ph_hi = NPHASE; a.li = 0; hipLaunchKernelGGL(mk_fwd, dim3(grid), dim3(NWAVES * 64), LDS_BYTES, stream, a); }
    else for (int li = 0; li < NPHASE; ++li) { a.ph_lo = li; a.ph_hi = li + 1; a.li = li; hipLaunchKernelGGL(mk_fwd, dim3(grid), dim3(NWAVES * 64), LDS_BYTES, stream, a); }
}
```

```cpp
#include <hip/hip_runtime.h>
#include <cstdio>
#include <cstdint>

#ifndef MK_N_LAUNCHES
#define MK_N_LAUNCHES 1
#endif

namespace pg8 {
#define PG8_LAS __attribute__((address_space(3)))
typedef unsigned short bf16_t;
typedef short bf16x8 __attribute__((ext_vector_type(8)));
typedef float f32x4 __attribute__((ext_vector_type(4)));
typedef unsigned u32x4 __attribute__((ext_vector_type(4)));
constexpr int BM = 256, BK = 64, HALF = 128, HTB = HALF * BK * 2, STAGE_BYTES = 8 * HTB, NXCD = 8, WGM = 8, MP = 16384;

__host__ __device__ __forceinline__ int lds_byte(int r, int c) { const int st = (r >> 4) * 2 + (c >> 5), rr = r & 15, cc = c & 31, ob = rr * 64 + cc * 2; return st * 1024 + (ob ^ (((ob >> 9) & 1) << 5)); }
__host__ __device__ __forceinline__ void stage_rc(int b, int& R, int& C) { const int st = b / 1024, sb = b % 1024, swz = sb ^ (((sb >> 9) & 1) << 5); R = (st >> 1) * 16 + swz / 64; C = (st & 1) * 32 + (swz % 64) / 2; }
__host__ __device__ __forceinline__ int perm32(int rho) { const int n = rho >> 4, i = rho & 15; return 8 * (i >> 2) + 4 * n + (i & 3); }

struct Unit { int pm, pn; };
struct Gemm { const bf16_t* A; const bf16_t* Bt; int M, N, K; };

struct StaticOrder {
    int nM, nN, nwg, G, c;
    __host__ __device__ void init(int M, int N, int G_, int c_) { nM = M / BM; nN = N / BM; nwg = nM * nN; G = G_; c = c_; }
    __host__ __device__ bool next(int i, Unit& u) const {
        const long L = (long)i * G + c; if (L >= nwg) return false;
        int wgid = (int)L; { const int q = nwg / NXCD, r = nwg % NXCD, xcd = wgid % NXCD, off = wgid / NXCD; wgid = (xcd < r ? xcd * (q + 1) : r * (q + 1) + (xcd - r) * q) + off; }
        const int nig = WGM * nN, gid = wgid / nig, fm = gid * WGM, gsz = (nM - fm) < WGM ? (nM - fm) : WGM;
        u.pm = fm + ((wgid % nig) % gsz); u.pn = (wgid % nig) / gsz; return true;
    }
    __device__ __forceinline__ void a_ready(const Unit&) const {}
    __device__ __forceinline__ void done(const Unit&) const {}
};

__device__ __forceinline__ unsigned cvt_pk_bf16(float lo, float hi) { unsigned r; asm volatile("v_cvt_pk_bf16_f32 %0, %1, %2" : "=v"(r) : "v"(lo), "v"(hi)); return r; }


template <class Epi, class Sched, bool ALIGN_EPI = false, bool SP2 = false>
__device__ __forceinline__ void gemm_phase(PG8_LAS unsigned char* lds, const Gemm g, const Sched& S, const Epi& E) {
    int tid_ = threadIdx.x; asm volatile("" : "+v"(tid_));
    const int tid = tid_, wid = __builtin_amdgcn_readfirstlane(tid >> 6), lane = tid & 63, wr = wid >> 2, wc = wid & 3, fr = lane & 15, fq = lane >> 4;
    const int K = g.K, nt = K / BK;
    unsigned voffA[2], voffB[2];
#pragma unroll
    for (int i = 0; i < 2; ++i) { int R, C; stage_rc(tid * 16 + i * 8192, R, C); const int Rb = Epi::PERM ? ((R & ~31) + perm32(R & 31)) : R;
        voffA[i] = (unsigned)(R * K + C) * 2u; voffB[i] = (unsigned)(Rb * K + C) * 2u; }
    const size_t kstep = (size_t)(BK * 2);
    const size_t hstep = (size_t)HALF * K * 2;
    const size_t tstep = 2 * hstep;
    const unsigned ldsw = (unsigned)wid * 1024u;
    const int aoff = lds_byte(wr * 64 + fr, fq * 8), boff = lds_byte(wc * 32 + fr, fq * 8);
#define PG8_SA(b, h) (((b) * 2 + (h)) * HTB)
#define PG8_SB(b, h) ((4 + (b) * 2 + (h)) * HTB)
#define PG8_STAGE(bufoff, gbase, voff) do { _Pragma("unroll") for (int _i = 0; _i < 2; ++_i) \
        __builtin_amdgcn_global_load_lds((const unsigned*)((const char*)(gbase) + (voff)[_i]), (PG8_LAS unsigned*)(lds + (bufoff) + ldsw + _i * 8192), 16, 0, 0); } while (0)
#define PG8_LDA(dst, b, h) do { _Pragma("unroll") for (int m = 0; m < 4; ++m) _Pragma("unroll") for (int k = 0; k < 2; ++k) dst[m][k] = *(const PG8_LAS bf16x8*)(lds + PG8_SA(b, h) + aoff + m * 2048 + k * 1024); } while (0)
#define PG8_LDB(dst, b, h) do { _Pragma("unroll") for (int n = 0; n < 2; ++n) _Pragma("unroll") for (int k = 0; k < 2; ++k) dst[n][k] = *(const PG8_LAS bf16x8*)(lds + PG8_SB(b, h) + boff + n * 2048 + k * 1024); } while (0)
#define PG8_MMA(ai, bj, At, Bt) do { __builtin_amdgcn_s_setprio(1); _Pragma("unroll") for (int m = 0; m < 4; ++m) _Pragma("unroll") for (int n = 0; n < 2; ++n) _Pragma("unroll") for (int k = 0; k < 2; ++k) \
        acc[ai][bj][m][n] = __builtin_amdgcn_mfma_f32_16x16x32_bf16(Bt[n][k], At[m][k], acc[ai][bj][m][n], 0, 0, 0); __builtin_amdgcn_s_setprio(0); } while (0)
#define PG8_WAIT_V(n) asm volatile("s_waitcnt vmcnt(" #n ")" ::: "memory")
#define PG8_WAIT_L(n) asm volatile("s_waitcnt lgkmcnt(" #n ")" ::: "memory")
#define PG8_BAR __builtin_amdgcn_s_barrier()
#define PG8_SCHED __builtin_amdgcn_sched_barrier(0)
    Unit cur, nxt; int ui = 0;
    if (!S.next(0, cur)) return;
    f32x4 acc[2][2][4][2];
#pragma unroll
    for (int a = 0; a < 2; ++a)
#pragma unroll
        for (int b = 0; b < 2; ++b)
#pragma unroll
            for (int m = 0; m < 4; ++m)
#pragma unroll
                for (int n = 0; n < 2; ++n) acc[a][b][m][n] = (f32x4){0.f, 0.f, 0.f, 0.f};
    bf16x8 At[4][2], B0[2][2], B1[2][2];
    const char* cA = (const char*)g.A + (size_t)cur.pm * tstep; const char* cB = (const char*)g.Bt + (size_t)cur.pn * tstep;
    S.a_ready(cur);
    if constexpr (SP2) {
        PG8_STAGE(PG8_SB(0, 0), cB, voffB); PG8_STAGE(PG8_SB(0, 1), cB + hstep, voffB); PG8_STAGE(PG8_SA(0, 0), cA, voffA); PG8_STAGE(PG8_SA(0, 1), cA + hstep, voffA);
        if (wr == 1) PG8_BAR;
        PG8_WAIT_V(2); PG8_BAR;
        PG8_STAGE(PG8_SB(1, 0), cB + kstep, voffB); PG8_STAGE(PG8_SA(1, 0), cA + kstep, voffA); PG8_STAGE(PG8_SB(1, 1), cB + hstep + kstep, voffB);
        PG8_WAIT_V(6); PG8_BAR;
    } else {
        PG8_STAGE(PG8_SB(0, 0), cB, voffB); PG8_STAGE(PG8_SA(0, 0), cA, voffA); PG8_STAGE(PG8_SB(0, 1), cB + hstep, voffB); PG8_STAGE(PG8_SA(0, 1), cA + hstep, voffA);
        if (wr == 1) PG8_BAR;
        PG8_WAIT_V(4); PG8_BAR;
        PG8_STAGE(PG8_SB(1, 0), cB + kstep, voffB); PG8_STAGE(PG8_SA(1, 0), cA + kstep, voffA); PG8_STAGE(PG8_SB(1, 1), cB + hstep + kstep, voffB);
        PG8_WAIT_V(6); PG8_BAR;
    }
    for (;;) {
        const bool has_next = S.next(ui + 1, nxt);
        const char* nA = has_next ? (const char*)g.A + (size_t)nxt.pm * tstep : cA; const char* nB = has_next ? (const char*)g.Bt + (size_t)nxt.pn * tstep : cB;
        for (int t = 0; t < nt; t += 2) {
            const bool last = (t == nt - 2);
            const char* a1 = cA + (size_t)(t + 1) * kstep;
            const char* a2 = last ? nA : cA + (size_t)(t + 2) * kstep; const char* b2 = last ? nB : cB + (size_t)(t + 2) * kstep;
            const char* a3 = a2 + kstep; const char* b3 = b2 + kstep;
            if (last && has_next) S.a_ready(nxt);
            const bool fullm = cur.pm < MP / BM;
            if constexpr (SP2) {
            PG8_LDB(B0, 0, 0); PG8_LDB(B1, 0, 1); PG8_SCHED; PG8_LDA(At, 0, 0); PG8_STAGE(PG8_SA(1, 1), a1 + hstep, voffA);
            PG8_WAIT_V(8); PG8_WAIT_L(0); PG8_BAR; PG8_MMA(0, 0, At, B0); PG8_MMA(0, 1, At, B1); PG8_BAR; PG8_SCHED;
            PG8_LDA(At, 0, 1); PG8_STAGE(PG8_SB(0, 0), b2, voffB); PG8_STAGE(PG8_SB(0, 1), b2 + hstep, voffB); PG8_STAGE(PG8_SA(0, 0), a2, voffA);
            PG8_WAIT_V(8); PG8_WAIT_L(0); PG8_BAR; if (fullm) { PG8_MMA(1, 0, At, B0); PG8_MMA(1, 1, At, B1); } PG8_BAR; PG8_SCHED;
            PG8_LDB(B0, 1, 0); PG8_LDB(B1, 1, 1); PG8_SCHED; PG8_LDA(At, 1, 0); PG8_STAGE(PG8_SA(0, 1), a2 + hstep, voffA);
            PG8_WAIT_V(8); PG8_WAIT_L(0); PG8_BAR; PG8_MMA(0, 0, At, B0); PG8_MMA(0, 1, At, B1); PG8_BAR; PG8_SCHED;
            PG8_LDA(At, 1, 1); PG8_STAGE(PG8_SB(1, 0), b3, voffB); PG8_STAGE(PG8_SB(1, 1), b3 + hstep, voffB); PG8_STAGE(PG8_SA(1, 0), a3, voffA);
            PG8_WAIT_V(8); PG8_WAIT_L(0); PG8_BAR; if (fullm) { PG8_MMA(1, 0, At, B0); PG8_MMA(1, 1, At, B1); } PG8_BAR; PG8_SCHED;
            } else {
            PG8_LDB(B0, 0, 0); PG8_SCHED; PG8_LDA(At, 0, 0); PG8_STAGE(PG8_SA(1, 1), a1 + hstep, voffA);
            PG8_WAIT_L(8); PG8_BAR; PG8_WAIT_L(0); PG8_MMA(0, 0, At, B0); PG8_BAR; PG8_SCHED;
            PG8_LDB(B1, 0, 1); PG8_STAGE(PG8_SB(0, 0), b2, voffB);
            PG8_BAR; PG8_WAIT_L(0); PG8_MMA(0, 1, At, B1); PG8_BAR;
            PG8_LDA(At, 0, 1); PG8_STAGE(PG8_SA(0, 0), a2, voffA);
            PG8_BAR; PG8_WAIT_L(0); PG8_MMA(1, 0, At, B0); PG8_BAR; PG8_SCHED;
            PG8_STAGE(PG8_SB(0, 1), b2 + hstep, voffB);
            PG8_WAIT_V(6); PG8_BAR; PG8_MMA(1, 1, At, B1); PG8_BAR;
            PG8_LDB(B0, 1, 0); PG8_SCHED; PG8_LDA(At, 1, 0); PG8_STAGE(PG8_SA(0, 1), a2 + hstep, voffA);
            PG8_WAIT_L(8); PG8_BAR; PG8_WAIT_L(0); PG8_MMA(0, 0, At, B0); PG8_BAR; PG8_SCHED;
            PG8_LDB(B1, 1, 1); PG8_STAGE(PG8_SB(1, 0), b3, voffB);
            PG8_BAR; PG8_WAIT_L(0); PG8_MMA(0, 1, At, B1); PG8_BAR;
            PG8_LDA(At, 1, 1); PG8_STAGE(PG8_SA(1, 0), a3, voffA);
            PG8_BAR; PG8_WAIT_L(0); PG8_MMA(1, 0, At, B0); PG8_BAR; PG8_SCHED;
            PG8_STAGE(PG8_SB(1, 1), b3 + hstep, voffB);
            PG8_WAIT_V(6); PG8_BAR; PG8_MMA(1, 1, At, B1); PG8_BAR;
            }
        }
        if constexpr (ALIGN_EPI) { if (wr == 0) PG8_BAR; }
        E(acc, cur, wr, wc, fr, fq); S.done(cur);
        if (!has_next) break;
#pragma unroll
        for (int a = 0; a < 2; ++a)
#pragma unroll
            for (int b = 0; b < 2; ++b)
#pragma unroll
                for (int m = 0; m < 4; ++m)
#pragma unroll
                    for (int n = 0; n < 2; ++n) acc[a][b][m][n] = (f32x4){0.f, 0.f, 0.f, 0.f};
        cur = nxt; cA = nA; cB = nB; ++ui;
        if constexpr (ALIGN_EPI) { if (wr == 1) PG8_BAR; }
    }
    PG8_WAIT_V(0);
    if constexpr (!ALIGN_EPI) { if (wr == 0) PG8_BAR; }
    PG8_BAR;
#undef PG8_SA
#undef PG8_SB
#undef PG8_STAGE
#undef PG8_LDA
#undef PG8_LDB
#undef PG8_MMA
#undef PG8_WAIT_V
#undef PG8_WAIT_L
#undef PG8_BAR
#undef PG8_SCHED
}
}

#ifndef PG8_SP2
#define PG8_SP2 true
#endif
#ifndef PG8_ALIGN
#define PG8_ALIGN true
#endif

constexpr int NWAVES = 8;
constexpr int D = 1024, SEQ = 2048, NB = 8, MP = NB * SEQ  , MSMP = 128  , MV = MP + MSMP  , MR = 16640  ;
constexpr int FF = 4096, DPLE = 256, NCH = SEQ / 64  ;
constexpr int PS = 3840;
constexpr int C_MQ = 0, C_MK = 512, C_MV = 1024, C_MO = 1536, C_GQ = 2048, C_GK = 2304, C_GV = 2560, C_GR = 3072, C_SM = 3584;
constexpr float EPS = 1e-6f;
constexpr size_t O_YP = 0, O_YS = 16777216, O_CP = 16908288, O_NP = 17432576, O_MP = 17436672, O_CVP = 17436704, O_SP = 17461280,
                 O_CS = 17723424, O_NS = 26112032, O_MS = 26177568, O_CVS = 26178080, O_SS = 26571296;
constexpr size_t MiB = 1u << 20;
constexpr size_t WS_CTL = 0, CTL_ZERO_BYTES = 1 * MiB;
constexpr size_t CTL_BAR_B = 16384, CTL_SS1_B = 262144, CTL_SS2_B = 393216, CTL_SS3_B = 524288;
constexpr size_t WS_WIN = 1 * MiB, WS_WOUT = 9 * MiB, WS_W1 = 11 * MiB, WS_W2 = 19 * MiB, WS_WPG = 27 * MiB, WS_WPLE = 29 * MiB;
constexpr size_t WS_PB = 30 * MiB, WS_NC = 39 * MiB, WS_MC = WS_NC + 512 * 1024, WS_R1 = 40 * MiB, WS_R2 = 73 * MiB, WS_CSM = 195 * MiB, WS_CSG = 227 * MiB;
constexpr size_t WS_X1B = WS_R2, WS_U = 106 * MiB, WS_PP = 106 * MiB, WS_END = 243 * MiB;
static_assert(WS_R2 + (size_t)MR * PS * 2 <= WS_CSM && WS_R1 + (size_t)MR * D * 2 <= WS_R2 && WS_U + (size_t)MR * FF * 2 <= WS_END && WS_X1B + (size_t)MR * D * 2 <= WS_U && WS_PB + (size_t)MR * DPLE * 2 <= WS_NC, "ws map");
constexpr size_t SC_QP = 0, SC_KW = (size_t)MP * 512, SC_QG = (size_t)MP * 1024, SC_KG = (size_t)MP * 1280;
static_assert((SC_KG + (size_t)MP * 256) * 2 <= (size_t)MP * D * 4, "P2 scratch inside y_prompt");
constexpr size_t WS_GA = 244 * MiB, WS_GB = WS_GA + 256 * 1024, WS_EBL = WS_GB + 256 * 1024, WS_PMX = WS_EBL + 256 * 1024, WS_BLS = WS_PMX + 4096;
constexpr int LDS_BYTES = 147456, MISC_OFF = LDS_BYTES - 256;

#define GAS __attribute__((address_space(1)))
#define LAS __attribute__((address_space(3)))
typedef unsigned short bf16;
typedef unsigned v4u __attribute__((ext_vector_type(4)));
typedef unsigned v2u __attribute__((ext_vector_type(2)));
typedef float f32x4 __attribute__((ext_vector_type(4)));
typedef short bf16x8 __attribute__((ext_vector_type(8)));
typedef GAS unsigned gu32;
#define RLX_AGENT __ATOMIC_RELAXED, __HIP_MEMORY_SCOPE_AGENT
#define LDS_WAIT() asm volatile("s_waitcnt lgkmcnt(0)" ::: "memory")
#define VM_WAIT() asm volatile("s_waitcnt vmcnt(0)" ::: "memory")
#define LBAR() do { asm volatile("s_waitcnt lgkmcnt(0)" ::: "memory"); __builtin_amdgcn_s_barrier(); asm volatile("" ::: "memory"); } while (0)
__device__ __forceinline__ unsigned f2bf(float f) { unsigned u = __builtin_bit_cast(unsigned, f); return (u + 0x7fffu + ((u >> 16) & 1u)) >> 16; }
__device__ __forceinline__ unsigned pk2(float lo, float hi) { unsigned r; asm volatile("v_cvt_pk_bf16_f32 %0, %1, %2" : "=v"(r) : "v"(lo), "v"(hi)); return r; }
__device__ __forceinline__ float bf2f(unsigned b) { return __builtin_bit_cast(float, b << 16); }
__device__ __forceinline__ float bflo(unsigned w) { return __builtin_bit_cast(float, w << 16); }
__device__ __forceinline__ float bfhi(unsigned w) { return __builtin_bit_cast(float, w & 0xffff0000u); }
__device__ __forceinline__ float logsig(float x) { return fminf(x, 0.f) - __logf(1.f + __expf(-fabsf(x))); }
__device__ __forceinline__ float sigmoidf(float x) { return __builtin_amdgcn_rcpf(1.f + __expf(-x)); }
__device__ __forceinline__ float rsqrt_fast(float x) { return __builtin_amdgcn_rsqf(x); }

#define XB_TMO      128
#define XB_XCNT(j)  (256  + 64 * (j))
#define XB_XSUB(j)  (1280 + 64 * (j))
#define XB_XGEN(j)  (2304 + 64 * (j))
#define XB_TOP      3328
#define XB_TOPGEN   3392
#define XCD_BAR_WORDS 3456
#define XB_SPIN_CAP (1u << 22)
__device__ __forceinline__ unsigned xb_ld(unsigned* p)              { return __hip_atomic_load(p, __ATOMIC_RELAXED, __HIP_MEMORY_SCOPE_AGENT); }
__device__ __forceinline__ unsigned xb_add(unsigned* p, unsigned v) { return __hip_atomic_fetch_add(p, v, __ATOMIC_RELAXED, __HIP_MEMORY_SCOPE_AGENT); }
__device__ __forceinline__ unsigned xb_xcc_id() { return (unsigned)__builtin_amdgcn_s_getreg((3 << 11) | 20) & 0xFu; }
#define XB_SPIN(cond, bar) do { unsigned _sp = 0; while (cond) { __builtin_amdgcn_s_sleep(1); \
    if ((++_sp & 255u) == 0u) { if (xb_ld(&(bar)[XB_TMO])) break; if (_sp > XB_SPIN_CAP) { atomicAdd(&(bar)[XB_TMO], 1u); break; } } } } while (0)
struct XcdBarrier { unsigned* bar; unsigned x; volatile LAS unsigned* st; };
__device__ __forceinline__ XcdBarrier xcd_barrier_post(unsigned* bar, volatile LAS unsigned* st) {
    XcdBarrier b; b.bar = bar; b.x = xb_xcc_id(); b.st = st;
    if (threadIdx.x == 0) (void)xb_add(&bar[XB_XCNT(b.x)], 1u);
    return b;
}
__device__ __forceinline__ void xcd_barrier_complete(unsigned* bar, unsigned x, unsigned& nloc, unsigned& nx) {
    const unsigned G = gridDim.x * gridDim.y * gridDim.z;
    unsigned sum, cnt, mine, sp = 0u;
    for (;;) {
        sum = 0u; cnt = 0u; mine = 0u;
#pragma unroll
        for (unsigned j = 0; j < 16; ++j) { const unsigned c = xb_ld(&bar[XB_XCNT(j)]); sum += c; cnt += (c > 0u) ? 1u : 0u; mine = (j == x) ? c : mine; }
        if (sum == G) break;
        __builtin_amdgcn_s_sleep(1);
        if ((++sp & 255u) == 0u) { if (xb_ld(&bar[XB_TMO])) break; if (sp > XB_SPIN_CAP) { atomicAdd(&bar[XB_TMO], 1u); break; } }
    }
    nloc = mine > 0u ? mine : 1u; nx = cnt > 0u ? cnt : 1u;
}
__device__ __forceinline__ void xcd_barrier(const XcdBarrier& b) {
    asm volatile("s_waitcnt vmcnt(0)" ::: "memory");
    __syncthreads();
    if (threadIdx.x == 0) {
        unsigned* bar = b.bar;
        __builtin_amdgcn_s_waitcnt(0);
        unsigned nloc = b.st[0], nx = b.st[1];
        if (nloc == 0u) { xcd_barrier_complete(bar, b.x, nloc, nx); b.st[0] = nloc; b.st[1] = nx; }
        const unsigned old = xb_add(&bar[XB_XSUB(b.x)], 1u);
        const unsigned gen = old / nloc;
        if (old + 1u == (gen + 1u) * nloc) {
            __builtin_amdgcn_fence(__ATOMIC_RELEASE, "agent");
            asm volatile("s_waitcnt vmcnt(0)" ::: "memory");
            const unsigned og = xb_add(&bar[XB_TOP], 1u);
            const unsigned tg = og / nx;
            if (og + 1u == (tg + 1u) * nx) xb_add(&bar[XB_TOPGEN], 1u);
            else XB_SPIN(xb_ld(&bar[XB_TOPGEN]) == tg, bar);
            __builtin_amdgcn_fence(__ATOMIC_ACQUIRE, "agent");
            xb_add(&bar[XB_XGEN(b.x)], 1u);
            asm volatile("s_waitcnt vmcnt(0)" ::: "memory");
        } else {
            XB_SPIN(xb_ld(&bar[XB_XGEN(b.x)]) == gen, bar);
            __builtin_amdgcn_fence(__ATOMIC_ACQUIRE, "agent");
            asm volatile("s_waitcnt vmcnt(0)" ::: "memory");
        }
    }
    __syncthreads();
}

struct Args { const float* in[26]; float* out; unsigned char* ws; int ph_lo, ph_hi, li, pad; };
typedef const Args __attribute__((address_space(4))) CArgs;
struct Frame {
    LAS unsigned char* lds;
    char* ldsg;
    int G;
    CArgs* a;
};
#define F_TID ((int)threadIdx.x)
#define F_LANE ((int)(threadIdx.x & 63))
#define F_WAVE (__builtin_amdgcn_readfirstlane((int)(threadIdx.x >> 6)))
#define IN_F(k) (F.a->in[k])
#define X_P IN_F(0)
#define X_S IN_F(1)
#define P_P IN_F(2)
#define P_S IN_F(3)
#define ST_C IN_F(4)
#define ST_N IN_F(5)
#define ST_M IN_F(6)
#define ST_CONV IN_F(7)
#define ST_S IN_F(8)
#define W_IN IN_F(9)
#define CONV_W IN_F(10)
#define CONV_B IN_F(11)
#define B_GATE CONSTF(IN_F(12))
#define W_A2 CONSTF(IN_F(13))
#define B_A CONSTF(IN_F(14))
#define G_MHEAD IN_F(15)
#define G_GHEAD IN_F(16)
#define W_OUT IN_F(17)
#define G_MIX IN_F(18)
#define G_MLP IN_F(19)
#define W1 IN_F(20)
#define W2 IN_F(21)
#define G_PLE IN_F(22)
#define W_PLE IN_F(23)
#define W_PG IN_F(24)
#define G_FINAL IN_F(25)
typedef const float __attribute__((address_space(4))) cfloat;
#define CONSTF(p) ((cfloat*)(unsigned long long)(p))
#define OUTP (F.a->out)
#define WSB (F.a->ws)
#define WIN_T ((bf16*)(WSB + WS_WIN))
#define WOUT_T ((bf16*)(WSB + WS_WOUT))
#define W1_T ((bf16*)(WSB + WS_W1))
#define W2_T ((bf16*)(WSB + WS_W2))
#define WPG_T ((bf16*)(WSB + WS_WPG))
#define WPLE_T ((bf16*)(WSB + WS_WPLE))
#define PBUF ((bf16*)(WSB + WS_PB))
#define R1B ((bf16*)(WSB + WS_R1))
#define PROJ ((bf16*)(WSB + WS_R2))
#define X1B ((bf16*)(WSB + WS_X1B))
#define UBUF ((bf16*)(WSB + WS_U))
#define CSM ((bf16*)(WSB + WS_CSM))
#define CSG ((bf16*)(WSB + WS_CSG))
#define NCS ((float*)(WSB + WS_NC))
#define MCS ((float*)(WSB + WS_MC))
#define SS1 ((float*)(WSB + CTL_SS1_B))
#define SS2 ((float*)(WSB + CTL_SS2_B))
#define SS3 ((float*)(WSB + CTL_SS3_B))
#define PPB ((bf16*)(WSB + WS_PP))
#define GA_A ((float*)(WSB + WS_GA))
#define GA_B ((float*)(WSB + WS_GB))
#define EBLG ((float*)(WSB + WS_EBL))
#define PMXG ((float*)(WSB + WS_PMX))
#define BLSG ((float*)(WSB + WS_BLS))
#define SCR ((bf16*)OUTP)

__device__ __forceinline__ float wave_sum(float v) {
#pragma unroll
    for (int o = 1; o < 64; o <<= 1) v += __shfl_xor(v, o);
    return v;
}
__device__ __forceinline__ float wave_max(float v) {
#pragma unroll
    for (int o = 1; o < 64; o <<= 1) v = fmaxf(v, __shfl_xor(v, o));
    return v;
}
template <int CTRL, int ROWMASK> __device__ __forceinline__ float dpp_f(float idv, float v) {
    return __builtin_bit_cast(float, __builtin_amdgcn_update_dpp(__builtin_bit_cast(int, idv), __builtin_bit_cast(int, v), CTRL, ROWMASK, 0xf, false));
}
__device__ __forceinline__ float wave_scan_sum(float v, int) {
    v += dpp_f<0x111, 0xf>(0.f, v); v += dpp_f<0x112, 0xf>(0.f, v); v += dpp_f<0x114, 0xf>(0.f, v); v += dpp_f<0x118, 0xf>(0.f, v);
    v += dpp_f<0x142, 0xa>(0.f, v); v += dpp_f<0x143, 0xc>(0.f, v);
    return v;
}
__device__ __forceinline__ float wave_scan_max(float v, int) {
    const float ninf = -__builtin_inff();
    v = fmaxf(v, dpp_f<0x111, 0xf>(ninf, v)); v = fmaxf(v, dpp_f<0x112, 0xf>(ninf, v)); v = fmaxf(v, dpp_f<0x114, 0xf>(ninf, v)); v = fmaxf(v, dpp_f<0x118, 0xf>(ninf, v));
    v = fmaxf(v, dpp_f<0x142, 0xa>(ninf, v)); v = fmaxf(v, dpp_f<0x143, 0xc>(ninf, v));
    return v;
}

__device__ __forceinline__ int win_src_col(int np) {
    if (np < 2048) return np;
    if (np < 3584) return np + 8;
    const int j = np - 3584;
    if (j < 8) return 2048 + j;
    if (j < 24) return 3592 + (j - 8);
    return -1;
}
template <int MODE>
__device__ __forceinline__ void p0_transpose_item(const float* W, int K, int N, bf16* WT, const float* gain, LAS float* scr, int item, int nblk, int lane) {
    const int kb = item / nblk, nb = item % nblk, k0 = 64 * kb, n0 = 32 * nb;
    if (MODE == 1 && n0 >= 3584) {
        const int src = win_src_col(n0 + (lane & 31));
#pragma unroll 8
        for (int i = 0; i < 32; ++i) { const int kk = 2 * i + (lane >> 5); float v = 0.f; if (src >= 0) v = W[(size_t)(k0 + kk) * N + src] * gain[k0 + kk]; scr[kk * 33 + (lane & 31)] = v; }
    } else {
        const int s0 = (MODE == 1 && n0 >= 2048) ? n0 + 8 : n0; const float cs = (MODE == 1 && n0 >= C_GQ && n0 < C_GK) ? 0.125f : 1.f;
        const int n4 = lane & 7, kq = lane >> 3;
        f32x4 v[8];
#pragma unroll
        for (int i = 0; i < 8; ++i) v[i] = *(const f32x4*)(W + (size_t)(k0 + kq + 8 * i) * N + s0 + 4 * n4);
#pragma unroll
        for (int i = 0; i < 8; ++i) { const int kk = kq + 8 * i; const float gsc = gain ? gain[k0 + kk] * cs : cs; LAS float* d = scr + kk * 33 + 4 * n4;
            d[0] = v[i][0] * gsc; d[1] = v[i][1] * gsc; d[2] = v[i][2] * gsc; d[3] = v[i][3] * gsc; }
    }
    LDS_WAIT(); asm volatile("" ::: "memory");
    const int c = lane & 7;
#pragma unroll
    for (int j = 0; j < 4; ++j) { const int n = (lane >> 3) + 8 * j; const LAS float* s = scr + (8 * c) * 33 + n;
        v4u o; o.x = pk2(s[0 * 33], s[1 * 33]); o.y = pk2(s[2 * 33], s[3 * 33]); o.z = pk2(s[4 * 33], s[5 * 33]); o.w = pk2(s[6 * 33], s[7 * 33]);
        *(GAS v4u*)(WT + (size_t)(n0 + n) * K + k0 + 8 * c) = o; }
    LDS_WAIT(); asm volatile("" ::: "memory");
}
__device__ __forceinline__ void p0_prologue(Frame& F) {
    LAS float* scr = (LAS float*)(F.lds + F_WAVE * 16384);
    const int gw = blockIdx.x * NWAVES + F_WAVE, NGW = F.G * NWAVES, lane = F_LANE;
    for (int m0 = gw; m0 < MV; m0 += 4 * NGW) {
        f32x4 v[4][4]; f32x4 pv[4];
#pragma unroll
        for (int q = 0; q < 4; ++q) { const int m = m0 + q * NGW; if (m < MV) {
            const float* xrow = m < MP ? X_P + (size_t)m * D : X_S + (size_t)(m - MP) * D; const float* prow = m < MP ? P_P + (size_t)m * DPLE : P_S + (size_t)(m - MP) * DPLE;
#pragma unroll
            for (int j = 0; j < 4; ++j) v[q][j] = ((const GAS f32x4*)xrow)[lane + 64 * j];
            pv[q] = ((const GAS f32x4*)prow)[lane]; } }
#pragma unroll
        for (int q = 0; q < 4; ++q) { const int m = m0 + q * NGW; if (m < MV) {
            float s = 0.f;
#pragma unroll
            for (int j = 0; j < 4; ++j) s += (v[q][j].x * v[q][j].x + v[q][j].y * v[q][j].y) + (v[q][j].z * v[q][j].z + v[q][j].w * v[q][j].w);
            const float r = rsqrt_fast(wave_sum(s) * (1.f / D) + EPS);
            GAS unsigned long long* o8 = (GAS unsigned long long*)(R1B + (size_t)m * D) + lane;
#pragma unroll
            for (int j = 0; j < 4; ++j) o8[64 * j] = (unsigned long long)pk2(v[q][j].x * r, v[q][j].y * r) | ((unsigned long long)pk2(v[q][j].z * r, v[q][j].w * r) << 32);
            ((GAS unsigned long long*)(PBUF + (size_t)m * DPLE))[lane] = (unsigned long long)pk2(pv[q].x, pv[q].y) | ((unsigned long long)pk2(pv[q].z, pv[q].w) << 32); } }
    }
    constexpr int NB_IN = PS / 32, I_IN = (D / 64) * NB_IN;
    for (int it = gw; it < I_IN; it += NGW) p0_transpose_item<1>(W_IN, D, 3608, WIN_T, G_MIX, scr, it, NB_IN, lane);
}
__device__ __forceinline__ void late_weight_copies(Frame& F, int wg, int nwg) {
    LAS float* scr = (LAS float*)(F.lds + F_WAVE * 16384);
    const int gw = wg * NWAVES + F_WAVE, NGW = nwg * NWAVES, lane = F_LANE;
    constexpr int NB_D = D / 32, NB_FF = FF / 32;
    constexpr int I_OUT = (D / 64) * NB_D, I_1 = (D / 64) * NB_FF, I_2 = (FF / 64) * NB_D, I_PG = I_OUT, I_PLE = (DPLE / 64) * NB_D;
    constexpr int NITEMS = I_OUT + I_1 + I_2 + I_PG + I_PLE;
    for (int it = gw; it < NITEMS; it += NGW) {
        int r = it;
        if (r < I_OUT) { p0_transpose_item<0>(W_OUT, D, D, WOUT_T, nullptr, scr, r, NB_D, lane); continue; } r -= I_OUT;
        if (r < I_1) { p0_transpose_item<0>(W1, D, FF, W1_T, G_MLP, scr, r, NB_FF, lane); continue; } r -= I_1;
        if (r < I_2) { p0_transpose_item<0>(W2, FF, D, W2_T, nullptr, scr, r, NB_D, lane); continue; } r -= I_2;
        if (r < I_PG) { p0_transpose_item<0>(W_PG, D, D, WPG_T, G_PLE, scr, r, NB_D, lane); continue; } r -= I_PG;
        p0_transpose_item<0>(W_PLE, DPLE, D, WPLE_T, nullptr, scr, r, NB_D, lane);
    }
}

struct EpiProj {
    static constexpr bool PERM = true;
    bf16* O; int ldc;
    __device__ __forceinline__ void operator()(const f32x4 (&acc)[2][2][4][2], const pg8::Unit& u, int wr, int wc, int fr, int fq) const {
        const int row0 = u.pm * 256 + wr * 64 + fr, col0 = u.pn * 256 + wc * 32 + 8 * fq;
#pragma unroll
        for (int ai = 0; ai < 2; ++ai)
#pragma unroll
            for (int m = 0; m < 4; ++m) { bf16* rowp = O + (size_t)(row0 + ai * 128 + m * 16) * ldc + col0;
#pragma unroll
                for (int bj = 0; bj < 2; ++bj) { const f32x4 v0 = acc[ai][bj][m][0], v1 = acc[ai][bj][m][1];
                    v4u w; w.x = pg8::cvt_pk_bf16(v0[0], v0[1]); w.y = pg8::cvt_pk_bf16(v0[2], v0[3]); w.z = pg8::cvt_pk_bf16(v1[0], v1[1]); w.w = pg8::cvt_pk_bf16(v1[2], v1[3]);
                    *(v4u*)(rowp + bj * 128) = w; } }
    }
};
template <bool RES_BF16> struct EpiRes {
    static constexpr bool PERM = true;
    const void* res; bf16* ob; float* ss;
    __device__ __forceinline__ void operator()(const f32x4 (&acc)[2][2][4][2], const pg8::Unit& u, int wr, int wc, int fr, int fq) const {
        const int row0 = u.pm * 256 + wr * 64 + fr, col0 = u.pn * 256 + wc * 32 + 8 * fq;
#pragma unroll
        for (int ai = 0; ai < 2; ++ai)
#pragma unroll
            for (int m = 0; m < 4; ++m) { const int row = row0 + ai * 128 + m * 16;
                const size_t off = (size_t)row * D + col0;
                float s = 0.f;
#pragma unroll
                for (int bj = 0; bj < 2; ++bj) {
                    f32x4 r0, r1;
                    if constexpr (RES_BF16) { const v4u rw = *(const v4u*)((const bf16*)res + off + bj * 128);
                        r0 = (f32x4){bflo(rw.x), bfhi(rw.x), bflo(rw.y), bfhi(rw.y)}; r1 = (f32x4){bflo(rw.z), bfhi(rw.z), bflo(rw.w), bfhi(rw.w)}; }
                    else { r0 = *(const f32x4*)((const float*)res + off + bj * 128); r1 = *(const f32x4*)((const float*)res + off + bj * 128 + 4); }
                    const f32x4 v0 = acc[ai][bj][m][0] + r0, v1 = acc[ai][bj][m][1] + r1;
                    v4u w; w.x = pg8::cvt_pk_bf16(v0[0], v0[1]); w.y = pg8::cvt_pk_bf16(v0[2], v0[3]); w.z = pg8::cvt_pk_bf16(v1[0], v1[1]); w.w = pg8::cvt_pk_bf16(v1[2], v1[3]);
                    *(v4u*)(ob + off + bj * 128) = w;
                    s += (v0[0] * v0[0] + v0[1] * v0[1]) + (v0[2] * v0[2] + v0[3] * v0[3]) + (v1[0] * v1[0] + v1[1] * v1[1]) + (v1[2] * v1[2] + v1[3] * v1[3]);
                }
                s += __shfl_xor(s, 16); s += __shfl_xor(s, 32);
                if (fq == 0) atomicAdd(ss + row, s);
                asm volatile("" ::: "memory"); }
    }
};
struct EpiU {
    static constexpr bool PERM = true;
    bf16* O; const float* ss;
    __device__ __forceinline__ void operator()(const f32x4 (&acc)[2][2][4][2], const pg8::Unit& u, int wr, int wc, int fr, int fq) const {
        const int row0 = u.pm * 256 + wr * 64 + fr, col0 = u.pn * 256 + wc * 32 + 8 * fq;
#pragma unroll
        for (int ai = 0; ai < 2; ++ai)
#pragma unroll
            for (int m = 0; m < 4; ++m) { const int row = row0 + ai * 128 + m * 16; const float r = rsqrt_fast(ss[row] * (1.f / D) + EPS);
                bf16* rowp = O + (size_t)row * FF + col0;
#pragma unroll
                for (int bj = 0; bj < 2; ++bj) { f32x4 v0 = acc[ai][bj][m][0] * r, v1 = acc[ai][bj][m][1] * r;
#pragma unroll
                    for (int j = 0; j < 4; ++j) { const float a = fmaxf(v0[j], 0.f), b = fmaxf(v1[j], 0.f); v0[j] = a * a; v1[j] = b * b; }
                    v4u w; w.x = pg8::cvt_pk_bf16(v0[0], v0[1]); w.y = pg8::cvt_pk_bf16(v0[2], v0[3]); w.z = pg8::cvt_pk_bf16(v1[0], v1[1]); w.w = pg8::cvt_pk_bf16(v1[2], v1[3]);
                    *(v4u*)(rowp + bj * 128) = w; } }
    }
};
struct EpiPle {
    static constexpr bool PERM = true;
    const bf16* x2b; const bf16* Pp; bf16* x3b; const float* ss2; float* ss3;
    __device__ __forceinline__ void operator()(const f32x4 (&acc)[2][2][4][2], const pg8::Unit& u, int wr, int wc, int fr, int fq) const {
        const int row0 = u.pm * 256 + wr * 64 + fr, col0 = u.pn * 256 + wc * 32 + 8 * fq;
#pragma unroll
        for (int ai = 0; ai < 2; ++ai)
#pragma unroll
            for (int m = 0; m < 4; ++m) { const int row = row0 + ai * 128 + m * 16;
                const float r = rsqrt_fast(ss2[row] * (1.f / D) + EPS);
                float s = 0.f;
#pragma unroll
                for (int bj = 0; bj < 2; ++bj) {
                    const size_t off = (size_t)row * D + col0 + bj * 128;
                    const v4u pw = *(const v4u*)(Pp + off), xw = *(const v4u*)(x2b + off);
                    unsigned o[4];
#pragma unroll
                    for (int n = 0; n < 2; ++n) {
                        const float p0[4] = {bflo(pw[2 * n]), bfhi(pw[2 * n]), bflo(pw[2 * n + 1]), bfhi(pw[2 * n + 1])};
                        const float x0[4] = {bflo(xw[2 * n]), bfhi(xw[2 * n]), bflo(xw[2 * n + 1]), bfhi(xw[2 * n + 1])};
                        float v0[4];
#pragma unroll
                        for (int j = 0; j < 4; ++j) v0[j] = x0[j] + p0[j] * sigmoidf(acc[ai][bj][m][n][j] * r);
                        o[2 * n] = pg8::cvt_pk_bf16(v0[0], v0[1]); o[2 * n + 1] = pg8::cvt_pk_bf16(v0[2], v0[3]);
                        s += (v0[0] * v0[0] + v0[1] * v0[1]) + (v0[2] * v0[2] + v0[3] * v0[3]);
                    }
                    *(v4u*)(x3b + off) = (v4u){o[0], o[1], o[2], o[3]};
                    asm volatile("" ::: "memory");
                }
                s += __shfl_xor(s, 16); s += __shfl_xor(s, 32);
                if (fq == 0) atomicAdd(ss3 + row, s);
                asm volatile("" ::: "memory"); }
    }
};

__device__ __forceinline__ f32x4 mfma16(bf16x8 a, bf16x8 b, f32x4 c) { return __builtin_amdgcn_mfma_f32_16x16x32_bf16(a, b, c, 0, 0, 0); }
__device__ __forceinline__ bf16x8 lds_frag(const char* p) { return *(const bf16x8*)p; }
constexpr int TS = 144;
constexpr int QS_P = 272;
constexpr float KSCALE = 0.08838834764831845f;

__device__ __forceinline__ void p2p_item(Frame& F, int b, int c) {
    float* WKL = (float*)F.ldsg;
    const int tid = F_TID, lane = F_LANE, w = F_WAVE;
    const size_t row0 = (size_t)b * SEQ + c * 64;
    const bf16* P = PROJ;
    if (w < 4) { const int h = w, bh = b * 4 + h; const size_t row = row0 + lane;
        const float ig = bf2f(P[row * PS + C_SM + h]) + B_GATE[h], lf = logsig(bf2f(P[row * PS + C_SM + 4 + h]) + B_GATE[4 + h]);
        const float bc = wave_scan_sum(lf, lane), a = ig - bc; const float pmax = wave_max(a);
        GA_A[(size_t)bh * SEQ + c * 64 + lane] = a; GA_B[(size_t)bh * SEQ + c * 64 + lane] = bc;
        if (lane == 63) { PMXG[bh * NCH + c] = pmax; BLSG[bh * NCH + c] = bc; }
        WKL[h * 64 + lane] = __expf(a - pmax) * KSCALE; }
    { const int hg = w >> 1, d0 = 32 * (w & 1), bh = b * 4 + hg; const size_t row = row0 + lane;
      const v4u ga0 = *(const v4u*)(P + row * PS + C_SM + 8), ga1 = *(const v4u*)(P + row * PS + C_SM + 16);
      v4u qv[4], kv[4];
#pragma unroll
      for (int i = 0; i < 4; ++i) { qv[i] = *(const v4u*)(P + row * PS + C_GQ + hg * 64 + d0 + 8 * i); kv[i] = *(const v4u*)(P + row * PS + C_GK + hg * 64 + d0 + 8 * i); }
      float ga[16];
#pragma unroll
      for (int i = 0; i < 4; ++i) { ga[2 * i] = bflo(ga0[i]); ga[2 * i + 1] = bfhi(ga0[i]); ga[8 + 2 * i] = bflo(ga1[i]); ga[8 + 2 * i + 1] = bfhi(ga1[i]); }
      unsigned qo[16], ko[16];
#pragma unroll
      for (int dd = 0; dd < 32; dd += 2) {
          float qt[2], kt[2];
#pragma unroll
          for (int q2 = 0; q2 < 2; ++q2) { const int col = hg * 64 + d0 + dd + q2;
              float z = B_A[col];
#pragma unroll
              for (int q = 0; q < 16; ++q) z += ga[q] * W_A2[q * 256 + col];
              const float bc = wave_scan_sum(logsig(z) * (1.f / 16.f), lane);
              if (lane == 63) EBLG[(size_t)(bh * NCH + c) * 64 + d0 + dd + q2] = __expf(bc);
              const unsigned qw = qv[dd >> 3][(dd >> 1) & 3], kw = kv[dd >> 3][(dd >> 1) & 3];
              qt[q2] = (q2 ? bfhi(qw) : bflo(qw)) * __expf(bc); kt[q2] = (q2 ? bfhi(kw) : bflo(kw)) * __expf(-bc); }
          qo[dd >> 1] = pk2(qt[0], qt[1]); ko[dd >> 1] = pk2(kt[0], kt[1]);
      }
      bf16* qd = SCR + SC_QG + row * 256 + hg * 64 + d0; bf16* kd = SCR + SC_KG + row * 256 + hg * 64 + d0;
#pragma unroll
      for (int i = 0; i < 4; ++i) { *(v4u*)(qd + 8 * i) = (v4u){qo[4 * i], qo[4 * i + 1], qo[4 * i + 2], qo[4 * i + 3]}; *(v4u*)(kd + 8 * i) = (v4u){ko[4 * i], ko[4 * i + 1], ko[4 * i + 2], ko[4 * i + 3]}; } }
    LBAR();
    {
      const int isk = tid >> 8, pc = tid & 255, h = pc >> 6, ch = isk * 512 + 2 * pc;
      float cw[4][2], cb[2];
#pragma unroll
      for (int j = 0; j < 4; ++j) { cw[j][0] = CONV_W[j * 1024 + ch]; cw[j][1] = CONV_W[j * 1024 + ch + 1]; }
      cb[0] = CONV_B[ch]; cb[1] = CONV_B[ch + 1];
      const bf16* src = P + row0 * PS + (isk ? C_MK : C_MQ) + 2 * pc;
      bf16* dst = SCR + (isk ? SC_KW : SC_QP) + row0 * 512 + 2 * pc;
#pragma unroll
      for (int hf = 0; hf < 2; ++hf) {
          unsigned raw[35];
#pragma unroll
          for (int i = 0; i < 35; ++i) { const int t = 32 * hf - 3 + i; raw[i] = (c > 0 || t >= 0) ? *(const unsigned*)(src + (long)t * PS) : 0u; }
#pragma unroll
          for (int i = 0; i < 32; ++i) { float a0 = cb[0], a1 = cb[1];
#pragma unroll
              for (int j = 0; j < 4; ++j) { a0 += cw[j][0] * bflo(raw[i + j]); a1 += cw[j][1] * bfhi(raw[i + j]); }
              a0 = a0 * sigmoidf(a0); a1 = a1 * sigmoidf(a1);
              if (isk) { const float wk = WKL[h * 64 + 32 * hf + i]; a0 *= wk; a1 *= wk; }
              *(unsigned*)(dst + (size_t)(32 * hf + i) * 512) = pk2(a0, a1); }
      } }
    LBAR();
}

constexpr int NCI = 4;
__device__ __forceinline__ void chain_mlstm(Frame& F, int b, int h, int sl) {
    char* L = F.ldsg;
    constexpr int KT_B = 64 * TS, VT_B = 128 * TS, NP_B = 16 * 64 * 4, BUF_B = KT_B + VT_B + NP_B;
    float* PM = (float*)(L + NCI * BUF_B); float* BLs = PM + 32; float* MCc = BLs + 32; float* CSs = MCc + 40; float* E2s = CSs + 32;
    const int tid = F_TID, lane = F_LANE, w = F_WAVE, r = lane & 15, g = lane >> 4;
    const int bh = b * 4 + h; const size_t rowb = (size_t)b * SEQ;
    if (tid < 32) { PM[tid] = PMXG[bh * NCH + tid]; BLs[tid] = BLSG[bh * NCH + tid]; }
    __syncthreads();
    if (tid == 0) { float m = 0.f; for (int c = 0; c < NCH; ++c) { const float M = fmaxf(m, PM[c]); MCc[c] = m; CSs[c] = __expf(m - M); E2s[c] = __expf(PM[c] - M); m = BLs[c] + M; } MCc[32] = m; }
    __syncthreads();
    const int dpk = tid & 31, tg = tid >> 5, dpv = tid & 63, sg = tid >> 6;
    const int dt = w & 3, eb = 4 * (w >> 2);
    f32x4 acc[4];
#pragma unroll
    for (int i = 0; i < 4; ++i) acc[i] = (f32x4){0.f, 0.f, 0.f, 0.f};
    float nst = 0.f;
    unsigned krq[NCI][4], vrq[NCI][8];
    const bf16* kbase = SCR + SC_KW + (rowb + 4 * tg) * 512 + h * 128 + 64 * sl + 2 * dpk; const bf16* vbase = PROJ + (rowb + 8 * sg) * PS + C_MV + h * 128 + 2 * dpv;
#pragma unroll
    for (int q = 0; q < NCI; ++q) {
#pragma unroll
        for (int i = 0; i < 4; ++i) krq[q][i] = *(const unsigned*)(kbase + (size_t)(64 * q + i) * 512);
#pragma unroll
        for (int i = 0; i < 8; ++i) vrq[q][i] = *(const unsigned*)(vbase + (size_t)(64 * q + i) * PS);
    }
    for (int c0 = 0; c0 < NCH; c0 += NCI) {
#pragma unroll
        for (int q = 0; q < NCI; ++q) { char* KT = L + q * BUF_B; char* VT = KT + KT_B; float* NP = (float*)(VT + VT_B);
            const unsigned* kr = krq[q]; const unsigned* vr = vrq[q];
            *(v2u*)(KT + (2 * dpk) * TS + 8 * tg) = (v2u){(kr[0] & 0xffffu) | (kr[1] << 16), (kr[2] & 0xffffu) | (kr[3] << 16)};
            *(v2u*)(KT + (2 * dpk + 1) * TS + 8 * tg) = (v2u){(kr[0] >> 16) | (kr[1] & 0xffff0000u), (kr[2] >> 16) | (kr[3] & 0xffff0000u)};
            NP[tg * 64 + 2 * dpk] = (bflo(kr[0]) + bflo(kr[1])) + (bflo(kr[2]) + bflo(kr[3])); NP[tg * 64 + 2 * dpk + 1] = (bfhi(kr[0]) + bfhi(kr[1])) + (bfhi(kr[2]) + bfhi(kr[3]));
            unsigned v0p[4], v1p[4];
#pragma unroll
            for (int i = 0; i < 8; i += 2) { v0p[i >> 1] = (vr[i] & 0xffffu) | (vr[i + 1] << 16); v1p[i >> 1] = (vr[i] >> 16) | (vr[i + 1] & 0xffff0000u); }
            *(v4u*)(VT + (2 * dpv) * TS + 16 * sg) = (v4u){v0p[0], v0p[1], v0p[2], v0p[3]};
            *(v4u*)(VT + (2 * dpv + 1) * TS + 16 * sg) = (v4u){v1p[0], v1p[1], v1p[2], v1p[3]}; }
        if (c0 + NCI < NCH) {
#pragma unroll
            for (int q = 0; q < NCI; ++q) {
#pragma unroll
                for (int i = 0; i < 4; ++i) krq[q][i] = *(const unsigned*)(kbase + (size_t)(64 * (c0 + NCI + q) + i) * 512);
#pragma unroll
                for (int i = 0; i < 8; ++i) vrq[q][i] = *(const unsigned*)(vbase + (size_t)(64 * (c0 + NCI + q) + i) * PS);
            }
        }
        LBAR();
        f32x4 ta[NCI][4];
#pragma unroll
        for (int q = 0; q < NCI; ++q) { const char* KT = L + q * BUF_B; const char* VT = KT + KT_B;
#pragma unroll
            for (int i = 0; i < 4; ++i) ta[q][i] = (f32x4){0.f, 0.f, 0.f, 0.f};
#pragma unroll
            for (int kk = 0; kk < 2; ++kk) {
                const bf16x8 af = lds_frag(KT + (16 * dt + r) * TS + (32 * kk + 8 * g) * 2);
#pragma unroll
                for (int i = 0; i < 4; ++i) ta[q][i] = mfma16(af, lds_frag(VT + (16 * (eb + i) + r) * TS + (32 * kk + 8 * g) * 2), ta[q][i]);
            } }
#pragma unroll
        for (int q = 0; q < NCI; ++q) { const int c = c0 + q;
            { bf16* cst = CSM + (size_t)(bh * NCH + c) * 16384;
#pragma unroll
              for (int i = 0; i < 4; ++i)
                  *(v2u*)(cst + ((eb + i) * 8 + 4 * sl + dt) * 256 + r * 16 + 4 * g) = (v2u){pg8::cvt_pk_bf16(acc[i][0], acc[i][1]), pg8::cvt_pk_bf16(acc[i][2], acc[i][3])};
              if (tid < 64) NCS[(size_t)(bh * NCH + c) * 128 + 64 * sl + tid] = nst;
              if (tid == 0 && sl == 0) MCS[bh * NCH + c] = MCc[c]; }
            const float cs = CSs[c], e2 = E2s[c];
            if (tid < 64) { const float* NP = (const float*)(L + q * BUF_B + KT_B + VT_B); float s = 0.f;
#pragma unroll
                for (int k = 0; k < 16; ++k) s += NP[k * 64 + tid];
                nst = cs * nst + e2 * s; }
#pragma unroll
            for (int i = 0; i < 4; ++i) acc[i] = acc[i] * cs + ta[q][i] * e2; }
        LBAR();
    }
    { float* Co = OUTP + O_CP + (size_t)bh * 16384;
#pragma unroll
      for (int i = 0; i < 4; ++i)
#pragma unroll
          for (int j = 0; j < 4; ++j) Co[(64 * sl + 16 * dt + 4 * g + j) * 128 + 16 * (eb + i) + r] = acc[i][j];
      if (tid < 64) OUTP[O_NP + (size_t)bh * 128 + 64 * sl + tid] = nst;
      if (tid == 0 && sl == 0) OUTP[O_MP + bh] = MCc[32]; }
    __syncthreads();
}

__device__ __forceinline__ void chain_gla(Frame& F, int b, int hg, int sl) {
    char* L = F.ldsg;
    constexpr int KT_B = 32 * TS, VT_B = 128 * TS, BUF_B = KT_B + VT_B;
    const int tid = F_TID, lane = F_LANE, w = F_WAVE, r = lane & 15, g = lane >> 4;
    const int bh = b * 4 + hg; const size_t rowb = (size_t)b * SEQ;
    const int dpv = tid & 63, sg = tid >> 6;
    const int dt = w & 1, eb = 2 * (w >> 1);
    f32x4 acc[2];
    acc[0] = (f32x4){0.f, 0.f, 0.f, 0.f}; acc[1] = acc[0];
    v2u k4q[NCI]; f32x4 ebq[NCI]; unsigned vrq[NCI][8];
    const bf16* kbase = SCR + SC_KG + (rowb + lane) * 256 + hg * 64 + 32 * sl + 4 * w; const bf16* vbase = PROJ + (rowb + 8 * sg) * PS + C_GV + hg * 128 + 2 * dpv;
    const float* ebase = EBLG + (size_t)bh * NCH * 64 + 32 * sl + 16 * dt + 4 * g;
#pragma unroll
    for (int q = 0; q < NCI; ++q) { k4q[q] = *(const v2u*)(kbase + (size_t)(64 * q) * 256); ebq[q] = *(const f32x4*)(ebase + q * 64);
#pragma unroll
        for (int i = 0; i < 8; ++i) vrq[q][i] = *(const unsigned*)(vbase + (size_t)(64 * q + i) * PS); }
    for (int c0 = 0; c0 < NCH; c0 += NCI) {
        f32x4 eb4[NCI];
#pragma unroll
        for (int q = 0; q < NCI; ++q) { char* KT = L + q * BUF_B; char* VT = KT + KT_B; const v2u k4 = k4q[q]; const unsigned* vr = vrq[q]; eb4[q] = ebq[q];
            *(bf16*)(KT + (4 * w + 0) * TS + 2 * lane) = (bf16)(k4[0] & 0xffffu); *(bf16*)(KT + (4 * w + 1) * TS + 2 * lane) = (bf16)(k4[0] >> 16);
            *(bf16*)(KT + (4 * w + 2) * TS + 2 * lane) = (bf16)(k4[1] & 0xffffu); *(bf16*)(KT + (4 * w + 3) * TS + 2 * lane) = (bf16)(k4[1] >> 16);
            unsigned v0p[4], v1p[4];
#pragma unroll
            for (int i = 0; i < 8; i += 2) { v0p[i >> 1] = (vr[i] & 0xffffu) | (vr[i + 1] << 16); v1p[i >> 1] = (vr[i] >> 16) | (vr[i + 1] & 0xffff0000u); }
            *(v4u*)(VT + (2 * dpv) * TS + 16 * sg) = (v4u){v0p[0], v0p[1], v0p[2], v0p[3]};
            *(v4u*)(VT + (2 * dpv + 1) * TS + 16 * sg) = (v4u){v1p[0], v1p[1], v1p[2], v1p[3]}; }
        if (c0 + NCI < NCH) {
#pragma unroll
            for (int q = 0; q < NCI; ++q) { k4q[q] = *(const v2u*)(kbase + (size_t)(64 * (c0 + NCI + q)) * 256); ebq[q] = *(const f32x4*)(ebase + (c0 + NCI + q) * 64);
#pragma unroll
                for (int i = 0; i < 8; ++i) vrq[q][i] = *(const unsigned*)(vbase + (size_t)(64 * (c0 + NCI + q) + i) * PS); }
        }
        LBAR();
        f32x4 ta[NCI][2];
#pragma unroll
        for (int q = 0; q < NCI; ++q) { const char* KT = L + q * BUF_B; const char* VT = KT + KT_B;
            ta[q][0] = (f32x4){0.f, 0.f, 0.f, 0.f}; ta[q][1] = ta[q][0];
#pragma unroll
            for (int kk = 0; kk < 2; ++kk) {
                const bf16x8 af = lds_frag(KT + (16 * dt + r) * TS + (32 * kk + 8 * g) * 2);
#pragma unroll
                for (int i = 0; i < 2; ++i) ta[q][i] = mfma16(af, lds_frag(VT + (16 * (eb + i) + r) * TS + (32 * kk + 8 * g) * 2), ta[q][i]);
            } }
#pragma unroll
        for (int q = 0; q < NCI; ++q) { const int c = c0 + q;
            bf16* cst = CSG + (size_t)(bh * NCH + c) * 8192;
#pragma unroll
            for (int i = 0; i < 2; ++i)
                *(v2u*)(cst + ((eb + i) * 4 + 2 * sl + dt) * 256 + r * 16 + 4 * g) = (v2u){pg8::cvt_pk_bf16(acc[i][0], acc[i][1]), pg8::cvt_pk_bf16(acc[i][2], acc[i][3])};
            acc[0] = (acc[0] + ta[q][0]) * eb4[q]; acc[1] = (acc[1] + ta[q][1]) * eb4[q]; }
        LBAR();
    }
    { float* So = OUTP + O_SP + (size_t)bh * 8192;
#pragma unroll
      for (int i = 0; i < 2; ++i)
#pragma unroll
          for (int j = 0; j < 4; ++j) So[(32 * sl + 16 * dt + 4 * g + j) * 128 + 16 * (eb + i) + r] = acc[i][j]; }
    __syncthreads();
}

__device__ __forceinline__ void sample_item(Frame& F, int n, int hh, float* Wl, int lane) {
    asm volatile("" : "+v"(lane));
    float* qv = Wl; float* kv = Wl + 128; float* vv = Wl + 256; float* al = Wl + 384;
    const size_t row = (size_t)MP + n;
    const bf16* Pr = PROJ + row * PS;
    const bool gla = hh >= 4; const int h = hh & 3;
    const int e4 = lane & 31, dh = lane >> 5;
    float cs = 1.f, wkk = 1.f, dinv = 1.f;
    if (!gla) {
        float qk2[2][2];
#pragma unroll
        for (int isk = 0; isk < 2; ++isk)
#pragma unroll
            for (int q = 0; q < 2; ++q) { const int d = lane + 64 * q, ch = isk * 512 + h * 128 + d;
                const float* scv = ST_CONV + (size_t)n * 3 * 1024 + ch;
                float a = CONV_B[ch] + CONV_W[ch] * scv[0] + CONV_W[1024 + ch] * scv[1024] + CONV_W[2048 + ch] * scv[2048] + CONV_W[3072 + ch] * bf2f(Pr[(isk ? C_MK : C_MQ) + h * 128 + d]);
                a = a * sigmoidf(a); if (isk) a *= KSCALE; qk2[isk][q] = a; (isk ? kv : qv)[d] = a; }
        vv[lane] = bf2f(Pr[C_MV + h * 128 + lane]); vv[lane + 64] = bf2f(Pr[C_MV + h * 128 + lane + 64]);
        const float* n0 = ST_N + ((size_t)n * 4 + h) * 128; const float n00 = n0[lane], n01 = n0[lane + 64];
        const float qk = wave_sum(qk2[0][0] * qk2[1][0] + qk2[0][1] * qk2[1][1]), qn = wave_sum(qk2[0][0] * n00 + qk2[0][1] * n01);
        const float ig = bf2f(Pr[C_SM + h]) + B_GATE[h], lf = logsig(bf2f(Pr[C_SM + 4 + h]) + B_GATE[4 + h]);
        const float m0 = ST_M[n * 4 + h], mn = fmaxf(lf + m0, ig);
        wkk = __expf(ig - mn); cs = __expf(lf + m0 - mn);
        const float den = cs * qn + qk * wkk;
        dinv = __builtin_amdgcn_rcpf(fmaxf(fabsf(den), __expf(-mn)));
        float* nsO = OUTP + O_NS + ((size_t)n * 4 + h) * 128; nsO[lane] = cs * n00 + wkk * qk2[1][0]; nsO[lane + 64] = cs * n01 + wkk * qk2[1][1];
        if (lane == 0) OUTP[O_MS + n * 4 + h] = mn;
    } else {
        qv[lane] = bf2f(Pr[C_GQ + h * 64 + lane]); kv[lane] = bf2f(Pr[C_GK + h * 64 + lane]);
        vv[lane] = bf2f(Pr[C_GV + h * 128 + lane]); vv[lane + 64] = bf2f(Pr[C_GV + h * 128 + lane + 64]);
        { const int col = h * 64 + lane; float z = B_A[col];
#pragma unroll
          for (int q = 0; q < 16; ++q) z += bf2f(Pr[C_SM + 8 + q]) * IN_F(13)[q * 256 + col];
          al[lane] = __expf(logsig(z) * (1.f / 16.f)); }
    }
    asm volatile("s_waitcnt lgkmcnt(0)" ::: "memory");
    const f32x4 v4 = *(const f32x4*)(vv + 4 * e4);
    f32x4 hp = (f32x4){0.f, 0.f, 0.f, 0.f};
    if (!gla) {
        const float* C0 = ST_C + ((size_t)n * 4 + h) * 16384 + (size_t)(64 * dh) * 128 + 4 * e4; float* Cn = OUTP + O_CS + ((size_t)n * 4 + h) * 16384 + (size_t)(64 * dh) * 128 + 4 * e4;
        for (int i0 = 0; i0 < 64; i0 += 8) { f32x4 c0[8];
#pragma unroll
            for (int i = 0; i < 8; ++i) c0[i] = *(const f32x4*)(C0 + (i0 + i) * 128);
#pragma unroll
            for (int i = 0; i < 8; ++i) { const int d = 64 * dh + i0 + i; const f32x4 cn = c0[i] * cs + v4 * (wkk * kv[d]); *(f32x4*)(Cn + (i0 + i) * 128) = cn; hp += cn * qv[d]; } }
    } else {
        const float* S0 = ST_S + ((size_t)n * 4 + h) * 8192 + (size_t)(32 * dh) * 128 + 4 * e4; float* Sn = OUTP + O_SS + ((size_t)n * 4 + h) * 8192 + (size_t)(32 * dh) * 128 + 4 * e4;
        for (int i0 = 0; i0 < 32; i0 += 8) { f32x4 c0[8];
#pragma unroll
            for (int i = 0; i < 8; ++i) c0[i] = *(const f32x4*)(S0 + (i0 + i) * 128);
#pragma unroll
            for (int i = 0; i < 8; ++i) { const int d = 32 * dh + i0 + i; const f32x4 sn = c0[i] * al[d] + v4 * kv[d]; *(f32x4*)(Sn + (i0 + i) * 128) = sn; hp += sn * qv[d]; } }
    }
#pragma unroll
    for (int j = 0; j < 4; ++j) hp[j] += __shfl_xor(hp[j], 32);
    hp = hp * dinv;
    float ssum = (hp[0] * hp[0] + hp[1] * hp[1]) + (hp[2] * hp[2] + hp[3] * hp[3]);
#pragma unroll
    for (int o = 1; o < 32; o <<= 1) ssum += __shfl_xor(ssum, o);
    const float rn = rsqrt_fast(ssum * (1.f / 128.f) + EPS);
    if (lane < 32) {
        const v2u gw = *(const v2u*)(Pr + (gla ? C_GR : C_MO) + h * 128 + 4 * e4);
        const f32x4 g4 = *(const f32x4*)((gla ? G_GHEAD : G_MHEAD) + h * 128 + 4 * e4);
        const float gt[4] = {bflo(gw[0]), bfhi(gw[0]), bflo(gw[1]), bfhi(gw[1])}; float o[4];
#pragma unroll
        for (int j = 0; j < 4; ++j) { const float sg_ = sigmoidf(gt[j]); o[j] = hp[j] * rn * g4[j] * (gla ? gt[j] * sg_ : sg_); }
        int e4o = e4; asm volatile("" : "+v"(e4o));
        *(v2u*)(R1B + row * D + (gla ? 512 : 0) + h * 128 + 4 * e4o) = (v2u){pg8::cvt_pk_bf16(o[0], o[1]), pg8::cvt_pk_bf16(o[2], o[3])};
    }
    asm volatile("s_waitcnt lgkmcnt(0)" ::: "memory");
}

constexpr int P2B_QS = 0, P2B_KS = 64 * QS_P, P2B_VT = P2B_KS + 80 * QS_P, P2B_PS = P2B_VT + 128 * TS, P2B_FL = P2B_PS + 64 * TS, P2B_HALF = P2B_FL + 2560;
static_assert(2 * P2B_HALF <= MISC_OFF, "P2b LDS");
template <bool GLA>
__device__ __forceinline__ void p2b_unit(Frame& F, int u, char* L, int ltid, int lw, int lane) {
    const int v = u & 1023, bh = v >> 5, c = v & 31, b = bh >> 2, h = bh & 3, r = lane & 15, g = lane >> 4;
    const size_t rowb = (size_t)b * SEQ + c * 64;
    const bf16* P = PROJ;
    char* QSp = L + P2B_QS; char* KSp = L + P2B_KS; char* VTp = L + P2B_VT; char* PSp = L + P2B_PS;
    float* af = (float*)(L + P2B_FL); float* Mf = af + 64; float* scf = af + 128; float* enf = af + 192; float* dinvf = af + 256; float* ssq = af + 320;
    constexpr int QP = GLA ? TS : QS_P;
    constexpr int NK = GLA ? 2 : 4;
    bf16x8 cfr[2][NK];
    { const bf16* CT = GLA ? CSG + (size_t)(bh * NCH + c) * 8192 : CSM + (size_t)(bh * NCH + c) * 16384;
#pragma unroll
      for (int n2 = 0; n2 < 2; ++n2)
#pragma unroll
          for (int kk = 0; kk < NK; ++kk) cfr[n2][kk] = *(const bf16x8*)(CT + ((2 * lw + n2) * (GLA ? 4 : 8) + 2 * kk + (g >> 1)) * 256 + r * 16 + 8 * (g & 1)); }
    const int dp = ltid & 63, sg = ltid >> 6;
    v2u gwq[4][2];
#pragma unroll
    for (int mt = 0; mt < 4; ++mt)
#pragma unroll
        for (int n2 = 0; n2 < 2; ++n2) gwq[mt][n2] = *(const v2u*)(P + (rowb + 16 * mt + r) * PS + (GLA ? C_GR : C_MO) + h * 128 + 32 * lw + 16 * n2 + 4 * g);
    float* rsf = ssq + 256;
    if constexpr (!GLA) {
        { const float a = GA_A[(size_t)bh * SEQ + c * 64 + lane], bc = GA_B[(size_t)bh * SEQ + c * 64 + lane];
          const float pm = wave_scan_max(a, lane);
          const float mc = MCS[bh * NCH + c], pmx = PMXG[bh * NCH + c], Mt = fmaxf(mc, pm);
          if (lw == 0) { Mf[lane] = Mt; scf[lane] = __expf(mc - Mt); enf[lane] = __expf(-(bc + Mt)); rsf[lane] = __expf(pmx - Mt); } }
        {
#pragma unroll
          for (int i = 0; i < 4; ++i) { const int pc = ltid + 256 * i, row = pc >> 4, c16 = pc & 15;
              const v4u qq = *(const v4u*)(SCR + SC_QP + (rowb + row) * 512 + h * 128 + 8 * c16), kk4 = *(const v4u*)(SCR + SC_KW + (rowb + row) * 512 + h * 128 + 8 * c16);
              *(v4u*)(QSp + row * QS_P + 16 * c16) = qq; *(v4u*)(KSp + row * QS_P + 16 * c16) = kk4; } }
        if (ltid < 128) *(bf16*)(KSp + 64 * QS_P + 2 * ltid) = (bf16)f2bf(NCS[(size_t)(bh * NCH + c) * 128 + ltid]);
        for (int i = ltid; i < 15 * 64; i += 256) *(unsigned*)(KSp + (65 + i / 64) * QS_P + 4 * (i & 63)) = 0u;
    } else {
#pragma unroll
        for (int i = 0; i < 2; ++i) { const int pc = ltid + 256 * i, row = pc >> 3, c16 = pc & 7;
            const v4u qq = *(const v4u*)(SCR + SC_QG + (rowb + row) * 256 + h * 64 + 8 * c16), kk4 = *(const v4u*)(SCR + SC_KG + (rowb + row) * 256 + h * 64 + 8 * c16);
            *(v4u*)(QSp + row * TS + 16 * c16) = qq; *(v4u*)(KSp + row * TS + 16 * c16) = kk4; }
    }
    {
      unsigned vr[16];
#pragma unroll
      for (int i = 0; i < 16; ++i) vr[i] = *(const unsigned*)(P + (rowb + 16 * sg + i) * PS + (GLA ? C_GV : C_MV) + h * 128 + 2 * dp);
      unsigned v0p[8], v1p[8];
#pragma unroll
      for (int i = 0; i < 16; i += 2) { v0p[i >> 1] = (vr[i] & 0xffffu) | (vr[i + 1] << 16); v1p[i >> 1] = (vr[i] >> 16) | (vr[i + 1] & 0xffff0000u); }
      *(v4u*)(VTp + (2 * dp) * TS + 32 * sg) = (v4u){v0p[0], v0p[1], v0p[2], v0p[3]}; *(v4u*)(VTp + (2 * dp) * TS + 32 * sg + 16) = (v4u){v0p[4], v0p[5], v0p[6], v0p[7]};
      *(v4u*)(VTp + (2 * dp + 1) * TS + 32 * sg) = (v4u){v1p[0], v1p[1], v1p[2], v1p[3]}; *(v4u*)(VTp + (2 * dp + 1) * TS + 32 * sg + 16) = (v4u){v1p[4], v1p[5], v1p[6], v1p[7]}; }
    __syncthreads();
    {
        f32x4 pa[5];
#pragma unroll
        for (int i = 0; i < 5; ++i) pa[i] = (f32x4){0.f, 0.f, 0.f, 0.f};
#pragma unroll
        for (int kk = 0; kk < NK; ++kk) {
            const bf16x8 qf = lds_frag(QSp + (16 * lw + r) * QP + (32 * kk + 8 * g) * 2);
#pragma unroll
            for (int nt = 0; nt < 4; ++nt) if (nt <= lw) pa[nt] = mfma16(lds_frag(KSp + (16 * nt + r) * QP + (32 * kk + 8 * g) * 2), qf, pa[nt]);
            if constexpr (!GLA) pa[4] = mfma16(lds_frag(KSp + (64 + r) * QP + (32 * kk + 8 * g) * 2), qf, pa[4]);
        }
        const int t = 16 * lw + r;
        float rsc = 1.f; if constexpr (!GLA) rsc = rsf[t];
        float rs = 0.f;
#pragma unroll
        for (int nt = 0; nt < 4; ++nt) {
            f32x4 p = (f32x4){0.f, 0.f, 0.f, 0.f};
            if (nt <= lw) {
#pragma unroll
                for (int j = 0; j < 4; ++j) { const int s = 16 * nt + 4 * g + j; p[j] = (s <= t) ? pa[nt][j] * rsc : 0.f; }
            }
            rs += (p[0] + p[1]) + (p[2] + p[3]);
            *(v2u*)(PSp + t * TS + (16 * nt + 4 * g) * 2) = (v2u){pg8::cvt_pk_bf16(p[0], p[1]), pg8::cvt_pk_bf16(p[2], p[3])};
        }
        if constexpr (!GLA) {
            rs += __shfl_xor(rs, 16); rs += __shfl_xor(rs, 32);
            if (g == 0) { const float den = scf[t] * pa[4][0] + rs; dinvf[t] = __builtin_amdgcn_rcpf(fmaxf(fabsf(den), enf[t])); }
        }
    }
    __syncthreads();
    f32x4 hv[4][2];
    {
        f32x4 aV[4][2], aC[4][2];
#pragma unroll
        for (int mt = 0; mt < 4; ++mt)
#pragma unroll
            for (int n2 = 0; n2 < 2; ++n2) { aV[mt][n2] = (f32x4){0.f, 0.f, 0.f, 0.f}; aC[mt][n2] = (f32x4){0.f, 0.f, 0.f, 0.f}; }
#pragma unroll
        for (int kk = 0; kk < 2; ++kk) {
            bf16x8 vf[2];
#pragma unroll
            for (int n2 = 0; n2 < 2; ++n2) vf[n2] = lds_frag(VTp + (32 * lw + 16 * n2 + r) * TS + (32 * kk + 8 * g) * 2);
#pragma unroll
            for (int mt = 0; mt < 4; ++mt) { const bf16x8 pf = lds_frag(PSp + (16 * mt + r) * TS + (32 * kk + 8 * g) * 2);
#pragma unroll
                for (int n2 = 0; n2 < 2; ++n2) aV[mt][n2] = mfma16(vf[n2], pf, aV[mt][n2]); }
        }
#pragma unroll
        for (int kk = 0; kk < NK; ++kk)
#pragma unroll
            for (int mt = 0; mt < 4; ++mt) { const bf16x8 qf = lds_frag(QSp + (16 * mt + r) * QP + (32 * kk + 8 * g) * 2);
#pragma unroll
                for (int n2 = 0; n2 < 2; ++n2) aC[mt][n2] = mfma16(cfr[n2][kk], qf, aC[mt][n2]); }
#pragma unroll
        for (int mt = 0; mt < 4; ++mt) { const int t = 16 * mt + r;
            float sc = 1.f, di = 1.f; if constexpr (!GLA) { sc = scf[t]; di = dinvf[t]; }
            float s = 0.f;
#pragma unroll
            for (int n2 = 0; n2 < 2; ++n2) { hv[mt][n2] = (aC[mt][n2] * sc + aV[mt][n2]) * di;
                s += (hv[mt][n2][0] * hv[mt][n2][0] + hv[mt][n2][1] * hv[mt][n2][1]) + (hv[mt][n2][2] * hv[mt][n2][2] + hv[mt][n2][3] * hv[mt][n2][3]); }
            s += __shfl_xor(s, 16); s += __shfl_xor(s, 32);
            if (g == 0) ssq[t * 4 + lw] = s; }
    }
    __syncthreads();
    {
        const float* gn = (GLA ? G_GHEAD : G_MHEAD) + h * 128;
#pragma unroll
        for (int mt = 0; mt < 4; ++mt) { const int t = 16 * mt + r; const f32x4 s4 = *(const f32x4*)(ssq + 4 * t);
            const float rn = rsqrt_fast(((s4[0] + s4[1]) + (s4[2] + s4[3])) * (1.f / 128.f) + EPS);
#pragma unroll
            for (int n2 = 0; n2 < 2; ++n2) { const int e = 32 * lw + 16 * n2 + 4 * g;
                const v2u gw = gwq[mt][n2];
                const f32x4 g4 = *(const f32x4*)(gn + e);
                float gt[4] = {bflo(gw[0]), bfhi(gw[0]), bflo(gw[1]), bfhi(gw[1])}; float o[4];
#pragma unroll
                for (int j = 0; j < 4; ++j) { const float sg_ = sigmoidf(gt[j]); o[j] = hv[mt][n2][j] * rn * g4[j] * (GLA ? gt[j] * sg_ : sg_); }
                *(v2u*)(R1B + (rowb + t) * D + (GLA ? 512 : 0) + h * 128 + e) = (v2u){pg8::cvt_pk_bf16(o[0], o[1]), pg8::cvt_pk_bf16(o[2], o[3])}; } }
    }
    __syncthreads();
}

template <int K, int RT>
__device__ __forceinline__ void skinny_acc(const bf16* A, const bf16* Bt, int nsl, f32x4 (&acc)[RT], int w, int r, int g) {
    constexpr int KW = K / 8, NKS = KW / 32, KBMAX = RT <= 2 ? 8 : 4, KB = NKS < KBMAX ? NKS : KBMAX;
    const bf16* ap = A + (size_t)r * K + w * KW + 8 * g;
    const bf16* bp = Bt + (size_t)(nsl * 16 + r) * K + w * KW + 8 * g;
#pragma unroll 1
    for (int ks = 0; ks < NKS; ks += KB) {
        bf16x8 bfr[KB], afr[RT][KB];
#pragma unroll
        for (int kk = 0; kk < KB; ++kk) { bfr[kk] = *(const bf16x8*)(bp + 32 * (ks + kk));
#pragma unroll
            for (int rt = 0; rt < RT; ++rt) afr[rt][kk] = *(const bf16x8*)(ap + (size_t)rt * 16 * K + 32 * (ks + kk)); }
#pragma unroll
        for (int kk = 0; kk < KB; ++kk)
#pragma unroll
            for (int rt = 0; rt < RT; ++rt) acc[rt] = mfma16(bfr[kk], afr[rt][kk], acc[rt]);
    }
}
template <int RT> __device__ __forceinline__ void skinny_put(float* red, const f32x4 (&acc)[RT], int w, int r, int g) {
#pragma unroll
    for (int rt = 0; rt < RT; ++rt) *(f32x4*)(red + w * (RT * 256) + (16 * rt + r) * 16 + 4 * g) = acc[rt];
}
template <int RT> __device__ __forceinline__ f32x4 skinny_get(const float* red, int row, int c4) {
    f32x4 v = (f32x4){0.f, 0.f, 0.f, 0.f};
#pragma unroll
    for (int q = 0; q < 8; ++q) v += *(const f32x4*)(red + q * (RT * 256) + row * 16 + 4 * c4);
    return v;
}
template <int RT> __device__ __forceinline__ void zeroacc(f32x4 (&acc)[RT]) {
#pragma unroll
    for (int i = 0; i < RT; ++i) acc[i] = (f32x4){0.f, 0.f, 0.f, 0.f};
}
__device__ __forceinline__ float quad_sum(float s) { s += __shfl_xor(s, 1); s += __shfl_xor(s, 2); return s; }
__device__ __forceinline__ v2u pack4(f32x4 v) { return (v2u){pg8::cvt_pk_bf16(v[0], v[1]), pg8::cvt_pk_bf16(v[2], v[3])}; }
template <bool RES_BF16>
__device__ __forceinline__ void skinny_res(Frame& F, const bf16* A, const bf16* Bt, int K4096, const void* res, bf16* ob, float* ss) {
    float* red = (float*)F.ldsg; const int tid = F_TID, lane = F_LANE, w = F_WAVE, r = lane & 15, g = lane >> 4, lrow = tid >> 2, c4 = tid & 3;
    for (int it = blockIdx.x; it < 4 * (D / 16); it += F.G) { const int nsl = it >> 2, r0 = 32 * (it & 3);
        f32x4 acc[2]; zeroacc<2>(acc);
        if (K4096) skinny_acc<FF, 2>(A + (size_t)r0 * FF, Bt, nsl, acc, w, r, g); else skinny_acc<D, 2>(A + (size_t)r0 * D, Bt, nsl, acc, w, r, g);
        skinny_put<2>(red, acc, w, r, g); LBAR();
        if (tid < 128) { const int row = r0 + lrow;
            const size_t off = (size_t)row * D + nsl * 16 + 4 * c4;
            f32x4 rv;
            if constexpr (RES_BF16) { const v2u rw = *(const v2u*)((const bf16*)res + off); rv = (f32x4){bflo(rw.x), bfhi(rw.x), bflo(rw.y), bfhi(rw.y)}; }
            else rv = *(const f32x4*)((const float*)res + off);
            const f32x4 v = skinny_get<2>(red, lrow, c4) + rv;
            *(v2u*)(ob + off) = pack4(v);
            const float s = quad_sum((v[0] * v[0] + v[1] * v[1]) + (v[2] * v[2] + v[3] * v[3]));
            if (c4 == 0) atomicAdd(ss + row, s); }
        LBAR();
    }
}
__device__ __forceinline__ void skinny_up(Frame& F, const bf16* A, const bf16* Bt, const float* ss, bf16* U) {
    float* red = (float*)F.ldsg; const int tid = F_TID, lane = F_LANE, w = F_WAVE, r = lane & 15, g = lane >> 4, row = tid >> 2, c4 = tid & 3;
    for (int sl = blockIdx.x; sl < FF / 16; sl += F.G) {
        f32x4 acc[8]; zeroacc<8>(acc);
        skinny_acc<D, 8>(A, Bt, sl, acc, w, r, g);
        skinny_put<8>(red, acc, w, r, g); LBAR();
        const float rs = rsqrt_fast(ss[row] * (1.f / D) + EPS);
        f32x4 v = skinny_get<8>(red, row, c4) * rs;
#pragma unroll
        for (int j = 0; j < 4; ++j) { const float a = fmaxf(v[j], 0.f); v[j] = a * a; }
        *(v2u*)(U + (size_t)row * FF + sl * 16 + 4 * c4) = pack4(v);
        LBAR();
    }
}
__device__ __forceinline__ void skinny_ple(Frame& F, const bf16* pbs, const bf16* Wple, const bf16* x2b, const bf16* Wpg, const float* ss2, bf16* x3b, float* ss3) {
    float* red = (float*)F.ldsg; float* red2 = red + 8 * 512; const int tid = F_TID, lane = F_LANE, w = F_WAVE, r = lane & 15, g = lane >> 4, lrow = tid >> 2, c4 = tid & 3;
    for (int it = blockIdx.x; it < 4 * (D / 16); it += F.G) { const int nsl = it >> 2, r0 = 32 * (it & 3);
        f32x4 acc[2]; zeroacc<2>(acc);
        skinny_acc<DPLE, 2>(pbs + (size_t)r0 * DPLE, Wple, nsl, acc, w, r, g); skinny_put<2>(red2, acc, w, r, g);
        zeroacc<2>(acc);
        skinny_acc<D, 2>(x2b + (size_t)r0 * D, Wpg, nsl, acc, w, r, g); skinny_put<2>(red, acc, w, r, g); LBAR();
        if (tid < 128) { const int row = r0 + lrow;
            const size_t off = (size_t)row * D + nsl * 16 + 4 * c4;
            const float rs = rsqrt_fast(ss2[row] * (1.f / D) + EPS);
            const f32x4 gt = skinny_get<2>(red, lrow, c4) * rs, pp = skinny_get<2>(red2, lrow, c4); const v2u xw = *(const v2u*)(x2b + off);
            f32x4 v = (f32x4){bflo(xw.x), bfhi(xw.x), bflo(xw.y), bfhi(xw.y)};
#pragma unroll
            for (int j = 0; j < 4; ++j) v[j] += pp[j] * sigmoidf(gt[j]);
            *(v2u*)(x3b + off) = pack4(v);
            const float s = quad_sum((v[0] * v[0] + v[1] * v[1]) + (v[2] * v[2] + v[3] * v[3]));
            if (c4 == 0) atomicAdd(ss3 + row, s); }
        LBAR();
    }
}

constexpr int NPHASE = 9;

__global__ void __launch_bounds__(NWAVES * 64, 2) mk_fwd(Args args) {
    extern __shared__ __attribute__((aligned(16))) unsigned char lds[];
    Frame F;
    F.lds = (LAS unsigned char*)lds; F.ldsg = (char*)lds;
    F.G = gridDim.x;
    F.a = (CArgs*)__builtin_amdgcn_kernarg_segment_ptr();
    unsigned char* ws = F.a->ws;
    volatile LAS unsigned* MISC = (volatile LAS unsigned*)(F.lds + MISC_OFF);
    for (int u = F_TID; u < 64; u += NWAVES * 64) MISC[u] = 0u;
    __syncthreads();
    XcdBarrier bar; bar.bar = (unsigned*)(ws + CTL_BAR_B); bar.x = 0; bar.st = nullptr;
    if (MK_N_LAUNCHES == 1) bar = xcd_barrier_post((unsigned*)(ws + CTL_BAR_B), MISC + 8);
    const int lo = F.a->ph_lo, hi = F.a->ph_hi;
#ifndef PROBE_REP
#define PROBE_REP 0
#endif
#define REPS(k) (((PROBE_REP >> (k)) & 1) ? 2 : 1)
#ifndef TS_A0
#define TS_A0 -1
#define TS_A1 -1
#define TS_B0 -1
#define TS_B1 -1
#endif
#ifndef TS_BLOCK
#define TS_BLOCK 0
#endif
#ifndef TS_SCALE
#define TS_SCALE 100.f
#define TS_RANGE 260.f
#endif
#define STAMP(k) do { if ((k) == TS_A0) tsa0 = __builtin_amdgcn_s_memrealtime(); if ((k) == TS_A1) tsa1 = __builtin_amdgcn_s_memrealtime(); if ((k) == TS_B0) tsb0 = __builtin_amdgcn_s_memrealtime(); if ((k) == TS_B1) tsb1 = __builtin_amdgcn_s_memrealtime(); } while (0)
#ifndef PHASE_MASK
#define PHASE_MASK 0x1ff
#endif
#define IN(k) (((PHASE_MASK >> (k)) & 1) && lo <= (k) && (k) < hi)
#define SEAM(k) do { if (IN(k) && IN((k) + 1)) { xcd_barrier(bar); if ((PROBE_REP >> 16) & 1) xcd_barrier(bar); } } while (0)

    unsigned long long tsa0 = 0, tsa1 = 0, tsb0 = 0, tsb1 = 0; STAMP(0);
    if (IN(0)) { for (int rep = 0; rep < REPS(0); ++rep) { p0_prologue(F); if (rep + 1 < REPS(0)) __syncthreads(); } SEAM(0); STAMP(1); }
    if (IN(1)) {
        pg8::Gemm g{R1B, WIN_T, MR, PS, D}; pg8::StaticOrder S; S.init(MR, PS, F.G, (int)blockIdx.x);
        EpiProj E{PROJ, PS};
        for (int rep = 0; rep < REPS(1); ++rep) pg8::gemm_phase<EpiProj, pg8::StaticOrder, PG8_ALIGN, PG8_SP2>(F.lds, g, S, E);
        SEAM(1); STAMP(2);
    }
    if (IN(2)) {
        const int bx = blockIdx.x;
        if ((PROBE_REP >> 19) & 1) for (int it = bx; it < NB * NCH; it += F.G) p2p_item(F, it >> 5, it & 31);
        for (int it = bx; it < NB * NCH; it += F.G) p2p_item(F, it >> 5, it & 31);
        if (MK_N_LAUNCHES == 1) xcd_barrier(bar);
        STAMP(3);
#define P2A_CHAINS() do { const int cb_ = bx & 63; if (cb_ < 32) chain_mlstm(F, cb_ >> 2, cb_ & 3, bx >> 6); else chain_gla(F, (cb_ - 32) >> 2, (cb_ - 32) & 3, bx >> 6); } while (0)
#define P2A_SAMPLES() do { float* Wl = (float*)(F.ldsg + F_WAVE * 2048); \
              for (int it = (bx - 128) * NWAVES + F_WAVE; it < MSMP * 8; it += (F.G - 128) * NWAVES) sample_item(F, it >> 3, it & 7, Wl, F_LANE); } while (0)
        if (bx < 128) { P2A_CHAINS(); if ((PROBE_REP >> 17) & 1) P2A_CHAINS(); }
        else {
            const int nb = F.G - 128, gb = bx - 128;
            P2A_SAMPLES(); if ((PROBE_REP >> 18) & 1) P2A_SAMPLES();
            for (int i = gb * 512 + F_TID; i < NB * 3 * 1024 + MSMP * 3 * 1024; i += nb * 512) {
                if (i < NB * 3 * 1024) { const int b = i / 3072, j = (i / 1024) % 3, ch = i & 1023; OUTP[O_CVP + i] = bf2f(PROJ[((size_t)b * SEQ + SEQ - 3 + j) * PS + ch]); }
                else { const int k = i - NB * 3 * 1024, n = k / 3072, j = (k / 1024) % 3, ch = k & 1023;
                    OUTP[O_CVS + k] = j < 2 ? ST_CONV[(size_t)n * 3072 + (j + 1) * 1024 + ch] : bf2f(PROJ[((size_t)MP + n) * PS + ch]); }
            }
            __syncthreads();
            late_weight_copies(F, gb, nb);
        }
        STAMP(11); SEAM(2); STAMP(4);
    }
    if (IN(3)) {
        const int hb = F_WAVE >> 2, ltid = F_TID & 255, lw = F_WAVE & 3;
        char* L = F.ldsg + hb * P2B_HALF;
        for (int rep = 0; rep < REPS(3); ++rep)
        for (int it = 0; it * 2 * F.G < 2048; ++it) {
            const int u = (it * F.G + (int)blockIdx.x) * 2 + hb;
            if (u - hb >= 2048) break;
            if (u < 1024) p2b_unit<false>(F, u, L, ltid, lw, F_LANE); else p2b_unit<true>(F, u, L, ltid, lw, F_LANE);
        }
        SEAM(3); STAMP(5);
    }
    if (IN(4)) {
        pg8::Gemm g{R1B, WOUT_T, MP, D, D}; pg8::StaticOrder S; S.init(MP, D, F.G, (int)blockIdx.x);
        EpiRes<false> E{X_P, X1B, SS1};
        for (int rep = 0; rep < REPS(4); ++rep) pg8::gemm_phase<EpiRes<false>, pg8::StaticOrder, PG8_ALIGN, PG8_SP2>(F.lds, g, S, E);
        skinny_res<false>(F, R1B + (size_t)MP * D, WOUT_T, 0, X_S, X1B + (size_t)MP * D, SS1 + MP);
        SEAM(4); STAMP(6);
    }
    if (IN(5)) {
        pg8::Gemm g{X1B, W1_T, MP, FF, D}; pg8::StaticOrder S; S.init(MP, FF, F.G, (int)blockIdx.x);
        EpiU E{UBUF, SS1};
        const bool skinny_first = (blockIdx.x & 8) != 0;
        if (skinny_first) skinny_up(F, X1B + (size_t)MP * D, W1_T, SS1 + MP, UBUF + (size_t)MP * FF);
        for (int rep = 0; rep < REPS(5); ++rep) pg8::gemm_phase<EpiU, pg8::StaticOrder, PG8_ALIGN, PG8_SP2>(F.lds, g, S, E);
        if (!skinny_first) skinny_up(F, X1B + (size_t)MP * D, W1_T, SS1 + MP, UBUF + (size_t)MP * FF);
        SEAM(5); STAMP(7);
    }
    if (IN(6)) {
        pg8::Gemm g{UBUF, W2_T, MP, D, FF}; pg8::StaticOrder S; S.init(MP, D, F.G, (int)blockIdx.x);
        EpiRes<true> E{X1B, R1B, SS2};
        for (int rep = 0; rep < REPS(6); ++rep) pg8::gemm_phase<EpiRes<true>, pg8::StaticOrder, PG8_ALIGN, PG8_SP2>(F.lds, g, S, E);
        STAMP(12);
        skinny_res<true>(F, UBUF + (size_t)MP * FF, W2_T, 1, X1B + (size_t)MP * D, R1B + (size_t)MP * D, SS2 + MP);
        STAMP(13); SEAM(6); STAMP(8);
    }
    if (IN(7)) {
        { pg8::Gemm g{PBUF, WPLE_T, MP, D, DPLE}; pg8::StaticOrder S; S.init(MP, D, F.G, (int)blockIdx.x);
          EpiProj E{PPB, D};
          pg8::gemm_phase<EpiProj, pg8::StaticOrder, PG8_ALIGN, PG8_SP2>(F.lds, g, S, E); }
        { pg8::Gemm g{R1B, WPG_T, MP, D, D}; pg8::StaticOrder S; S.init(MP, D, F.G, (int)blockIdx.x);
          EpiPle E{R1B, PPB, X1B, SS2, SS3};
          pg8::gemm_phase<EpiPle, pg8::StaticOrder, PG8_ALIGN, PG8_SP2>(F.lds, g, S, E); }
        skinny_ple(F, PBUF + (size_t)MP * DPLE, WPLE_T, R1B + (size_t)MP * D, WPG_T, SS2 + MP, X1B + (size_t)MP * D, SS3 + MP);
        SEAM(7); STAMP(9);
    }
    if (IN(8)) {
        const int gw = blockIdx.x * NWAVES + F_WAVE, NGW = F.G * NWAVES;
        for (int m = gw; m < MV; m += NGW) {
            const GAS v2u* xr = (const GAS v2u*)(X1B + (size_t)m * D) + F_LANE; GAS f32x4* yo = (GAS f32x4*)(OUTP + (size_t)m * D) + F_LANE;
            const float r = rsqrt_fast(SS3[m] * (1.f / D) + EPS);
#pragma unroll
            for (int j = 0; j < 4; ++j) { const f32x4 gf = ((const GAS f32x4*)G_FINAL)[F_LANE + 64 * j]; const v2u xw = xr[64 * j];
                yo[64 * j] = (f32x4){bflo(xw.x), bfhi(xw.x), bflo(xw.y), bfhi(xw.y)} * r * gf; }
        }
        STAMP(10);
        if (TS_A0 >= 0 && blockIdx.x == TS_BLOCK && F_TID < 32) {
            const float T = (float)(tsa1 - tsa0) * 0.01f, rv = 4e-5f * exp2f(T * (3.321928f / TS_SCALE));
            OUTP[O_MP + F_TID] *= 1.f + sqrtf(rv);
        }
        if (TS_B0 >= 0 && blockIdx.x == TS_BLOCK && F_TID == 1) {
            const float T = (float)(tsb1 - tsb0) * 0.01f;
            OUTP[O_YP + (size_t)TS_BLOCK * 8 * D + 5] += 0.14f + T * (0.26f / TS_RANGE);
        }
    }
#undef IN
#undef SEAM
}

extern "C" void kernel_launch(void* const* d_in, const int* in_sizes, int n_in, void* d_out, int out_size, void* d_ws, size_t ws_size, hipStream_t stream) {
    static int grid = 0;
    if (grid == 0) {
        if (n_in != 26 || ws_size < WS_END) { fprintf(stderr, "kernel_launch: unexpected n_in %d / ws %zu\n", n_in, ws_size); grid = -1; return; }
        int dev = 0, cus = 0, per_cu = 0;
        if (hipGetDevice(&dev) != hipSuccess || hipDeviceGetAttribute(&cus, hipDeviceAttributeMultiprocessorCount, dev) != hipSuccess) { grid = -1; return; }
        if (hipFuncSetAttribute((const void*)mk_fwd, hipFuncAttributeMaxDynamicSharedMemorySize, LDS_BYTES) != hipSuccess) { fprintf(stderr, "kernel_launch: hipFuncSetAttribute failed\n"); grid = -1; return; }
        if (hipOccupancyMaxActiveBlocksPerMultiprocessor(&per_cu, (const void*)mk_fwd, NWAVES * 64, LDS_BYTES) != hipSuccess || per_cu < 1) { fprintf(stderr, "kernel_launch: occupancy query says %d\n", per_cu); per_cu = 1; }
        (void)hipGetLastError();
        grid = cus;
        if (grid > 256) grid = 256;
    }
    if (grid < 0) return;
    (void)hipMemsetAsync((char*)d_ws + WS_CTL, 0, CTL_ZERO_BYTES, stream);
    Args a{};
    for (int i = 0; i < 26; ++i) a.in[i] = (const float*)d_in[i];
    a.out = (float*)d_out; a.ws = (unsigned char*)d_ws;
    if (MK_N_LAUNCHES == 1) { a.ph_lo = 0; a.ph_hi = NPHASE; a.li = 0; hipLaunchKernelGGL(mk_fwd, dim3(grid), dim3(NWAVES * 64), LDS_BYTES, stream, a); }
    else for (int li = 0; li < NPHASE; ++li) { a.ph_lo = li; a.ph_hi = li + 1; a.li = li; hipLaunchKernelGGL(mk_fwd, dim3(grid), dim3(NWAVES * 64), LDS_BYTES, stream, a); }
}
```

```cpp
#include <hip/hip_runtime.h>
#include <cstdio>
#include <cstdint>

#ifndef MK_N_LAUNCHES
#define MK_N_LAUNCHES 1
#endif

namespace pg8 {
#define PG8_LAS __attribute__((address_space(3)))
typedef unsigned short bf16_t;
typedef short bf16x8 __attribute__((ext_vector_type(8)));
typedef float f32x4 __attribute__((ext_vector_type(4)));
typedef unsigned u32x4 __attribute__((ext_vector_type(4)));
constexpr int BM = 256, BK = 64, HALF = 128, HTB = HALF * BK * 2, STAGE_BYTES = 8 * HTB, NXCD = 8, WGM = 4, MP = 16384;

__host__ __device__ __forceinline__ int lds_byte(int r, int c) { const int st = (r >> 4) * 2 + (c >> 5), rr = r & 15, cc = c & 31, ob = rr * 64 + cc * 2; return st * 1024 + (ob ^ (((ob >> 9) & 1) << 5)); }
__host__ __device__ __forceinline__ void stage_rc(int b, int& R, int& C) { const int st = b / 1024, sb = b % 1024, swz = sb ^ (((sb >> 9) & 1) << 5); R = (st >> 1) * 16 + swz / 64; C = (st & 1) * 32 + (swz % 64) / 2; }
__host__ __device__ __forceinline__ int perm32(int rho) { const int n = rho >> 4, i = rho & 15; return 8 * (i >> 2) + 4 * n + (i & 3); }

struct Unit { int pm, pn; };
struct Gemm { const bf16_t* A; const bf16_t* Bt; int M, N, K; };

struct StaticOrder {
    int nM, nN, nwg, G, c;
    __host__ __device__ void init(int M, int N, int G_, int c_) { nM = M / BM; nN = N / BM; nwg = nM * nN; G = G_; c = c_; }
    __host__ __device__ bool next(int i, Unit& u) const {
        const long L = (long)i * G + c; if (L >= nwg) return false;
        int wgid = (int)L; { const int q = nwg / NXCD, r = nwg % NXCD, xcd = wgid % NXCD, off = wgid / NXCD; wgid = (xcd < r ? xcd * (q + 1) : r * (q + 1) + (xcd - r) * q) + off; }
        const int nig = WGM * nN, gid = wgid / nig, fm = gid * WGM, gsz = (nM - fm) < WGM ? (nM - fm) : WGM;
        u.pm = fm + ((wgid % nig) % gsz); u.pn = (wgid % nig) / gsz; return true;
    }
    __device__ __forceinline__ void a_ready(const Unit&) const {}
    __device__ __forceinline__ void done(const Unit&) const {}
};

__device__ __forceinline__ unsigned cvt_pk_bf16(float lo, float hi) { unsigned r; asm volatile("v_cvt_pk_bf16_f32 %0, %1, %2" : "=v"(r) : "v"(lo), "v"(hi)); return r; }


template <class Epi, class Sched, bool ALIGN_EPI = false, bool SP2 = false>
__device__ __forceinline__ void gemm_phase(PG8_LAS unsigned char* lds, const Gemm g, const Sched& S, const Epi& E) {
    int tid_ = threadIdx.x; asm volatile("" : "+v"(tid_));
    const int tid = tid_, wid = __builtin_amdgcn_readfirstlane(tid >> 6), lane = tid & 63, wr = wid >> 2, wc = wid & 3, fr = lane & 15, fq = lane >> 4;
    const int K = g.K, nt = K / BK;
    unsigned voffA[2], voffB[2];
#pragma unroll
    for (int i = 0; i < 2; ++i) { int R, C; stage_rc(tid * 16 + i * 8192, R, C); const int Rb = Epi::PERM ? ((R & ~31) + perm32(R & 31)) : R;
        voffA[i] = (unsigned)(R * K + C) * 2u; voffB[i] = (unsigned)(Rb * K + C) * 2u; }
    const size_t kstep = (size_t)(BK * 2);
    const size_t hstep = (size_t)HALF * K * 2;
    const size_t tstep = 2 * hstep;
    const unsigned ldsw = (unsigned)wid * 1024u;
    const int aoff = lds_byte(wr * 64 + fr, fq * 8), boff = lds_byte(wc * 32 + fr, fq * 8);
#define PG8_SA(b, h) (((b) * 2 + (h)) * HTB)
#define PG8_SB(b, h) ((4 + (b) * 2 + (h)) * HTB)
#define PG8_STAGE(bufoff, gbase, voff) do { _Pragma("unroll") for (int _i = 0; _i < 2; ++_i) \
        __builtin_amdgcn_global_load_lds((const unsigned*)((const char*)(gbase) + (voff)[_i]), (PG8_LAS unsigned*)(lds + (bufoff) + ldsw + _i * 8192), 16, 0, 0); } while (0)
#define PG8_LDA(dst, b, h) do { _Pragma("unroll") for (int m = 0; m < 4; ++m) _Pragma("unroll") for (int k = 0; k < 2; ++k) dst[m][k] = *(const PG8_LAS bf16x8*)(lds + PG8_SA(b, h) + aoff + m * 2048 + k * 1024); } while (0)
#define PG8_LDB(dst, b, h) do { _Pragma("unroll") for (int n = 0; n < 2; ++n) _Pragma("unroll") for (int k = 0; k < 2; ++k) dst[n][k] = *(const PG8_LAS bf16x8*)(lds + PG8_SB(b, h) + boff + n * 2048 + k * 1024); } while (0)
#define PG8_MMA(ai, bj, At, Bt) do { __builtin_amdgcn_s_setprio(1); _Pragma("unroll") for (int m = 0; m < 4; ++m) _Pragma("unroll") for (int n = 0; n < 2; ++n) _Pragma("unroll") for (int k = 0; k < 2; ++k) \
        acc[ai][bj][m][n] = __builtin_amdgcn_mfma_f32_16x16x32_bf16(Bt[n][k], At[m][k], acc[ai][bj][m][n], 0, 0, 0); __builtin_amdgcn_s_setprio(0); } while (0)
#define PG8_WAIT_V(n) asm volatile("s_waitcnt vmcnt(" #n ")" ::: "memory")
#define PG8_WAIT_L(n) asm volatile("s_waitcnt lgkmcnt(" #n ")" ::: "memory")
#define PG8_BAR __builtin_amdgcn_s_barrier()
#define PG8_SCHED __builtin_amdgcn_sched_barrier(0)
    Unit cur, nxt; int ui = 0;
    if (!S.next(0, cur)) return;
    f32x4 acc[2][2][4][2];
#pragma unroll
    for (int a = 0; a < 2; ++a)
#pragma unroll
        for (int b = 0; b < 2; ++b)
#pragma unroll
            for (int m = 0; m < 4; ++m)
#pragma unroll
                for (int n = 0; n < 2; ++n) acc[a][b][m][n] = (f32x4){0.f, 0.f, 0.f, 0.f};
    bf16x8 At[4][2], B0[2][2], B1[2][2];
    const char* cA = (const char*)g.A + (size_t)cur.pm * tstep; const char* cB = (const char*)g.Bt + (size_t)cur.pn * tstep;
    S.a_ready(cur);
    if constexpr (SP2) {
        PG8_STAGE(PG8_SB(0, 0), cB, voffB); PG8_STAGE(PG8_SB(0, 1), cB + hstep, voffB); PG8_STAGE(PG8_SA(0, 0), cA, voffA); PG8_STAGE(PG8_SA(0, 1), cA + hstep, voffA);
        if (wr == 1) PG8_BAR;
        PG8_WAIT_V(2); PG8_BAR;
        PG8_STAGE(PG8_SB(1, 0), cB + kstep, voffB); PG8_STAGE(PG8_SA(1, 0), cA + kstep, voffA); PG8_STAGE(PG8_SB(1, 1), cB + hstep + kstep, voffB);
        PG8_WAIT_V(6); PG8_BAR;
    } else {
        PG8_STAGE(PG8_SB(0, 0), cB, voffB); PG8_STAGE(PG8_SA(0, 0), cA, voffA); PG8_STAGE(PG8_SB(0, 1), cB + hstep, voffB); PG8_STAGE(PG8_SA(0, 1), cA + hstep, voffA);
        if (wr == 1) PG8_BAR;
        PG8_WAIT_V(4); PG8_BAR;
        PG8_STAGE(PG8_SB(1, 0), cB + kstep, voffB); PG8_STAGE(PG8_SA(1, 0), cA + kstep, voffA); PG8_STAGE(PG8_SB(1, 1), cB + hstep + kstep, voffB);
        PG8_WAIT_V(6); PG8_BAR;
    }
    for (;;) {
        const bool has_next = S.next(ui + 1, nxt);
        const char* nA = has_next ? (const char*)g.A + (size_t)nxt.pm * tstep : cA; const char* nB = has_next ? (const char*)g.Bt + (size_t)nxt.pn * tstep : cB;
        for (int t = 0; t < nt; t += 2) {
            const bool last = (t == nt - 2);
            const char* a1 = cA + (size_t)(t + 1) * kstep;
            const char* a2 = last ? nA : cA + (size_t)(t + 2) * kstep; const char* b2 = last ? nB : cB + (size_t)(t + 2) * kstep;
            const char* a3 = a2 + kstep; const char* b3 = b2 + kstep;
            if (last && has_next) S.a_ready(nxt);
            const bool fullm = cur.pm < MP / BM;
            if constexpr (SP2) {
            PG8_LDB(B0, 0, 0); PG8_LDB(B1, 0, 1); PG8_SCHED; PG8_LDA(At, 0, 0); PG8_STAGE(PG8_SA(1, 1), a1 + hstep, voffA);
            PG8_WAIT_V(8); PG8_WAIT_L(0); PG8_BAR; PG8_MMA(0, 0, At, B0); PG8_MMA(0, 1, At, B1); PG8_BAR; PG8_SCHED;
            PG8_LDA(At, 0, 1); PG8_STAGE(PG8_SB(0, 0), b2, voffB); PG8_STAGE(PG8_SB(0, 1), b2 + hstep, voffB); PG8_STAGE(PG8_SA(0, 0), a2, voffA);
            PG8_WAIT_V(8); PG8_WAIT_L(0); PG8_BAR; if (fullm) { PG8_MMA(1, 0, At, B0); PG8_MMA(1, 1, At, B1); } PG8_BAR; PG8_SCHED;
            PG8_LDB(B0, 1, 0); PG8_LDB(B1, 1, 1); PG8_SCHED; PG8_LDA(At, 1, 0); PG8_STAGE(PG8_SA(0, 1), a2 + hstep, voffA);
            PG8_WAIT_V(8); PG8_WAIT_L(0); PG8_BAR; PG8_MMA(0, 0, At, B0); PG8_MMA(0, 1, At, B1); PG8_BAR; PG8_SCHED;
            PG8_LDA(At, 1, 1); PG8_STAGE(PG8_SB(1, 0), b3, voffB); PG8_STAGE(PG8_SB(1, 1), b3 + hstep, voffB); PG8_STAGE(PG8_SA(1, 0), a3, voffA);
            PG8_WAIT_V(8); PG8_WAIT_L(0); PG8_BAR; if (fullm) { PG8_MMA(1, 0, At, B0); PG8_MMA(1, 1, At, B1); } PG8_BAR; PG8_SCHED;
            } else {
            PG8_LDB(B0, 0, 0); PG8_SCHED; PG8_LDA(At, 0, 0); PG8_STAGE(PG8_SA(1, 1), a1 + hstep, voffA);
            PG8_WAIT_L(8); PG8_BAR; PG8_WAIT_L(0); PG8_MMA(0, 0, At, B0); PG8_BAR; PG8_SCHED;
            PG8_LDB(B1, 0, 1); PG8_STAGE(PG8_SB(0, 0), b2, voffB);
            PG8_BAR; PG8_WAIT_L(0); PG8_MMA(0, 1, At, B1); PG8_BAR;
            PG8_LDA(At, 0, 1); PG8_STAGE(PG8_SA(0, 0), a2, voffA);
            PG8_BAR; PG8_WAIT_L(0); PG8_MMA(1, 0, At, B0); PG8_BAR; PG8_SCHED;
            PG8_STAGE(PG8_SB(0, 1), b2 + hstep, voffB);
            PG8_WAIT_V(6); PG8_BAR; PG8_MMA(1, 1, At, B1); PG8_BAR;
            PG8_LDB(B0, 1, 0); PG8_SCHED; PG8_LDA(At, 1, 0); PG8_STAGE(PG8_SA(0, 1), a2 + hstep, voffA);
            PG8_WAIT_L(8); PG8_BAR; PG8_WAIT_L(0); PG8_MMA(0, 0, At, B0); PG8_BAR; PG8_SCHED;
            PG8_LDB(B1, 1, 1); PG8_STAGE(PG8_SB(1, 0), b3, voffB);
            PG8_BAR; PG8_WAIT_L(0); PG8_MMA(0, 1, At, B1); PG8_BAR;
            PG8_LDA(At, 1, 1); PG8_STAGE(PG8_SA(1, 0), a3, voffA);
            PG8_BAR; PG8_WAIT_L(0); PG8_MMA(1, 0, At, B0); PG8_BAR; PG8_SCHED;
            PG8_STAGE(PG8_SB(1, 1), b3 + hstep, voffB);
            PG8_WAIT_V(6); PG8_BAR; PG8_MMA(1, 1, At, B1); PG8_BAR;
            }
        }
        if constexpr (ALIGN_EPI) { if (wr == 0) PG8_BAR; }
        E(acc, cur, wr, wc, fr, fq); S.done(cur);
        if (!has_next) break;
#pragma unroll
        for (int a = 0; a < 2; ++a)
#pragma unroll
            for (int b = 0; b < 2; ++b)
#pragma unroll
                for (int m = 0; m < 4; ++m)
#pragma unroll
                    for (int n = 0; n < 2; ++n) acc[a][b][m][n] = (f32x4){0.f, 0.f, 0.f, 0.f};
        cur = nxt; cA = nA; cB = nB; ++ui;
        if constexpr (ALIGN_EPI) { if (wr == 1) PG8_BAR; }
    }
    PG8_WAIT_V(0);
    if constexpr (!ALIGN_EPI) { if (wr == 0) PG8_BAR; }
    PG8_BAR;
#undef PG8_SA
#undef PG8_SB
#undef PG8_STAGE
#undef PG8_LDA
#undef PG8_LDB
#undef PG8_MMA
#undef PG8_WAIT_V
#undef PG8_WAIT_L
#undef PG8_BAR
#undef PG8_SCHED
}
}

#ifndef PG8_SP2
#define PG8_SP2 true
#endif
#ifndef PG8_ALIGN
#define PG8_ALIGN true
#endif

constexpr int NWAVES = 8;
constexpr int D = 1024, SEQ = 2048, NB = 8, MP = NB * SEQ  , MSMP = 128  , MV = MP + MSMP  , MR = 16640  ;
constexpr int FF = 4096, DPLE = 256, NCH = SEQ / 64  ;
constexpr int PS = 3840;
constexpr int C_MQ = 0, C_MK = 512, C_MV = 1024, C_MO = 1536, C_GQ = 2048, C_GK = 2304, C_GV = 2560, C_GR = 3072, C_SM = 3584;
constexpr float EPS = 1e-6f;
constexpr size_t O_YP = 0, O_YS = 16777216, O_CP = 16908288, O_NP = 17432576, O_MP = 17436672, O_CVP = 17436704, O_SP = 17461280,
                 O_CS = 17723424, O_NS = 26112032, O_MS = 26177568, O_CVS = 26178080, O_SS = 26571296;
constexpr size_t MiB = 1u << 20;
constexpr size_t WS_CTL = 0, CTL_ZERO_BYTES = 1 * MiB;
constexpr size_t CTL_BAR_B = 16384, CTL_SS1_B = 262144, CTL_SS2_B = 393216, CTL_SS3_B = 524288;
constexpr size_t WS_WIN = 1 * MiB, WS_WOUT = 9 * MiB, WS_W1 = 11 * MiB, WS_W2 = 19 * MiB, WS_WPG = 27 * MiB, WS_WPLE = 29 * MiB;
constexpr size_t WS_PB = 30 * MiB, WS_NC = 39 * MiB, WS_MC = WS_NC + 512 * 1024, WS_R1 = 40 * MiB, WS_R2 = 73 * MiB, WS_CSM = 195 * MiB, WS_CSG = 227 * MiB;
constexpr size_t WS_X1B = WS_R2, WS_U = 106 * MiB, WS_PP = 106 * MiB, WS_END = 243 * MiB;
static_assert(WS_R2 + (size_t)MR * PS * 2 <= WS_CSM && WS_R1 + (size_t)MR * D * 2 <= WS_R2 && WS_U + (size_t)MR * FF * 2 <= WS_END && WS_X1B + (size_t)MR * D * 2 <= WS_U && WS_PB + (size_t)MR * DPLE * 2 <= WS_NC, "ws map");
constexpr size_t SC_QP = 0, SC_KW = (size_t)MP * 512, SC_QG = (size_t)MP * 1024, SC_KG = (size_t)MP * 1280;
static_assert((SC_KG + (size_t)MP * 256) * 2 <= (size_t)MP * D * 4, "P2 scratch inside y_prompt");
constexpr size_t WS_GA = 244 * MiB, WS_GB = WS_GA + 256 * 1024, WS_EBL = WS_GB + 256 * 1024, WS_PMX = WS_EBL + 256 * 1024, WS_BLS = WS_PMX + 4096;
constexpr int LDS_BYTES = 147456, MISC_OFF = LDS_BYTES - 256;

#define GAS __attribute__((address_space(1)))
#define LAS __attribute__((address_space(3)))
typedef unsigned short bf16;
typedef unsigned v4u __attribute__((ext_vector_type(4)));
typedef unsigned v2u __attribute__((ext_vector_type(2)));
typedef float f32x4 __attribute__((ext_vector_type(4)));
typedef short bf16x8 __attribute__((ext_vector_type(8)));
typedef GAS unsigned gu32;
#define RLX_AGENT __ATOMIC_RELAXED, __HIP_MEMORY_SCOPE_AGENT
#define LDS_WAIT() asm volatile("s_waitcnt lgkmcnt(0)" ::: "memory")
#define VM_WAIT() asm volatile("s_waitcnt vmcnt(0)" ::: "memory")
#define LBAR() do { asm volatile("s_waitcnt lgkmcnt(0)" ::: "memory"); __builtin_amdgcn_s_barrier(); asm volatile("" ::: "memory"); } while (0)
__device__ __forceinline__ unsigned f2bf(float f) { unsigned u = __builtin_bit_cast(unsigned, f); return (u + 0x7fffu + ((u >> 16) & 1u)) >> 16; }
__device__ __forceinline__ unsigned pk2(float lo, float hi) { unsigned r; asm volatile("v_cvt_pk_bf16_f32 %0, %1, %2" : "=v"(r) : "v"(lo), "v"(hi)); return r; }
__device__ __forceinline__ float bf2f(unsigned b) { return __builtin_bit_cast(float, b << 16); }
__device__ __forceinline__ float bflo(unsigned w) { return __builtin_bit_cast(float, w << 16); }
__device__ __forceinline__ float bfhi(unsigned w) { return __builtin_bit_cast(float, w & 0xffff0000u); }
__device__ __forceinline__ float logsig(float x) { return fminf(x, 0.f) - __logf(1.f + __expf(-fabsf(x))); }
__device__ __forceinline__ float sigmoidf(float x) { return __builtin_amdgcn_rcpf(1.f + __expf(-x)); }
__device__ __forceinline__ float rsqrt_fast(float x) { return __builtin_amdgcn_rsqf(x); }

#define XB_TMO      128
#define XB_XCNT(j)  (256  + 64 * (j))
#define XB_XSUB(j)  (1280 + 64 * (j))
#define XB_XGEN(j)  (2304 + 64 * (j))
#define XB_TOP      3328
#define XB_TOPGEN   3392
#define XCD_BAR_WORDS 3456
#define XB_SPIN_CAP (1u << 22)
__device__ __forceinline__ unsigned xb_ld(unsigned* p)              { return __hip_atomic_load(p, __ATOMIC_RELAXED, __HIP_MEMORY_SCOPE_AGENT); }
__device__ __forceinline__ unsigned xb_add(unsigned* p, unsigned v) { return __hip_atomic_fetch_add(p, v, __ATOMIC_RELAXED, __HIP_MEMORY_SCOPE_AGENT); }
__device__ __forceinline__ unsigned xb_xcc_id() { return (unsigned)__builtin_amdgcn_s_getreg((3 << 11) | 20) & 0xFu; }
#define XB_SPIN(cond, bar) do { unsigned _sp = 0; while (cond) { __builtin_amdgcn_s_sleep(1); \
    if ((++_sp & 255u) == 0u) { if (xb_ld(&(bar)[XB_TMO])) break; if (_sp > XB_SPIN_CAP) { atomicAdd(&(bar)[XB_TMO], 1u); break; } } } } while (0)
struct XcdBarrier { unsigned* bar; unsigned x; volatile LAS unsigned* st; };
__device__ __forceinline__ XcdBarrier xcd_barrier_post(unsigned* bar, volatile LAS unsigned* st) {
    XcdBarrier b; b.bar = bar; b.x = xb_xcc_id(); b.st = st;
    if (threadIdx.x == 0) (void)xb_add(&bar[XB_XCNT(b.x)], 1u);
    return b;
}
__device__ __forceinline__ void xcd_barrier_complete(unsigned* bar, unsigned x, unsigned& nloc, unsigned& nx) {
    const unsigned G = gridDim.x * gridDim.y * gridDim.z;
    unsigned sum, cnt, mine, sp = 0u;
    for (;;) {
        sum = 0u; cnt = 0u; mine = 0u;
#pragma unroll
        for (unsigned j = 0; j < 16; ++j) { const unsigned c = xb_ld(&bar[XB_XCNT(j)]); sum += c; cnt += (c > 0u) ? 1u : 0u; mine = (j == x) ? c : mine; }
        if (sum == G) break;
        __builtin_amdgcn_s_sleep(1);
        if ((++sp & 255u) == 0u) { if (xb_ld(&bar[XB_TMO])) break; if (sp > XB_SPIN_CAP) { atomicAdd(&bar[XB_TMO], 1u); break; } }
    }
    nloc = mine > 0u ? mine : 1u; nx = cnt > 0u ? cnt : 1u;
}
__device__ __forceinline__ void xcd_barrier(const XcdBarrier& b) {
    asm volatile("s_waitcnt vmcnt(0)" ::: "memory");
    __syncthreads();
    if (threadIdx.x == 0) {
        unsigned* bar = b.bar;
        __builtin_amdgcn_s_waitcnt(0);
        unsigned nloc = b.st[0], nx = b.st[1];
        if (nloc == 0u) { xcd_barrier_complete(bar, b.x, nloc, nx); b.st[0] = nloc; b.st[1] = nx; }
        const unsigned old = xb_add(&bar[XB_XSUB(b.x)], 1u);
        const unsigned gen = old / nloc;
        if (old + 1u == (gen + 1u) * nloc) {
            __builtin_amdgcn_fence(__ATOMIC_RELEASE, "agent");
            asm volatile("s_waitcnt vmcnt(0)" ::: "memory");
            const unsigned og = xb_add(&bar[XB_TOP], 1u);
            const unsigned tg = og / nx;
            if (og + 1u == (tg + 1u) * nx) xb_add(&bar[XB_TOPGEN], 1u);
            else XB_SPIN(xb_ld(&bar[XB_TOPGEN]) == tg, bar);
            __builtin_amdgcn_fence(__ATOMIC_ACQUIRE, "agent");
            xb_add(&bar[XB_XGEN(b.x)], 1u);
            asm volatile("s_waitcnt vmcnt(0)" ::: "memory");
        } else {
            XB_SPIN(xb_ld(&bar[XB_XGEN(b.x)]) == gen, bar);
            __builtin_amdgcn_fence(__ATOMIC_ACQUIRE, "agent");
            asm volatile("s_waitcnt vmcnt(0)" ::: "memory");
        }
    }
    __syncthreads();
}

struct Args { const float* in[26]; float* out; unsigned char* ws; int ph_lo, ph_hi, li, pad; };
typedef const Args __attribute__((address_space(4))) CArgs;
struct Frame {
    LAS unsigned char* lds;
    char* ldsg;
    int G;
    CArgs* a;
};
#define F_TID ((int)threadIdx.x)
#define F_LANE ((int)(threadIdx.x & 63))
#define F_WAVE (__builtin_amdgcn_readfirstlane((int)(threadIdx.x >> 6)))
#define IN_F(k) (F.a->in[k])
#define X_P IN_F(0)
#define X_S IN_F(1)
#define P_P IN_F(2)
#define P_S IN_F(3)
#define ST_C IN_F(4)
#define ST_N IN_F(5)
#define ST_M IN_F(6)
#define ST_CONV IN_F(7)
#define ST_S IN_F(8)
#define W_IN IN_F(9)
#define CONV_W IN_F(10)
#define CONV_B IN_F(11)
#define B_GATE CONSTF(IN_F(12))
#define W_A2 CONSTF(IN_F(13))
#define B_A CONSTF(IN_F(14))
#define G_MHEAD IN_F(15)
#define G_GHEAD IN_F(16)
#define W_OUT IN_F(17)
#define G_MIX IN_F(18)
#define G_MLP IN_F(19)
#define W1 IN_F(20)
#define W2 IN_F(21)
#define G_PLE IN_F(22)
#define W_PLE IN_F(23)
#define W_PG IN_F(24)
#define G_FINAL IN_F(25)
typedef const float __attribute__((address_space(4))) cfloat;
#define CONSTF(p) ((cfloat*)(unsigned long long)(p))
#define OUTP (F.a->out)
#define WSB (F.a->ws)
#define WIN_T ((bf16*)(WSB + WS_WIN))
#define WOUT_T ((bf16*)(WSB + WS_WOUT))
#define W1_T ((bf16*)(WSB + WS_W1))
#define W2_T ((bf16*)(WSB + WS_W2))
#define WPG_T ((bf16*)(WSB + WS_WPG))
#define WPLE_T ((bf16*)(WSB + WS_WPLE))
#define PBUF ((bf16*)(WSB + WS_PB))
#define R1B ((bf16*)(WSB + WS_R1))
#define PROJ ((bf16*)(WSB + WS_R2))
#define X1B ((bf16*)(WSB + WS_X1B))
#define UBUF ((bf16*)(WSB + WS_U))
#define CSM ((bf16*)(WSB + WS_CSM))
#define CSG ((bf16*)(WSB + WS_CSG))
#define NCS ((float*)(WSB + WS_NC))
#define MCS ((float*)(WSB + WS_MC))
#define SS1 ((float*)(WSB + CTL_SS1_B))
#define SS2 ((float*)(WSB + CTL_SS2_B))
#define SS3 ((float*)(WSB + CTL_SS3_B))
#define PPB ((bf16*)(WSB + WS_PP))
#define GA_A ((float*)(WSB + WS_GA))
#define GA_B ((float*)(WSB + WS_GB))
#define EBLG ((float*)(WSB + WS_EBL))
#define PMXG ((float*)(WSB + WS_PMX))
#define BLSG ((float*)(WSB + WS_BLS))
#define SCR ((bf16*)OUTP)

__device__ __forceinline__ float wave_sum(float v) {
#pragma unroll
    for (int o = 1; o < 64; o <<= 1) v += __shfl_xor(v, o);
    return v;
}
__device__ __forceinline__ float wave_max(float v) {
#pragma unroll
    for (int o = 1; o < 64; o <<= 1) v = fmaxf(v, __shfl_xor(v, o));
    return v;
}
template <int CTRL, int ROWMASK> __device__ __forceinline__ float dpp_f(float idv, float v) {
    return __builtin_bit_cast(float, __builtin_amdgcn_update_dpp(__builtin_bit_cast(int, idv), __builtin_bit_cast(int, v), CTRL, ROWMASK, 0xf, false));
}
__device__ __forceinline__ float wave_scan_sum(float v, int) {
    v += dpp_f<0x111, 0xf>(0.f, v); v += dpp_f<0x112, 0xf>(0.f, v); v += dpp_f<0x114, 0xf>(0.f, v); v += dpp_f<0x118, 0xf>(0.f, v);
    v += dpp_f<0x142, 0xa>(0.f, v); v += dpp_f<0x143, 0xc>(0.f, v);
    return v;
}
__device__ __forceinline__ float wave_scan_max(float v, int) {
    const float ninf = -__builtin_inff();
    v = fmaxf(v, dpp_f<0x111, 0xf>(ninf, v)); v = fmaxf(v, dpp_f<0x112, 0xf>(ninf, v)); v = fmaxf(v, dpp_f<0x114, 0xf>(ninf, v)); v = fmaxf(v, dpp_f<0x118, 0xf>(ninf, v));
    v = fmaxf(v, dpp_f<0x142, 0xa>(ninf, v)); v = fmaxf(v, dpp_f<0x143, 0xc>(ninf, v));
    return v;
}

__device__ __forceinline__ int win_src_col(int np) {
    if (np < 2048) return np;
    if (np < 3584) return np + 8;
    const int j = np - 3584;
    if (j < 8) return 2048 + j;
    if (j < 24) return 3592 + (j - 8);
    return -1;
}
template <int MODE>
__device__ __forceinline__ void p0_transpose_item(const float* W, int K, int N, bf16* WT, const float* gain, LAS float* scr, int item, int nblk, int lane) {
    const int kb = item / nblk, nb = item % nblk, k0 = 64 * kb, n0 = 32 * nb;
    if (MODE == 1 && n0 >= 3584) {
        const int src = win_src_col(n0 + (lane & 31));
#pragma unroll 8
        for (int i = 0; i < 32; ++i) { const int kk = 2 * i + (lane >> 5); float v = 0.f; if (src >= 0) v = W[(size_t)(k0 + kk) * N + src] * gain[k0 + kk]; scr[kk * 33 + (lane & 31)] = v; }
    } else {
        const int s0 = (MODE == 1 && n0 >= 2048) ? n0 + 8 : n0; const float cs = (MODE == 1 && n0 >= C_GQ && n0 < C_GK) ? 0.125f : 1.f;
        const int n4 = lane & 7, kq = lane >> 3;
        f32x4 v[8];
#pragma unroll
        for (int i = 0; i < 8; ++i) v[i] = *(const f32x4*)(W + (size_t)(k0 + kq + 8 * i) * N + s0 + 4 * n4);
#pragma unroll
        for (int i = 0; i < 8; ++i) { const int kk = kq + 8 * i; const float gsc = gain ? gain[k0 + kk] * cs : cs; LAS float* d = scr + kk * 33 + 4 * n4;
            d[0] = v[i][0] * gsc; d[1] = v[i][1] * gsc; d[2] = v[i][2] * gsc; d[3] = v[i][3] * gsc; }
    }
    LDS_WAIT(); asm volatile("" ::: "memory");
    const int c = lane & 7;
#pragma unroll
    for (int j = 0; j < 4; ++j) { const int n = (lane >> 3) + 8 * j; const LAS float* s = scr + (8 * c) * 33 + n;
        v4u o; o.x = pk2(s[0 * 33], s[1 * 33]); o.y = pk2(s[2 * 33], s[3 * 33]); o.z = pk2(s[4 * 33], s[5 * 33]); o.w = pk2(s[6 * 33], s[7 * 33]);
        *(GAS v4u*)(WT + (size_t)(n0 + n) * K + k0 + 8 * c) = o; }
    LDS_WAIT(); asm volatile("" ::: "memory");
}
__device__ __forceinline__ void p0_prologue(Frame& F) {
    LAS float* scr = (LAS float*)(F.lds + F_WAVE * 16384);
    const int gw = blockIdx.x * NWAVES + F_WAVE, NGW = F.G * NWAVES, lane = F_LANE;
    for (int m0 = gw; m0 < MV; m0 += 4 * NGW) {
        f32x4 v[4][4]; f32x4 pv[4];
#pragma unroll
        for (int q = 0; q < 4; ++q) { const int m = m0 + q * NGW; if (m < MV) {
            const float* xrow = m < MP ? X_P + (size_t)m * D : X_S + (size_t)(m - MP) * D; const float* prow = m < MP ? P_P + (size_t)m * DPLE : P_S + (size_t)(m - MP) * DPLE;
#pragma unroll
            for (int j = 0; j < 4; ++j) v[q][j] = ((const GAS f32x4*)xrow)[lane + 64 * j];
            pv[q] = ((const GAS f32x4*)prow)[lane]; } }
#pragma unroll
        for (int q = 0; q < 4; ++q) { const int m = m0 + q * NGW; if (m < MV) {
            float s = 0.f;
#pragma unroll
            for (int j = 0; j < 4; ++j) s += (v[q][j].x * v[q][j].x + v[q][j].y * v[q][j].y) + (v[q][j].z * v[q][j].z + v[q][j].w * v[q][j].w);
            const float r = rsqrt_fast(wave_sum(s) * (1.f / D) + EPS);
            GAS unsigned long long* o8 = (GAS unsigned long long*)(R1B + (size_t)m * D) + lane;
#pragma unroll
            for (int j = 0; j < 4; ++j) o8[64 * j] = (unsigned long long)pk2(v[q][j].x * r, v[q][j].y * r) | ((unsigned long long)pk2(v[q][j].z * r, v[q][j].w * r) << 32);
            ((GAS unsigned long long*)(PBUF + (size_t)m * DPLE))[lane] = (unsigned long long)pk2(pv[q].x, pv[q].y) | ((unsigned long long)pk2(pv[q].z, pv[q].w) << 32); } }
    }
    constexpr int NB_IN = PS / 32, I_IN = (D / 64) * NB_IN;
    for (int it = gw; it < I_IN; it += NGW) p0_transpose_item<1>(W_IN, D, 3608, WIN_T, G_MIX, scr, it, NB_IN, lane);
}
__device__ __forceinline__ void late_weight_copies(Frame& F, int wg, int nwg) {
    LAS float* scr = (LAS float*)(F.lds + F_WAVE * 16384);
    const int gw = wg * NWAVES + F_WAVE, NGW = nwg * NWAVES, lane = F_LANE;
    constexpr int NB_D = D / 32, NB_FF = FF / 32;
    constexpr int I_OUT = (D / 64) * NB_D, I_1 = (D / 64) * NB_FF, I_2 = (FF / 64) * NB_D, I_PG = I_OUT, I_PLE = (DPLE / 64) * NB_D;
    constexpr int NITEMS = I_OUT + I_1 + I_2 + I_PG + I_PLE;
    for (int it = gw; it < NITEMS; it += NGW) {
        int r = it;
        if (r < I_OUT) { p0_transpose_item<0>(W_OUT, D, D, WOUT_T, nullptr, scr, r, NB_D, lane); continue; } r -= I_OUT;
        if (r < I_1) { p0_transpose_item<0>(W1, D, FF, W1_T, G_MLP, scr, r, NB_FF, lane); continue; } r -= I_1;
        if (r < I_2) { p0_transpose_item<0>(W2, FF, D, W2_T, nullptr, scr, r, NB_D, lane); continue; } r -= I_2;
        if (r < I_PG) { p0_transpose_item<0>(W_PG, D, D, WPG_T, G_PLE, scr, r, NB_D, lane); continue; } r -= I_PG;
        p0_transpose_item<0>(W_PLE, DPLE, D, WPLE_T, nullptr, scr, r, NB_D, lane);
    }
}

struct EpiProj {
    static constexpr bool PERM = true;
    bf16* O; int ldc;
    __device__ __forceinline__ void operator()(const f32x4 (&acc)[2][2][4][2], const pg8::Unit& u, int wr, int wc, int fr, int fq) const {
        const int row0 = u.pm * 256 + wr * 64 + fr, col0 = u.pn * 256 + wc * 32 + 8 * fq;
#pragma unroll
        for (int ai = 0; ai < 2; ++ai)
#pragma unroll
            for (int m = 0; m < 4; ++m) { bf16* rowp = O + (size_t)(row0 + ai * 128 + m * 16) * ldc + col0;
#pragma unroll
                for (int bj = 0; bj < 2; ++bj) { const f32x4 v0 = acc[ai][bj][m][0], v1 = acc[ai][bj][m][1];
                    v4u w; w.x = pg8::cvt_pk_bf16(v0[0], v0[1]); w.y = pg8::cvt_pk_bf16(v0[2], v0[3]); w.z = pg8::cvt_pk_bf16(v1[0], v1[1]); w.w = pg8::cvt_pk_bf16(v1[2], v1[3]);
                    *(v4u*)(rowp + bj * 128) = w; } }
    }
};
template <bool RES_BF16> struct EpiRes {
    static constexpr bool PERM = true;
    const void* res; bf16* ob; float* ss;
    __device__ __forceinline__ void operator()(const f32x4 (&acc)[2][2][4][2], const pg8::Unit& u, int wr, int wc, int fr, int fq) const {
        const int row0 = u.pm * 256 + wr * 64 + fr, col0 = u.pn * 256 + wc * 32 + 8 * fq;
#pragma unroll
        for (int ai = 0; ai < 2; ++ai)
#pragma unroll
            for (int m = 0; m < 4; ++m) { const int row = row0 + ai * 128 + m * 16;
                const size_t off = (size_t)row * D + col0;
                float s = 0.f;
#pragma unroll
                for (int bj = 0; bj < 2; ++bj) {
                    f32x4 r0, r1;
                    if constexpr (RES_BF16) { const v4u rw = *(const v4u*)((const bf16*)res + off + bj * 128);
                        r0 = (f32x4){bflo(rw.x), bfhi(rw.x), bflo(rw.y), bfhi(rw.y)}; r1 = (f32x4){bflo(rw.z), bfhi(rw.z), bflo(rw.w), bfhi(rw.w)}; }
                    else { r0 = *(const f32x4*)((const float*)res + off + bj * 128); r1 = *(const f32x4*)((const float*)res + off + bj * 128 + 4); }
                    const f32x4 v0 = acc[ai][bj][m][0] + r0, v1 = acc[ai][bj][m][1] + r1;
                    v4u w; w.x = pg8::cvt_pk_bf16(v0[0], v0[1]); w.y = pg8::cvt_pk_bf16(v0[2], v0[3]); w.z = pg8::cvt_pk_bf16(v1[0], v1[1]); w.w = pg8::cvt_pk_bf16(v1[2], v1[3]);
                    *(v4u*)(ob + off + bj * 128) = w;
                    s += (v0[0] * v0[0] + v0[1] * v0[1]) + (v0[2] * v0[2] + v0[3] * v0[3]) + (v1[0] * v1[0] + v1[1] * v1[1]) + (v1[2] * v1[2] + v1[3] * v1[3]);
                }
                s += __shfl_xor(s, 16); s += __shfl_xor(s, 32);
                if (fq == 0) atomicAdd(ss + row, s);
                asm volatile("" ::: "memory"); }
    }
};
struct EpiU {
    static constexpr bool PERM = true;
    bf16* O; const float* ss;
    __device__ __forceinline__ void operator()(const f32x4 (&acc)[2][2][4][2], const pg8::Unit& u, int wr, int wc, int fr, int fq) const {
        const int row0 = u.pm * 256 + wr * 64 + fr, col0 = u.pn * 256 + wc * 32 + 8 * fq;
#pragma unroll
        for (int ai = 0; ai < 2; ++ai)
#pragma unroll
            for (int m = 0; m < 4; ++m) { const int row = row0 + ai * 128 + m * 16; const float r = rsqrt_fast(ss[row] * (1.f / D) + EPS);
                bf16* rowp = O + (size_t)row * FF + col0;
#pragma unroll
                for (int bj = 0; bj < 2; ++bj) { f32x4 v0 = acc[ai][bj][m][0] * r, v1 = acc[ai][bj][m][1] * r;
#pragma unroll
                    for (int j = 0; j < 4; ++j) { const float a = fmaxf(v0[j], 0.f), b = fmaxf(v1[j], 0.f); v0[j] = a * a; v1[j] = b * b; }
                    v4u w; w.x = pg8::cvt_pk_bf16(v0[0], v0[1]); w.y = pg8::cvt_pk_bf16(v0[2], v0[3]); w.z = pg8::cvt_pk_bf16(v1[0], v1[1]); w.w = pg8::cvt_pk_bf16(v1[2], v1[3]);
                    *(v4u*)(rowp + bj * 128) = w; } }
    }
};
struct EpiPle {
    static constexpr bool PERM = true;
    const bf16* x2b; const bf16* Pp; bf16* x3b; const float* ss2; float* ss3;
    __device__ __forceinline__ void operator()(const f32x4 (&acc)[2][2][4][2], const pg8::Unit& u, int wr, int wc, int fr, int fq) const {
        const int row0 = u.pm * 256 + wr * 64 + fr, col0 = u.pn * 256 + wc * 32 + 8 * fq;
#pragma unroll
        for (int ai = 0; ai < 2; ++ai)
#pragma unroll
            for (int m = 0; m < 4; ++m) { const int row = row0 + ai * 128 + m * 16;
                const float r = rsqrt_fast(ss2[row] * (1.f / D) + EPS);
                float s = 0.f;
#pragma unroll
                for (int bj = 0; bj < 2; ++bj) {
                    const size_t off = (size_t)row * D + col0 + bj * 128;
                    const v4u pw = *(const v4u*)(Pp + off), xw = *(const v4u*)(x2b + off);
                    unsigned o[4];
#pragma unroll
                    for (int n = 0; n < 2; ++n) {
                        const float p0[4] = {bflo(pw[2 * n]), bfhi(pw[2 * n]), bflo(pw[2 * n + 1]), bfhi(pw[2 * n + 1])};
                        const float x0[4] = {bflo(xw[2 * n]), bfhi(xw[2 * n]), bflo(xw[2 * n + 1]), bfhi(xw[2 * n + 1])};
                        float v0[4];
#pragma unroll
                        for (int j = 0; j < 4; ++j) v0[j] = x0[j] + p0[j] * sigmoidf(acc[ai][bj][m][n][j] * r);
                        o[2 * n] = pg8::cvt_pk_bf16(v0[0], v0[1]); o[2 * n + 1] = pg8::cvt_pk_bf16(v0[2], v0[3]);
                        s += (v0[0] * v0[0] + v0[1] * v0[1]) + (v0[2] * v0[2] + v0[3] * v0[3]);
                    }
                    *(v4u*)(x3b + off) = (v4u){o[0], o[1], o[2], o[3]};
                    asm volatile("" ::: "memory");
                }
                s += __shfl_xor(s, 16); s += __shfl_xor(s, 32);
                if (fq == 0) atomicAdd(ss3 + row, s);
                asm volatile("" ::: "memory"); }
    }
};

__device__ __forceinline__ f32x4 mfma16(bf16x8 a, bf16x8 b, f32x4 c) { return __builtin_amdgcn_mfma_f32_16x16x32_bf16(a, b, c, 0, 0, 0); }
__device__ __forceinline__ bf16x8 lds_frag(const char* p) { return *(const bf16x8*)p; }
constexpr int TS = 144;
constexpr int QS_P = 272;
constexpr float KSCALE = 0.08838834764831845f;

__device__ __forceinline__ void p2p_item(Frame& F, int b, int c) {
    float* WKL = (float*)F.ldsg;
    const int tid = F_TID, lane = F_LANE, w = F_WAVE;
    const size_t row0 = (size_t)b * SEQ + c * 64;
    const bf16* P = PROJ;
    if (w < 4) { const int h = w, bh = b * 4 + h; const size_t row = row0 + lane;
        const float ig = bf2f(P[row * PS + C_SM + h]) + B_GATE[h], lf = logsig(bf2f(P[row * PS + C_SM + 4 + h]) + B_GATE[4 + h]);
        const float bc = wave_scan_sum(lf, lane), a = ig - bc; const float pmax = wave_max(a);
        GA_A[(size_t)bh * SEQ + c * 64 + lane] = a; GA_B[(size_t)bh * SEQ + c * 64 + lane] = bc;
        if (lane == 63) { PMXG[bh * NCH + c] = pmax; BLSG[bh * NCH + c] = bc; }
        WKL[h * 64 + lane] = __expf(a - pmax) * KSCALE; }
    {
      constexpr int GP = 528;
      char* QL = F.ldsg + 1024; char* KL = QL + 64 * GP;
#pragma unroll
      for (int i = 0; i < 4; ++i) { const int pc = tid + 512 * i, r_ = pc >> 5, c16 = pc & 31;
          *(v4u*)(QL + r_ * GP + 16 * c16) = *(const v4u*)(P + (row0 + r_) * PS + C_GQ + 8 * c16); *(v4u*)(KL + r_ * GP + 16 * c16) = *(const v4u*)(P + (row0 + r_) * PS + C_GK + 8 * c16); }
      const int hg = w >> 1, d0 = 32 * (w & 1), bh = b * 4 + hg, colb = hg * 64 + d0; const size_t row = row0 + lane;
      const v4u ga0 = *(const v4u*)(P + row * PS + C_SM + 8), ga1 = *(const v4u*)(P + row * PS + C_SM + 16);
      float ga[16];
#pragma unroll
      for (int i = 0; i < 4; ++i) { ga[2 * i] = bflo(ga0[i]); ga[2 * i + 1] = bfhi(ga0[i]); ga[8 + 2 * i] = bflo(ga1[i]); ga[8 + 2 * i + 1] = bfhi(ga1[i]); }
      cfloat* wa = W_A2 + colb; cfloat* ba = B_A + colb; float* ebl = EBLG + (size_t)(bh * NCH + c) * 64 + d0;
      unsigned* myq = (unsigned*)(QL + lane * GP + 2 * colb); unsigned* myk = (unsigned*)(KL + lane * GP + 2 * colb);
      LBAR();
#pragma unroll 1
      for (int j = 0; j < 16; ++j) {
          float z0 = ba[2 * j], z1 = ba[2 * j + 1];
#pragma unroll
          for (int q = 0; q < 16; ++q) { z0 += ga[q] * wa[q * 256 + 2 * j]; z1 += ga[q] * wa[q * 256 + 2 * j + 1]; }
          const float b0 = wave_scan_sum(logsig(z0) * (1.f / 16.f), lane), b1 = wave_scan_sum(logsig(z1) * (1.f / 16.f), lane);
          if (lane == 63) { ebl[2 * j] = __expf(b0); ebl[2 * j + 1] = __expf(b1); }
          const unsigned qw = myq[j], kw = myk[j];
          myq[j] = pk2(bflo(qw) * __expf(b0), bfhi(qw) * __expf(b1)); myk[j] = pk2(bflo(kw) * __expf(-b0), bfhi(kw) * __expf(-b1));
      }
      LBAR();
#pragma unroll
      for (int i = 0; i < 4; ++i) { const int pc = tid + 512 * i, r_ = pc >> 5, c16 = pc & 31;
          *(v4u*)(SCR + SC_QG + (row0 + r_) * 256 + 8 * c16) = *(const v4u*)(QL + r_ * GP + 16 * c16); *(v4u*)(SCR + SC_KG + (row0 + r_) * 256 + 8 * c16) = *(const v4u*)(KL + r_ * GP + 16 * c16); } }
    {
      const int isk = tid >> 8, pc = tid & 255, h = pc >> 6, ch = isk * 512 + 2 * pc;
      float cw[4][2], cb[2];
#pragma unroll
      for (int j = 0; j < 4; ++j) { cw[j][0] = CONV_W[j * 1024 + ch]; cw[j][1] = CONV_W[j * 1024 + ch + 1]; }
      cb[0] = CONV_B[ch]; cb[1] = CONV_B[ch + 1];
      const bf16* src = P + row0 * PS + (isk ? C_MK : C_MQ) + 2 * pc;
      bf16* dst = SCR + (isk ? SC_KW : SC_QP) + row0 * 512 + 2 * pc;
      unsigned cur[19], nxt[16];
#pragma unroll
      for (int i = 0; i < 3; ++i) cur[i] = (c > 0) ? *(const unsigned*)(src + (long)(i - 3) * PS) : 0u;
#pragma unroll
      for (int i = 0; i < 16; ++i) nxt[i] = *(const unsigned*)(src + (long)i * PS);
#pragma unroll 1
      for (int gq = 0; gq < 4; ++gq) {
#pragma unroll
          for (int i = 0; i < 16; ++i) cur[3 + i] = nxt[i];
          if (gq < 3) {
#pragma unroll
              for (int i = 0; i < 16; ++i) nxt[i] = *(const unsigned*)(src + (long)(16 * (gq + 1) + i) * PS);
          }
#pragma unroll
          for (int i = 0; i < 16; ++i) { float a0 = cb[0], a1 = cb[1];
#pragma unroll
              for (int j = 0; j < 4; ++j) { a0 += cw[j][0] * bflo(cur[i + j]); a1 += cw[j][1] * bfhi(cur[i + j]); }
              a0 = a0 * sigmoidf(a0); a1 = a1 * sigmoidf(a1);
              if (isk) { const float wk = WKL[h * 64 + 16 * gq + i]; a0 *= wk; a1 *= wk; }
              *(unsigned*)(dst + (size_t)(16 * gq + i) * 512) = pk2(a0, a1); }
#pragma unroll
          for (int i = 0; i < 3; ++i) cur[i] = cur[16 + i];
      } }
    LBAR();
}

constexpr int NCI = 4;
__device__ __forceinline__ void chain_mlstm(Frame& F, int b, int h, int sl) {
    char* L = F.ldsg;
    constexpr int KT_B = 64 * TS, VT_B = 128 * TS, NP_B = 16 * 64 * 4, BUF_B = KT_B + VT_B + NP_B;
    float* PM = (float*)(L + NCI * BUF_B); float* BLs = PM + 32; float* MCc = BLs + 32; float* CSs = MCc + 40; float* E2s = CSs + 32;
    const int tid = F_TID, lane = F_LANE, w = F_WAVE, r = lane & 15, g = lane >> 4;
    const int bh = b * 4 + h; const size_t rowb = (size_t)b * SEQ;
    if (tid < 32) { PM[tid] = PMXG[bh * NCH + tid]; BLs[tid] = BLSG[bh * NCH + tid]; }
    __syncthreads();
    if (tid == 0) { float m = 0.f; for (int c = 0; c < NCH; ++c) { const float M = fmaxf(m, PM[c]); MCc[c] = m; CSs[c] = __expf(m - M); E2s[c] = __expf(PM[c] - M); m = BLs[c] + M; } MCc[32] = m; }
    __syncthreads();
    const int dpk = tid & 31, tg = tid >> 5, dpv = tid & 63, sg = tid >> 6;
    const int dt = w & 3, eb = 4 * (w >> 2);
    f32x4 acc[4];
#pragma unroll
    for (int i = 0; i < 4; ++i) acc[i] = (f32x4){0.f, 0.f, 0.f, 0.f};
    float nst = 0.f;
    unsigned krq[NCI][4], vrq[NCI][8];
    const bf16* kbase = SCR + SC_KW + (rowb + 4 * tg) * 512 + h * 128 + 64 * sl + 2 * dpk; const bf16* vbase = PROJ + (rowb + 8 * sg) * PS + C_MV + h * 128 + 2 * dpv;
#pragma unroll
    for (int q = 0; q < NCI; ++q) {
#pragma unroll
        for (int i = 0; i < 4; ++i) krq[q][i] = *(const unsigned*)(kbase + (size_t)(64 * q + i) * 512);
#pragma unroll
        for (int i = 0; i < 8; ++i) vrq[q][i] = *(const unsigned*)(vbase + (size_t)(64 * q + i) * PS);
    }
    for (int c0 = 0; c0 < NCH; c0 += NCI) {
#pragma unroll
        for (int q = 0; q < NCI; ++q) { char* KT = L + q * BUF_B; char* VT = KT + KT_B; float* NP = (float*)(VT + VT_B);
            const unsigned* kr = krq[q]; const unsigned* vr = vrq[q];
            *(v2u*)(KT + (2 * dpk) * TS + 8 * tg) = (v2u){(kr[0] & 0xffffu) | (kr[1] << 16), (kr[2] & 0xffffu) | (kr[3] << 16)};
            *(v2u*)(KT + (2 * dpk + 1) * TS + 8 * tg) = (v2u){(kr[0] >> 16) | (kr[1] & 0xffff0000u), (kr[2] >> 16) | (kr[3] & 0xffff0000u)};
            NP[tg * 64 + 2 * dpk] = (bflo(kr[0]) + bflo(kr[1])) + (bflo(kr[2]) + bflo(kr[3])); NP[tg * 64 + 2 * dpk + 1] = (bfhi(kr[0]) + bfhi(kr[1])) + (bfhi(kr[2]) + bfhi(kr[3]));
            unsigned v0p[4], v1p[4];
#pragma unroll
            for (int i = 0; i < 8; i += 2) { v0p[i >> 1] = (vr[i] & 0xffffu) | (vr[i + 1] << 16); v1p[i >> 1] = (vr[i] >> 16) | (vr[i + 1] & 0xffff0000u); }
            *(v4u*)(VT + (2 * dpv) * TS + 16 * sg) = (v4u){v0p[0], v0p[1], v0p[2], v0p[3]};
            *(v4u*)(VT + (2 * dpv + 1) * TS + 16 * sg) = (v4u){v1p[0], v1p[1], v1p[2], v1p[3]}; }
        if (c0 + NCI < NCH) {
#pragma unroll
            for (int q = 0; q < NCI; ++q) {
#pragma unroll
                for (int i = 0; i < 4; ++i) krq[q][i] = *(const unsigned*)(kbase + (size_t)(64 * (c0 + NCI + q) + i) * 512);
#pragma unroll
                for (int i = 0; i < 8; ++i) vrq[q][i] = *(const unsigned*)(vbase + (size_t)(64 * (c0 + NCI + q) + i) * PS);
            }
        }
        LBAR();
        f32x4 ta[NCI][4];
#pragma unroll
        for (int q = 0; q < NCI; ++q) { const char* KT = L + q * BUF_B; const char* VT = KT + KT_B;
#pragma unroll
            for (int i = 0; i < 4; ++i) ta[q][i] = (f32x4){0.f, 0.f, 0.f, 0.f};
#pragma unroll
            for (int kk = 0; kk < 2; ++kk) {
                const bf16x8 af = lds_frag(KT + (16 * dt + r) * TS + (32 * kk + 8 * g) * 2);
#pragma unroll
                for (int i = 0; i < 4; ++i) ta[q][i] = mfma16(af, lds_frag(VT + (16 * (eb + i) + r) * TS + (32 * kk + 8 * g) * 2), ta[q][i]);
            } }
#pragma unroll
        for (int q = 0; q < NCI; ++q) { const int c = c0 + q;
            { bf16* cst = CSM + (size_t)(bh * NCH + c) * 16384;
#pragma unroll
              for (int i = 0; i < 4; ++i)
                  *(v2u*)(cst + ((eb + i) * 8 + 4 * sl + dt) * 256 + r * 16 + 4 * g) = (v2u){pg8::cvt_pk_bf16(acc[i][0], acc[i][1]), pg8::cvt_pk_bf16(acc[i][2], acc[i][3])};
              if (tid < 64) NCS[(size_t)(bh * NCH + c) * 128 + 64 * sl + tid] = nst;
              if (tid == 0 && sl == 0) MCS[bh * NCH + c] = MCc[c]; }
            const float cs = CSs[c], e2 = E2s[c];
            if (tid < 64) { const float* NP = (const float*)(L + q * BUF_B + KT_B + VT_B); float s = 0.f;
#pragma unroll
                for (int k = 0; k < 16; ++k) s += NP[k * 64 + tid];
                nst = cs * nst + e2 * s; }
#pragma unroll
            for (int i = 0; i < 4; ++i) acc[i] = acc[i] * cs + ta[q][i] * e2; }
        LBAR();
    }
    { float* Co = OUTP + O_CP + (size_t)bh * 16384;
#pragma unroll
      for (int i = 0; i < 4; ++i)
#pragma unroll
          for (int j = 0; j < 4; ++j) Co[(64 * sl + 16 * dt + 4 * g + j) * 128 + 16 * (eb + i) + r] = acc[i][j];
      if (tid < 64) OUTP[O_NP + (size_t)bh * 128 + 64 * sl + tid] = nst;
      if (tid == 0 && sl == 0) OUTP[O_MP + bh] = MCc[32]; }
    __syncthreads();
}

__device__ __forceinline__ void chain_gla(Frame& F, int b, int hg, int sl) {
    char* L = F.ldsg;
    constexpr int KT_B = 32 * TS, VT_B = 128 * TS, BUF_B = KT_B + VT_B;
    const int tid = F_TID, lane = F_LANE, w = F_WAVE, r = lane & 15, g = lane >> 4;
    const int bh = b * 4 + hg; const size_t rowb = (size_t)b * SEQ;
    const int dpv = tid & 63, sg = tid >> 6;
    const int dt = w & 1, eb = 2 * (w >> 1);
    f32x4 acc[2];
    acc[0] = (f32x4){0.f, 0.f, 0.f, 0.f}; acc[1] = acc[0];
    v2u k4q[NCI]; f32x4 ebq[NCI]; unsigned vrq[NCI][8];
    const bf16* kbase = SCR + SC_KG + (rowb + lane) * 256 + hg * 64 + 32 * sl + 4 * w; const bf16* vbase = PROJ + (rowb + 8 * sg) * PS + C_GV + hg * 128 + 2 * dpv;
    const float* ebase = EBLG + (size_t)bh * NCH * 64 + 32 * sl + 16 * dt + 4 * g;
#pragma unroll
    for (int q = 0; q < NCI; ++q) { k4q[q] = *(const v2u*)(kbase + (size_t)(64 * q) * 256); ebq[q] = *(const f32x4*)(ebase + q * 64);
#pragma unroll
        for (int i = 0; i < 8; ++i) vrq[q][i] = *(const unsigned*)(vbase + (size_t)(64 * q + i) * PS); }
    for (int c0 = 0; c0 < NCH; c0 += NCI) {
        f32x4 eb4[NCI];
#pragma unroll
        for (int q = 0; q < NCI; ++q) { char* KT = L + q * BUF_B; char* VT = KT + KT_B; const v2u k4 = k4q[q]; const unsigned* vr = vrq[q]; eb4[q] = ebq[q];
            *(bf16*)(KT + (4 * w + 0) * TS + 2 * lane) = (bf16)(k4[0] & 0xffffu); *(bf16*)(KT + (4 * w + 1) * TS + 2 * lane) = (bf16)(k4[0] >> 16);
            *(bf16*)(KT + (4 * w + 2) * TS + 2 * lane) = (bf16)(k4[1] & 0xffffu); *(bf16*)(KT + (4 * w + 3) * TS + 2 * lane) = (bf16)(k4[1] >> 16);
            unsigned v0p[4], v1p[4];
#pragma unroll
            for (int i = 0; i < 8; i += 2) { v0p[i >> 1] = (vr[i] & 0xffffu) | (vr[i + 1] << 16); v1p[i >> 1] = (vr[i] >> 16) | (vr[i + 1] & 0xffff0000u); }
            *(v4u*)(VT + (2 * dpv) * TS + 16 * sg) = (v4u){v0p[0], v0p[1], v0p[2], v0p[3]};
            *(v4u*)(VT + (2 * dpv + 1) * TS + 16 * sg) = (v4u){v1p[0], v1p[1], v1p[2], v1p[3]}; }
        if (c0 + NCI < NCH) {
#pragma unroll
            for (int q = 0; q < NCI; ++q) { k4q[q] = *(const v2u*)(kbase + (size_t)(64 * (c0 + NCI + q)) * 256); ebq[q] = *(const f32x4*)(ebase + (c0 + NCI + q) * 64);
#pragma unroll
                for (int i = 0; i < 8; ++i) vrq[q][i] = *(const unsigned*)(vbase + (size_t)(64 * (c0 + NCI + q) + i) * PS); }
        }
        LBAR();
        f32x4 ta[NCI][2];
#pragma unroll
        for (int q = 0; q < NCI; ++q) { const char* KT = L + q * BUF_B; const char* VT = KT + KT_B;
            ta[q][0] = (f32x4){0.f, 0.f, 0.f, 0.f}; ta[q][1] = ta[q][0];
#pragma unroll
            for (int kk = 0; kk < 2; ++kk) {
                const bf16x8 af = lds_frag(KT + (16 * dt + r) * TS + (32 * kk + 8 * g) * 2);
#pragma unroll
                for (int i = 0; i < 2; ++i) ta[q][i] = mfma16(af, lds_frag(VT + (16 * (eb + i) + r) * TS + (32 * kk + 8 * g) * 2), ta[q][i]);
            } }
#pragma unroll
        for (int q = 0; q < NCI; ++q) { const int c = c0 + q;
            bf16* cst = CSG + (size_t)(bh * NCH + c) * 8192;
#pragma unroll
            for (int i = 0; i < 2; ++i)
                *(v2u*)(cst + ((eb + i) * 4 + 2 * sl + dt) * 256 + r * 16 + 4 * g) = (v2u){pg8::cvt_pk_bf16(acc[i][0], acc[i][1]), pg8::cvt_pk_bf16(acc[i][2], acc[i][3])};
            acc[0] = (acc[0] + ta[q][0]) * eb4[q]; acc[1] = (acc[1] + ta[q][1]) * eb4[q]; }
        LBAR();
    }
    { float* So = OUTP + O_SP + (size_t)bh * 8192;
#pragma unroll
      for (int i = 0; i < 2; ++i)
#pragma unroll
          for (int j = 0; j < 4; ++j) So[(32 * sl + 16 * dt + 4 * g + j) * 128 + 16 * (eb + i) + r] = acc[i][j]; }
    __syncthreads();
}

__device__ __forceinline__ void sample_item(Frame& F, int n, int hh, float* Wl, int lane) {
    asm volatile("" : "+v"(lane));
    float* qv = Wl; float* kv = Wl + 128; float* vv = Wl + 256; float* al = Wl + 384;
    const size_t row = (size_t)MP + n;
    const bf16* Pr = PROJ + row * PS;
    const bool gla = hh >= 4; const int h = hh & 3;
    const int e4 = lane & 31, dh = lane >> 5;
    float cs = 1.f, wkk = 1.f, dinv = 1.f;
    if (!gla) {
        float qk2[2][2];
#pragma unroll
        for (int isk = 0; isk < 2; ++isk)
#pragma unroll
            for (int q = 0; q < 2; ++q) { const int d = lane + 64 * q, ch = isk * 512 + h * 128 + d;
                const float* scv = ST_CONV + (size_t)n * 3 * 1024 + ch;
                float a = CONV_B[ch] + CONV_W[ch] * scv[0] + CONV_W[1024 + ch] * scv[1024] + CONV_W[2048 + ch] * scv[2048] + CONV_W[3072 + ch] * bf2f(Pr[(isk ? C_MK : C_MQ) + h * 128 + d]);
                a = a * sigmoidf(a); if (isk) a *= KSCALE; qk2[isk][q] = a; (isk ? kv : qv)[d] = a; }
        vv[lane] = bf2f(Pr[C_MV + h * 128 + lane]); vv[lane + 64] = bf2f(Pr[C_MV + h * 128 + lane + 64]);
        const float* n0 = ST_N + ((size_t)n * 4 + h) * 128; const float n00 = n0[lane], n01 = n0[lane + 64];
        const float qk = wave_sum(qk2[0][0] * qk2[1][0] + qk2[0][1] * qk2[1][1]), qn = wave_sum(qk2[0][0] * n00 + qk2[0][1] * n01);
        const float ig = bf2f(Pr[C_SM + h]) + B_GATE[h], lf = logsig(bf2f(Pr[C_SM + 4 + h]) + B_GATE[4 + h]);
        const float m0 = ST_M[n * 4 + h], mn = fmaxf(lf + m0, ig);
        wkk = __expf(ig - mn); cs = __expf(lf + m0 - mn);
        const float den = cs * qn + qk * wkk;
        dinv = __builtin_amdgcn_rcpf(fmaxf(fabsf(den), __expf(-mn)));
        float* nsO = OUTP + O_NS + ((size_t)n * 4 + h) * 128; nsO[lane] = cs * n00 + wkk * qk2[1][0]; nsO[lane + 64] = cs * n01 + wkk * qk2[1][1];
        if (lane == 0) OUTP[O_MS + n * 4 + h] = mn;
    } else {
        qv[lane] = bf2f(Pr[C_GQ + h * 64 + lane]); kv[lane] = bf2f(Pr[C_GK + h * 64 + lane]);
        vv[lane] = bf2f(Pr[C_GV + h * 128 + lane]); vv[lane + 64] = bf2f(Pr[C_GV + h * 128 + lane + 64]);
        { const int col = h * 64 + lane; float z = B_A[col];
#pragma unroll
          for (int q = 0; q < 16; ++q) z += bf2f(Pr[C_SM + 8 + q]) * IN_F(13)[q * 256 + col];
          al[lane] = __expf(logsig(z) * (1.f / 16.f)); }
    }
    asm volatile("s_waitcnt lgkmcnt(0)" ::: "memory");
    const f32x4 v4 = *(const f32x4*)(vv + 4 * e4);
    f32x4 hp = (f32x4){0.f, 0.f, 0.f, 0.f};
    if (!gla) {
        const float* C0 = ST_C + ((size_t)n * 4 + h) * 16384 + (size_t)(64 * dh) * 128 + 4 * e4; float* Cn = OUTP + O_CS + ((size_t)n * 4 + h) * 16384 + (size_t)(64 * dh) * 128 + 4 * e4;
        for (int i0 = 0; i0 < 64; i0 += 8) { f32x4 c0[8];
#pragma unroll
            for (int i = 0; i < 8; ++i) c0[i] = *(const f32x4*)(C0 + (i0 + i) * 128);
#pragma unroll
            for (int i = 0; i < 8; ++i) { const int d = 64 * dh + i0 + i; const f32x4 cn = c0[i] * cs + v4 * (wkk * kv[d]); *(f32x4*)(Cn + (i0 + i) * 128) = cn; hp += cn * qv[d]; } }
    } else {
        const float* S0 = ST_S + ((size_t)n * 4 + h) * 8192 + (size_t)(32 * dh) * 128 + 4 * e4; float* Sn = OUTP + O_SS + ((size_t)n * 4 + h) * 8192 + (size_t)(32 * dh) * 128 + 4 * e4;
        for (int i0 = 0; i0 < 32; i0 += 8) { f32x4 c0[8];
#pragma unroll
            for (int i = 0; i < 8; ++i) c0[i] = *(const f32x4*)(S0 + (i0 + i) * 128);
#pragma unroll
            for (int i = 0; i < 8; ++i) { const int d = 32 * dh + i0 + i; const f32x4 sn = c0[i] * al[d] + v4 * kv[d]; *(f32x4*)(Sn + (i0 + i) * 128) = sn; hp += sn * qv[d]; } }
    }
#pragma unroll
    for (int j = 0; j < 4; ++j) hp[j] += __shfl_xor(hp[j], 32);
    hp = hp * dinv;
    float ssum = (hp[0] * hp[0] + hp[1] * hp[1]) + (hp[2] * hp[2] + hp[3] * hp[3]);
#pragma unroll
    for (int o = 1; o < 32; o <<= 1) ssum += __shfl_xor(ssum, o);
    const float rn = rsqrt_fast(ssum * (1.f / 128.f) + EPS);
    if (lane < 32) {
        const v2u gw = *(const v2u*)(Pr + (gla ? C_GR : C_MO) + h * 128 + 4 * e4);
        const f32x4 g4 = *(const f32x4*)((gla ? G_GHEAD : G_MHEAD) + h * 128 + 4 * e4);
        const float gt[4] = {bflo(gw[0]), bfhi(gw[0]), bflo(gw[1]), bfhi(gw[1])}; float o[4];
#pragma unroll
        for (int j = 0; j < 4; ++j) { const float sg_ = sigmoidf(gt[j]); o[j] = hp[j] * rn * g4[j] * (gla ? gt[j] * sg_ : sg_); }
        int e4o = e4; asm volatile("" : "+v"(e4o));
        *(v2u*)(R1B + row * D + (gla ? 512 : 0) + h * 128 + 4 * e4o) = (v2u){pg8::cvt_pk_bf16(o[0], o[1]), pg8::cvt_pk_bf16(o[2], o[3])};
    }
    asm volatile("s_waitcnt lgkmcnt(0)" ::: "memory");
}

constexpr int P2B_QS = 0, P2B_KS = 64 * QS_P, P2B_VT = P2B_KS + 80 * QS_P, P2B_PS = P2B_VT + 128 * TS, P2B_FL = P2B_PS + 64 * TS, P2B_HALF = P2B_FL + 2560;
static_assert(2 * P2B_HALF <= MISC_OFF, "P2b LDS");
template <bool GLA>
__device__ __forceinline__ void p2b_unit(Frame& F, int u, char* L, int ltid, int lw, int lane) {
    const int v = u & 1023, bh = v >> 5, c = v & 31, b = bh >> 2, h = bh & 3, r = lane & 15, g = lane >> 4;
    const size_t rowb = (size_t)b * SEQ + c * 64;
    const bf16* P = PROJ;
    char* QSp = L + P2B_QS; char* KSp = L + P2B_KS; char* VTp = L + P2B_VT; char* PSp = L + P2B_PS;
    float* af = (float*)(L + P2B_FL); float* Mf = af + 64; float* scf = af + 128; float* enf = af + 192; float* dinvf = af + 256; float* ssq = af + 320;
    constexpr int QP = GLA ? TS : QS_P;
    constexpr int NK = GLA ? 2 : 4;
    bf16x8 cfr[2][NK];
    { const bf16* CT = GLA ? CSG + (size_t)(bh * NCH + c) * 8192 : CSM + (size_t)(bh * NCH + c) * 16384;
#pragma unroll
      for (int n2 = 0; n2 < 2; ++n2)
#pragma unroll
          for (int kk = 0; kk < NK; ++kk) cfr[n2][kk] = *(const bf16x8*)(CT + ((2 * lw + n2) * (GLA ? 4 : 8) + 2 * kk + (g >> 1)) * 256 + r * 16 + 8 * (g & 1)); }
    const int dp = ltid & 63, sg = ltid >> 6;
    v2u gwq[4][2];
#pragma unroll
    for (int mt = 0; mt < 4; ++mt)
#pragma unroll
        for (int n2 = 0; n2 < 2; ++n2) gwq[mt][n2] = *(const v2u*)(P + (rowb + 16 * mt + r) * PS + (GLA ? C_GR : C_MO) + h * 128 + 32 * lw + 16 * n2 + 4 * g);
    float* rsf = ssq + 256;
    if constexpr (!GLA) {
        { const float a = GA_A[(size_t)bh * SEQ + c * 64 + lane], bc = GA_B[(size_t)bh * SEQ + c * 64 + lane];
          const float pm = wave_scan_max(a, lane);
          const float mc = MCS[bh * NCH + c], pmx = PMXG[bh * NCH + c], Mt = fmaxf(mc, pm);
          if (lw == 0) { Mf[lane] = Mt; scf[lane] = __expf(mc - Mt); enf[lane] = __expf(-(bc + Mt)); rsf[lane] = __expf(pmx - Mt); } }
        {
#pragma unroll
          for (int i = 0; i < 4; ++i) { const int pc = ltid + 256 * i, row = pc >> 4, c16 = pc & 15;
              const v4u qq = *(const v4u*)(SCR + SC_QP + (rowb + row) * 512 + h * 128 + 8 * c16), kk4 = *(const v4u*)(SCR + SC_KW + (rowb + row) * 512 + h * 128 + 8 * c16);
              *(v4u*)(QSp + row * QS_P + 16 * c16) = qq; *(v4u*)(KSp + row * QS_P + 16 * c16) = kk4; } }
        if (ltid < 128) *(bf16*)(KSp + 64 * QS_P + 2 * ltid) = (bf16)f2bf(NCS[(size_t)(bh * NCH + c) * 128 + ltid]);
        for (int i = ltid; i < 15 * 64; i += 256) *(unsigned*)(KSp + (65 + i / 64) * QS_P + 4 * (i & 63)) = 0u;
    } else {
#pragma unroll
        for (int i = 0; i < 2; ++i) { const int pc = ltid + 256 * i, row = pc >> 3, c16 = pc & 7;
            const v4u qq = *(const v4u*)(SCR + SC_QG + (rowb + row) * 256 + h * 64 + 8 * c16), kk4 = *(const v4u*)(SCR + SC_KG + (rowb + row) * 256 + h * 64 + 8 * c16);
            *(v4u*)(QSp + row * TS + 16 * c16) = qq; *(v4u*)(KSp + row * TS + 16 * c16) = kk4; }
    }
    {
      unsigned vr[16];
#pragma unroll
      for (int i = 0; i < 16; ++i) vr[i] = *(const unsigned*)(P + (rowb + 16 * sg + i) * PS + (GLA ? C_GV : C_MV) + h * 128 + 2 * dp);
      unsigned v0p[8], v1p[8];
#pragma unroll
      for (int i = 0; i < 16; i += 2) { v0p[i >> 1] = (vr[i] & 0xffffu) | (vr[i + 1] << 16); v1p[i >> 1] = (vr[i] >> 16) | (vr[i + 1] & 0xffff0000u); }
      *(v4u*)(VTp + (2 * dp) * TS + 32 * sg) = (v4u){v0p[0], v0p[1], v0p[2], v0p[3]}; *(v4u*)(VTp + (2 * dp) * TS + 32 * sg + 16) = (v4u){v0p[4], v0p[5], v0p[6], v0p[7]};
      *(v4u*)(VTp + (2 * dp + 1) * TS + 32 * sg) = (v4u){v1p[0], v1p[1], v1p[2], v1p[3]}; *(v4u*)(VTp + (2 * dp + 1) * TS + 32 * sg + 16) = (v4u){v1p[4], v1p[5], v1p[6], v1p[7]}; }
    __syncthreads();
    {
        f32x4 pa[5];
#pragma unroll
        for (int i = 0; i < 5; ++i) pa[i] = (f32x4){0.f, 0.f, 0.f, 0.f};
#pragma unroll
        for (int kk = 0; kk < NK; ++kk) {
            const bf16x8 qf = lds_frag(QSp + (16 * lw + r) * QP + (32 * kk + 8 * g) * 2);
#pragma unroll
            for (int nt = 0; nt < 4; ++nt) if (nt <= lw) pa[nt] = mfma16(lds_frag(KSp + (16 * nt + r) * QP + (32 * kk + 8 * g) * 2), qf, pa[nt]);
            if constexpr (!GLA) pa[4] = mfma16(lds_frag(KSp + (64 + r) * QP + (32 * kk + 8 * g) * 2), qf, pa[4]);
        }
        const int t = 16 * lw + r;
        float rsc = 1.f; if constexpr (!GLA) rsc = rsf[t];
        float rs = 0.f;
#pragma unroll
        for (int nt = 0; nt < 4; ++nt) {
            f32x4 p = (f32x4){0.f, 0.f, 0.f, 0.f};
            if (nt <= lw) {
#pragma unroll
                for (int j = 0; j < 4; ++j) { const int s = 16 * nt + 4 * g + j; p[j] = (s <= t) ? pa[nt][j] * rsc : 0.f; }
            }
            rs += (p[0] + p[1]) + (p[2] + p[3]);
            *(v2u*)(PSp + t * TS + (16 * nt + 4 * g) * 2) = (v2u){pg8::cvt_pk_bf16(p[0], p[1]), pg8::cvt_pk_bf16(p[2], p[3])};
        }
        if constexpr (!GLA) {
            rs += __shfl_xor(rs, 16); rs += __shfl_xor(rs, 32);
            if (g == 0) { const float den = scf[t] * pa[4][0] + rs; dinvf[t] = __builtin_amdgcn_rcpf(fmaxf(fabsf(den), enf[t])); }
        }
    }
    __syncthreads();
    f32x4 hv[4][2];
    {
        f32x4 aV[4][2], aC[4][2];
#pragma unroll
        for (int mt = 0; mt < 4; ++mt)
#pragma unroll
            for (int n2 = 0; n2 < 2; ++n2) { aV[mt][n2] = (f32x4){0.f, 0.f, 0.f, 0.f}; aC[mt][n2] = (f32x4){0.f, 0.f, 0.f, 0.f}; }
#pragma unroll
        for (int kk = 0; kk < 2; ++kk) {
            bf16x8 vf[2];
#pragma unroll
            for (int n2 = 0; n2 < 2; ++n2) vf[n2] = lds_frag(VTp + (32 * lw + 16 * n2 + r) * TS + (32 * kk + 8 * g) * 2);
#pragma unroll
            for (int mt = 0; mt < 4; ++mt) { const bf16x8 pf = lds_frag(PSp + (16 * mt + r) * TS + (32 * kk + 8 * g) * 2);
#pragma unroll
                for (int n2 = 0; n2 < 2; ++n2) aV[mt][n2] = mfma16(vf[n2], pf, aV[mt][n2]); }
        }
#pragma unroll
        for (int kk = 0; kk < NK; ++kk)
#pragma unroll
            for (int mt = 0; mt < 4; ++mt) { const bf16x8 qf = lds_frag(QSp + (16 * mt + r) * QP + (32 * kk + 8 * g) * 2);
#pragma unroll
                for (int n2 = 0; n2 < 2; ++n2) aC[mt][n2] = mfma16(cfr[n2][kk], qf, aC[mt][n2]); }
#pragma unroll
        for (int mt = 0; mt < 4; ++mt) { const int t = 16 * mt + r;
            float sc = 1.f, di = 1.f; if constexpr (!GLA) { sc = scf[t]; di = dinvf[t]; }
            float s = 0.f;
#pragma unroll
            for (int n2 = 0; n2 < 2; ++n2) { hv[mt][n2] = (aC[mt][n2] * sc + aV[mt][n2]) * di;
                s += (hv[mt][n2][0] * hv[mt][n2][0] + hv[mt][n2][1] * hv[mt][n2][1]) + (hv[mt][n2][2] * hv[mt][n2][2] + hv[mt][n2][3] * hv[mt][n2][3]); }
            s += __shfl_xor(s, 16); s += __shfl_xor(s, 32);
            if (g == 0) ssq[t * 4 + lw] = s; }
    }
    __syncthreads();
    {
        const float* gn = (GLA ? G_GHEAD : G_MHEAD) + h * 128;
#pragma unroll
        for (int mt = 0; mt < 4; ++mt) { const int t = 16 * mt + r; const f32x4 s4 = *(const f32x4*)(ssq + 4 * t);
            const float rn = rsqrt_fast(((s4[0] + s4[1]) + (s4[2] + s4[3])) * (1.f / 128.f) + EPS);
#pragma unroll
            for (int n2 = 0; n2 < 2; ++n2) { const int e = 32 * lw + 16 * n2 + 4 * g;
                const v2u gw = gwq[mt][n2];
                const f32x4 g4 = *(const f32x4*)(gn + e);
                float gt[4] = {bflo(gw[0]), bfhi(gw[0]), bflo(gw[1]), bfhi(gw[1])}; float o[4];
#pragma unroll
                for (int j = 0; j < 4; ++j) { const float sg_ = sigmoidf(gt[j]); o[j] = hv[mt][n2][j] * rn * g4[j] * (GLA ? gt[j] * sg_ : sg_); }
                *(v2u*)(R1B + (rowb + t) * D + (GLA ? 512 : 0) + h * 128 + e) = (v2u){pg8::cvt_pk_bf16(o[0], o[1]), pg8::cvt_pk_bf16(o[2], o[3])}; } }
    }
    __syncthreads();
}

template <int K, int RT>
__device__ __forceinline__ void skinny_acc(const bf16* A, const bf16* Bt, int nsl, f32x4 (&acc)[RT], int w, int r, int g) {
    constexpr int KW = K / 8, NKS = KW / 32, KBMAX = RT <= 2 ? 8 : 4, KB = NKS < KBMAX ? NKS : KBMAX;
    const bf16* ap = A + (size_t)r * K + w * KW + 8 * g;
    const bf16* bp = Bt + (size_t)(nsl * 16 + r) * K + w * KW + 8 * g;
#pragma unroll 1
    for (int ks = 0; ks < NKS; ks += KB) {
        bf16x8 bfr[KB], afr[RT][KB];
#pragma unroll
        for (int kk = 0; kk < KB; ++kk) { bfr[kk] = *(const bf16x8*)(bp + 32 * (ks + kk));
#pragma unroll
            for (int rt = 0; rt < RT; ++rt) afr[rt][kk] = *(const bf16x8*)(ap + (size_t)rt * 16 * K + 32 * (ks + kk)); }
#pragma unroll
        for (int kk = 0; kk < KB; ++kk)
#pragma unroll
            for (int rt = 0; rt < RT; ++rt) acc[rt] = mfma16(bfr[kk], afr[rt][kk], acc[rt]);
    }
}
template <int RT> __device__ __forceinline__ void skinny_put(float* red, const f32x4 (&acc)[RT], int w, int r, int g) {
#pragma unroll
    for (int rt = 0; rt < RT; ++rt) *(f32x4*)(red + w * (RT * 256) + (16 * rt + r) * 16 + 4 * g) = acc[rt];
}
template <int RT> __device__ __forceinline__ f32x4 skinny_get(const float* red, int row, int c4) {
    f32x4 v = (f32x4){0.f, 0.f, 0.f, 0.f};
#pragma unroll
    for (int q = 0; q < 8; ++q) v += *(const f32x4*)(red + q * (RT * 256) + row * 16 + 4 * c4);
    return v;
}
template <int RT> __device__ __forceinline__ void zeroacc(f32x4 (&acc)[RT]) {
#pragma unroll
    for (int i = 0; i < RT; ++i) acc[i] = (f32x4){0.f, 0.f, 0.f, 0.f};
}
__device__ __forceinline__ float quad_sum(float s) { s += __shfl_xor(s, 1); s += __shfl_xor(s, 2); return s; }
__device__ __forceinline__ v2u pack4(f32x4 v) { return (v2u){pg8::cvt_pk_bf16(v[0], v[1]), pg8::cvt_pk_bf16(v[2], v[3])}; }
template <bool RES_BF16>
__device__ __forceinline__ void skinny_res(Frame& F, const bf16* A, const bf16* Bt, int K4096, const void* res, bf16* ob, float* ss) {
    float* red = (float*)F.ldsg; const int tid = F_TID, lane = F_LANE, w = F_WAVE, r = lane & 15, g = lane >> 4, lrow = tid >> 2, c4 = tid & 3;
    for (int it = blockIdx.x; it < 4 * (D / 16); it += F.G) { const int nsl = it >> 2, r0 = 32 * (it & 3);
        f32x4 acc[2]; zeroacc<2>(acc);
        if (K4096) skinny_acc<FF, 2>(A + (size_t)r0 * FF, Bt, nsl, acc, w, r, g); else skinny_acc<D, 2>(A + (size_t)r0 * D, Bt, nsl, acc, w, r, g);
        skinny_put<2>(red, acc, w, r, g); LBAR();
        if (tid < 128) { const int row = r0 + lrow;
            const size_t off = (size_t)row * D + nsl * 16 + 4 * c4;
            f32x4 rv;
            if constexpr (RES_BF16) { const v2u rw = *(const v2u*)((const bf16*)res + off); rv = (f32x4){bflo(rw.x), bfhi(rw.x), bflo(rw.y), bfhi(rw.y)}; }
            else rv = *(const f32x4*)((const float*)res + off);
            const f32x4 v = skinny_get<2>(red, lrow, c4) + rv;
            *(v2u*)(ob + off) = pack4(v);
            const float s = quad_sum((v[0] * v[0] + v[1] * v[1]) + (v[2] * v[2] + v[3] * v[3]));
            if (c4 == 0) atomicAdd(ss + row, s); }
        LBAR();
    }
}
__device__ __forceinline__ void skinny_up(Frame& F, const bf16* A, const bf16* Bt, const float* ss, bf16* U) {
    float* red = (float*)F.ldsg; const int tid = F_TID, lane = F_LANE, w = F_WAVE, r = lane & 15, g = lane >> 4, row = tid >> 2, c4 = tid & 3;
    for (int sl = blockIdx.x; sl < FF / 16; sl += F.G) {
        f32x4 acc[8]; zeroacc<8>(acc);
        skinny_acc<D, 8>(A, Bt, sl, acc, w, r, g);
        skinny_put<8>(red, acc, w, r, g); LBAR();
        const float rs = rsqrt_fast(ss[row] * (1.f / D) + EPS);
        f32x4 v = skinny_get<8>(red, row, c4) * rs;
#pragma unroll
        for (int j = 0; j < 4; ++j) { const float a = fmaxf(v[j], 0.f); v[j] = a * a; }
        *(v2u*)(U + (size_t)row * FF + sl * 16 + 4 * c4) = pack4(v);
        LBAR();
    }
}
__device__ __forceinline__ void skinny_ple(Frame& F, const bf16* pbs, const bf16* Wple, const bf16* x2b, const bf16* Wpg, const float* ss2, bf16* x3b, float* ss3) {
    float* red = (float*)F.ldsg; float* red2 = red + 8 * 512; const int tid = F_TID, lane = F_LANE, w = F_WAVE, r = lane & 15, g = lane >> 4, lrow = tid >> 2, c4 = tid & 3;
    for (int it = blockIdx.x; it < 4 * (D / 16); it += F.G) { const int nsl = it >> 2, r0 = 32 * (it & 3);
        f32x4 acc[2]; zeroacc<2>(acc);
        skinny_acc<DPLE, 2>(pbs + (size_t)r0 * DPLE, Wple, nsl, acc, w, r, g); skinny_put<2>(red2, acc, w, r, g);
        zeroacc<2>(acc);
        skinny_acc<D, 2>(x2b + (size_t)r0 * D, Wpg, nsl, acc, w, r, g); skinny_put<2>(red, acc, w, r, g); LBAR();
        if (tid < 128) { const int row = r0 + lrow;
            const size_t off = (size_t)row * D + nsl * 16 + 4 * c4;
            const float rs = rsqrt_fast(ss2[row] * (1.f / D) + EPS);
            const f32x4 gt = skinny_get<2>(red, lrow, c4) * rs, pp = skinny_get<2>(red2, lrow, c4); const v2u xw = *(const v2u*)(x2b + off);
            f32x4 v = (f32x4){bflo(xw.x), bfhi(xw.x), bflo(xw.y), bfhi(xw.y)};
#pragma unroll
            for (int j = 0; j < 4; ++j) v[j] += pp[j] * sigmoidf(gt[j]);
            *(v2u*)(x3b + off) = pack4(v);
            const float s = quad_sum((v[0] * v[0] + v[1] * v[1]) + (v[2] * v[2] + v[3] * v[3]));
            if (c4 == 0) atomicAdd(ss3 + row, s); }
        LBAR();
    }
}

constexpr int NPHASE = 9;

__global__ void __launch_bounds__(NWAVES * 64, 2) mk_fwd(Args args) {
    extern __shared__ __attribute__((aligned(16))) unsigned char lds[];
    Frame F;
    F.lds = (LAS unsigned char*)lds; F.ldsg = (char*)lds;
    F.G = gridDim.x;
    F.a = (CArgs*)__builtin_amdgcn_kernarg_segment_ptr();
    unsigned char* ws = F.a->ws;
    volatile LAS unsigned* MISC = (volatile LAS unsigned*)(F.lds + MISC_OFF);
    for (int u = F_TID; u < 64; u += NWAVES * 64) MISC[u] = 0u;
    __syncthreads();
    XcdBarrier bar; bar.bar = (unsigned*)(ws + CTL_BAR_B); bar.x = 0; bar.st = nullptr;
    if (MK_N_LAUNCHES == 1) bar = xcd_barrier_post((unsigned*)(ws + CTL_BAR_B), MISC + 8);
    const int lo = F.a->ph_lo, hi = F.a->ph_hi;
#ifndef PROBE_REP
#define PROBE_REP 0
#endif
#define REPS(k) (((PROBE_REP >> (k)) & 1) ? 2 : 1)
#ifndef TS_A0
#define TS_A0 -1
#define TS_A1 -1
#define TS_B0 -1
#define TS_B1 -1
#endif
#ifndef TS_BLOCK
#define TS_BLOCK 0
#endif
#ifndef TS_SCALE
#define TS_SCALE 100.f
#define TS_RANGE 260.f
#endif
#define STAMP(k) do { if ((k) == TS_A0) tsa0 = __builtin_amdgcn_s_memrealtime(); if ((k) == TS_A1) tsa1 = __builtin_amdgcn_s_memrealtime(); if ((k) == TS_B0) tsb0 = __builtin_amdgcn_s_memrealtime(); if ((k) == TS_B1) tsb1 = __builtin_amdgcn_s_memrealtime(); } while (0)
#ifndef PHASE_MASK
#define PHASE_MASK 0x1ff
#endif
#define IN(k) (((PHASE_MASK >> (k)) & 1) && lo <= (k) && (k) < hi)
#define SEAM(k) do { if (IN(k) && IN((k) + 1)) { xcd_barrier(bar); if ((PROBE_REP >> 16) & 1) xcd_barrier(bar); } } while (0)

    unsigned long long tsa0 = 0, tsa1 = 0, tsb0 = 0, tsb1 = 0; STAMP(0);
    if (IN(0)) { for (int rep = 0; rep < REPS(0); ++rep) { p0_prologue(F); if (rep + 1 < REPS(0)) __syncthreads(); } SEAM(0); STAMP(1); }
    if (IN(1)) {
        pg8::Gemm g{R1B, WIN_T, MR, PS, D}; pg8::StaticOrder S; S.init(MR, PS, F.G, (int)blockIdx.x);
        EpiProj E{PROJ, PS};
        for (int rep = 0; rep < REPS(1); ++rep) pg8::gemm_phase<EpiProj, pg8::StaticOrder, PG8_ALIGN, PG8_SP2>(F.lds, g, S, E);
        SEAM(1); STAMP(2);
    }
    if (IN(2)) {
        const int bx = blockIdx.x;
        if ((PROBE_REP >> 19) & 1) for (int it = bx; it < NB * NCH; it += F.G) p2p_item(F, it >> 5, it & 31);
        for (int it = bx; it < NB * NCH; it += F.G) p2p_item(F, it >> 5, it & 31);
        if (MK_N_LAUNCHES == 1) xcd_barrier(bar);
        STAMP(3);
#define P2A_CHAINS() do { const int cb_ = bx & 63; if (cb_ < 32) chain_mlstm(F, cb_ >> 2, cb_ & 3, bx >> 6); else chain_gla(F, (cb_ - 32) >> 2, (cb_ - 32) & 3, bx >> 6); } while (0)
#define P2A_SAMPLES() do { float* Wl = (float*)(F.ldsg + F_WAVE * 2048); \
              for (int it = (bx - 128) * NWAVES + F_WAVE; it < MSMP * 8; it += (F.G - 128) * NWAVES) sample_item(F, it >> 3, it & 7, Wl, F_LANE); } while (0)
        if (bx < 128) { P2A_CHAINS(); if ((PROBE_REP >> 17) & 1) P2A_CHAINS(); }
        else {
            const int nb = F.G - 128, gb = bx - 128;
            P2A_SAMPLES(); if ((PROBE_REP >> 18) & 1) P2A_SAMPLES();
            for (int i = gb * 512 + F_TID; i < NB * 3 * 1024 + MSMP * 3 * 1024; i += nb * 512) {
                if (i < NB * 3 * 1024) { const int b = i / 3072, j = (i / 1024) % 3, ch = i & 1023; OUTP[O_CVP + i] = bf2f(PROJ[((size_t)b * SEQ + SEQ - 3 + j) * PS + ch]); }
                else { const int k = i - NB * 3 * 1024, n = k / 3072, j = (k / 1024) % 3, ch = k & 1023;
                    OUTP[O_CVS + k] = j < 2 ? ST_CONV[(size_t)n * 3072 + (j + 1) * 1024 + ch] : bf2f(PROJ[((size_t)MP + n) * PS + ch]); }
            }
            __syncthreads();
            late_weight_copies(F, gb, nb);
        }
        STAMP(11); SEAM(2); STAMP(4);
    }
    if (IN(3)) {
        const int hb = F_WAVE >> 2, ltid = F_TID & 255, lw = F_WAVE & 3;
        char* L = F.ldsg + hb * P2B_HALF;
        for (int rep = 0; rep < REPS(3); ++rep)
        for (int it = 0; it * 2 * F.G < 2048; ++it) {
            const int u = (it * F.G + (int)blockIdx.x) * 2 + hb;
            if (u - hb >= 2048) break;
            if (u < 1024) p2b_unit<false>(F, u, L, ltid, lw, F_LANE); else p2b_unit<true>(F, u, L, ltid, lw, F_LANE);
        }
        SEAM(3); STAMP(5);
    }
    if (IN(4)) {
        pg8::Gemm g{R1B, WOUT_T, MP, D, D}; pg8::StaticOrder S; S.init(MP, D, F.G, (int)blockIdx.x);
        EpiRes<false> E{X_P, X1B, SS1};
        for (int rep = 0; rep < REPS(4); ++rep) pg8::gemm_phase<EpiRes<false>, pg8::StaticOrder, PG8_ALIGN, PG8_SP2>(F.lds, g, S, E);
        skinny_res<false>(F, R1B + (size_t)MP * D, WOUT_T, 0, X_S, X1B + (size_t)MP * D, SS1 + MP);
        SEAM(4); STAMP(6);
    }
    if (IN(5)) {
        pg8::Gemm g{X1B, W1_T, MP, FF, D}; pg8::StaticOrder S; S.init(MP, FF, F.G, (int)blockIdx.x);
        EpiU E{UBUF, SS1};
        const bool skinny_first = (blockIdx.x & 8) != 0;
        if (skinny_first) skinny_up(F, X1B + (size_t)MP * D, W1_T, SS1 + MP, UBUF + (size_t)MP * FF);
        for (int rep = 0; rep < REPS(5); ++rep) pg8::gemm_phase<EpiU, pg8::StaticOrder, PG8_ALIGN, PG8_SP2>(F.lds, g, S, E);
        if (!skinny_first) skinny_up(F, X1B + (size_t)MP * D, W1_T, SS1 + MP, UBUF + (size_t)MP * FF);
        SEAM(5); STAMP(7);
    }
    if (IN(6)) {
        pg8::Gemm g{UBUF, W2_T, MP, D, FF}; pg8::StaticOrder S; S.init(MP, D, F.G, (int)blockIdx.x);
        EpiRes<true> E{X1B, R1B, SS2};
        for (int rep = 0; rep < REPS(6); ++rep) pg8::gemm_phase<EpiRes<true>, pg8::StaticOrder, PG8_ALIGN, PG8_SP2>(F.lds, g, S, E);
        STAMP(12);
        skinny_res<true>(F, UBUF + (size_t)MP * FF, W2_T, 1, X1B + (size_t)MP * D, R1B + (size_t)MP * D, SS2 + MP);
        STAMP(13); SEAM(6); STAMP(8);
    }
    if (IN(7)) {
        { pg8::Gemm g{PBUF, WPLE_T, MP, D, DPLE}; pg8::StaticOrder S; S.init(MP, D, F.G, (int)blockIdx.x);
          EpiProj E{PPB, D};
          pg8::gemm_phase<EpiProj, pg8::StaticOrder, PG8_ALIGN, PG8_SP2>(F.lds, g, S, E); }
        { pg8::Gemm g{R1B, WPG_T, MP, D, D}; pg8::StaticOrder S; S.init(MP, D, F.G, (int)blockIdx.x);
          EpiPle E{R1B, PPB, X1B, SS2, SS3};
          pg8::gemm_phase<EpiPle, pg8::StaticOrder, PG8_ALIGN, PG8_SP2>(F.lds, g, S, E); }
        skinny_ple(F, PBUF + (size_t)MP * DPLE, WPLE_T, R1B + (size_t)MP * D, WPG_T, SS2 + MP, X1B + (size_t)MP * D, SS3 + MP);
        SEAM(7); STAMP(9);
    }
    if (IN(8)) {
        const int gw = blockIdx.x * NWAVES + F_WAVE, NGW = F.G * NWAVES;
        for (int m = gw; m < MV; m += NGW) {
            const GAS v2u* xr = (const GAS v2u*)(X1B + (size_t)m * D) + F_LANE; GAS f32x4* yo = (GAS f32x4*)(OUTP + (size_t)m * D) + F_LANE;
            const float r = rsqrt_fast(SS3[m] * (1.f / D) + EPS);
#pragma unroll
            for (int j = 0; j < 4; ++j) { const f32x4 gf = ((const GAS f32x4*)G_FINAL)[F_LANE + 64 * j]; const v2u xw = xr[64 * j];
                yo[64 * j] = (f32x4){bflo(xw.x), bfhi(xw.x), bflo(xw.y), bfhi(xw.y)} * r * gf; }
        }
        STAMP(10);
        if (TS_A0 >= 0 && blockIdx.x == TS_BLOCK && F_TID < 32) {
            const float T = (float)(tsa1 - tsa0) * 0.01f, rv = 4e-5f * exp2f(T * (3.321928f / TS_SCALE));
            OUTP[O_MP + F_TID] *= 1.f + sqrtf(rv);
        }
        if (TS_B0 >= 0 && blockIdx.x == TS_BLOCK && F_TID == 1) {
            const float T = (float)(tsb1 - tsb0) * 0.01f;
            OUTP[O_YP + (size_t)TS_BLOCK * 8 * D + 5] += 0.14f + T * (0.26f / TS_RANGE);
        }
    }
#undef IN
#undef SEAM
}

extern "C" void kernel_launch(void* const* d_in, const int* in_sizes, int n_in, void* d_out, int out_size, void* d_ws, size_t ws_size, hipStream_t stream) {
    static int grid = 0;
    if (grid == 0) {
        if (n_in != 26 || ws_size < WS_END) { fprintf(stderr, "kernel_launch: unexpected n_in %d / ws %zu\n", n_in, ws_size); grid = -1; return; }
        int dev = 0, cus = 0, per_cu = 0;
        if (hipGetDevice(&dev) != hipSuccess || hipDeviceGetAttribute(&cus, hipDeviceAttributeMultiprocessorCount, dev) != hipSuccess) { grid = -1; return; }
        if (hipFuncSetAttribute((const void*)mk_fwd, hipFuncAttributeMaxDynamicSharedMemorySize, LDS_BYTES) != hipSuccess) { fprintf(stderr, "kernel_launch: hipFuncSetAttribute failed\n"); grid = -1; return; }
        if (hipOccupancyMaxActiveBlocksPerMultiprocessor(&per_cu, (const void*)mk_fwd, NWAVES * 64, LDS_BYTES) != hipSuccess || per_cu < 1) { fprintf(stderr, "kernel_launch: occupancy query says %d\n", per_cu); per_cu = 1; }
        (void)hipGetLastError();
        grid = cus;
        if (grid > 256) grid = 256;
    }
    if (grid < 0) return;
    (void)hipMemsetAsync((char*)d_ws + WS_CTL, 0, CTL_ZERO_BYTES, stream);
    Args a{};
    for (int i = 0; i < 26; ++i) a.in[i] = (const float*)d_in[i];
    a.out = (float*)d_out; a.ws = (unsigned char*)d_ws;
    if (MK_N_LAUNCHES == 1) { a.ph_lo = 0; a.ph_hi = NPHASE; a.li = 0; hipLaunchKernelGGL(mk_fwd, dim3(grid), dim3(NWAVES * 64), LDS_BYTES, stream, a); }
    else for (int li = 0; li < NPHASE; ++li) { a.ph_lo = li; a.ph_hi = li + 1; a.li = li; hipLaunchKernelGGL(mk_fwd, dim3(grid), dim3(NWAVES * 64), LDS_BYTES, stream, a); }
}
```

```cpp
#include <hip/hip_runtime.h>
#include <cstdio>
#include <cstdint>

#ifndef MK_N_LAUNCHES
#define MK_N_LAUNCHES 1
#endif

namespace pg8 {
#define PG8_LAS __attribute__((address_space(3)))
typedef unsigned short bf16_t;
typedef short bf16x8 __attribute__((ext_vector_type(8)));
typedef float f32x4 __attribute__((ext_vector_type(4)));
typedef unsigned u32x4 __attribute__((ext_vector_type(4)));
constexpr int BM = 256, BK = 64, HALF = 128, HTB = HALF * BK * 2, STAGE_BYTES = 8 * HTB, NXCD = 8, WGM = 4, MP = 16384;

__host__ __device__ __forceinline__ int lds_byte(int r, int c) { const int st = (r >> 4) * 2 + (c >> 5), rr = r & 15, cc = c & 31, ob = rr * 64 + cc * 2; return st * 1024 + (ob ^ (((ob >> 9) & 1) << 5)); }
__host__ __device__ __forceinline__ void stage_rc(int b, int& R, int& C) { const int st = b / 1024, sb = b % 1024, swz = sb ^ (((sb >> 9) & 1) << 5); R = (st >> 1) * 16 + swz / 64; C = (st & 1) * 32 + (swz % 64) / 2; }
__host__ __device__ __forceinline__ int perm32(int rho) { const int n = rho >> 4, i = rho & 15; return 8 * (i >> 2) + 4 * n + (i & 3); }

struct Unit { int pm, pn; };
struct Gemm { const bf16_t* A; const bf16_t* Bt; int M, N, K; };

struct StaticOrder {
    int nM, nN, nwg, G, c;
    __host__ __device__ void init(int M, int N, int G_, int c_) { nM = M / BM; nN = N / BM; nwg = nM * nN; G = G_; c = c_; }
    __host__ __device__ bool next(int i, Unit& u) const {
        const long L = (long)i * G + c; if (L >= nwg) return false;
        int wgid = (int)L; { const int q = nwg / NXCD, r = nwg % NXCD, xcd = wgid % NXCD, off = wgid / NXCD; wgid = (xcd < r ? xcd * (q + 1) : r * (q + 1) + (xcd - r) * q) + off; }
        const int nig = WGM * nN, gid = wgid / nig, fm = gid * WGM, gsz = (nM - fm) < WGM ? (nM - fm) : WGM;
        u.pm = fm + ((wgid % nig) % gsz); u.pn = (wgid % nig) / gsz; return true;
    }
    __device__ __forceinline__ void a_ready(const Unit&) const {}
    __device__ __forceinline__ void done(const Unit&) const {}
};

__device__ __forceinline__ unsigned cvt_pk_bf16(float lo, float hi) { unsigned r; asm volatile("v_cvt_pk_bf16_f32 %0, %1, %2" : "=v"(r) : "v"(lo), "v"(hi)); return r; }


template <class Epi, class Sched, bool ALIGN_EPI = false, bool SP2 = false>
__device__ __forceinline__ void gemm_phase(PG8_LAS unsigned char* lds, const Gemm g, const Sched& S, const Epi& E) {
    int tid_ = threadIdx.x; asm volatile("" : "+v"(tid_));
    const int tid = tid_, wid = __builtin_amdgcn_readfirstlane(tid >> 6), lane = tid & 63, wr = wid >> 2, wc = wid & 3, fr = lane & 15, fq = lane >> 4;
    const int K = g.K, nt = K / BK;
    unsigned voffA[2], voffB[2];
#pragma unroll
    for (int i = 0; i < 2; ++i) { int R, C; stage_rc(tid * 16 + i * 8192, R, C); const int Rb = Epi::PERM ? ((R & ~31) + perm32(R & 31)) : R;
        voffA[i] = (unsigned)(R * K + C) * 2u; voffB[i] = (unsigned)(Rb * K + C) * 2u; }
    const size_t kstep = (size_t)(BK * 2);
    const size_t hstep = (size_t)HALF * K * 2;
    const size_t tstep = 2 * hstep;
    const unsigned ldsw = (unsigned)wid * 1024u;
    const int aoff = lds_byte(wr * 64 + fr, fq * 8), boff = lds_byte(wc * 32 + fr, fq * 8);
#define PG8_SA(b, h) (((b) * 2 + (h)) * HTB)
#define PG8_SB(b, h) ((4 + (b) * 2 + (h)) * HTB)
#define PG8_STAGE(bufoff, gbase, voff) do { _Pragma("unroll") for (int _i = 0; _i < 2; ++_i) \
        __builtin_amdgcn_global_load_lds((const unsigned*)((const char*)(gbase) + (voff)[_i]), (PG8_LAS unsigned*)(lds + (bufoff) + ldsw + _i * 8192), 16, 0, 0); } while (0)
#define PG8_LDA(dst, b, h) do { _Pragma("unroll") for (int m = 0; m < 4; ++m) _Pragma("unroll") for (int k = 0; k < 2; ++k) dst[m][k] = *(const PG8_LAS bf16x8*)(lds + PG8_SA(b, h) + aoff + m * 2048 + k * 1024); } while (0)
#define PG8_LDB(dst, b, h) do { _Pragma("unroll") for (int n = 0; n < 2; ++n) _Pragma("unroll") for (int k = 0; k < 2; ++k) dst[n][k] = *(const PG8_LAS bf16x8*)(lds + PG8_SB(b, h) + boff + n * 2048 + k * 1024); } while (0)
#define PG8_MMA(ai, bj, At, Bt) do { __builtin_amdgcn_s_setprio(1); _Pragma("unroll") for (int m = 0; m < 4; ++m) _Pragma("unroll") for (int n = 0; n < 2; ++n) _Pragma("unroll") for (int k = 0; k < 2; ++k) \
        acc[ai][bj][m][n] = __builtin_amdgcn_mfma_f32_16x16x32_bf16(Bt[n][k], At[m][k], acc[ai][bj][m][n], 0, 0, 0); __builtin_amdgcn_s_setprio(0); } while (0)
#define PG8_WAIT_V(n) asm volatile("s_waitcnt vmcnt(" #n ")" ::: "memory")
#define PG8_WAIT_L(n) asm volatile("s_waitcnt lgkmcnt(" #n ")" ::: "memory")
#define PG8_BAR __builtin_amdgcn_s_barrier()
#define PG8_SCHED __builtin_amdgcn_sched_barrier(0)
    Unit cur, nxt; int ui = 0;
    if (!S.next(0, cur)) return;
    f32x4 acc[2][2][4][2];
#pragma unroll
    for (int a = 0; a < 2; ++a)
#pragma unroll
        for (int b = 0; b < 2; ++b)
#pragma unroll
            for (int m = 0; m < 4; ++m)
#pragma unroll
                for (int n = 0; n < 2; ++n) acc[a][b][m][n] = (f32x4){0.f, 0.f, 0.f, 0.f};
    bf16x8 At[4][2], B0[2][2], B1[2][2];
    const char* cA = (const char*)g.A + (size_t)cur.pm * tstep; const char* cB = (const char*)g.Bt + (size_t)cur.pn * tstep;
    S.a_ready(cur);
    if constexpr (SP2) {
        PG8_STAGE(PG8_SB(0, 0), cB, voffB); PG8_STAGE(PG8_SB(0, 1), cB + hstep, voffB); PG8_STAGE(PG8_SA(0, 0), cA, voffA); PG8_STAGE(PG8_SA(0, 1), cA + hstep, voffA);
        if (wr == 1) PG8_BAR;
        PG8_WAIT_V(2); PG8_BAR;
        PG8_STAGE(PG8_SB(1, 0), cB + kstep, voffB); PG8_STAGE(PG8_SA(1, 0), cA + kstep, voffA); PG8_STAGE(PG8_SB(1, 1), cB + hstep + kstep, voffB);
        PG8_WAIT_V(6); PG8_BAR;
    } else {
        PG8_STAGE(PG8_SB(0, 0), cB, voffB); PG8_STAGE(PG8_SA(0, 0), cA, voffA); PG8_STAGE(PG8_SB(0, 1), cB + hstep, voffB); PG8_STAGE(PG8_SA(0, 1), cA + hstep, voffA);
        if (wr == 1) PG8_BAR;
        PG8_WAIT_V(4); PG8_BAR;
        PG8_STAGE(PG8_SB(1, 0), cB + kstep, voffB); PG8_STAGE(PG8_SA(1, 0), cA + kstep, voffA); PG8_STAGE(PG8_SB(1, 1), cB + hstep + kstep, voffB);
        PG8_WAIT_V(6); PG8_BAR;
    }
    for (;;) {
        const bool has_next = S.next(ui + 1, nxt);
        const char* nA = has_next ? (const char*)g.A + (size_t)nxt.pm * tstep : cA; const char* nB = has_next ? (const char*)g.Bt + (size_t)nxt.pn * tstep : cB;
        for (int t = 0; t < nt; t += 2) {
            const bool last = (t == nt - 2);
            const char* a1 = cA + (size_t)(t + 1) * kstep;
            const char* a2 = last ? nA : cA + (size_t)(t + 2) * kstep; const char* b2 = last ? nB : cB + (size_t)(t + 2) * kstep;
            const char* a3 = a2 + kstep; const char* b3 = b2 + kstep;
            if (last && has_next) S.a_ready(nxt);
            const bool fullm = cur.pm < MP / BM;
            if constexpr (SP2) {
            PG8_LDB(B0, 0, 0); PG8_LDB(B1, 0, 1); PG8_SCHED; PG8_LDA(At, 0, 0); PG8_STAGE(PG8_SA(1, 1), a1 + hstep, voffA);
            PG8_WAIT_V(8); PG8_WAIT_L(0); PG8_BAR; PG8_MMA(0, 0, At, B0); PG8_MMA(0, 1, At, B1); PG8_BAR; PG8_SCHED;
            PG8_LDA(At, 0, 1); PG8_STAGE(PG8_SB(0, 0), b2, voffB); PG8_STAGE(PG8_SB(0, 1), b2 + hstep, voffB); PG8_STAGE(PG8_SA(0, 0), a2, voffA);
            PG8_WAIT_V(8); PG8_WAIT_L(0); PG8_BAR; if (fullm) { PG8_MMA(1, 0, At, B0); PG8_MMA(1, 1, At, B1); } PG8_BAR; PG8_SCHED;
            PG8_LDB(B0, 1, 0); PG8_LDB(B1, 1, 1); PG8_SCHED; PG8_LDA(At, 1, 0); PG8_STAGE(PG8_SA(0, 1), a2 + hstep, voffA);
            PG8_WAIT_V(8); PG8_WAIT_L(0); PG8_BAR; PG8_MMA(0, 0, At, B0); PG8_MMA(0, 1, At, B1); PG8_BAR; PG8_SCHED;
            PG8_LDA(At, 1, 1); PG8_STAGE(PG8_SB(1, 0), b3, voffB); PG8_STAGE(PG8_SB(1, 1), b3 + hstep, voffB); PG8_STAGE(PG8_SA(1, 0), a3, voffA);
            PG8_WAIT_V(8); PG8_WAIT_L(0); PG8_BAR; if (fullm) { PG8_MMA(1, 0, At, B0); PG8_MMA(1, 1, At, B1); } PG8_BAR; PG8_SCHED;
            } else {
            PG8_LDB(B0, 0, 0); PG8_SCHED; PG8_LDA(At, 0, 0); PG8_STAGE(PG8_SA(1, 1), a1 + hstep, voffA);
            PG8_WAIT_L(8); PG8_BAR; PG8_WAIT_L(0); PG8_MMA(0, 0, At, B0); PG8_BAR; PG8_SCHED;
            PG8_LDB(B1, 0, 1); PG8_STAGE(PG8_SB(0, 0), b2, voffB);
            PG8_BAR; PG8_WAIT_L(0); PG8_MMA(0, 1, At, B1); PG8_BAR;
            PG8_LDA(At, 0, 1); PG8_STAGE(PG8_SA(0, 0), a2, voffA);
            PG8_BAR; PG8_WAIT_L(0); PG8_MMA(1, 0, At, B0); PG8_BAR; PG8_SCHED;
            PG8_STAGE(PG8_SB(0, 1), b2 + hstep, voffB);
            PG8_WAIT_V(6); PG8_BAR; PG8_MMA(1, 1, At, B1); PG8_BAR;
            PG8_LDB(B0, 1, 0); PG8_SCHED; PG8_LDA(At, 1, 0); PG8_STAGE(PG8_SA(0, 1), a2 + hstep, voffA);
            PG8_WAIT_L(8); PG8_BAR; PG8_WAIT_L(0); PG8_MMA(0, 0, At, B0); PG8_BAR; PG8_SCHED;
            PG8_LDB(B1, 1, 1); PG8_STAGE(PG8_SB(1, 0), b3, voffB);
            PG8_BAR; PG8_WAIT_L(0); PG8_MMA(0, 1, At, B1); PG8_BAR;
            PG8_LDA(At, 1, 1); PG8_STAGE(PG8_SA(1, 0), a3, voffA);
            PG8_BAR; PG8_WAIT_L(0); PG8_MMA(1, 0, At, B0); PG8_BAR; PG8_SCHED;
            PG8_STAGE(PG8_SB(1, 1), b3 + hstep, voffB);
            PG8_WAIT_V(6); PG8_BAR; PG8_MMA(1, 1, At, B1); PG8_BAR;
            }
        }
        if constexpr (ALIGN_EPI) { if (wr == 0) PG8_BAR; }
        E(acc, cur, wr, wc, fr, fq); S.done(cur);
        if (!has_next) break;
#pragma unroll
        for (int a = 0; a < 2; ++a)
#pragma unroll
            for (int b = 0; b < 2; ++b)
#pragma unroll
                for (int m = 0; m < 4; ++m)
#pragma unroll
                    for (int n = 0; n < 2; ++n) acc[a][b][m][n] = (f32x4){0.f, 0.f, 0.f, 0.f};
        cur = nxt; cA = nA; cB = nB; ++ui;
        if constexpr (ALIGN_EPI) { if (wr == 1) PG8_BAR; }
    }
    PG8_WAIT_V(0);
    if constexpr (!ALIGN_EPI) { if (wr == 0) PG8_BAR; }
    PG8_BAR;
#undef PG8_SA
#undef PG8_SB
#undef PG8_STAGE
#undef PG8_LDA
#undef PG8_LDB
#undef PG8_MMA
#undef PG8_WAIT_V
#undef PG8_WAIT_L
#undef PG8_BAR
#undef PG8_SCHED
}
}

#ifndef PG8_SP2
#define PG8_SP2 true
#endif
#ifndef PG8_ALIGN
#define PG8_ALIGN true
#endif

constexpr int NWAVES = 8;
constexpr int D = 1024, SEQ = 2048, NB = 8, MP = NB * SEQ  , MSMP = 128  , MV = MP + MSMP  , MR = 16640  ;
constexpr int FF = 4096, DPLE = 256, NCH = SEQ / 64  ;
constexpr int PS = 3840;
constexpr int C_MQ = 0, C_MK = 512, C_MV = 1024, C_MO = 1536, C_GQ = 2048, C_GK = 2304, C_GV = 2560, C_GR = 3072, C_SM = 3584;
constexpr float EPS = 1e-6f;
constexpr size_t O_YP = 0, O_YS = 16777216, O_CP = 16908288, O_NP = 17432576, O_MP = 17436672, O_CVP = 17436704, O_SP = 17461280,
                 O_CS = 17723424, O_NS = 26112032, O_MS = 26177568, O_CVS = 26178080, O_SS = 26571296;
constexpr size_t MiB = 1u << 20;
constexpr size_t WS_CTL = 0, CTL_ZERO_BYTES = 1 * MiB;
constexpr size_t CTL_BAR_B = 16384, CTL_SS1_B = 262144, CTL_SS2_B = 393216, CTL_SS3_B = 524288;
constexpr size_t WS_WIN = 1 * MiB, WS_WOUT = 9 * MiB, WS_W1 = 11 * MiB, WS_W2 = 19 * MiB, WS_WPG = 27 * MiB, WS_WPLE = 29 * MiB;
constexpr size_t WS_PB = 30 * MiB, WS_NC = 39 * MiB, WS_MC = WS_NC + 512 * 1024, WS_R1 = 40 * MiB, WS_R2 = 73 * MiB, WS_CSM = 195 * MiB, WS_CSG = 227 * MiB;
constexpr size_t WS_X1B = WS_R2, WS_U = 106 * MiB, WS_PP = 106 * MiB, WS_END = 243 * MiB;
static_assert(WS_R2 + (size_t)MR * PS * 2 <= WS_CSM && WS_R1 + (size_t)MR * D * 2 <= WS_R2 && WS_U + (size_t)MR * FF * 2 <= WS_END && WS_X1B + (size_t)MR * D * 2 <= WS_U && WS_PB + (size_t)MR * DPLE * 2 <= WS_NC, "ws map");
constexpr size_t SC_QP = 0, SC_KW = (size_t)MP * 512, SC_QG = (size_t)MP * 1024, SC_KG = (size_t)MP * 1280;
static_assert((SC_KG + (size_t)MP * 256) * 2 <= (size_t)MP * D * 4, "P2 scratch inside y_prompt");
constexpr size_t WS_GA = 244 * MiB, WS_GB = WS_GA + 256 * 1024, WS_EBL = WS_GB + 256 * 1024, WS_PMX = WS_EBL + 256 * 1024, WS_BLS = WS_PMX + 4096;
constexpr int LDS_BYTES = 147456, MISC_OFF = LDS_BYTES - 256;

#define GAS __attribute__((address_space(1)))
#define LAS __attribute__((address_space(3)))
typedef unsigned short bf16;
typedef unsigned v4u __attribute__((ext_vector_type(4)));
typedef unsigned v2u __attribute__((ext_vector_type(2)));
typedef float f32x4 __attribute__((ext_vector_type(4)));
typedef short bf16x8 __attribute__((ext_vector_type(8)));
typedef GAS unsigned gu32;
#define RLX_AGENT __ATOMIC_RELAXED, __HIP_MEMORY_SCOPE_AGENT
#define LDS_WAIT() asm volatile("s_waitcnt lgkmcnt(0)" ::: "memory")
#define VM_WAIT() asm volatile("s_waitcnt vmcnt(0)" ::: "memory")
#define LBAR() do { asm volatile("s_waitcnt lgkmcnt(0)" ::: "memory"); __builtin_amdgcn_s_barrier(); asm volatile("" ::: "memory"); } while (0)
__device__ __forceinline__ unsigned f2bf(float f) { unsigned u = __builtin_bit_cast(unsigned, f); return (u + 0x7fffu + ((u >> 16) & 1u)) >> 16; }
__device__ __forceinline__ unsigned pk2(float lo, float hi) { unsigned r; asm volatile("v_cvt_pk_bf16_f32 %0, %1, %2" : "=v"(r) : "v"(lo), "v"(hi)); return r; }
__device__ __forceinline__ float bf2f(unsigned b) { return __builtin_bit_cast(float, b << 16); }
__device__ __forceinline__ float bflo(unsigned w) { return __builtin_bit_cast(float, w << 16); }
__device__ __forceinline__ float bfhi(unsigned w) { return __builtin_bit_cast(float, w & 0xffff0000u); }
__device__ __forceinline__ float logsig(float x) { return fminf(x, 0.f) - __logf(1.f + __expf(-fabsf(x))); }
__device__ __forceinline__ float sigmoidf(float x) { return __builtin_amdgcn_rcpf(1.f + __expf(-x)); }
__device__ __forceinline__ float rsqrt_fast(float x) { return __builtin_amdgcn_rsqf(x); }

#define XB_TMO      128
#define XB_XCNT(j)  (256  + 64 * (j))
#define XB_XSUB(j)  (1280 + 64 * (j))
#define XB_XGEN(j)  (2304 + 64 * (j))
#define XB_TOP      3328
#define XB_TOPGEN   3392
#define XCD_BAR_WORDS 3456
#define XB_SPIN_CAP (1u << 22)
__device__ __forceinline__ unsigned xb_ld(unsigned* p)              { return __hip_atomic_load(p, __ATOMIC_RELAXED, __HIP_MEMORY_SCOPE_AGENT); }
__device__ __forceinline__ unsigned xb_add(unsigned* p, unsigned v) { return __hip_atomic_fetch_add(p, v, __ATOMIC_RELAXED, __HIP_MEMORY_SCOPE_AGENT); }
__device__ __forceinline__ unsigned xb_xcc_id() { return (unsigned)__builtin_amdgcn_s_getreg((3 << 11) | 20) & 0xFu; }
#define XB_SPIN(cond, bar) do { unsigned _sp = 0; while (cond) { __builtin_amdgcn_s_sleep(1); \
    if ((++_sp & 255u) == 0u) { if (xb_ld(&(bar)[XB_TMO])) break; if (_sp > XB_SPIN_CAP) { atomicAdd(&(bar)[XB_TMO], 1u); break; } } } } while (0)
struct XcdBarrier { unsigned* bar; unsigned x; volatile LAS unsigned* st; };
__device__ __forceinline__ XcdBarrier xcd_barrier_post(unsigned* bar, volatile LAS unsigned* st) {
    XcdBarrier b; b.bar = bar; b.x = xb_xcc_id(); b.st = st;
    if (threadIdx.x == 0) (void)xb_add(&bar[XB_XCNT(b.x)], 1u);
    return b;
}
__device__ __forceinline__ void xcd_barrier_complete(unsigned* bar, unsigned x, unsigned& nloc, unsigned& nx) {
    const unsigned G = gridDim.x * gridDim.y * gridDim.z;
    unsigned sum, cnt, mine, sp = 0u;
    for (;;) {
        sum = 0u; cnt = 0u; mine = 0u;
#pragma unroll
        for (unsigned j = 0; j < 16; ++j) { const unsigned c = xb_ld(&bar[XB_XCNT(j)]); sum += c; cnt += (c > 0u) ? 1u : 0u; mine = (j == x) ? c : mine; }
        if (sum == G) break;
        __builtin_amdgcn_s_sleep(1);
        if ((++sp & 255u) == 0u) { if (xb_ld(&bar[XB_TMO])) break; if (sp > XB_SPIN_CAP) { atomicAdd(&bar[XB_TMO], 1u); break; } }
    }
    nloc = mine > 0u ? mine : 1u; nx = cnt > 0u ? cnt : 1u;
}
__device__ __forceinline__ void xcd_barrier(const XcdBarrier& b) {
    asm volatile("s_waitcnt vmcnt(0)" ::: "memory");
    __syncthreads();
    if (threadIdx.x == 0) {
        unsigned* bar = b.bar;
        __builtin_amdgcn_s_waitcnt(0);
        unsigned nloc = b.st[0], nx = b.st[1];
        if (nloc == 0u) { xcd_barrier_complete(bar, b.x, nloc, nx); b.st[0] = nloc; b.st[1] = nx; }
        const unsigned old = xb_add(&bar[XB_XSUB(b.x)], 1u);
        const unsigned gen = old / nloc;
        if (old + 1u == (gen + 1u) * nloc) {
            __builtin_amdgcn_fence(__ATOMIC_RELEASE, "agent");
            asm volatile("s_waitcnt vmcnt(0)" ::: "memory");
            const unsigned og = xb_add(&bar[XB_TOP], 1u);
            const unsigned tg = og / nx;
            if (og + 1u == (tg + 1u) * nx) xb_add(&bar[XB_TOPGEN], 1u);
            else XB_SPIN(xb_ld(&bar[XB_TOPGEN]) == tg, bar);
            __builtin_amdgcn_fence(__ATOMIC_ACQUIRE, "agent");
            xb_add(&bar[XB_XGEN(b.x)], 1u);
            asm volatile("s_waitcnt vmcnt(0)" ::: "memory");
        } else {
            XB_SPIN(xb_ld(&bar[XB_XGEN(b.x)]) == gen, bar);
            __builtin_amdgcn_fence(__ATOMIC_ACQUIRE, "agent");
            asm volatile("s_waitcnt vmcnt(0)" ::: "memory");
        }
    }
    __syncthreads();
}

struct Args { const float* in[26]; float* out; unsigned char* ws; int ph_lo, ph_hi, li, pad; };
typedef const Args __attribute__((address_space(4))) CArgs;
struct Frame {
    LAS unsigned char* lds;
    char* ldsg;
    int G;
    CArgs* a;
};
#define F_TID ((int)threadIdx.x)
#define F_LANE ((int)(threadIdx.x & 63))
#define F_WAVE (__builtin_amdgcn_readfirstlane((int)(threadIdx.x >> 6)))
#define IN_F(k) (F.a->in[k])
#define X_P IN_F(0)
#define X_S IN_F(1)
#define P_P IN_F(2)
#define P_S IN_F(3)
#define ST_C IN_F(4)
#define ST_N IN_F(5)
#define ST_M IN_F(6)
#define ST_CONV IN_F(7)
#define ST_S IN_F(8)
#define W_IN IN_F(9)
#define CONV_W IN_F(10)
#define CONV_B IN_F(11)
#define B_GATE CONSTF(IN_F(12))
#define W_A2 CONSTF(IN_F(13))
#define B_A CONSTF(IN_F(14))
#define G_MHEAD IN_F(15)
#define G_GHEAD IN_F(16)
#define W_OUT IN_F(17)
#define G_MIX IN_F(18)
#define G_MLP IN_F(19)
#define W1 IN_F(20)
#define W2 IN_F(21)
#define G_PLE IN_F(22)
#define W_PLE IN_F(23)
#define W_PG IN_F(24)
#define G_FINAL IN_F(25)
typedef const float __attribute__((address_space(4))) cfloat;
#define CONSTF(p) ((cfloat*)(unsigned long long)(p))
#define OUTP (F.a->out)
#define WSB (F.a->ws)
#define WIN_T ((bf16*)(WSB + WS_WIN))
#define WOUT_T ((bf16*)(WSB + WS_WOUT))
#define W1_T ((bf16*)(WSB + WS_W1))
#define W2_T ((bf16*)(WSB + WS_W2))
#define WPG_T ((bf16*)(WSB + WS_WPG))
#define WPLE_T ((bf16*)(WSB + WS_WPLE))
#define PBUF ((bf16*)(WSB + WS_PB))
#define R1B ((bf16*)(WSB + WS_R1))
#define PROJ ((bf16*)(WSB + WS_R2))
#define X1B ((bf16*)(WSB + WS_X1B))
#define UBUF ((bf16*)(WSB + WS_U))
#define CSM ((bf16*)(WSB + WS_CSM))
#define CSG ((bf16*)(WSB + WS_CSG))
#define NCS ((float*)(WSB + WS_NC))
#define MCS ((float*)(WSB + WS_MC))
#define SS1 ((float*)(WSB + CTL_SS1_B))
#define SS2 ((float*)(WSB + CTL_SS2_B))
#define SS3 ((float*)(WSB + CTL_SS3_B))
#define PPB ((bf16*)(WSB + WS_PP))
#define GA_A ((float*)(WSB + WS_GA))
#define GA_B ((float*)(WSB + WS_GB))
#define EBLG ((float*)(WSB + WS_EBL))
#define PMXG ((float*)(WSB + WS_PMX))
#define BLSG ((float*)(WSB + WS_BLS))
#define SCR ((bf16*)OUTP)

__device__ __forceinline__ float wave_sum(float v) {
#pragma unroll
    for (int o = 1; o < 64; o <<= 1) v += __shfl_xor(v, o);
    return v;
}
__device__ __forceinline__ float wave_max(float v) {
#pragma unroll
    for (int o = 1; o < 64; o <<= 1) v = fmaxf(v, __shfl_xor(v, o));
    return v;
}
template <int CTRL, int ROWMASK> __device__ __forceinline__ float dpp_f(float idv, float v) {
    return __builtin_bit_cast(float, __builtin_amdgcn_update_dpp(__builtin_bit_cast(int, idv), __builtin_bit_cast(int, v), CTRL, ROWMASK, 0xf, false));
}
__device__ __forceinline__ float wave_scan_sum(float v, int) {
    v += dpp_f<0x111, 0xf>(0.f, v); v += dpp_f<0x112, 0xf>(0.f, v); v += dpp_f<0x114, 0xf>(0.f, v); v += dpp_f<0x118, 0xf>(0.f, v);
    v += dpp_f<0x142, 0xa>(0.f, v); v += dpp_f<0x143, 0xc>(0.f, v);
    return v;
}
__device__ __forceinline__ float wave_scan_max(float v, int) {
    const float ninf = -__builtin_inff();
    v = fmaxf(v, dpp_f<0x111, 0xf>(ninf, v)); v = fmaxf(v, dpp_f<0x112, 0xf>(ninf, v)); v = fmaxf(v, dpp_f<0x114, 0xf>(ninf, v)); v = fmaxf(v, dpp_f<0x118, 0xf>(ninf, v));
    v = fmaxf(v, dpp_f<0x142, 0xa>(ninf, v)); v = fmaxf(v, dpp_f<0x143, 0xc>(ninf, v));
    return v;
}

__device__ __forceinline__ int win_src_col(int np) {
    if (np < 2048) return np;
    if (np < 3584) return np + 8;
    const int j = np - 3584;
    if (j < 8) return 2048 + j;
    if (j < 24) return 3592 + (j - 8);
    return -1;
}
template <int MODE>
__device__ __forceinline__ void p0_transpose_item(const float* W, int K, int N, bf16* WT, const float* gain, LAS float* scr, int item, int nblk, int lane) {
    const int kb = item / nblk, nb = item % nblk, k0 = 64 * kb, n0 = 32 * nb;
    if (MODE == 1 && n0 >= 3584) {
        const int src = win_src_col(n0 + (lane & 31));
#pragma unroll 8
        for (int i = 0; i < 32; ++i) { const int kk = 2 * i + (lane >> 5); float v = 0.f; if (src >= 0) v = W[(size_t)(k0 + kk) * N + src] * gain[k0 + kk]; scr[kk * 33 + (lane & 31)] = v; }
    } else {
        const int s0 = (MODE == 1 && n0 >= 2048) ? n0 + 8 : n0; const float cs = (MODE == 1 && n0 >= C_GQ && n0 < C_GK) ? 0.125f : 1.f;
        const int n4 = lane & 7, kq = lane >> 3;
        f32x4 v[8];
#pragma unroll
        for (int i = 0; i < 8; ++i) v[i] = *(const f32x4*)(W + (size_t)(k0 + kq + 8 * i) * N + s0 + 4 * n4);
#pragma unroll
        for (int i = 0; i < 8; ++i) { const int kk = kq + 8 * i; const float gsc = gain ? gain[k0 + kk] * cs : cs; LAS float* d = scr + kk * 33 + 4 * n4;
            d[0] = v[i][0] * gsc; d[1] = v[i][1] * gsc; d[2] = v[i][2] * gsc; d[3] = v[i][3] * gsc; }
    }
    LDS_WAIT(); asm volatile("" ::: "memory");
    const int c = lane & 7;
#pragma unroll
    for (int j = 0; j < 4; ++j) { const int n = (lane >> 3) + 8 * j; const LAS float* s = scr + (8 * c) * 33 + n;
        v4u o; o.x = pk2(s[0 * 33], s[1 * 33]); o.y = pk2(s[2 * 33], s[3 * 33]); o.z = pk2(s[4 * 33], s[5 * 33]); o.w = pk2(s[6 * 33], s[7 * 33]);
        *(GAS v4u*)(WT + (size_t)(n0 + n) * K + k0 + 8 * c) = o; }
    LDS_WAIT(); asm volatile("" ::: "memory");
}
__device__ __forceinline__ void p0_prologue(Frame& F) {
    LAS float* scr = (LAS float*)(F.lds + F_WAVE * 16384);
    const int gw = blockIdx.x * NWAVES + F_WAVE, NGW = F.G * NWAVES, lane = F_LANE;
    for (int m0 = gw; m0 < MV; m0 += 4 * NGW) {
        f32x4 v[4][4]; f32x4 pv[4];
#pragma unroll
        for (int q = 0; q < 4; ++q) { const int m = m0 + q * NGW; if (m < MV) {
            const float* xrow = m < MP ? X_P + (size_t)m * D : X_S + (size_t)(m - MP) * D; const float* prow = m < MP ? P_P + (size_t)m * DPLE : P_S + (size_t)(m - MP) * DPLE;
#pragma unroll
            for (int j = 0; j < 4; ++j) v[q][j] = ((const GAS f32x4*)xrow)[lane + 64 * j];
            pv[q] = ((const GAS f32x4*)prow)[lane]; } }
#pragma unroll
        for (int q = 0; q < 4; ++q) { const int m = m0 + q * NGW; if (m < MV) {
            float s = 0.f;
#pragma unroll
            for (int j = 0; j < 4; ++j) s += (v[q][j].x * v[q][j].x + v[q][j].y * v[q][j].y) + (v[q][j].z * v[q][j].z + v[q][j].w * v[q][j].w);
            const float r = rsqrt_fast(wave_sum(s) * (1.f / D) + EPS);
            GAS unsigned long long* o8 = (GAS unsigned long long*)(R1B + (size_t)m * D) + lane;
#pragma unroll
            for (int j = 0; j < 4; ++j) o8[64 * j] = (unsigned long long)pk2(v[q][j].x * r, v[q][j].y * r) | ((unsigned long long)pk2(v[q][j].z * r, v[q][j].w * r) << 32);
            ((GAS unsigned long long*)(PBUF + (size_t)m * DPLE))[lane] = (unsigned long long)pk2(pv[q].x, pv[q].y) | ((unsigned long long)pk2(pv[q].z, pv[q].w) << 32); } }
    }
    constexpr int NB_IN = PS / 32, I_IN = (D / 64) * NB_IN;
    for (int it = gw; it < I_IN; it += NGW) p0_transpose_item<1>(W_IN, D, 3608, WIN_T, G_MIX, scr, it, NB_IN, lane);
}
__device__ __forceinline__ void late_weight_copies(Frame& F, int wg, int nwg) {
    LAS float* scr = (LAS float*)(F.lds + F_WAVE * 16384);
    const int gw = wg * NWAVES + F_WAVE, NGW = nwg * NWAVES, lane = F_LANE;
    constexpr int NB_D = D / 32, NB_FF = FF / 32;
    constexpr int I_OUT = (D / 64) * NB_D, I_1 = (D / 64) * NB_FF, I_2 = (FF / 64) * NB_D, I_PG = I_OUT, I_PLE = (DPLE / 64) * NB_D;
    constexpr int NITEMS = I_OUT + I_1 + I_2 + I_PG + I_PLE;
    for (int it = gw; it < NITEMS; it += NGW) {
        int r = it;
        if (r < I_OUT) { p0_transpose_item<0>(W_OUT, D, D, WOUT_T, nullptr, scr, r, NB_D, lane); continue; } r -= I_OUT;
        if (r < I_1) { p0_transpose_item<0>(W1, D, FF, W1_T, G_MLP, scr, r, NB_FF, lane); continue; } r -= I_1;
        if (r < I_2) { p0_transpose_item<0>(W2, FF, D, W2_T, nullptr, scr, r, NB_D, lane); continue; } r -= I_2;
        if (r < I_PG) { p0_transpose_item<0>(W_PG, D, D, WPG_T, G_PLE, scr, r, NB_D, lane); continue; } r -= I_PG;
        p0_transpose_item<0>(W_PLE, DPLE, D, WPLE_T, nullptr, scr, r, NB_D, lane);
    }
}

struct EpiProj {
    static constexpr bool PERM = true;
    bf16* O; int ldc;
    __device__ __forceinline__ void operator()(const f32x4 (&acc)[2][2][4][2], const pg8::Unit& u, int wr, int wc, int fr, int fq) const {
        const int row0 = u.pm * 256 + wr * 64 + fr, col0 = u.pn * 256 + wc * 32 + 8 * fq;
#pragma unroll
        for (int ai = 0; ai < 2; ++ai)
#pragma unroll
            for (int m = 0; m < 4; ++m) { bf16* rowp = O + (size_t)(row0 + ai * 128 + m * 16) * ldc + col0;
#pragma unroll
                for (int bj = 0; bj < 2; ++bj) { const f32x4 v0 = acc[ai][bj][m][0], v1 = acc[ai][bj][m][1];
                    v4u w; w.x = pg8::cvt_pk_bf16(v0[0], v0[1]); w.y = pg8::cvt_pk_bf16(v0[2], v0[3]); w.z = pg8::cvt_pk_bf16(v1[0], v1[1]); w.w = pg8::cvt_pk_bf16(v1[2], v1[3]);
                    *(v4u*)(rowp + bj * 128) = w; } }
    }
};
template <bool RES_BF16> struct EpiRes {
    static constexpr bool PERM = true;
    const void* res; bf16* ob; float* ss;
    __device__ __forceinline__ void operator()(const f32x4 (&acc)[2][2][4][2], const pg8::Unit& u, int wr, int wc, int fr, int fq) const {
        const int row0 = u.pm * 256 + wr * 64 + fr, col0 = u.pn * 256 + wc * 32 + 8 * fq;
#pragma unroll
        for (int ai = 0; ai < 2; ++ai)
#pragma unroll
            for (int m = 0; m < 4; ++m) { const int row = row0 + ai * 128 + m * 16;
                const size_t off = (size_t)row * D + col0;
                float s = 0.f;
#pragma unroll
                for (int bj = 0; bj < 2; ++bj) {
                    f32x4 r0, r1;
                    if constexpr (RES_BF16) { const v4u rw = *(const v4u*)((const bf16*)res + off + bj * 128);
                        r0 = (f32x4){bflo(rw.x), bfhi(rw.x), bflo(rw.y), bfhi(rw.y)}; r1 = (f32x4){bflo(rw.z), bfhi(rw.z), bflo(rw.w), bfhi(rw.w)}; }
                    else { r0 = *(const f32x4*)((const float*)res + off + bj * 128); r1 = *(const f32x4*)((const float*)res + off + bj * 128 + 4); }
                    const f32x4 v0 = acc[ai][bj][m][0] + r0, v1 = acc[ai][bj][m][1] + r1;
                    v4u w; w.x = pg8::cvt_pk_bf16(v0[0], v0[1]); w.y = pg8::cvt_pk_bf16(v0[2], v0[3]); w.z = pg8::cvt_pk_bf16(v1[0], v1[1]); w.w = pg8::cvt_pk_bf16(v1[2], v1[3]);
                    *(v4u*)(ob + off + bj * 128) = w;
                    s += (v0[0] * v0[0] + v0[1] * v0[1]) + (v0[2] * v0[2] + v0[3] * v0[3]) + (v1[0] * v1[0] + v1[1] * v1[1]) + (v1[2] * v1[2] + v1[3] * v1[3]);
                }
                s += __shfl_xor(s, 16); s += __shfl_xor(s, 32);
                if (fq == 0) atomicAdd(ss + row, s);
                asm volatile("" ::: "memory"); }
    }
};
struct EpiU {
    static constexpr bool PERM = true;
    bf16* O; const float* ss;
    __device__ __forceinline__ void operator()(const f32x4 (&acc)[2][2][4][2], const pg8::Unit& u, int wr, int wc, int fr, int fq) const {
        const int row0 = u.pm * 256 + wr * 64 + fr, col0 = u.pn * 256 + wc * 32 + 8 * fq;
#pragma unroll
        for (int ai = 0; ai < 2; ++ai)
#pragma unroll
            for (int m = 0; m < 4; ++m) { const int row = row0 + ai * 128 + m * 16; const float r = rsqrt_fast(ss[row] * (1.f / D) + EPS);
                bf16* rowp = O + (size_t)row * FF + col0;
#pragma unroll
                for (int bj = 0; bj < 2; ++bj) { f32x4 v0 = acc[ai][bj][m][0] * r, v1 = acc[ai][bj][m][1] * r;
#pragma unroll
                    for (int j = 0; j < 4; ++j) { const float a = fmaxf(v0[j], 0.f), b = fmaxf(v1[j], 0.f); v0[j] = a * a; v1[j] = b * b; }
                    v4u w; w.x = pg8::cvt_pk_bf16(v0[0], v0[1]); w.y = pg8::cvt_pk_bf16(v0[2], v0[3]); w.z = pg8::cvt_pk_bf16(v1[0], v1[1]); w.w = pg8::cvt_pk_bf16(v1[2], v1[3]);
                    *(v4u*)(rowp + bj * 128) = w; } }
    }
};
struct EpiPle {
    static constexpr bool PERM = true;
    const bf16* x2b; const bf16* Pp; bf16* x3b; const float* ss2; float* ss3;
    __device__ __forceinline__ void operator()(const f32x4 (&acc)[2][2][4][2], const pg8::Unit& u, int wr, int wc, int fr, int fq) const {
        const int row0 = u.pm * 256 + wr * 64 + fr, col0 = u.pn * 256 + wc * 32 + 8 * fq;
#pragma unroll
        for (int ai = 0; ai < 2; ++ai)
#pragma unroll
            for (int m = 0; m < 4; ++m) { const int row = row0 + ai * 128 + m * 16;
                const float r = rsqrt_fast(ss2[row] * (1.f / D) + EPS);
                float s = 0.f;
#pragma unroll
                for (int bj = 0; bj < 2; ++bj) {
                    const size_t off = (size_t)row * D + col0 + bj * 128;
                    const v4u pw = *(const v4u*)(Pp + off), xw = *(const v4u*)(x2b + off);
                    unsigned o[4];
#pragma unroll
                    for (int n = 0; n < 2; ++n) {
                        const float p0[4] = {bflo(pw[2 * n]), bfhi(pw[2 * n]), bflo(pw[2 * n + 1]), bfhi(pw[2 * n + 1])};
                        const float x0[4] = {bflo(xw[2 * n]), bfhi(xw[2 * n]), bflo(xw[2 * n + 1]), bfhi(xw[2 * n + 1])};
                        float v0[4];
#pragma unroll
                        for (int j = 0; j < 4; ++j) v0[j] = x0[j] + p0[j] * sigmoidf(acc[ai][bj][m][n][j] * r);
                        o[2 * n] = pg8::cvt_pk_bf16(v0[0], v0[1]); o[2 * n + 1] = pg8::cvt_pk_bf16(v0[2], v0[3]);
                        s += (v0[0] * v0[0] + v0[1] * v0[1]) + (v0[2] * v0[2] + v0[3] * v0[3]);
                    }
                    *(v4u*)(x3b + off) = (v4u){o[0], o[1], o[2], o[3]};
                    asm volatile("" ::: "memory");
                }
                s += __shfl_xor(s, 16); s += __shfl_xor(s, 32);
                if (fq == 0) atomicAdd(ss3 + row, s);
                asm volatile("" ::: "memory"); }
    }
};

__device__ __forceinline__ f32x4 mfma16(bf16x8 a, bf16x8 b, f32x4 c) { return __builtin_amdgcn_mfma_f32_16x16x32_bf16(a, b, c, 0, 0, 0); }
__device__ __forceinline__ bf16x8 lds_frag(const char* p) { return *(const bf16x8*)p; }
constexpr int TS = 144;
constexpr int QS_P = 272;
constexpr float KSCALE = 0.08838834764831845f;

__device__ __forceinline__ void p2p_item(Frame& F, int b, int c) {
    float* WKL = (float*)F.ldsg;
    const int tid = F_TID, lane = F_LANE, w = F_WAVE;
    const size_t row0 = (size_t)b * SEQ + c * 64;
    const bf16* P = PROJ;
    if (w < 4) { const int h = w, bh = b * 4 + h; const size_t row = row0 + lane;
        const float ig = bf2f(P[row * PS + C_SM + h]) + B_GATE[h], lf = logsig(bf2f(P[row * PS + C_SM + 4 + h]) + B_GATE[4 + h]);
        const float bc = wave_scan_sum(lf, lane), a = ig - bc; const float pmax = wave_max(a);
        GA_A[(size_t)bh * SEQ + c * 64 + lane] = a; GA_B[(size_t)bh * SEQ + c * 64 + lane] = bc;
        if (lane == 63) { PMXG[bh * NCH + c] = pmax; BLSG[bh * NCH + c] = bc; }
        WKL[h * 64 + lane] = __expf(a - pmax) * KSCALE; }
    {
      constexpr int GP = 528;
      char* QL = F.ldsg + 1024; char* KL = QL + 64 * GP;
#pragma unroll
      for (int i = 0; i < 4; ++i) { const int pc = tid + 512 * i, r_ = pc >> 5, c16 = pc & 31;
          *(v4u*)(QL + r_ * GP + 16 * c16) = *(const v4u*)(P + (row0 + r_) * PS + C_GQ + 8 * c16); *(v4u*)(KL + r_ * GP + 16 * c16) = *(const v4u*)(P + (row0 + r_) * PS + C_GK + 8 * c16); }
      const int hg = w >> 1, d0 = 32 * (w & 1), bh = b * 4 + hg, colb = hg * 64 + d0; const size_t row = row0 + lane;
      const v4u ga0 = *(const v4u*)(P + row * PS + C_SM + 8), ga1 = *(const v4u*)(P + row * PS + C_SM + 16);
      float ga[16];
#pragma unroll
      for (int i = 0; i < 4; ++i) { ga[2 * i] = bflo(ga0[i]); ga[2 * i + 1] = bfhi(ga0[i]); ga[8 + 2 * i] = bflo(ga1[i]); ga[8 + 2 * i + 1] = bfhi(ga1[i]); }
      cfloat* wa = W_A2 + colb; cfloat* ba = B_A + colb; float* ebl = EBLG + (size_t)(bh * NCH + c) * 64 + d0;
      unsigned* myq = (unsigned*)(QL + lane * GP + 2 * colb); unsigned* myk = (unsigned*)(KL + lane * GP + 2 * colb);
      LBAR();
#pragma unroll 1
      for (int j = 0; j < 16; ++j) {
          float z0 = ba[2 * j], z1 = ba[2 * j + 1];
#pragma unroll
          for (int q = 0; q < 16; ++q) { z0 += ga[q] * wa[q * 256 + 2 * j]; z1 += ga[q] * wa[q * 256 + 2 * j + 1]; }
          const float b0 = wave_scan_sum(logsig(z0) * (1.f / 16.f), lane), b1 = wave_scan_sum(logsig(z1) * (1.f / 16.f), lane);
          if (lane == 63) { ebl[2 * j] = __expf(b0); ebl[2 * j + 1] = __expf(b1); }
          const unsigned qw = myq[j], kw = myk[j];
          myq[j] = pk2(bflo(qw) * __expf(b0), bfhi(qw) * __expf(b1)); myk[j] = pk2(bflo(kw) * __expf(-b0), bfhi(kw) * __expf(-b1));
      }
      LBAR();
#pragma unroll
      for (int i = 0; i < 4; ++i) { const int pc = tid + 512 * i, r_ = pc >> 5, c16 = pc & 31;
          *(v4u*)(SCR + SC_QG + (row0 + r_) * 256 + 8 * c16) = *(const v4u*)(QL + r_ * GP + 16 * c16); *(v4u*)(SCR + SC_KG + (row0 + r_) * 256 + 8 * c16) = *(const v4u*)(KL + r_ * GP + 16 * c16); } }
    {
      const int isk = tid >> 8, pc = tid & 255, h = pc >> 6, ch = isk * 512 + 2 * pc;
      float cw[4][2], cb[2];
#pragma unroll
      for (int j = 0; j < 4; ++j) { cw[j][0] = CONV_W[j * 1024 + ch]; cw[j][1] = CONV_W[j * 1024 + ch + 1]; }
      cb[0] = CONV_B[ch]; cb[1] = CONV_B[ch + 1];
      const bf16* src = P + row0 * PS + (isk ? C_MK : C_MQ) + 2 * pc;
      bf16* dst = SCR + (isk ? SC_KW : SC_QP) + row0 * 512 + 2 * pc;
      unsigned cur[19], nxt[16];
#pragma unroll
      for (int i = 0; i < 3; ++i) cur[i] = (c > 0) ? *(const unsigned*)(src + (long)(i - 3) * PS) : 0u;
#pragma unroll
      for (int i = 0; i < 16; ++i) nxt[i] = *(const unsigned*)(src + (long)i * PS);
#pragma unroll 1
      for (int gq = 0; gq < 4; ++gq) {
#pragma unroll
          for (int i = 0; i < 16; ++i) cur[3 + i] = nxt[i];
          if (gq < 3) {
#pragma unroll
              for (int i = 0; i < 16; ++i) nxt[i] = *(const unsigned*)(src + (long)(16 * (gq + 1) + i) * PS);
          }
#pragma unroll
          for (int i = 0; i < 16; ++i) { float a0 = cb[0], a1 = cb[1];
#pragma unroll
              for (int j = 0; j < 4; ++j) { a0 += cw[j][0] * bflo(cur[i + j]); a1 += cw[j][1] * bfhi(cur[i + j]); }
              a0 = a0 * sigmoidf(a0); a1 = a1 * sigmoidf(a1);
              if (isk) { const float wk = WKL[h * 64 + 16 * gq + i]; a0 *= wk; a1 *= wk; }
              *(unsigned*)(dst + (size_t)(16 * gq + i) * 512) = pk2(a0, a1); }
#pragma unroll
          for (int i = 0; i < 3; ++i) cur[i] = cur[16 + i];
      } }
    LBAR();
}

constexpr int NCI = 2;
__device__ __forceinline__ void chain_mlstm(Frame& F, int b, int h, int sl) {
    char* L = F.ldsg;
    constexpr int KT_B = 64 * TS, VT_B = 128 * TS, NP_B = 16 * 64 * 4, BUF_B = KT_B + VT_B + NP_B;
    float* PM = (float*)(L + NCI * BUF_B); float* BLs = PM + 32; float* MCc = BLs + 32; float* CSs = MCc + 40; float* E2s = CSs + 32;
    const int tid = F_TID, lane = F_LANE, w = F_WAVE, r = lane & 15, g = lane >> 4;
    const int bh = b * 4 + h; const size_t rowb = (size_t)b * SEQ;
    if (tid < 32) { PM[tid] = PMXG[bh * NCH + tid]; BLs[tid] = BLSG[bh * NCH + tid]; }
    __syncthreads();
    if (tid == 0) { float m = 0.f; for (int c = 0; c < NCH; ++c) { const float M = fmaxf(m, PM[c]); MCc[c] = m; CSs[c] = __expf(m - M); E2s[c] = __expf(PM[c] - M); m = BLs[c] + M; } MCc[32] = m; }
    __syncthreads();
    const int dpk = tid & 31, tg = tid >> 5, dpv = tid & 63, sg = tid >> 6;
    const int dt = w & 3, eb = 4 * (w >> 2);
    f32x4 acc[4];
#pragma unroll
    for (int i = 0; i < 4; ++i) acc[i] = (f32x4){0.f, 0.f, 0.f, 0.f};
    float nst = 0.f;
    unsigned krq[NCI][4], vrq[NCI][8];
    const bf16* kbase = SCR + SC_KW + (rowb + 4 * tg) * 512 + h * 128 + 64 * sl + 2 * dpk; const bf16* vbase = PROJ + (rowb + 8 * sg) * PS + C_MV + h * 128 + 2 * dpv;
#pragma unroll
    for (int q = 0; q < NCI; ++q) {
#pragma unroll
        for (int i = 0; i < 4; ++i) krq[q][i] = *(const unsigned*)(kbase + (size_t)(64 * q + i) * 512);
#pragma unroll
        for (int i = 0; i < 8; ++i) vrq[q][i] = *(const unsigned*)(vbase + (size_t)(64 * q + i) * PS);
    }
    for (int c0 = 0; c0 < NCH; c0 += NCI) {
#pragma unroll
        for (int q = 0; q < NCI; ++q) { char* KT = L + q * BUF_B; char* VT = KT + KT_B; float* NP = (float*)(VT + VT_B);
            const unsigned* kr = krq[q]; const unsigned* vr = vrq[q];
            *(v2u*)(KT + (2 * dpk) * TS + 8 * tg) = (v2u){(kr[0] & 0xffffu) | (kr[1] << 16), (kr[2] & 0xffffu) | (kr[3] << 16)};
            *(v2u*)(KT + (2 * dpk + 1) * TS + 8 * tg) = (v2u){(kr[0] >> 16) | (kr[1] & 0xffff0000u), (kr[2] >> 16) | (kr[3] & 0xffff0000u)};
            NP[tg * 64 + 2 * dpk] = (bflo(kr[0]) + bflo(kr[1])) + (bflo(kr[2]) + bflo(kr[3])); NP[tg * 64 + 2 * dpk + 1] = (bfhi(kr[0]) + bfhi(kr[1])) + (bfhi(kr[2]) + bfhi(kr[3]));
            unsigned v0p[4], v1p[4];
#pragma unroll
            for (int i = 0; i < 8; i += 2) { v0p[i >> 1] = (vr[i] & 0xffffu) | (vr[i + 1] << 16); v1p[i >> 1] = (vr[i] >> 16) | (vr[i + 1] & 0xffff0000u); }
            *(v4u*)(VT + (2 * dpv) * TS + 16 * sg) = (v4u){v0p[0], v0p[1], v0p[2], v0p[3]};
            *(v4u*)(VT + (2 * dpv + 1) * TS + 16 * sg) = (v4u){v1p[0], v1p[1], v1p[2], v1p[3]}; }
        if (c0 + NCI < NCH) {
#pragma unroll
            for (int q = 0; q < NCI; ++q) {
#pragma unroll
                for (int i = 0; i < 4; ++i) krq[q][i] = *(const unsigned*)(kbase + (size_t)(64 * (c0 + NCI + q) + i) * 512);
#pragma unroll
                for (int i = 0; i < 8; ++i) vrq[q][i] = *(const unsigned*)(vbase + (size_t)(64 * (c0 + NCI + q) + i) * PS);
            }
        }
        LBAR();
        f32x4 ta[NCI][4];
#pragma unroll
        for (int q = 0; q < NCI; ++q) { const char* KT = L + q * BUF_B; const char* VT = KT + KT_B;
#pragma unroll
            for (int i = 0; i < 4; ++i) ta[q][i] = (f32x4){0.f, 0.f, 0.f, 0.f};
#pragma unroll
            for (int kk = 0; kk < 2; ++kk) {
                const bf16x8 af = lds_frag(KT + (16 * dt + r) * TS + (32 * kk + 8 * g) * 2);
#pragma unroll
                for (int i = 0; i < 4; ++i) ta[q][i] = mfma16(af, lds_frag(VT + (16 * (eb + i) + r) * TS + (32 * kk + 8 * g) * 2), ta[q][i]);
            } }
#pragma unroll
        for (int q = 0; q < NCI; ++q) { const int c = c0 + q;
            { bf16* cst = CSM + (size_t)(bh * NCH + c) * 16384;
#pragma unroll
              for (int i = 0; i < 4; ++i)
                  *(v2u*)(cst + ((eb + i) * 8 + 4 * sl + dt) * 256 + r * 16 + 4 * g) = (v2u){pg8::cvt_pk_bf16(acc[i][0], acc[i][1]), pg8::cvt_pk_bf16(acc[i][2], acc[i][3])};
              if (tid < 64) NCS[(size_t)(bh * NCH + c) * 128 + 64 * sl + tid] = nst;
              if (tid == 0 && sl == 0) MCS[bh * NCH + c] = MCc[c]; }
            const float cs = CSs[c], e2 = E2s[c];
            if (tid < 64) { const float* NP = (const float*)(L + q * BUF_B + KT_B + VT_B); float s = 0.f;
#pragma unroll
                for (int k = 0; k < 16; ++k) s += NP[k * 64 + tid];
                nst = cs * nst + e2 * s; }
#pragma unroll
            for (int i = 0; i < 4; ++i) acc[i] = acc[i] * cs + ta[q][i] * e2; }
        LBAR();
    }
    { float* Co = OUTP + O_CP + (size_t)bh * 16384;
#pragma unroll
      for (int i = 0; i < 4; ++i)
#pragma unroll
          for (int j = 0; j < 4; ++j) Co[(64 * sl + 16 * dt + 4 * g + j) * 128 + 16 * (eb + i) + r] = acc[i][j];
      if (tid < 64) OUTP[O_NP + (size_t)bh * 128 + 64 * sl + tid] = nst;
      if (tid == 0 && sl == 0) OUTP[O_MP + bh] = MCc[32]; }
    __syncthreads();
}

__device__ __forceinline__ void chain_gla(Frame& F, int b, int hg, int sl) {
    char* L = F.ldsg;
    constexpr int KT_B = 32 * TS, VT_B = 128 * TS, BUF_B = KT_B + VT_B;
    const int tid = F_TID, lane = F_LANE, w = F_WAVE, r = lane & 15, g = lane >> 4;
    const int bh = b * 4 + hg; const size_t rowb = (size_t)b * SEQ;
    const int dpv = tid & 63, sg = tid >> 6;
    const int dt = w & 1, eb = 2 * (w >> 1);
    f32x4 acc[2];
    acc[0] = (f32x4){0.f, 0.f, 0.f, 0.f}; acc[1] = acc[0];
    v2u k4q[NCI]; f32x4 ebq[NCI]; unsigned vrq[NCI][8];
    const bf16* kbase = SCR + SC_KG + (rowb + lane) * 256 + hg * 64 + 32 * sl + 4 * w; const bf16* vbase = PROJ + (rowb + 8 * sg) * PS + C_GV + hg * 128 + 2 * dpv;
    const float* ebase = EBLG + (size_t)bh * NCH * 64 + 32 * sl + 16 * dt + 4 * g;
#pragma unroll
    for (int q = 0; q < NCI; ++q) { k4q[q] = *(const v2u*)(kbase + (size_t)(64 * q) * 256); ebq[q] = *(const f32x4*)(ebase + q * 64);
#pragma unroll
        for (int i = 0; i < 8; ++i) vrq[q][i] = *(const unsigned*)(vbase + (size_t)(64 * q + i) * PS); }
    for (int c0 = 0; c0 < NCH; c0 += NCI) {
        f32x4 eb4[NCI];
#pragma unroll
        for (int q = 0; q < NCI; ++q) { char* KT = L + q * BUF_B; char* VT = KT + KT_B; const v2u k4 = k4q[q]; const unsigned* vr = vrq[q]; eb4[q] = ebq[q];
            *(bf16*)(KT + (4 * w + 0) * TS + 2 * lane) = (bf16)(k4[0] & 0xffffu); *(bf16*)(KT + (4 * w + 1) * TS + 2 * lane) = (bf16)(k4[0] >> 16);
            *(bf16*)(KT + (4 * w + 2) * TS + 2 * lane) = (bf16)(k4[1] & 0xffffu); *(bf16*)(KT + (4 * w + 3) * TS + 2 * lane) = (bf16)(k4[1] >> 16);
            unsigned v0p[4], v1p[4];
#pragma unroll
            for (int i = 0; i < 8; i += 2) { v0p[i >> 1] = (vr[i] & 0xffffu) | (vr[i + 1] << 16); v1p[i >> 1] = (vr[i] >> 16) | (vr[i + 1] & 0xffff0000u); }
            *(v4u*)(VT + (2 * dpv) * TS + 16 * sg) = (v4u){v0p[0], v0p[1], v0p[2], v0p[3]};
            *(v4u*)(VT + (2 * dpv + 1) * TS + 16 * sg) = (v4u){v1p[0], v1p[1], v1p[2], v1p[3]}; }
        if (c0 + NCI < NCH) {
#pragma unroll
            for (int q = 0; q < NCI; ++q) { k4q[q] = *(const v2u*)(kbase + (size_t)(64 * (c0 + NCI + q)) * 256); ebq[q] = *(const f32x4*)(ebase + (c0 + NCI + q) * 64);
#pragma unroll
                for (int i = 0; i < 8; ++i) vrq[q][i] = *(const unsigned*)(vbase + (size_t)(64 * (c0 + NCI + q) + i) * PS); }
        }
        LBAR();
        f32x4 ta[NCI][2];
#pragma unroll
        for (int q = 0; q < NCI; ++q) { const char* KT = L + q * BUF_B; const char* VT = KT + KT_B;
            ta[q][0] = (f32x4){0.f, 0.f, 0.f, 0.f}; ta[q][1] = ta[q][0];
#pragma unroll
            for (int kk = 0; kk < 2; ++kk) {
                const bf16x8 af = lds_frag(KT + (16 * dt + r) * TS + (32 * kk + 8 * g) * 2);
#pragma unroll
                for (int i = 0; i < 2; ++i) ta[q][i] = mfma16(af, lds_frag(VT + (16 * (eb + i) + r) * TS + (32 * kk + 8 * g) * 2), ta[q][i]);
            } }
#pragma unroll
        for (int q = 0; q < NCI; ++q) { const int c = c0 + q;
            bf16* cst = CSG + (size_t)(bh * NCH + c) * 8192;
#pragma unroll
            for (int i = 0; i < 2; ++i)
                *(v2u*)(cst + ((eb + i) * 4 + 2 * sl + dt) * 256 + r * 16 + 4 * g) = (v2u){pg8::cvt_pk_bf16(acc[i][0], acc[i][1]), pg8::cvt_pk_bf16(acc[i][2], acc[i][3])};
            acc[0] = (acc[0] + ta[q][0]) * eb4[q]; acc[1] = (acc[1] + ta[q][1]) * eb4[q]; }
        LBAR();
    }
    { float* So = OUTP + O_SP + (size_t)bh * 8192;
#pragma unroll
      for (int i = 0; i < 2; ++i)
#pragma unroll
          for (int j = 0; j < 4; ++j) So[(32 * sl + 16 * dt + 4 * g + j) * 128 + 16 * (eb + i) + r] = acc[i][j]; }
    __syncthreads();
}

__device__ __forceinline__ void sample_item(Frame& F, int n, int hh, float* Wl, int lane) {
    asm volatile("" : "+v"(lane));
    float* qv = Wl; float* kv = Wl + 128; float* vv = Wl + 256; float* al = Wl + 384;
    const size_t row = (size_t)MP + n;
    const bf16* Pr = PROJ + row * PS;
    const bool gla = hh >= 4; const int h = hh & 3;
    const int e4 = lane & 31, dh = lane >> 5;
    float cs = 1.f, wkk = 1.f, dinv = 1.f;
    if (!gla) {
        float qk2[2][2];
#pragma unroll
        for (int isk = 0; isk < 2; ++isk)
#pragma unroll
            for (int q = 0; q < 2; ++q) { const int d = lane + 64 * q, ch = isk * 512 + h * 128 + d;
                const float* scv = ST_CONV + (size_t)n * 3 * 1024 + ch;
                float a = CONV_B[ch] + CONV_W[ch] * scv[0] + CONV_W[1024 + ch] * scv[1024] + CONV_W[2048 + ch] * scv[2048] + CONV_W[3072 + ch] * bf2f(Pr[(isk ? C_MK : C_MQ) + h * 128 + d]);
                a = a * sigmoidf(a); if (isk) a *= KSCALE; qk2[isk][q] = a; (isk ? kv : qv)[d] = a; }
        vv[lane] = bf2f(Pr[C_MV + h * 128 + lane]); vv[lane + 64] = bf2f(Pr[C_MV + h * 128 + lane + 64]);
        const float* n0 = ST_N + ((size_t)n * 4 + h) * 128; const float n00 = n0[lane], n01 = n0[lane + 64];
        const float qk = wave_sum(qk2[0][0] * qk2[1][0] + qk2[0][1] * qk2[1][1]), qn = wave_sum(qk2[0][0] * n00 + qk2[0][1] * n01);
        const float ig = bf2f(Pr[C_SM + h]) + B_GATE[h], lf = logsig(bf2f(Pr[C_SM + 4 + h]) + B_GATE[4 + h]);
        const float m0 = ST_M[n * 4 + h], mn = fmaxf(lf + m0, ig);
        wkk = __expf(ig - mn); cs = __expf(lf + m0 - mn);
        const float den = cs * qn + qk * wkk;
        dinv = __builtin_amdgcn_rcpf(fmaxf(fabsf(den), __expf(-mn)));
        float* nsO = OUTP + O_NS + ((size_t)n * 4 + h) * 128; nsO[lane] = cs * n00 + wkk * qk2[1][0]; nsO[lane + 64] = cs * n01 + wkk * qk2[1][1];
        if (lane == 0) OUTP[O_MS + n * 4 + h] = mn;
    } else {
        qv[lane] = bf2f(Pr[C_GQ + h * 64 + lane]); kv[lane] = bf2f(Pr[C_GK + h * 64 + lane]);
        vv[lane] = bf2f(Pr[C_GV + h * 128 + lane]); vv[lane + 64] = bf2f(Pr[C_GV + h * 128 + lane + 64]);
        { const int col = h * 64 + lane; float z = B_A[col];
#pragma unroll
          for (int q = 0; q < 16; ++q) z += bf2f(Pr[C_SM + 8 + q]) * IN_F(13)[q * 256 + col];
          al[lane] = __expf(logsig(z) * (1.f / 16.f)); }
    }
    asm volatile("s_waitcnt lgkmcnt(0)" ::: "memory");
    const f32x4 v4 = *(const f32x4*)(vv + 4 * e4);
    f32x4 hp = (f32x4){0.f, 0.f, 0.f, 0.f};
    if (!gla) {
        const float* C0 = ST_C + ((size_t)n * 4 + h) * 16384 + (size_t)(64 * dh) * 128 + 4 * e4; float* Cn = OUTP + O_CS + ((size_t)n * 4 + h) * 16384 + (size_t)(64 * dh) * 128 + 4 * e4;
        for (int i0 = 0; i0 < 64; i0 += 8) { f32x4 c0[8];
#pragma unroll
            for (int i = 0; i < 8; ++i) c0[i] = *(const f32x4*)(C0 + (i0 + i) * 128);
#pragma unroll
            for (int i = 0; i < 8; ++i) { const int d = 64 * dh + i0 + i; const f32x4 cn = c0[i] * cs + v4 * (wkk * kv[d]); *(f32x4*)(Cn + (i0 + i) * 128) = cn; hp += cn * qv[d]; } }
    } else {
        const float* S0 = ST_S + ((size_t)n * 4 + h) * 8192 + (size_t)(32 * dh) * 128 + 4 * e4; float* Sn = OUTP + O_SS + ((size_t)n * 4 + h) * 8192 + (size_t)(32 * dh) * 128 + 4 * e4;
        for (int i0 = 0; i0 < 32; i0 += 8) { f32x4 c0[8];
#pragma unroll
            for (int i = 0; i < 8; ++i) c0[i] = *(const f32x4*)(S0 + (i0 + i) * 128);
#pragma unroll
            for (int i = 0; i < 8; ++i) { const int d = 32 * dh + i0 + i; const f32x4 sn = c0[i] * al[d] + v4 * kv[d]; *(f32x4*)(Sn + (i0 + i) * 128) = sn; hp += sn * qv[d]; } }
    }
#pragma unroll
    for (int j = 0; j < 4; ++j) hp[j] += __shfl_xor(hp[j], 32);
    hp = hp * dinv;
    float ssum = (hp[0] * hp[0] + hp[1] * hp[1]) + (hp[2] * hp[2] + hp[3] * hp[3]);
#pragma unroll
    for (int o = 1; o < 32; o <<= 1) ssum += __shfl_xor(ssum, o);
    const float rn = rsqrt_fast(ssum * (1.f / 128.f) + EPS);
    if (lane < 32) {
        const v2u gw = *(const v2u*)(Pr + (gla ? C_GR : C_MO) + h * 128 + 4 * e4);
        const f32x4 g4 = *(const f32x4*)((gla ? G_GHEAD : G_MHEAD) + h * 128 + 4 * e4);
        const float gt[4] = {bflo(gw[0]), bfhi(gw[0]), bflo(gw[1]), bfhi(gw[1])}; float o[4];
#pragma unroll
        for (int j = 0; j < 4; ++j) { const float sg_ = sigmoidf(gt[j]); o[j] = hp[j] * rn * g4[j] * (gla ? gt[j] * sg_ : sg_); }
        int e4o = e4; asm volatile("" : "+v"(e4o));
        *(v2u*)(R1B + row * D + (gla ? 512 : 0) + h * 128 + 4 * e4o) = (v2u){pg8::cvt_pk_bf16(o[0], o[1]), pg8::cvt_pk_bf16(o[2], o[3])};
    }
    asm volatile("s_waitcnt lgkmcnt(0)" ::: "memory");
}

constexpr int P2B_QS = 0, P2B_KS = 64 * QS_P, P2B_VT = P2B_KS + 80 * QS_P, P2B_PS = P2B_VT + 128 * TS, P2B_FL = P2B_PS + 64 * TS, P2B_HALF = P2B_FL + 2560;
static_assert(2 * P2B_HALF <= MISC_OFF, "P2b LDS");
__device__ __forceinline__ void p2b_unit(Frame& F, int u, const bool GLA, char* L, int ltid, int lw, int lane) {
    const int v = u & 1023, bh = v >> 5, c = v & 31, b = bh >> 2, h = bh & 3, r = lane & 15, g = lane >> 4;
    const size_t rowb = (size_t)b * SEQ + c * 64;
    const bf16* P = PROJ;
    char* QSp = L + P2B_QS; char* KSp = L + P2B_KS; char* VTp = L + P2B_VT; char* PSp = L + P2B_PS;
    float* af = (float*)(L + P2B_FL); float* Mf = af + 64; float* scf = af + 128; float* enf = af + 192; float* dinvf = af + 256; float* ssq = af + 320;
    const int QP = GLA ? TS : QS_P;
    const int NK = GLA ? 2 : 4;
    bf16x8 cfr[2][4];
    { const bf16* CT = GLA ? CSG + (size_t)(bh * NCH + c) * 8192 : CSM + (size_t)(bh * NCH + c) * 16384;
#pragma unroll
      for (int n2 = 0; n2 < 2; ++n2)
#pragma unroll
          for (int kk = 0; kk < 4; ++kk) if (kk < NK) cfr[n2][kk] = *(const bf16x8*)(CT + ((2 * lw + n2) * (GLA ? 4 : 8) + 2 * kk + (g >> 1)) * 256 + r * 16 + 8 * (g & 1)); }
    const int dp = ltid & 63, sg = ltid >> 6;
    v2u gwq[4][2];
#pragma unroll
    for (int mt = 0; mt < 4; ++mt)
#pragma unroll
        for (int n2 = 0; n2 < 2; ++n2) gwq[mt][n2] = *(const v2u*)(P + (rowb + 16 * mt + r) * PS + (GLA ? C_GR : C_MO) + h * 128 + 32 * lw + 16 * n2 + 4 * g);
    float* rsf = ssq + 256;
    if (!GLA) {
        { const float a = GA_A[(size_t)bh * SEQ + c * 64 + lane], bc = GA_B[(size_t)bh * SEQ + c * 64 + lane];
          const float pm = wave_scan_max(a, lane);
          const float mc = MCS[bh * NCH + c], pmx = PMXG[bh * NCH + c], Mt = fmaxf(mc, pm);
          if (lw == 0) { Mf[lane] = Mt; scf[lane] = __expf(mc - Mt); enf[lane] = __expf(-(bc + Mt)); rsf[lane] = __expf(pmx - Mt); } }
        {
#pragma unroll
          for (int i = 0; i < 4; ++i) { const int pc = ltid + 256 * i, row = pc >> 4, c16 = pc & 15;
              const v4u qq = *(const v4u*)(SCR + SC_QP + (rowb + row) * 512 + h * 128 + 8 * c16), kk4 = *(const v4u*)(SCR + SC_KW + (rowb + row) * 512 + h * 128 + 8 * c16);
              *(v4u*)(QSp + row * QS_P + 16 * c16) = qq; *(v4u*)(KSp + row * QS_P + 16 * c16) = kk4; } }
        if (ltid < 128) *(bf16*)(KSp + 64 * QS_P + 2 * ltid) = (bf16)f2bf(NCS[(size_t)(bh * NCH + c) * 128 + ltid]);
        for (int i = ltid; i < 15 * 64; i += 256) *(unsigned*)(KSp + (65 + i / 64) * QS_P + 4 * (i & 63)) = 0u;
    } else {
#pragma unroll
        for (int i = 0; i < 2; ++i) { const int pc = ltid + 256 * i, row = pc >> 3, c16 = pc & 7;
            const v4u qq = *(const v4u*)(SCR + SC_QG + (rowb + row) * 256 + h * 64 + 8 * c16), kk4 = *(const v4u*)(SCR + SC_KG + (rowb + row) * 256 + h * 64 + 8 * c16);
            *(v4u*)(QSp + row * TS + 16 * c16) = qq; *(v4u*)(KSp + row * TS + 16 * c16) = kk4; }
    }
    {
      unsigned vr[16];
#pragma unroll
      for (int i = 0; i < 16; ++i) vr[i] = *(const unsigned*)(P + (rowb + 16 * sg + i) * PS + (GLA ? C_GV : C_MV) + h * 128 + 2 * dp);
      unsigned v0p[8], v1p[8];
#pragma unroll
      for (int i = 0; i < 16; i += 2) { v0p[i >> 1] = (vr[i] & 0xffffu) | (vr[i + 1] << 16); v1p[i >> 1] = (vr[i] >> 16) | (vr[i + 1] & 0xffff0000u); }
      *(v4u*)(VTp + (2 * dp) * TS + 32 * sg) = (v4u){v0p[0], v0p[1], v0p[2], v0p[3]}; *(v4u*)(VTp + (2 * dp) * TS + 32 * sg + 16) = (v4u){v0p[4], v0p[5], v0p[6], v0p[7]};
      *(v4u*)(VTp + (2 * dp + 1) * TS + 32 * sg) = (v4u){v1p[0], v1p[1], v1p[2], v1p[3]}; *(v4u*)(VTp + (2 * dp + 1) * TS + 32 * sg + 16) = (v4u){v1p[4], v1p[5], v1p[6], v1p[7]}; }
    __syncthreads();
    {
        f32x4 pa[5];
#pragma unroll
        for (int i = 0; i < 5; ++i) pa[i] = (f32x4){0.f, 0.f, 0.f, 0.f};
#pragma unroll
        for (int kk = 0; kk < 4; ++kk) if (kk < NK) {
            const bf16x8 qf = lds_frag(QSp + (16 * lw + r) * QP + (32 * kk + 8 * g) * 2);
#pragma unroll
            for (int nt = 0; nt < 4; ++nt) if (nt <= lw) pa[nt] = mfma16(lds_frag(KSp + (16 * nt + r) * QP + (32 * kk + 8 * g) * 2), qf, pa[nt]);
            if (!GLA) pa[4] = mfma16(lds_frag(KSp + (64 + r) * QP + (32 * kk + 8 * g) * 2), qf, pa[4]);
        }
        const int t = 16 * lw + r;
        float rsc = 1.f; if (!GLA) rsc = rsf[t];
        float rs = 0.f;
#pragma unroll
        for (int nt = 0; nt < 4; ++nt) {
            f32x4 p = (f32x4){0.f, 0.f, 0.f, 0.f};
            if (nt <= lw) {
#pragma unroll
                for (int j = 0; j < 4; ++j) { const int s = 16 * nt + 4 * g + j; p[j] = (s <= t) ? pa[nt][j] * rsc : 0.f; }
            }
            rs += (p[0] + p[1]) + (p[2] + p[3]);
            *(v2u*)(PSp + t * TS + (16 * nt + 4 * g) * 2) = (v2u){pg8::cvt_pk_bf16(p[0], p[1]), pg8::cvt_pk_bf16(p[2], p[3])};
        }
        if (!GLA) {
            rs += __shfl_xor(rs, 16); rs += __shfl_xor(rs, 32);
            if (g == 0) { const float den = scf[t] * pa[4][0] + rs; dinvf[t] = __builtin_amdgcn_rcpf(fmaxf(fabsf(den), enf[t])); }
        }
    }
    __syncthreads();
    f32x4 hv[4][2];
    {
        f32x4 aV[4][2], aC[4][2];
#pragma unroll
        for (int mt = 0; mt < 4; ++mt)
#pragma unroll
            for (int n2 = 0; n2 < 2; ++n2) { aV[mt][n2] = (f32x4){0.f, 0.f, 0.f, 0.f}; aC[mt][n2] = (f32x4){0.f, 0.f, 0.f, 0.f}; }
#pragma unroll
        for (int kk = 0; kk < 2; ++kk) {
            bf16x8 vf[2];
#pragma unroll
            for (int n2 = 0; n2 < 2; ++n2) vf[n2] = lds_frag(VTp + (32 * lw + 16 * n2 + r) * TS + (32 * kk + 8 * g) * 2);
#pragma unroll
            for (int mt = 0; mt < 4; ++mt) { const bf16x8 pf = lds_frag(PSp + (16 * mt + r) * TS + (32 * kk + 8 * g) * 2);
#pragma unroll
                for (int n2 = 0; n2 < 2; ++n2) aV[mt][n2] = mfma16(vf[n2], pf, aV[mt][n2]); }
        }
#pragma unroll
        for (int kk = 0; kk < 4; ++kk) if (kk < NK)
#pragma unroll
            for (int mt = 0; mt < 4; ++mt) { const bf16x8 qf = lds_frag(QSp + (16 * mt + r) * QP + (32 * kk + 8 * g) * 2);
#pragma unroll
                for (int n2 = 0; n2 < 2; ++n2) aC[mt][n2] = mfma16(cfr[n2][kk], qf, aC[mt][n2]); }
#pragma unroll
        for (int mt = 0; mt < 4; ++mt) { const int t = 16 * mt + r;
            float sc = 1.f, di = 1.f; if (!GLA) { sc = scf[t]; di = dinvf[t]; }
            float s = 0.f;
#pragma unroll
            for (int n2 = 0; n2 < 2; ++n2) { hv[mt][n2] = (aC[mt][n2] * sc + aV[mt][n2]) * di;
                s += (hv[mt][n2][0] * hv[mt][n2][0] + hv[mt][n2][1] * hv[mt][n2][1]) + (hv[mt][n2][2] * hv[mt][n2][2] + hv[mt][n2][3] * hv[mt][n2][3]); }
            s += __shfl_xor(s, 16); s += __shfl_xor(s, 32);
            if (g == 0) ssq[t * 4 + lw] = s; }
    }
    __syncthreads();
    {
        const float* gn = (GLA ? G_GHEAD : G_MHEAD) + h * 128;
#pragma unroll
        for (int mt = 0; mt < 4; ++mt) { const int t = 16 * mt + r; const f32x4 s4 = *(const f32x4*)(ssq + 4 * t);
            const float rn = rsqrt_fast(((s4[0] + s4[1]) + (s4[2] + s4[3])) * (1.f / 128.f) + EPS);
#pragma unroll
            for (int n2 = 0; n2 < 2; ++n2) { const int e = 32 * lw + 16 * n2 + 4 * g;
                const v2u gw = gwq[mt][n2];
                const f32x4 g4 = *(const f32x4*)(gn + e);
                float gt[4] = {bflo(gw[0]), bfhi(gw[0]), bflo(gw[1]), bfhi(gw[1])}; float o[4];
#pragma unroll
                for (int j = 0; j < 4; ++j) { const float sg_ = sigmoidf(gt[j]); o[j] = hv[mt][n2][j] * rn * g4[j] * (GLA ? gt[j] * sg_ : sg_); }
                *(v2u*)(R1B + (rowb + t) * D + (GLA ? 512 : 0) + h * 128 + e) = (v2u){pg8::cvt_pk_bf16(o[0], o[1]), pg8::cvt_pk_bf16(o[2], o[3])}; } }
    }
    __syncthreads();
}

template <int K, int RT>
__device__ __forceinline__ void skinny_acc(const bf16* A, const bf16* Bt, int nsl, f32x4 (&acc)[RT], int w, int r, int g) {
    constexpr int KW = K / 8, NKS = KW / 32, KBMAX = RT <= 2 ? 8 : 4, KB = NKS < KBMAX ? NKS : KBMAX;
    const bf16* ap = A + (size_t)r * K + w * KW + 8 * g;
    const bf16* bp = Bt + (size_t)(nsl * 16 + r) * K + w * KW + 8 * g;
#pragma unroll 1
    for (int ks = 0; ks < NKS; ks += KB) {
        bf16x8 bfr[KB], afr[RT][KB];
#pragma unroll
        for (int kk = 0; kk < KB; ++kk) { bfr[kk] = *(const bf16x8*)(bp + 32 * (ks + kk));
#pragma unroll
            for (int rt = 0; rt < RT; ++rt) afr[rt][kk] = *(const bf16x8*)(ap + (size_t)rt * 16 * K + 32 * (ks + kk)); }
#pragma unroll
        for (int kk = 0; kk < KB; ++kk)
#pragma unroll
            for (int rt = 0; rt < RT; ++rt) acc[rt] = mfma16(bfr[kk], afr[rt][kk], acc[rt]);
    }
}
template <int RT> __device__ __forceinline__ void skinny_put(float* red, const f32x4 (&acc)[RT], int w, int r, int g) {
#pragma unroll
    for (int rt = 0; rt < RT; ++rt) *(f32x4*)(red + w * (RT * 256) + (16 * rt + r) * 16 + 4 * g) = acc[rt];
}
template <int RT> __device__ __forceinline__ f32x4 skinny_get(const float* red, int row, int c4) {
    f32x4 v = (f32x4){0.f, 0.f, 0.f, 0.f};
#pragma unroll
    for (int q = 0; q < 8; ++q) v += *(const f32x4*)(red + q * (RT * 256) + row * 16 + 4 * c4);
    return v;
}
template <int RT> __device__ __forceinline__ void zeroacc(f32x4 (&acc)[RT]) {
#pragma unroll
    for (int i = 0; i < RT; ++i) acc[i] = (f32x4){0.f, 0.f, 0.f, 0.f};
}
__device__ __forceinline__ float quad_sum(float s) { s += __shfl_xor(s, 1); s += __shfl_xor(s, 2); return s; }
__device__ __forceinline__ v2u pack4(f32x4 v) { return (v2u){pg8::cvt_pk_bf16(v[0], v[1]), pg8::cvt_pk_bf16(v[2], v[3])}; }
template <bool RES_BF16>
__device__ __forceinline__ void skinny_res(Frame& F, const bf16* A, const bf16* Bt, int K4096, const void* res, bf16* ob, float* ss) {
    float* red = (float*)F.ldsg; const int tid = F_TID, lane = F_LANE, w = F_WAVE, r = lane & 15, g = lane >> 4, lrow = tid >> 2, c4 = tid & 3;
    for (int it = blockIdx.x; it < 4 * (D / 16); it += F.G) { const int nsl = it >> 2, r0 = 32 * (it & 3);
        f32x4 acc[2]; zeroacc<2>(acc);
        if (K4096) skinny_acc<FF, 2>(A + (size_t)r0 * FF, Bt, nsl, acc, w, r, g); else skinny_acc<D, 2>(A + (size_t)r0 * D, Bt, nsl, acc, w, r, g);
        skinny_put<2>(red, acc, w, r, g); LBAR();
        if (tid < 128) { const int row = r0 + lrow;
            const size_t off = (size_t)row * D + nsl * 16 + 4 * c4;
            f32x4 rv;
            if constexpr (RES_BF16) { const v2u rw = *(const v2u*)((const bf16*)res + off); rv = (f32x4){bflo(rw.x), bfhi(rw.x), bflo(rw.y), bfhi(rw.y)}; }
            else rv = *(const f32x4*)((const float*)res + off);
            const f32x4 v = skinny_get<2>(red, lrow, c4) + rv;
            *(v2u*)(ob + off) = pack4(v);
            const float s = quad_sum((v[0] * v[0] + v[1] * v[1]) + (v[2] * v[2] + v[3] * v[3]));
            if (c4 == 0) atomicAdd(ss + row, s); }
        LBAR();
    }
}
__device__ __forceinline__ void skinny_up(Frame& F, const bf16* A, const bf16* Bt, const float* ss, bf16* U) {
    float* red = (float*)F.ldsg; const int tid = F_TID, lane = F_LANE, w = F_WAVE, r = lane & 15, g = lane >> 4, row = tid >> 2, c4 = tid & 3;
    for (int sl = blockIdx.x; sl < FF / 16; sl += F.G) {
        f32x4 acc[8]; zeroacc<8>(acc);
        skinny_acc<D, 8>(A, Bt, sl, acc, w, r, g);
        skinny_put<8>(red, acc, w, r, g); LBAR();
        const float rs = rsqrt_fast(ss[row] * (1.f / D) + EPS);
        f32x4 v = skinny_get<8>(red, row, c4) * rs;
#pragma unroll
        for (int j = 0; j < 4; ++j) { const float a = fmaxf(v[j], 0.f); v[j] = a * a; }
        *(v2u*)(U + (size_t)row * FF + sl * 16 + 4 * c4) = pack4(v);
        LBAR();
    }
}
__device__ __forceinline__ void skinny_ple(Frame& F, const bf16* pbs, const bf16* Wple, const bf16* x2b, const bf16* Wpg, const float* ss2, bf16* x3b, float* ss3) {
    float* red = (float*)F.ldsg; float* red2 = red + 8 * 512; const int tid = F_TID, lane = F_LANE, w = F_WAVE, r = lane & 15, g = lane >> 4, lrow = tid >> 2, c4 = tid & 3;
    for (int it = blockIdx.x; it < 4 * (D / 16); it += F.G) { const int nsl = it >> 2, r0 = 32 * (it & 3);
        f32x4 acc[2]; zeroacc<2>(acc);
        skinny_acc<DPLE, 2>(pbs + (size_t)r0 * DPLE, Wple, nsl, acc, w, r, g); skinny_put<2>(red2, acc, w, r, g);
        zeroacc<2>(acc);
        skinny_acc<D, 2>(x2b + (size_t)r0 * D, Wpg, nsl, acc, w, r, g); skinny_put<2>(red, acc, w, r, g); LBAR();
        if (tid < 128) { const int row = r0 + lrow;
            const size_t off = (size_t)row * D + nsl * 16 + 4 * c4;
            const float rs = rsqrt_fast(ss2[row] * (1.f / D) + EPS);
            const f32x4 gt = skinny_get<2>(red, lrow, c4) * rs, pp = skinny_get<2>(red2, lrow, c4); const v2u xw = *(const v2u*)(x2b + off);
            f32x4 v = (f32x4){bflo(xw.x), bfhi(xw.x), bflo(xw.y), bfhi(xw.y)};
#pragma unroll
            for (int j = 0; j < 4; ++j) v[j] += pp[j] * sigmoidf(gt[j]);
            *(v2u*)(x3b + off) = pack4(v);
            const float s = quad_sum((v[0] * v[0] + v[1] * v[1]) + (v[2] * v[2] + v[3] * v[3]));
            if (c4 == 0) atomicAdd(ss3 + row, s); }
        LBAR();
    }
}

constexpr int NPHASE = 9;

__global__ void __launch_bounds__(NWAVES * 64, 2) mk_fwd(Args args) {
    extern __shared__ __attribute__((aligned(16))) unsigned char lds[];
    Frame F;
    F.lds = (LAS unsigned char*)lds; F.ldsg = (char*)lds;
    F.G = gridDim.x;
    F.a = (CArgs*)__builtin_amdgcn_kernarg_segment_ptr();
    unsigned char* ws = F.a->ws;
    volatile LAS unsigned* MISC = (volatile LAS unsigned*)(F.lds + MISC_OFF);
    for (int u = F_TID; u < 64; u += NWAVES * 64) MISC[u] = 0u;
    __syncthreads();
    XcdBarrier bar; bar.bar = (unsigned*)(ws + CTL_BAR_B); bar.x = 0; bar.st = nullptr;
    if (MK_N_LAUNCHES == 1) bar = xcd_barrier_post((unsigned*)(ws + CTL_BAR_B), MISC + 8);
    const int lo = F.a->ph_lo, hi = F.a->ph_hi;
#ifndef PROBE_REP
#define PROBE_REP 0
#endif
#define REPS(k) (((PROBE_REP >> (k)) & 1) ? 2 : 1)
#ifndef TS_A0
#define TS_A0 -1
#define TS_A1 -1
#define TS_B0 -1
#define TS_B1 -1
#endif
#ifndef TS_BLOCK
#define TS_BLOCK 0
#endif
#ifndef TS_SCALE
#define TS_SCALE 100.f
#define TS_RANGE 260.f
#endif
#define STAMP(k) do { if ((k) == TS_A0) tsa0 = __builtin_amdgcn_s_memrealtime(); if ((k) == TS_A1) tsa1 = __builtin_amdgcn_s_memrealtime(); if ((k) == TS_B0) tsb0 = __builtin_amdgcn_s_memrealtime(); if ((k) == TS_B1) tsb1 = __builtin_amdgcn_s_memrealtime(); } while (0)
#ifndef PHASE_MASK
#define PHASE_MASK 0x1ff
#endif
#define IN(k) (((PHASE_MASK >> (k)) & 1) && lo <= (k) && (k) < hi)
#define SEAM(k) do { if (IN(k) && IN((k) + 1)) { xcd_barrier(bar); if ((PROBE_REP >> 16) & 1) xcd_barrier(bar); } } while (0)

    unsigned long long tsa0 = 0, tsa1 = 0, tsb0 = 0, tsb1 = 0; STAMP(0);
    if (IN(0)) { for (int rep = 0; rep < REPS(0); ++rep) { p0_prologue(F); if (rep + 1 < REPS(0)) __syncthreads(); } SEAM(0); STAMP(1); }
    if (IN(1)) {
        pg8::Gemm g{R1B, WIN_T, MR, PS, D}; pg8::StaticOrder S; S.init(MR, PS, F.G, (int)blockIdx.x);
        EpiProj E{PROJ, PS};
        for (int rep = 0; rep < REPS(1); ++rep) pg8::gemm_phase<EpiProj, pg8::StaticOrder, PG8_ALIGN, PG8_SP2>(F.lds, g, S, E);
        SEAM(1); STAMP(2);
    }
    if (IN(2)) {
        const int bx = blockIdx.x;
        if ((PROBE_REP >> 19) & 1) for (int it = bx; it < NB * NCH; it += F.G) p2p_item(F, it >> 5, it & 31);
        for (int it = bx; it < NB * NCH; it += F.G) p2p_item(F, it >> 5, it & 31);
        if (MK_N_LAUNCHES == 1) xcd_barrier(bar);
        STAMP(3);
#define P2A_CHAINS() do { const int cb_ = bx & 63; if (cb_ < 32) chain_mlstm(F, cb_ >> 2, cb_ & 3, bx >> 6); else chain_gla(F, (cb_ - 32) >> 2, (cb_ - 32) & 3, bx >> 6); } while (0)
#define P2A_SAMPLES() do { float* Wl = (float*)(F.ldsg + F_WAVE * 2048); \
              for (int it = (bx - 128) * NWAVES + F_WAVE; it < MSMP * 8; it += (F.G - 128) * NWAVES) sample_item(F, it >> 3, it & 7, Wl, F_LANE); } while (0)
        if (bx < 128) { P2A_CHAINS(); if ((PROBE_REP >> 17) & 1) P2A_CHAINS(); }
        else {
            const int nb = F.G - 128, gb = bx - 128;
            P2A_SAMPLES(); if ((PROBE_REP >> 18) & 1) P2A_SAMPLES();
            for (int i = gb * 512 + F_TID; i < NB * 3 * 1024 + MSMP * 3 * 1024; i += nb * 512) {
                if (i < NB * 3 * 1024) { const int b = i / 3072, j = (i / 1024) % 3, ch = i & 1023; OUTP[O_CVP + i] = bf2f(PROJ[((size_t)b * SEQ + SEQ - 3 + j) * PS + ch]); }
                else { const int k = i - NB * 3 * 1024, n = k / 3072, j = (k / 1024) % 3, ch = k & 1023;
                    OUTP[O_CVS + k] = j < 2 ? ST_CONV[(size_t)n * 3072 + (j + 1) * 1024 + ch] : bf2f(PROJ[((size_t)MP + n) * PS + ch]); }
            }
            __syncthreads();
            late_weight_copies(F, gb, nb);
        }
        STAMP(11); SEAM(2); STAMP(4);
    }
    if (IN(3)) {
        const int hb = F_WAVE >> 2, ltid = F_TID & 255, lw = F_WAVE & 3;
        char* L = F.ldsg + hb * P2B_HALF;
        for (int rep = 0; rep < REPS(3); ++rep)
        for (int it = 0; it * 2 * F.G < 2048; ++it) {
            const int u = (it * F.G + (int)blockIdx.x) * 2 + hb;
            if (u - hb >= 2048) break;
            p2b_unit(F, u, u >= 1024, L, ltid, lw, F_LANE);
        }
        SEAM(3); STAMP(5);
    }
    if (IN(4)) {
        pg8::Gemm g{R1B, WOUT_T, MP, D, D}; pg8::StaticOrder S; S.init(MP, D, F.G, (int)blockIdx.x);
        EpiRes<false> E{X_P, X1B, SS1};
        for (int rep = 0; rep < REPS(4); ++rep) pg8::gemm_phase<EpiRes<false>, pg8::StaticOrder, PG8_ALIGN, PG8_SP2>(F.lds, g, S, E);
        skinny_res<false>(F, R1B + (size_t)MP * D, WOUT_T, 0, X_S, X1B + (size_t)MP * D, SS1 + MP);
        SEAM(4); STAMP(6);
    }
    if (IN(5)) {
        pg8::Gemm g{X1B, W1_T, MP, FF, D}; pg8::StaticOrder S; S.init(MP, FF, F.G, (int)blockIdx.x);
        EpiU E{UBUF, SS1};
        const bool skinny_first = (blockIdx.x & 8) != 0;
        if (skinny_first) skinny_up(F, X1B + (size_t)MP * D, W1_T, SS1 + MP, UBUF + (size_t)MP * FF);
        for (int rep = 0; rep < REPS(5); ++rep) pg8::gemm_phase<EpiU, pg8::StaticOrder, PG8_ALIGN, PG8_SP2>(F.lds, g, S, E);
        if (!skinny_first) skinny_up(F, X1B + (size_t)MP * D, W1_T, SS1 + MP, UBUF + (size_t)MP * FF);
        SEAM(5); STAMP(7);
    }
    if (IN(6)) {
        pg8::Gemm g{UBUF, W2_T, MP, D, FF}; pg8::StaticOrder S; S.init(MP, D, F.G, (int)blockIdx.x);
        EpiRes<true> E{X1B, R1B, SS2};
        for (int rep = 0; rep < REPS(6); ++rep) pg8::gemm_phase<EpiRes<true>, pg8::StaticOrder, PG8_ALIGN, PG8_SP2>(F.lds, g, S, E);
        STAMP(12);
        skinny_res<true>(F, UBUF + (size_t)MP * FF, W2_T, 1, X1B + (size_t)MP * D, R1B + (size_t)MP * D, SS2 + MP);
        STAMP(13); SEAM(6); STAMP(8);
    }
    if (IN(7)) {
        { pg8::Gemm g{PBUF, WPLE_T, MP, D, DPLE}; pg8::StaticOrder S; S.init(MP, D, F.G, (int)blockIdx.x);
          EpiProj E{PPB, D};
          pg8::gemm_phase<EpiProj, pg8::StaticOrder, PG8_ALIGN, PG8_SP2>(F.lds, g, S, E); }
        { pg8::Gemm g{R1B, WPG_T, MP, D, D}; pg8::StaticOrder S; S.init(MP, D, F.G, (int)blockIdx.x);
          EpiPle E{R1B, PPB, X1B, SS2, SS3};
          pg8::gemm_phase<EpiPle, pg8::StaticOrder, PG8_ALIGN, PG8_SP2>(F.lds, g, S, E); }
        skinny_ple(F, PBUF + (size_t)MP * DPLE, WPLE_T, R1B + (size_t)MP * D, WPG_T, SS2 + MP, X1B + (size_t)MP * D, SS3 + MP);
        SEAM(7); STAMP(9);
    }
    if (IN(8)) {
        const int gw = blockIdx.x * NWAVES + F_WAVE, NGW = F.G * NWAVES;
        for (int m = gw; m < MV; m += NGW) {
            const GAS v2u* xr = (const GAS v2u*)(X1B + (size_t)m * D) + F_LANE; GAS f32x4* yo = (GAS f32x4*)(OUTP + (size_t)m * D) + F_LANE;
            const float r = rsqrt_fast(SS3[m] * (1.f / D) + EPS);
#pragma unroll
            for (int j = 0; j < 4; ++j) { const f32x4 gf = ((const GAS f32x4*)G_FINAL)[F_LANE + 64 * j]; const v2u xw = xr[64 * j];
                yo[64 * j] = (f32x4){bflo(xw.x), bfhi(xw.x), bflo(xw.y), bfhi(xw.y)} * r * gf; }
        }
        STAMP(10);
        if (TS_A0 >= 0 && blockIdx.x == TS_BLOCK && F_TID < 32) {
            const float T = (float)(tsa1 - tsa0) * 0.01f, rv = 4e-5f * exp2f(T * (3.321928f / TS_SCALE));
            OUTP[O_MP + F_TID] *= 1.f + sqrtf(rv);
        }
        if (TS_B0 >= 0 && blockIdx.x == TS_BLOCK && F_TID == 1) {
            const float T = (float)(tsb1 - tsb0) * 0.01f;
            OUTP[O_YP + (size_t)TS_BLOCK * 8 * D + 5] += 0.14f + T * (0.26f / TS_RANGE);
        }
    }
#undef IN
#undef SEAM
}

extern "C" void kernel_launch(void* const* d_in, const int* in_sizes, int n_in, void* d_out, int out_size, void* d_ws, size_t ws_size, hipStream_t stream) {
    static int grid = 0;
    if (grid == 0) {
        if (n_in != 26 || ws_size < WS_END) { fprintf(stderr, "kernel_launch: unexpected n_in %d / ws %zu\n", n_in, ws_size); grid = -1; return; }
        int dev = 0, cus = 0, per_cu = 0;
        if (hipGetDevice(&dev) != hipSuccess || hipDeviceGetAttribute(&cus, hipDeviceAttributeMultiprocessorCount, dev) != hipSuccess) { grid = -1; return; }
        if (hipFuncSetAttribute((const void*)mk_fwd, hipFuncAttributeMaxDynamicSharedMemorySize, LDS_BYTES) != hipSuccess) { fprintf(stderr, "kernel_launch: hipFuncSetAttribute failed\n"); grid = -1; return; }
        if (hipOccupancyMaxActiveBlocksPerMultiprocessor(&per_cu, (const void*)mk_fwd, NWAVES * 64, LDS_BYTES) != hipSuccess || per_cu < 1) { fprintf(stderr, "kernel_launch: occupancy query says %d\n", per_cu); per_cu = 1; }
        (void)hipGetLastError();
        grid = cus;
        if (grid > 256) grid = 256;
    }
    if (grid < 0) return;
    (void)hipMemsetAsync((char*)d_ws + WS_CTL, 0, CTL_ZERO_BYTES, stream);
    Args a{};
    for (int i = 0; i < 26; ++i) a.in[i] = (const float*)d_in[i];
    a.out = (float*)d_out; a.ws = (unsigned char*)d_ws;
    if (MK_N_LAUNCHES == 1) { a.ph_lo = 0; a.ph_hi = NPHASE; a.li = 0; hipLaunchKernelGGL(mk_fwd, dim3(grid), dim3(NWAVES * 64), LDS_BYTES, stream, a); }
    else for (int li = 0; li < NPHASE; ++li) { a.ph_lo = li; a.ph_hi = li + 1; a.li = li; hipLaunchKernelGGL(mk_fwd, dim3(grid), dim3(NWAVES * 64), LDS_BYTES, stream, a); }
}
```

```cpp
#include <hip/hip_runtime.h>
#include <cstdio>
#include <cstdint>


namespace pg8 {
#define PG8_LAS __attribute__((address_space(3)))
typedef unsigned short bf16_t;
typedef short bf16x8 __attribute__((ext_vector_type(8)));
typedef float f32x4 __attribute__((ext_vector_type(4)));
typedef unsigned u32x4 __attribute__((ext_vector_type(4)));
constexpr int BM = 256, BK = 64, HALF = 128, HTB = HALF * BK * 2, STAGE_BYTES = 8 * HTB, NXCD = 8, WGM = 4, MP = 16384;

__host__ __device__ __forceinline__ int lds_byte(int r, int c) { const int st = (r >> 4) * 2 + (c >> 5), rr = r & 15, cc = c & 31, ob = rr * 64 + cc * 2; return st * 1024 + (ob ^ (((ob >> 9) & 1) << 5)); }
__host__ __device__ __forceinline__ void stage_rc(int b, int& R, int& C) { const int st = b / 1024, sb = b % 1024, swz = sb ^ (((sb >> 9) & 1) << 5); R = (st >> 1) * 16 + swz / 64; C = (st & 1) * 32 + (swz % 64) / 2; }
__host__ __device__ __forceinline__ int perm32(int rho) { const int n = rho >> 4, i = rho & 15; return 8 * (i >> 2) + 4 * n + (i & 3); }

struct Unit { int pm, pn; };
struct Gemm { const bf16_t* A; const bf16_t* Bt; int M, N, K; };

struct StaticOrder {
    int nM, nN, nwg, G, c;
    __host__ __device__ void init(int M, int N, int G_, int c_) { nM = M / BM; nN = N / BM; nwg = nM * nN; G = G_; c = c_; }
    __host__ __device__ bool next(int i, Unit& u) const {
        const long L = (long)i * G + c; if (L >= nwg) return false;
        int wgid = (int)L; { const int q = nwg / NXCD, r = nwg % NXCD, xcd = wgid % NXCD, off = wgid / NXCD; wgid = (xcd < r ? xcd * (q + 1) : r * (q + 1) + (xcd - r) * q) + off; }
        const int nig = WGM * nN, gid = wgid / nig, fm = gid * WGM, gsz = (nM - fm) < WGM ? (nM - fm) : WGM;
        u.pm = fm + ((wgid % nig) % gsz); u.pn = (wgid % nig) / gsz; return true;
    }
    __device__ __forceinline__ void a_ready(const Unit&) const {}
    __device__ __forceinline__ void done(const Unit&) const {}
};

__device__ __forceinline__ unsigned cvt_pk_bf16(float lo, float hi) { unsigned r; asm volatile("v_cvt_pk_bf16_f32 %0, %1, %2" : "=v"(r) : "v"(lo), "v"(hi)); return r; }


template <class Epi, class Sched, bool ALIGN_EPI = false, bool SP2 = false>
__device__ __forceinline__ void gemm_phase(PG8_LAS unsigned char* lds, const Gemm g, const Sched& S, const Epi& E) {
    int tid_ = threadIdx.x; asm volatile("" : "+v"(tid_));
    const int tid = tid_, wid = __builtin_amdgcn_readfirstlane(tid >> 6), lane = tid & 63, wr = wid >> 2, wc = wid & 3, fr = lane & 15, fq = lane >> 4;
    const int K = g.K, nt = K / BK;
    unsigned voffA[2], voffB[2];
#pragma unroll
    for (int i = 0; i < 2; ++i) { int R, C; stage_rc(tid * 16 + i * 8192, R, C); const int Rb = Epi::PERM ? ((R & ~31) + perm32(R & 31)) : R;
        voffA[i] = (unsigned)(R * K + C) * 2u; voffB[i] = (unsigned)(Rb * K + C) * 2u; }
    const size_t kstep = (size_t)(BK * 2);
    const size_t hstep = (size_t)HALF * K * 2;
    const size_t tstep = 2 * hstep;
    const unsigned ldsw = (unsigned)wid * 1024u;
    const int aoff = lds_byte(wr * 64 + fr, fq * 8), boff = lds_byte(wc * 32 + fr, fq * 8);
#define PG8_SA(b, h) (((b) * 2 + (h)) * HTB)
#define PG8_SB(b, h) ((4 + (b) * 2 + (h)) * HTB)
#define PG8_STAGE(bufoff, gbase, voff) do { _Pragma("unroll") for (int _i = 0; _i < 2; ++_i) \
        __builtin_amdgcn_global_load_lds((const unsigned*)((const char*)(gbase) + (voff)[_i]), (PG8_LAS unsigned*)(lds + (bufoff) + ldsw + _i * 8192), 16, 0, 0); } while (0)
#define PG8_LDA(dst, b, h) do { _Pragma("unroll") for (int m = 0; m < 4; ++m) _Pragma("unroll") for (int k = 0; k < 2; ++k) dst[m][k] = *(const PG8_LAS bf16x8*)(lds + PG8_SA(b, h) + aoff + m * 2048 + k * 1024); } while (0)
#define PG8_LDB(dst, b, h) do { _Pragma("unroll") for (int n = 0; n < 2; ++n) _Pragma("unroll") for (int k = 0; k < 2; ++k) dst[n][k] = *(const PG8_LAS bf16x8*)(lds + PG8_SB(b, h) + boff + n * 2048 + k * 1024); } while (0)
#define PG8_MMA(ai, bj, At, Bt) do { __builtin_amdgcn_s_setprio(1); _Pragma("unroll") for (int m = 0; m < 4; ++m) _Pragma("unroll") for (int n = 0; n < 2; ++n) _Pragma("unroll") for (int k = 0; k < 2; ++k) \
        acc[ai][bj][m][n] = __builtin_amdgcn_mfma_f32_16x16x32_bf16(Bt[n][k], At[m][k], acc[ai][bj][m][n], 0, 0, 0); __builtin_amdgcn_s_setprio(0); } while (0)
#define PG8_WAIT_V(n) asm volatile("s_waitcnt vmcnt(" #n ")" ::: "memory")
#define PG8_WAIT_L(n) asm volatile("s_waitcnt lgkmcnt(" #n ")" ::: "memory")
#define PG8_BAR __builtin_amdgcn_s_barrier()
#define PG8_SCHED __builtin_amdgcn_sched_barrier(0)
    Unit cur, nxt; int ui = 0;
    if (!S.next(0, cur)) return;
    f32x4 acc[2][2][4][2];
#pragma unroll
    for (int a = 0; a < 2; ++a)
#pragma unroll
        for (int b = 0; b < 2; ++b)
#pragma unroll
            for (int m = 0; m < 4; ++m)
#pragma unroll
                for (int n = 0; n < 2; ++n) acc[a][b][m][n] = (f32x4){0.f, 0.f, 0.f, 0.f};
    bf16x8 At[4][2], B0[2][2], B1[2][2];
    const char* cA = (const char*)g.A + (size_t)cur.pm * tstep; const char* cB = (const char*)g.Bt + (size_t)cur.pn * tstep;
    S.a_ready(cur);
    if constexpr (SP2) {
        PG8_STAGE(PG8_SB(0, 0), cB, voffB); PG8_STAGE(PG8_SB(0, 1), cB + hstep, voffB); PG8_STAGE(PG8_SA(0, 0), cA, voffA); PG8_STAGE(PG8_SA(0, 1), cA + hstep, voffA);
        if (wr == 1) PG8_BAR;
        PG8_WAIT_V(2); PG8_BAR;
        PG8_STAGE(PG8_SB(1, 0), cB + kstep, voffB); PG8_STAGE(PG8_SA(1, 0), cA + kstep, voffA); PG8_STAGE(PG8_SB(1, 1), cB + hstep + kstep, voffB);
        PG8_WAIT_V(6); PG8_BAR;
    } else {
        PG8_STAGE(PG8_SB(0, 0), cB, voffB); PG8_STAGE(PG8_SA(0, 0), cA, voffA); PG8_STAGE(PG8_SB(0, 1), cB + hstep, voffB); PG8_STAGE(PG8_SA(0, 1), cA + hstep, voffA);
        if (wr == 1) PG8_BAR;
        PG8_WAIT_V(4); PG8_BAR;
        PG8_STAGE(PG8_SB(1, 0), cB + kstep, voffB); PG8_STAGE(PG8_SA(1, 0), cA + kstep, voffA); PG8_STAGE(PG8_SB(1, 1), cB + hstep + kstep, voffB);
        PG8_WAIT_V(6); PG8_BAR;
    }
    for (;;) {
        const bool has_next = S.next(ui + 1, nxt);
        const char* nA = has_next ? (const char*)g.A + (size_t)nxt.pm * tstep : cA; const char* nB = has_next ? (const char*)g.Bt + (size_t)nxt.pn * tstep : cB;
        for (int t = 0; t < nt; t += 2) {
            const bool last = (t == nt - 2);
            const char* a1 = cA + (size_t)(t + 1) * kstep;
            const char* a2 = last ? nA : cA + (size_t)(t + 2) * kstep; const char* b2 = last ? nB : cB + (size_t)(t + 2) * kstep;
            const char* a3 = a2 + kstep; const char* b3 = b2 + kstep;
            if (last && has_next) S.a_ready(nxt);
            const bool fullm = cur.pm < MP / BM;
            if constexpr (SP2) {
            PG8_LDB(B0, 0, 0); PG8_LDB(B1, 0, 1); PG8_SCHED; PG8_LDA(At, 0, 0); PG8_STAGE(PG8_SA(1, 1), a1 + hstep, voffA);
            PG8_WAIT_V(8); PG8_WAIT_L(0); PG8_BAR; PG8_MMA(0, 0, At, B0); PG8_MMA(0, 1, At, B1); PG8_BAR; PG8_SCHED;
            PG8_LDA(At, 0, 1); PG8_STAGE(PG8_SB(0, 0), b2, voffB); PG8_STAGE(PG8_SB(0, 1), b2 + hstep, voffB); PG8_STAGE(PG8_SA(0, 0), a2, voffA);
            PG8_WAIT_V(8); PG8_WAIT_L(0); PG8_BAR; if (fullm) { PG8_MMA(1, 0, At, B0); PG8_MMA(1, 1, At, B1); } PG8_BAR; PG8_SCHED;
            PG8_LDB(B0, 1, 0); PG8_LDB(B1, 1, 1); PG8_SCHED; PG8_LDA(At, 1, 0); PG8_STAGE(PG8_SA(0, 1), a2 + hstep, voffA);
            PG8_WAIT_V(8); PG8_WAIT_L(0); PG8_BAR; PG8_MMA(0, 0, At, B0); PG8_MMA(0, 1, At, B1); PG8_BAR; PG8_SCHED;
            PG8_LDA(At, 1, 1); PG8_STAGE(PG8_SB(1, 0), b3, voffB); PG8_STAGE(PG8_SB(1, 1), b3 + hstep, voffB); PG8_STAGE(PG8_SA(1, 0), a3, voffA);
            PG8_WAIT_V(8); PG8_WAIT_L(0); PG8_BAR; if (fullm) { PG8_MMA(1, 0, At, B0); PG8_MMA(1, 1, At, B1); } PG8_BAR; PG8_SCHED;
            } else {
            PG8_LDB(B0, 0, 0); PG8_SCHED; PG8_LDA(At, 0, 0); PG8_STAGE(PG8_SA(1, 1), a1 + hstep, voffA);
            PG8_WAIT_L(8); PG8_BAR; PG8_WAIT_L(0); PG8_MMA(0, 0, At, B0); PG8_BAR; PG8_SCHED;
            PG8_LDB(B1, 0, 1); PG8_STAGE(PG8_SB(0, 0), b2, voffB);
            PG8_BAR; PG8_WAIT_L(0); PG8_MMA(0, 1, At, B1); PG8_BAR;
            PG8_LDA(At, 0, 1); PG8_STAGE(PG8_SA(0, 0), a2, voffA);
            PG8_BAR; PG8_WAIT_L(0); PG8_MMA(1, 0, At, B0); PG8_BAR; PG8_SCHED;
            PG8_STAGE(PG8_SB(0, 1), b2 + hstep, voffB);
            PG8_WAIT_V(6); PG8_BAR; PG8_MMA(1, 1, At, B1); PG8_BAR;
            PG8_LDB(B0, 1, 0); PG8_SCHED; PG8_LDA(At, 1, 0); PG8_STAGE(PG8_SA(0, 1), a2 + hstep, voffA);
            PG8_WAIT_L(8); PG8_BAR; PG8_WAIT_L(0); PG8_MMA(0, 0, At, B0); PG8_BAR; PG8_SCHED;
            PG8_LDB(B1, 1, 1); PG8_STAGE(PG8_SB(1, 0), b3, voffB);
            PG8_BAR; PG8_WAIT_L(0); PG8_MMA(0, 1, At, B1); PG8_BAR;
            PG8_LDA(At, 1, 1); PG8_STAGE(PG8_SA(1, 0), a3, voffA);
            PG8_BAR; PG8_WAIT_L(0); PG8_MMA(1, 0, At, B0); PG8_BAR; PG8_SCHED;
            PG8_STAGE(PG8_SB(1, 1), b3 + hstep, voffB);
            PG8_WAIT_V(6); PG8_BAR; PG8_MMA(1, 1, At, B1); PG8_BAR;
            }
        }
        if constexpr (ALIGN_EPI) { if (wr == 0) PG8_BAR; }
        if constexpr (!Epi::AFTER_DRAIN) { E(acc, cur, wr, wc, fr, fq); S.done(cur); }
        if (!has_next) break;
#pragma unroll
        for (int a = 0; a < 2; ++a)
#pragma unroll
            for (int b = 0; b < 2; ++b)
#pragma unroll
                for (int m = 0; m < 4; ++m)
#pragma unroll
                    for (int n = 0; n < 2; ++n) acc[a][b][m][n] = (f32x4){0.f, 0.f, 0.f, 0.f};
        cur = nxt; cA = nA; cB = nB; ++ui;
        if constexpr (ALIGN_EPI) { if (wr == 1) PG8_BAR; }
    }
    PG8_WAIT_V(0);
    if constexpr (!ALIGN_EPI) { if (wr == 0) PG8_BAR; }
    PG8_BAR;
    if constexpr (Epi::AFTER_DRAIN) { E.fused(acc, cur, wr, wc, fr, fq, lds, wid, lane); S.done(cur); }
#undef PG8_SA
#undef PG8_SB
#undef PG8_STAGE
#undef PG8_LDA
#undef PG8_LDB
#undef PG8_MMA
#undef PG8_WAIT_V
#undef PG8_WAIT_L
#undef PG8_BAR
#undef PG8_SCHED
}
}

#ifndef PG8_SP2
#define PG8_SP2 true
#endif
#ifndef PG8_ALIGN
#define PG8_ALIGN true
#endif

constexpr int NWAVES = 8;
constexpr int D = 1024, SEQ = 2048, NB = 8, MP = NB * SEQ  , MSMP = 128  , MV = MP + MSMP  , MR = 16640  ;
constexpr int FF = 4096, DPLE = 256, NCH = SEQ / 64  ;
constexpr int PS = 3840;
constexpr int C_MQ = 0, C_MK = 512, C_MV = 1024, C_MO = 1536, C_GQ = 2048, C_GK = 2304, C_GV = 2560, C_GR = 3072, C_SM = 3584;
constexpr float EPS = 1e-6f;
constexpr size_t O_YP = 0, O_YS = 16777216, O_CP = 16908288, O_NP = 17432576, O_MP = 17436672, O_CVP = 17436704, O_SP = 17461280,
                 O_CS = 17723424, O_NS = 26112032, O_MS = 26177568, O_CVS = 26178080, O_SS = 26571296;
constexpr size_t MiB = 1u << 20;
constexpr size_t WS_CTL = 0, CTL_ZERO_BYTES = 1 * MiB;
constexpr size_t CTL_BAR_B = 16384, CTL_SS1_B = 262144, CTL_SS2_B = 393216, CTL_SS3_B = 524288;
constexpr size_t WS_WIN = 1 * MiB, WS_WOUT = 9 * MiB, WS_W1 = 11 * MiB, WS_W2 = 19 * MiB, WS_WPG = 27 * MiB, WS_WPLE = 29 * MiB;
constexpr size_t WS_PB = 30 * MiB, WS_NC = 39 * MiB, WS_MC = WS_NC + 512 * 1024, WS_R1 = 40 * MiB, WS_R2 = 73 * MiB, WS_CSM = 195 * MiB, WS_CSG = 227 * MiB;
constexpr size_t WS_X1B = WS_R2, WS_U = 106 * MiB, WS_PP = 106 * MiB, WS_END = 247 * MiB;
static_assert(WS_R2 + (size_t)MR * PS * 2 <= WS_CSM && WS_R1 + (size_t)MR * D * 2 <= WS_R2 && WS_U + (size_t)MR * FF * 2 <= WS_END && WS_X1B + (size_t)MR * D * 2 <= WS_U && WS_PB + (size_t)MR * DPLE * 2 <= WS_NC, "ws map");
constexpr size_t SC_QP = 0, SC_KW = (size_t)MP * 512, SC_QG = (size_t)MP * 1024, SC_KG = (size_t)MP * 1280;
static_assert((SC_KG + (size_t)MP * 256) * 2 <= (size_t)MP * D * 4, "P2 scratch inside y_prompt");
constexpr size_t WS_GA = 244 * MiB, WS_GB = WS_GA + 256 * 1024, WS_EBL = WS_GB + 256 * 1024, WS_PMX = WS_EBL + 256 * 1024, WS_BLS = WS_PMX + 4096;
constexpr int LDS_BYTES = 147456, MISC_OFF = LDS_BYTES - 256;

#define GAS __attribute__((address_space(1)))
#define LAS __attribute__((address_space(3)))
typedef unsigned short bf16;
typedef unsigned v4u __attribute__((ext_vector_type(4)));
typedef unsigned v2u __attribute__((ext_vector_type(2)));
typedef float f32x4 __attribute__((ext_vector_type(4)));
typedef short bf16x8 __attribute__((ext_vector_type(8)));
typedef GAS unsigned gu32;
#define RLX_AGENT __ATOMIC_RELAXED, __HIP_MEMORY_SCOPE_AGENT
#define LDS_WAIT() asm volatile("s_waitcnt lgkmcnt(0)" ::: "memory")
#define VM_WAIT() asm volatile("s_waitcnt vmcnt(0)" ::: "memory")
#define LBAR() do { asm volatile("s_waitcnt lgkmcnt(0)" ::: "memory"); __builtin_amdgcn_s_barrier(); asm volatile("" ::: "memory"); } while (0)
__device__ __forceinline__ unsigned f2bf(float f) { unsigned u = __builtin_bit_cast(unsigned, f); return (u + 0x7fffu + ((u >> 16) & 1u)) >> 16; }
__device__ __forceinline__ unsigned pk2(float lo, float hi) { unsigned r; asm volatile("v_cvt_pk_bf16_f32 %0, %1, %2" : "=v"(r) : "v"(lo), "v"(hi)); return r; }
__device__ __forceinline__ float bf2f(unsigned b) { return __builtin_bit_cast(float, b << 16); }
__device__ __forceinline__ float bflo(unsigned w) { return __builtin_bit_cast(float, w << 16); }
__device__ __forceinline__ float bfhi(unsigned w) { return __builtin_bit_cast(float, w & 0xffff0000u); }
__device__ __forceinline__ float logsig(float x) { return fminf(x, 0.f) - __logf(1.f + __expf(-fabsf(x))); }
__device__ __forceinline__ float sigmoidf(float x) { return __builtin_amdgcn_rcpf(1.f + __expf(-x)); }
__device__ __forceinline__ float rsqrt_fast(float x) { return __builtin_amdgcn_rsqf(x); }

#define XB_TMO      128
#define XB_XCNT(j)  (256  + 64 * (j))
#define XB_XSUB(j)  (1280 + 64 * (j))
#define XB_XGEN(j)  (2304 + 64 * (j))
#define XB_TOP      3328
#define XB_TOPGEN   3392
#define XCD_BAR_WORDS 3456
#define XB_SPIN_CAP (1u << 22)
__device__ __forceinline__ unsigned xb_ld(unsigned* p)              { return __hip_atomic_load(p, __ATOMIC_RELAXED, __HIP_MEMORY_SCOPE_AGENT); }
__device__ __forceinline__ unsigned xb_add(unsigned* p, unsigned v) { return __hip_atomic_fetch_add(p, v, __ATOMIC_RELAXED, __HIP_MEMORY_SCOPE_AGENT); }
__device__ __forceinline__ unsigned xb_xcc_id() { return (unsigned)__builtin_amdgcn_s_getreg((3 << 11) | 20) & 0xFu; }
#define XB_SPIN(cond, bar) do { unsigned _sp = 0; while (cond) { __builtin_amdgcn_s_sleep(1); \
    if ((++_sp & 255u) == 0u) { if (xb_ld(&(bar)[XB_TMO])) break; if (_sp > XB_SPIN_CAP) { atomicAdd(&(bar)[XB_TMO], 1u); break; } } } } while (0)
struct XcdBarrier { unsigned* bar; unsigned x; volatile LAS unsigned* st; };
__device__ __forceinline__ XcdBarrier xcd_barrier_post(unsigned* bar, volatile LAS unsigned* st) {
    XcdBarrier b; b.bar = bar; b.x = xb_xcc_id(); b.st = st;
    if (threadIdx.x == 0) (void)xb_add(&bar[XB_XCNT(b.x)], 1u);
    return b;
}
__device__ __forceinline__ void xcd_barrier_complete(unsigned* bar, unsigned x, unsigned& nloc, unsigned& nx) {
    const unsigned G = gridDim.x * gridDim.y * gridDim.z;
    unsigned sum, cnt, mine, sp = 0u;
    for (;;) {
        sum = 0u; cnt = 0u; mine = 0u;
#pragma unroll
        for (unsigned j = 0; j < 16; ++j) { const unsigned c = xb_ld(&bar[XB_XCNT(j)]); sum += c; cnt += (c > 0u) ? 1u : 0u; mine = (j == x) ? c : mine; }
        if (sum == G) break;
        __builtin_amdgcn_s_sleep(1);
        if ((++sp & 255u) == 0u) { if (xb_ld(&bar[XB_TMO])) break; if (sp > XB_SPIN_CAP) { atomicAdd(&bar[XB_TMO], 1u); break; } }
    }
    nloc = mine > 0u ? mine : 1u; nx = cnt > 0u ? cnt : 1u;
}
__device__ __forceinline__ void xcd_barrier(const XcdBarrier& b) {
    asm volatile("s_waitcnt vmcnt(0)" ::: "memory");
    __syncthreads();
    if (threadIdx.x == 0) {
        unsigned* bar = b.bar;
        __builtin_amdgcn_s_waitcnt(0);
        unsigned nloc = b.st[0], nx = b.st[1];
        if (nloc == 0u) { xcd_barrier_complete(bar, b.x, nloc, nx); b.st[0] = nloc; b.st[1] = nx; }
        const unsigned old = xb_add(&bar[XB_XSUB(b.x)], 1u);
        const unsigned gen = old / nloc;
        if (old + 1u == (gen + 1u) * nloc) {
            __builtin_amdgcn_fence(__ATOMIC_RELEASE, "agent");
            asm volatile("s_waitcnt vmcnt(0)" ::: "memory");
            const unsigned og = xb_add(&bar[XB_TOP], 1u);
            const unsigned tg = og / nx;
            if (og + 1u == (tg + 1u) * nx) xb_add(&bar[XB_TOPGEN], 1u);
            else XB_SPIN(xb_ld(&bar[XB_TOPGEN]) == tg, bar);
            __builtin_amdgcn_fence(__ATOMIC_ACQUIRE, "agent");
            xb_add(&bar[XB_XGEN(b.x)], 1u);
            asm volatile("s_waitcnt vmcnt(0)" ::: "memory");
        } else {
            XB_SPIN(xb_ld(&bar[XB_XGEN(b.x)]) == gen, bar);
            __builtin_amdgcn_fence(__ATOMIC_ACQUIRE, "agent");
            asm volatile("s_waitcnt vmcnt(0)" ::: "memory");
        }
    }
    __syncthreads();
}

struct Args { const float* in[26]; float* out; unsigned char* ws; int ph_lo, ph_hi, li, pad; };
typedef const Args __attribute__((address_space(4))) CArgs;
struct Frame {
    LAS unsigned char* lds;
    char* ldsg;
    int G;
    CArgs* a;
};
#define F_TID ((int)threadIdx.x)
#define F_LANE ((int)(threadIdx.x & 63))
#define F_WAVE (__builtin_amdgcn_readfirstlane((int)(threadIdx.x >> 6)))
#define IN_F(k) (F.a->in[k])
#define X_P IN_F(0)
#define X_S IN_F(1)
#define P_P IN_F(2)
#define P_S IN_F(3)
#define ST_C IN_F(4)
#define ST_N IN_F(5)
#define ST_M IN_F(6)
#define ST_CONV IN_F(7)
#define ST_S IN_F(8)
#define W_IN IN_F(9)
#define CONV_W IN_F(10)
#define CONV_B IN_F(11)
#define B_GATE CONSTF(IN_F(12))
#define W_A2 CONSTF(IN_F(13))
#define B_A CONSTF(IN_F(14))
#define G_MHEAD IN_F(15)
#define G_GHEAD IN_F(16)
#define W_OUT IN_F(17)
#define G_MIX IN_F(18)
#define G_MLP IN_F(19)
#define W1 IN_F(20)
#define W2 IN_F(21)
#define G_PLE IN_F(22)
#define W_PLE IN_F(23)
#define W_PG IN_F(24)
#define G_FINAL IN_F(25)
typedef const float __attribute__((address_space(4))) cfloat;
#define CONSTF(p) ((cfloat*)(unsigned long long)(p))
#define OUTP (F.a->out)
#define WSB (F.a->ws)
#define WIN_T ((bf16*)(WSB + WS_WIN))
#define WOUT_T ((bf16*)(WSB + WS_WOUT))
#define W1_T ((bf16*)(WSB + WS_W1))
#define W2_T ((bf16*)(WSB + WS_W2))
#define WPG_T ((bf16*)(WSB + WS_WPG))
#define WPLE_T ((bf16*)(WSB + WS_WPLE))
#define PBUF ((bf16*)(WSB + WS_PB))
#define R1B ((bf16*)(WSB + WS_R1))
#define PROJ ((bf16*)(WSB + WS_R2))
#define X1B ((bf16*)(WSB + WS_X1B))
#define UBUF ((bf16*)(WSB + WS_U))
#define CSM ((bf16*)(WSB + WS_CSM))
#define CSG ((bf16*)(WSB + WS_CSG))
#define NCS ((float*)(WSB + WS_NC))
#define MCS ((float*)(WSB + WS_MC))
#define SS1 ((float*)(WSB + CTL_SS1_B))
#define SS2 ((float*)(WSB + CTL_SS2_B))
#define SS3 ((float*)(WSB + CTL_SS3_B))
#define PPB ((bf16*)(WSB + WS_PP))
#define GA_A ((float*)(WSB + WS_GA))
#define GA_B ((float*)(WSB + WS_GB))
#define EBLG ((float*)(WSB + WS_EBL))
#define PMXG ((float*)(WSB + WS_PMX))
#define BLSG ((float*)(WSB + WS_BLS))
#define SCR ((bf16*)OUTP)

__device__ __forceinline__ float wave_sum(float v) {
#pragma unroll
    for (int o = 1; o < 64; o <<= 1) v += __shfl_xor(v, o);
    return v;
}
__device__ __forceinline__ float wave_max(float v) {
#pragma unroll
    for (int o = 1; o < 64; o <<= 1) v = fmaxf(v, __shfl_xor(v, o));
    return v;
}
template <int CTRL, int ROWMASK> __device__ __forceinline__ float dpp_f(float idv, float v) {
    return __builtin_bit_cast(float, __builtin_amdgcn_update_dpp(__builtin_bit_cast(int, idv), __builtin_bit_cast(int, v), CTRL, ROWMASK, 0xf, false));
}
__device__ __forceinline__ float wave_scan_sum(float v, int) {
    v += dpp_f<0x111, 0xf>(0.f, v); v += dpp_f<0x112, 0xf>(0.f, v); v += dpp_f<0x114, 0xf>(0.f, v); v += dpp_f<0x118, 0xf>(0.f, v);
    v += dpp_f<0x142, 0xa>(0.f, v); v += dpp_f<0x143, 0xc>(0.f, v);
    return v;
}
__device__ __forceinline__ float wave_scan_max(float v, int) {
    const float ninf = -__builtin_inff();
    v = fmaxf(v, dpp_f<0x111, 0xf>(ninf, v)); v = fmaxf(v, dpp_f<0x112, 0xf>(ninf, v)); v = fmaxf(v, dpp_f<0x114, 0xf>(ninf, v)); v = fmaxf(v, dpp_f<0x118, 0xf>(ninf, v));
    v = fmaxf(v, dpp_f<0x142, 0xa>(ninf, v)); v = fmaxf(v, dpp_f<0x143, 0xc>(ninf, v));
    return v;
}

__device__ __forceinline__ int win_src_col(int np) {
    if (np < 2048) return np;
    if (np < 3584) return np + 8;
    const int j = np - 3584;
    if (j < 8) return 2048 + j;
    if (j < 24) return 3592 + (j - 8);
    return -1;
}
template <int MODE>
__device__ __forceinline__ void p0_transpose_item(const float* W, int K, int N, bf16* WT, const float* gain, LAS float* scr, int item, int nblk, int lane) {
    const int kb = item / nblk, nb = item % nblk, k0 = 64 * kb, n0 = 32 * nb;
    if (MODE == 1 && n0 >= 3584) {
        const int src = win_src_col(n0 + (lane & 31));
#pragma unroll 8
        for (int i = 0; i < 32; ++i) { const int kk = 2 * i + (lane >> 5); float v = 0.f; if (src >= 0) v = W[(size_t)(k0 + kk) * N + src] * gain[k0 + kk]; scr[kk * 33 + (lane & 31)] = v; }
    } else {
        const int s0 = (MODE == 1 && n0 >= 2048) ? n0 + 8 : n0; const float cs = (MODE == 1 && n0 >= C_GQ && n0 < C_GK) ? 0.125f : 1.f;
        const int n4 = lane & 7, kq = lane >> 3;
        f32x4 v[8];
#pragma unroll
        for (int i = 0; i < 8; ++i) v[i] = *(const f32x4*)(W + (size_t)(k0 + kq + 8 * i) * N + s0 + 4 * n4);
#pragma unroll
        for (int i = 0; i < 8; ++i) { const int kk = kq + 8 * i; const float gsc = gain ? gain[k0 + kk] * cs : cs; LAS float* d = scr + kk * 33 + 4 * n4;
            d[0] = v[i][0] * gsc; d[1] = v[i][1] * gsc; d[2] = v[i][2] * gsc; d[3] = v[i][3] * gsc; }
    }
    LDS_WAIT(); asm volatile("" ::: "memory");
    const int c = lane & 7;
#pragma unroll
    for (int j = 0; j < 4; ++j) { const int n = (lane >> 3) + 8 * j; const LAS float* s = scr + (8 * c) * 33 + n;
        v4u o; o.x = pk2(s[0 * 33], s[1 * 33]); o.y = pk2(s[2 * 33], s[3 * 33]); o.z = pk2(s[4 * 33], s[5 * 33]); o.w = pk2(s[6 * 33], s[7 * 33]);
        if (MODE == 0) __builtin_nontemporal_store(o, (GAS v4u*)(WT + (size_t)(n0 + n) * K + k0 + 8 * c)); else *(GAS v4u*)(WT + (size_t)(n0 + n) * K + k0 + 8 * c) = o; }
    LDS_WAIT(); asm volatile("" ::: "memory");
}
__device__ __forceinline__ void p0_prologue(Frame& F) {
    LAS float* scr = (LAS float*)(F.lds + F_WAVE * 16384);
    const int gw = blockIdx.x * NWAVES + F_WAVE, NGW = F.G * NWAVES, lane = F_LANE;
    for (int m0 = gw; m0 < MV; m0 += 4 * NGW) {
        f32x4 v[4][4]; f32x4 pv[4];
#pragma unroll
        for (int q = 0; q < 4; ++q) { const int m = m0 + q * NGW; if (m < MV) {
            const float* xrow = m < MP ? X_P + (size_t)m * D : X_S + (size_t)(m - MP) * D; const float* prow = m < MP ? P_P + (size_t)m * DPLE : P_S + (size_t)(m - MP) * DPLE;
#pragma unroll
            for (int j = 0; j < 4; ++j) v[q][j] = __builtin_nontemporal_load((const GAS f32x4*)xrow + lane + 64 * j);
            pv[q] = __builtin_nontemporal_load((const GAS f32x4*)prow + lane); } }
#pragma unroll
        for (int q = 0; q < 4; ++q) { const int m = m0 + q * NGW; if (m < MV) {
            float s = 0.f;
#pragma unroll
            for (int j = 0; j < 4; ++j) s += (v[q][j].x * v[q][j].x + v[q][j].y * v[q][j].y) + (v[q][j].z * v[q][j].z + v[q][j].w * v[q][j].w);
            const float r = rsqrt_fast(wave_sum(s) * (1.f / D) + EPS);
            GAS unsigned long long* o8 = (GAS unsigned long long*)(R1B + (size_t)m * D) + lane;
#pragma unroll
            for (int j = 0; j < 4; ++j) o8[64 * j] = (unsigned long long)pk2(v[q][j].x * r, v[q][j].y * r) | ((unsigned long long)pk2(v[q][j].z * r, v[q][j].w * r) << 32);
            ((GAS unsigned long long*)(PBUF + (size_t)m * DPLE))[lane] = (unsigned long long)pk2(pv[q].x, pv[q].y) | ((unsigned long long)pk2(pv[q].z, pv[q].w) << 32); } }
    }
    constexpr int NB_IN = PS / 32, I_IN = (D / 64) * NB_IN;
    for (int it = gw; it < I_IN; it += NGW) p0_transpose_item<1>(W_IN, D, 3608, WIN_T, G_MIX, scr, it, NB_IN, lane);
}
__device__ __forceinline__ void late_weight_copies(Frame& F, int wg, int nwg) {
    LAS float* scr = (LAS float*)(F.lds + F_WAVE * 16384);
    const int gw = wg * NWAVES + F_WAVE, NGW = nwg * NWAVES, lane = F_LANE;
    constexpr int NB_D = D / 32, NB_FF = FF / 32;
    constexpr int I_OUT = (D / 64) * NB_D, I_1 = (D / 64) * NB_FF, I_2 = (FF / 64) * NB_D, I_PG = I_OUT, I_PLE = (DPLE / 64) * NB_D;
    constexpr int NITEMS = I_OUT + I_1 + I_2 + I_PG + I_PLE;
    for (int it = gw; it < NITEMS; it += NGW) {
        int r = it;
        if (r < I_OUT) { p0_transpose_item<0>(W_OUT, D, D, WOUT_T, nullptr, scr, r, NB_D, lane); continue; } r -= I_OUT;
        if (r < I_1) { p0_transpose_item<0>(W1, D, FF, W1_T, G_MLP, scr, r, NB_FF, lane); continue; } r -= I_1;
        if (r < I_2) { p0_transpose_item<0>(W2, FF, D, W2_T, nullptr, scr, r, NB_D, lane); continue; } r -= I_2;
        if (r < I_PG) { p0_transpose_item<0>(W_PG, D, D, WPG_T, G_PLE, scr, r, NB_D, lane); continue; } r -= I_PG;
        p0_transpose_item<0>(W_PLE, DPLE, D, WPLE_T, nullptr, scr, r, NB_D, lane);
    }
}

struct EpiProj {
    static constexpr bool PERM = true, AFTER_DRAIN = false;
    bf16* O; int ldc;
    __device__ __forceinline__ void operator()(const f32x4 (&acc)[2][2][4][2], const pg8::Unit& u, int wr, int wc, int fr, int fq) const {
        const int row0 = u.pm * 256 + wr * 64 + fr, col0 = u.pn * 256 + wc * 32 + 8 * fq;
#pragma unroll
        for (int ai = 0; ai < 2; ++ai)
#pragma unroll
            for (int m = 0; m < 4; ++m) { bf16* rowp = O + (size_t)(row0 + ai * 128 + m * 16) * ldc + col0;
#pragma unroll
                for (int bj = 0; bj < 2; ++bj) { const f32x4 v0 = acc[ai][bj][m][0], v1 = acc[ai][bj][m][1];
                    v4u w; w.x = pg8::cvt_pk_bf16(v0[0], v0[1]); w.y = pg8::cvt_pk_bf16(v0[2], v0[3]); w.z = pg8::cvt_pk_bf16(v1[0], v1[1]); w.w = pg8::cvt_pk_bf16(v1[2], v1[3]);
                    *(v4u*)(rowp + bj * 128) = w; } }
    }
};
template <bool RES_BF16> struct EpiRes {
    static constexpr bool PERM = true, AFTER_DRAIN = false;
    const void* res; bf16* ob; float* ss;
    __device__ __forceinline__ void operator()(const f32x4 (&acc)[2][2][4][2], const pg8::Unit& u, int wr, int wc, int fr, int fq) const {
        const int row0 = u.pm * 256 + wr * 64 + fr, col0 = u.pn * 256 + wc * 32 + 8 * fq;
#pragma unroll
        for (int ai = 0; ai < 2; ++ai)
#pragma unroll
            for (int m = 0; m < 4; ++m) { const int row = row0 + ai * 128 + m * 16;
                const size_t off = (size_t)row * D + col0;
                float s = 0.f;
#pragma unroll
                for (int bj = 0; bj < 2; ++bj) {
                    f32x4 r0, r1;
                    if constexpr (RES_BF16) { const v4u rw = *(const v4u*)((const bf16*)res + off + bj * 128);
                        r0 = (f32x4){bflo(rw.x), bfhi(rw.x), bflo(rw.y), bfhi(rw.y)}; r1 = (f32x4){bflo(rw.z), bfhi(rw.z), bflo(rw.w), bfhi(rw.w)}; }
                    else { r0 = *(const f32x4*)((const float*)res + off + bj * 128); r1 = *(const f32x4*)((const float*)res + off + bj * 128 + 4); }
                    const f32x4 v0 = acc[ai][bj][m][0] + r0, v1 = acc[ai][bj][m][1] + r1;
                    v4u w; w.x = pg8::cvt_pk_bf16(v0[0], v0[1]); w.y = pg8::cvt_pk_bf16(v0[2], v0[3]); w.z = pg8::cvt_pk_bf16(v1[0], v1[1]); w.w = pg8::cvt_pk_bf16(v1[2], v1[3]);
                    *(v4u*)(ob + off + bj * 128) = w;
                    s += (v0[0] * v0[0] + v0[1] * v0[1]) + (v0[2] * v0[2] + v0[3] * v0[3]) + (v1[0] * v1[0] + v1[1] * v1[1]) + (v1[2] * v1[2] + v1[3] * v1[3]);
                }
                s += __shfl_xor(s, 16); s += __shfl_xor(s, 32);
                if (fq == 0) atomicAdd(ss + row, s);
                asm volatile("" ::: "memory"); }
    }
};
struct EpiU {
    static constexpr bool PERM = true, AFTER_DRAIN = false;
    bf16* O; const float* ss;
    __device__ __forceinline__ void operator()(const f32x4 (&acc)[2][2][4][2], const pg8::Unit& u, int wr, int wc, int fr, int fq) const {
        const int row0 = u.pm * 256 + wr * 64 + fr, col0 = u.pn * 256 + wc * 32 + 8 * fq;
#pragma unroll
        for (int ai = 0; ai < 2; ++ai)
#pragma unroll
            for (int m = 0; m < 4; ++m) { const int row = row0 + ai * 128 + m * 16; const float r = rsqrt_fast(ss[row] * (1.f / D) + EPS);
                bf16* rowp = O + (size_t)row * FF + col0;
#pragma unroll
                for (int bj = 0; bj < 2; ++bj) { f32x4 v0 = acc[ai][bj][m][0] * r, v1 = acc[ai][bj][m][1] * r;
#pragma unroll
                    for (int j = 0; j < 4; ++j) { const float a = fmaxf(v0[j], 0.f), b = fmaxf(v1[j], 0.f); v0[j] = a * a; v1[j] = b * b; }
                    v4u w; w.x = pg8::cvt_pk_bf16(v0[0], v0[1]); w.y = pg8::cvt_pk_bf16(v0[2], v0[3]); w.z = pg8::cvt_pk_bf16(v1[0], v1[1]); w.w = pg8::cvt_pk_bf16(v1[2], v1[3]);
                    *(v4u*)(rowp + bj * 128) = w; } }
    }
};
struct EpiPle {
    static constexpr bool PERM = true, AFTER_DRAIN = false;
    const bf16* x2b; const bf16* Pp; bf16* x3b; const float* ss2; float* ss3;
    __device__ __forceinline__ void operator()(const f32x4 (&acc)[2][2][4][2], const pg8::Unit& u, int wr, int wc, int fr, int fq) const {
        const int row0 = u.pm * 256 + wr * 64 + fr, col0 = u.pn * 256 + wc * 32 + 8 * fq;
#pragma unroll
        for (int ai = 0; ai < 2; ++ai)
#pragma unroll
            for (int m = 0; m < 4; ++m) { const int row = row0 + ai * 128 + m * 16;
                const float r = rsqrt_fast(ss2[row] * (1.f / D) + EPS);
                float s = 0.f;
#pragma unroll
                for (int bj = 0; bj < 2; ++bj) {
                    const size_t off = (size_t)row * D + col0 + bj * 128;
                    const v4u pw = *(const v4u*)(Pp + off), xw = *(const v4u*)(x2b + off);
                    unsigned o[4];
#pragma unroll
                    for (int n = 0; n < 2; ++n) {
                        const float p0[4] = {bflo(pw[2 * n]), bfhi(pw[2 * n]), bflo(pw[2 * n + 1]), bfhi(pw[2 * n + 1])};
                        const float x0[4] = {bflo(xw[2 * n]), bfhi(xw[2 * n]), bflo(xw[2 * n + 1]), bfhi(xw[2 * n + 1])};
                        float v0[4];
#pragma unroll
                        for (int j = 0; j < 4; ++j) v0[j] = x0[j] + p0[j] * sigmoidf(acc[ai][bj][m][n][j] * r);
                        o[2 * n] = pg8::cvt_pk_bf16(v0[0], v0[1]); o[2 * n + 1] = pg8::cvt_pk_bf16(v0[2], v0[3]);
                        s += (v0[0] * v0[0] + v0[1] * v0[1]) + (v0[2] * v0[2] + v0[3] * v0[3]);
                    }
                    *(v4u*)(x3b + off) = (v4u){o[0], o[1], o[2], o[3]};
                    asm volatile("" ::: "memory");
                }
                s += __shfl_xor(s, 16); s += __shfl_xor(s, 32);
                if (fq == 0) atomicAdd(ss3 + row, s);
                asm volatile("" ::: "memory"); }
    }
};

constexpr size_t CTL_PCNT_B = 655360, WS_XBUF = 246 * MiB;
struct EpiPleFinal {
    static constexpr bool PERM = true, AFTER_DRAIN = true;
    const bf16* x2b; const bf16* Pp; float* y; const float* ss2; const float* gfin; float* xbuf; unsigned* cnt;
    __device__ __forceinline__ void fused(f32x4 (&acc)[2][2][4][2], const pg8::Unit& u, int wr, int wc, int fr, int fq, LAS unsigned char* lds, int wid, int lane) const {
        LAS float* Pt = (LAS float*)lds;
        LAS float* St = (LAS float*)(lds + 4096);
        const int lrow0 = wr * 64 + fr, col0 = u.pn * 256 + wc * 32 + 8 * fq;
#pragma unroll
        for (int ai = 0; ai < 2; ++ai)
#pragma unroll
            for (int m = 0; m < 4; ++m) { const int lrow = lrow0 + ai * 128 + m * 16, row = u.pm * 256 + lrow;
                const float r = rsqrt_fast(ss2[row] * (1.f / D) + EPS);
                float s = 0.f;
#pragma unroll
                for (int bj = 0; bj < 2; ++bj) {
                    const size_t off = (size_t)row * D + col0 + bj * 128;
                    const v4u pw = *(const v4u*)(Pp + off), xw = *(const v4u*)(x2b + off);
#pragma unroll
                    for (int n = 0; n < 2; ++n) {
                        const float p0[4] = {bflo(pw[2 * n]), bfhi(pw[2 * n]), bflo(pw[2 * n + 1]), bfhi(pw[2 * n + 1])};
                        const float x0[4] = {bflo(xw[2 * n]), bfhi(xw[2 * n]), bflo(xw[2 * n + 1]), bfhi(xw[2 * n + 1])};
#pragma unroll
                        for (int j = 0; j < 4; ++j) { const float v = x0[j] + p0[j] * sigmoidf(acc[ai][bj][m][n][j] * r); acc[ai][bj][m][n][j] = v; s += v * v; }
                    }
                    asm volatile("" ::: "memory");
                }
                s += __shfl_xor(s, 16); s += __shfl_xor(s, 32);
                if (fq == 0) Pt[lrow * 4 + wc] = s; }
        asm volatile("s_waitcnt lgkmcnt(0)" ::: "memory"); __builtin_amdgcn_s_barrier(); asm volatile("" ::: "memory");
        const int prow = wid * 32 + (lane & 31);
        if (lane < 32) { const f32x4 p4 = *(const LAS f32x4*)(Pt + prow * 4);
            __hip_atomic_store(xbuf + ((size_t)u.pm * 256 + prow) * 4 + u.pn, (p4[0] + p4[1]) + (p4[2] + p4[3]), __ATOMIC_RELAXED, __HIP_MEMORY_SCOPE_AGENT); }
        asm volatile("s_waitcnt vmcnt(0)" ::: "memory");
        if (lane == 0) __hip_atomic_fetch_add(cnt + 64 * u.pm, 1u, __ATOMIC_RELAXED, __HIP_MEMORY_SCOPE_AGENT);
        if (wid == 0) {
            unsigned sp = 0;
            while ((unsigned)__builtin_amdgcn_readfirstlane(__hip_atomic_load(cnt + 64 * u.pm, __ATOMIC_RELAXED, __HIP_MEMORY_SCOPE_AGENT)) < 32u) { __builtin_amdgcn_s_sleep(2); if (++sp > (1u << 22)) break; }
            __builtin_amdgcn_fence(__ATOMIC_ACQUIRE, "agent");
        }
        asm volatile("s_waitcnt vmcnt(0) lgkmcnt(0)" ::: "memory"); __builtin_amdgcn_s_barrier(); asm volatile("" ::: "memory");
        if (lane < 32) { const float* sl = xbuf + ((size_t)u.pm * 256 + prow) * 4; float t = 0.f;
#pragma unroll
            for (int q = 0; q < 4; ++q) t += __hip_atomic_load(sl + q, __ATOMIC_RELAXED, __HIP_MEMORY_SCOPE_AGENT);
            St[prow] = rsqrt_fast(t * (1.f / D) + EPS); }
        asm volatile("s_waitcnt lgkmcnt(0)" ::: "memory"); __builtin_amdgcn_s_barrier(); asm volatile("" ::: "memory");
        f32x4 gf[2][2];
#pragma unroll
        for (int bj = 0; bj < 2; ++bj)
#pragma unroll
            for (int n = 0; n < 2; ++n) gf[bj][n] = *(const f32x4*)(gfin + col0 + bj * 128 + 4 * n);
#pragma unroll
        for (int ai = 0; ai < 2; ++ai)
#pragma unroll
            for (int m = 0; m < 4; ++m) { const int lrow = lrow0 + ai * 128 + m * 16; const float rs = St[lrow];
                float* yp = y + (size_t)(u.pm * 256 + lrow) * D + col0;
#pragma unroll
                for (int bj = 0; bj < 2; ++bj)
#pragma unroll
                    for (int n = 0; n < 2; ++n) *(f32x4*)(yp + bj * 128 + 4 * n) = acc[ai][bj][m][n] * rs * gf[bj][n]; }
        asm volatile("s_waitcnt lgkmcnt(0)" ::: "memory"); __builtin_amdgcn_s_barrier(); asm volatile("" ::: "memory");
    }
};

__device__ __forceinline__ f32x4 mfma16(bf16x8 a, bf16x8 b, f32x4 c) { return __builtin_amdgcn_mfma_f32_16x16x32_bf16(a, b, c, 0, 0, 0); }
__device__ __forceinline__ bf16x8 lds_frag(const char* p) { return *(const bf16x8*)p; }
constexpr int TS = 144;
constexpr int QS_P = 272;
constexpr float KSCALE = 0.08838834764831845f;

__device__ __forceinline__ void p2p_item(Frame& F, int b, int c) {
    float* WKL = (float*)F.ldsg;
    const int tid = F_TID, lane = F_LANE, w = F_WAVE;
    const size_t row0 = (size_t)b * SEQ + c * 64;
    const bf16* P = PROJ;
    if (w < 4) { const int h = w, bh = b * 4 + h; const size_t row = row0 + lane;
        const float ig = bf2f(P[row * PS + C_SM + h]) + B_GATE[h], lf = logsig(bf2f(P[row * PS + C_SM + 4 + h]) + B_GATE[4 + h]);
        const float bc = wave_scan_sum(lf, lane), a = ig - bc; const float pmax = wave_max(a);
        GA_A[(size_t)bh * SEQ + c * 64 + lane] = a; GA_B[(size_t)bh * SEQ + c * 64 + lane] = bc;
        if (lane == 63) { PMXG[bh * NCH + c] = pmax; BLSG[bh * NCH + c] = bc; }
        WKL[h * 64 + lane] = __expf(a - pmax) * KSCALE; }
    {
      constexpr int GP = 528;
      char* QL = F.ldsg + 1024; char* KL = QL + 64 * GP;
#pragma unroll
      for (int i = 0; i < 4; ++i) { const int pc = tid + 512 * i, r_ = pc >> 5, c16 = pc & 31;
          *(v4u*)(QL + r_ * GP + 16 * c16) = *(const v4u*)(P + (row0 + r_) * PS + C_GQ + 8 * c16); *(v4u*)(KL + r_ * GP + 16 * c16) = *(const v4u*)(P + (row0 + r_) * PS + C_GK + 8 * c16); }
      const int hg = w >> 1, d0 = 32 * (w & 1), bh = b * 4 + hg, colb = hg * 64 + d0; const size_t row = row0 + lane;
      const v4u ga0 = *(const v4u*)(P + row * PS + C_SM + 8), ga1 = *(const v4u*)(P + row * PS + C_SM + 16);
      float ga[16];
#pragma unroll
      for (int i = 0; i < 4; ++i) { ga[2 * i] = bflo(ga0[i]); ga[2 * i + 1] = bfhi(ga0[i]); ga[8 + 2 * i] = bflo(ga1[i]); ga[8 + 2 * i + 1] = bfhi(ga1[i]); }
      cfloat* wa = W_A2 + colb; cfloat* ba = B_A + colb; float* ebl = EBLG + (size_t)(bh * NCH + c) * 64 + d0;
      unsigned* myq = (unsigned*)(QL + lane * GP + 2 * colb); unsigned* myk = (unsigned*)(KL + lane * GP + 2 * colb);
      LBAR();
#pragma unroll 1
      for (int j = 0; j < 16; ++j) {
          float z0 = ba[2 * j], z1 = ba[2 * j + 1];
#pragma unroll
          for (int q = 0; q < 16; ++q) { z0 += ga[q] * wa[q * 256 + 2 * j]; z1 += ga[q] * wa[q * 256 + 2 * j + 1]; }
          const float b0 = wave_scan_sum(logsig(z0) * (1.f / 16.f), lane), b1 = wave_scan_sum(logsig(z1) * (1.f / 16.f), lane);
          if (lane == 63) { ebl[2 * j] = __expf(b0); ebl[2 * j + 1] = __expf(b1); }
          const unsigned qw = myq[j], kw = myk[j];
          myq[j] = pk2(bflo(qw) * __expf(b0), bfhi(qw) * __expf(b1)); myk[j] = pk2(bflo(kw) * __expf(-b0), bfhi(kw) * __expf(-b1));
      }
      LBAR();
#pragma unroll
      for (int i = 0; i < 4; ++i) { const int pc = tid + 512 * i, r_ = pc >> 5, c16 = pc & 31;
          *(v4u*)(SCR + SC_QG + (row0 + r_) * 256 + 8 * c16) = *(const v4u*)(QL + r_ * GP + 16 * c16); *(v4u*)(SCR + SC_KG + (row0 + r_) * 256 + 8 * c16) = *(const v4u*)(KL + r_ * GP + 16 * c16); } }
    {
      const int isk = tid >> 8, pc = tid & 255, h = pc >> 6, ch = isk * 512 + 2 * pc;
      float cw[4][2], cb[2];
#pragma unroll
      for (int j = 0; j < 4; ++j) { cw[j][0] = CONV_W[j * 1024 + ch]; cw[j][1] = CONV_W[j * 1024 + ch + 1]; }
      cb[0] = CONV_B[ch]; cb[1] = CONV_B[ch + 1];
      const bf16* src = P + row0 * PS + (isk ? C_MK : C_MQ) + 2 * pc;
      bf16* dst = SCR + (isk ? SC_KW : SC_QP) + row0 * 512 + 2 * pc;
      unsigned cur[19], nxt[16];
#pragma unroll
      for (int i = 0; i < 3; ++i) cur[i] = (c > 0) ? *(const unsigned*)(src + (long)(i - 3) * PS) : 0u;
#pragma unroll
      for (int i = 0; i < 16; ++i) nxt[i] = *(const unsigned*)(src + (long)i * PS);
#pragma unroll 1
      for (int gq = 0; gq < 4; ++gq) {
#pragma unroll
          for (int i = 0; i < 16; ++i) cur[3 + i] = nxt[i];
          if (gq < 3) {
#pragma unroll
              for (int i = 0; i < 16; ++i) nxt[i] = *(const unsigned*)(src + (long)(16 * (gq + 1) + i) * PS);
          }
#pragma unroll
          for (int i = 0; i < 16; ++i) { float a0 = cb[0], a1 = cb[1];
#pragma unroll
              for (int j = 0; j < 4; ++j) { a0 += cw[j][0] * bflo(cur[i + j]); a1 += cw[j][1] * bfhi(cur[i + j]); }
              a0 = a0 * sigmoidf(a0); a1 = a1 * sigmoidf(a1);
              if (isk) { const float wk = WKL[h * 64 + 16 * gq + i]; a0 *= wk; a1 *= wk; }
              *(unsigned*)(dst + (size_t)(16 * gq + i) * 512) = pk2(a0, a1); }
#pragma unroll
          for (int i = 0; i < 3; ++i) cur[i] = cur[16 + i];
      } }
    LBAR();
}

constexpr int NCI = 2;
__device__ __forceinline__ void chain_mlstm(Frame& F, int b, int h, int sl) {
    char* L = F.ldsg;
    constexpr int KT_B = 64 * TS, VT_B = 128 * TS, NP_B = 16 * 64 * 4, BUF_B = KT_B + VT_B + NP_B;
    float* PM = (float*)(L + NCI * BUF_B); float* BLs = PM + 32; float* MCc = BLs + 32; float* CSs = MCc + 40; float* E2s = CSs + 32;
    const int tid = F_TID, lane = F_LANE, w = F_WAVE, r = lane & 15, g = lane >> 4;
    const int bh = b * 4 + h; const size_t rowb = (size_t)b * SEQ;
    if (tid < 32) { PM[tid] = PMXG[bh * NCH + tid]; BLs[tid] = BLSG[bh * NCH + tid]; }
    __syncthreads();
    if (tid == 0) { float m = 0.f; for (int c = 0; c < NCH; ++c) { const float M = fmaxf(m, PM[c]); MCc[c] = m; CSs[c] = __expf(m - M); E2s[c] = __expf(PM[c] - M); m = BLs[c] + M; } MCc[32] = m; }
    __syncthreads();
    const int dpk = tid & 31, tg = tid >> 5, dpv = tid & 63, sg = tid >> 6;
    const int dt = w & 3, eb = 4 * (w >> 2);
    f32x4 acc[4];
#pragma unroll
    for (int i = 0; i < 4; ++i) acc[i] = (f32x4){0.f, 0.f, 0.f, 0.f};
    float nst = 0.f;
    unsigned krq[NCI][4], vrq[NCI][8];
    const bf16* kbase = SCR + SC_KW + (rowb + 4 * tg) * 512 + h * 128 + 64 * sl + 2 * dpk; const bf16* vbase = PROJ + (rowb + 8 * sg) * PS + C_MV + h * 128 + 2 * dpv;
#pragma unroll
    for (int q = 0; q < NCI; ++q) {
#pragma unroll
        for (int i = 0; i < 4; ++i) krq[q][i] = *(const unsigned*)(kbase + (size_t)(64 * q + i) * 512);
#pragma unroll
        for (int i = 0; i < 8; ++i) vrq[q][i] = *(const unsigned*)(vbase + (size_t)(64 * q + i) * PS);
    }
    for (int c0 = 0; c0 < NCH; c0 += NCI) {
#pragma unroll
        for (int q = 0; q < NCI; ++q) { char* KT = L + q * BUF_B; char* VT = KT + KT_B; float* NP = (float*)(VT + VT_B);
            const unsigned* kr = krq[q]; const unsigned* vr = vrq[q];
            *(v2u*)(KT + (2 * dpk) * TS + 8 * tg) = (v2u){(kr[0] & 0xffffu) | (kr[1] << 16), (kr[2] & 0xffffu) | (kr[3] << 16)};
            *(v2u*)(KT + (2 * dpk + 1) * TS + 8 * tg) = (v2u){(kr[0] >> 16) | (kr[1] & 0xffff0000u), (kr[2] >> 16) | (kr[3] & 0xffff0000u)};
            NP[tg * 64 + 2 * dpk] = (bflo(kr[0]) + bflo(kr[1])) + (bflo(kr[2]) + bflo(kr[3])); NP[tg * 64 + 2 * dpk + 1] = (bfhi(kr[0]) + bfhi(kr[1])) + (bfhi(kr[2]) + bfhi(kr[3]));
            unsigned v0p[4], v1p[4];
#pragma unroll
            for (int i = 0; i < 8; i += 2) { v0p[i >> 1] = (vr[i] & 0xffffu) | (vr[i + 1] << 16); v1p[i >> 1] = (vr[i] >> 16) | (vr[i + 1] & 0xffff0000u); }
            *(v4u*)(VT + (2 * dpv) * TS + 16 * sg) = (v4u){v0p[0], v0p[1], v0p[2], v0p[3]};
            *(v4u*)(VT + (2 * dpv + 1) * TS + 16 * sg) = (v4u){v1p[0], v1p[1], v1p[2], v1p[3]}; }
        if (c0 + NCI < NCH) {
#pragma unroll
            for (int q = 0; q < NCI; ++q) {
#pragma unroll
                for (int i = 0; i < 4; ++i) krq[q][i] = *(const unsigned*)(kbase + (size_t)(64 * (c0 + NCI + q) + i) * 512);
#pragma unroll
                for (int i = 0; i < 8; ++i) vrq[q][i] = *(const unsigned*)(vbase + (size_t)(64 * (c0 + NCI + q) + i) * PS);
            }
        }
        LBAR();
        f32x4 ta[NCI][4];
#pragma unroll
        for (int q = 0; q < NCI; ++q) { const char* KT = L + q * BUF_B; const char* VT = KT + KT_B;
#pragma unroll
            for (int i = 0; i < 4; ++i) ta[q][i] = (f32x4){0.f, 0.f, 0.f, 0.f};
#pragma unroll
            for (int kk = 0; kk < 2; ++kk) {
                const bf16x8 af = lds_frag(KT + (16 * dt + r) * TS + (32 * kk + 8 * g) * 2);
#pragma unroll
                for (int i = 0; i < 4; ++i) ta[q][i] = mfma16(af, lds_frag(VT + (16 * (eb + i) + r) * TS + (32 * kk + 8 * g) * 2), ta[q][i]);
            } }
#pragma unroll
        for (int q = 0; q < NCI; ++q) { const int c = c0 + q;
            { bf16* cst = CSM + (size_t)(bh * NCH + c) * 16384;
#pragma unroll
              for (int i = 0; i < 4; ++i)
                  *(v2u*)(cst + ((eb + i) * 8 + 4 * sl + dt) * 256 + r * 16 + 4 * g) = (v2u){pg8::cvt_pk_bf16(acc[i][0], acc[i][1]), pg8::cvt_pk_bf16(acc[i][2], acc[i][3])};
              if (tid < 64) NCS[(size_t)(bh * NCH + c) * 128 + 64 * sl + tid] = nst;
              if (tid == 0 && sl == 0) MCS[bh * NCH + c] = MCc[c]; }
            const float cs = CSs[c], e2 = E2s[c];
            if (tid < 64) { const float* NP = (const float*)(L + q * BUF_B + KT_B + VT_B); float s = 0.f;
#pragma unroll
                for (int k = 0; k < 16; ++k) s += NP[k * 64 + tid];
                nst = cs * nst + e2 * s; }
#pragma unroll
            for (int i = 0; i < 4; ++i) acc[i] = acc[i] * cs + ta[q][i] * e2; }
        LBAR();
    }
    { float* Co = OUTP + O_CP + (size_t)bh * 16384;
#pragma unroll
      for (int i = 0; i < 4; ++i)
#pragma unroll
          for (int j = 0; j < 4; ++j) Co[(64 * sl + 16 * dt + 4 * g + j) * 128 + 16 * (eb + i) + r] = acc[i][j];
      if (tid < 64) OUTP[O_NP + (size_t)bh * 128 + 64 * sl + tid] = nst;
      if (tid == 0 && sl == 0) OUTP[O_MP + bh] = MCc[32]; }
    __syncthreads();
}

__device__ __forceinline__ void chain_gla(Frame& F, int b, int hg, int sl) {
    char* L = F.ldsg;
    constexpr int KT_B = 32 * TS, VT_B = 128 * TS, BUF_B = KT_B + VT_B;
    const int tid = F_TID, lane = F_LANE, w = F_WAVE, r = lane & 15, g = lane >> 4;
    const int bh = b * 4 + hg; const size_t rowb = (size_t)b * SEQ;
    const int dpv = tid & 63, sg = tid >> 6;
    const int dt = w & 1, eb = 2 * (w >> 1);
    f32x4 acc[2];
    acc[0] = (f32x4){0.f, 0.f, 0.f, 0.f}; acc[1] = acc[0];
    v2u k4q[NCI]; f32x4 ebq[NCI]; unsigned vrq[NCI][8];
    const bf16* kbase = SCR + SC_KG + (rowb + lane) * 256 + hg * 64 + 32 * sl + 4 * w; const bf16* vbase = PROJ + (rowb + 8 * sg) * PS + C_GV + hg * 128 + 2 * dpv;
    const float* ebase = EBLG + (size_t)bh * NCH * 64 + 32 * sl + 16 * dt + 4 * g;
#pragma unroll
    for (int q = 0; q < NCI; ++q) { k4q[q] = *(const v2u*)(kbase + (size_t)(64 * q) * 256); ebq[q] = *(const f32x4*)(ebase + q * 64);
#pragma unroll
        for (int i = 0; i < 8; ++i) vrq[q][i] = *(const unsigned*)(vbase + (size_t)(64 * q + i) * PS); }
    for (int c0 = 0; c0 < NCH; c0 += NCI) {
        f32x4 eb4[NCI];
#pragma unroll
        for (int q = 0; q < NCI; ++q) { char* KT = L + q * BUF_B; char* VT = KT + KT_B; const v2u k4 = k4q[q]; const unsigned* vr = vrq[q]; eb4[q] = ebq[q];
            *(bf16*)(KT + (4 * w + 0) * TS + 2 * lane) = (bf16)(k4[0] & 0xffffu); *(bf16*)(KT + (4 * w + 1) * TS + 2 * lane) = (bf16)(k4[0] >> 16);
            *(bf16*)(KT + (4 * w + 2) * TS + 2 * lane) = (bf16)(k4[1] & 0xffffu); *(bf16*)(KT + (4 * w + 3) * TS + 2 * lane) = (bf16)(k4[1] >> 16);
            unsigned v0p[4], v1p[4];
#pragma unroll
            for (int i = 0; i < 8; i += 2) { v0p[i >> 1] = (vr[i] & 0xffffu) | (vr[i + 1] << 16); v1p[i >> 1] = (vr[i] >> 16) | (vr[i + 1] & 0xffff0000u); }
            *(v4u*)(VT + (2 * dpv) * TS + 16 * sg) = (v4u){v0p[0], v0p[1], v0p[2], v0p[3]};
            *(v4u*)(VT + (2 * dpv + 1) * TS + 16 * sg) = (v4u){v1p[0], v1p[1], v1p[2], v1p[3]}; }
        if (c0 + NCI < NCH) {
#pragma unroll
            for (int q = 0; q < NCI; ++q) { k4q[q] = *(const v2u*)(kbase + (size_t)(64 * (c0 + NCI + q)) * 256); ebq[q] = *(const f32x4*)(ebase + (c0 + NCI + q) * 64);
#pragma unroll
                for (int i = 0; i < 8; ++i) vrq[q][i] = *(const unsigned*)(vbase + (size_t)(64 * (c0 + NCI + q) + i) * PS); }
        }
        LBAR();
        f32x4 ta[NCI][2];
#pragma unroll
        for (int q = 0; q < NCI; ++q) { const char* KT = L + q * BUF_B; const char* VT = KT + KT_B;
            ta[q][0] = (f32x4){0.f, 0.f, 0.f, 0.f}; ta[q][1] = ta[q][0];
#pragma unroll
            for (int kk = 0; kk < 2; ++kk) {
                const bf16x8 af = lds_frag(KT + (16 * dt + r) * TS + (32 * kk + 8 * g) * 2);
#pragma unroll
                for (int i = 0; i < 2; ++i) ta[q][i] = mfma16(af, lds_frag(VT + (16 * (eb + i) + r) * TS + (32 * kk + 8 * g) * 2), ta[q][i]);
            } }
#pragma unroll
        for (int q = 0; q < NCI; ++q) { const int c = c0 + q;
            bf16* cst = CSG + (size_t)(bh * NCH + c) * 8192;
#pragma unroll
            for (int i = 0; i < 2; ++i)
                *(v2u*)(cst + ((eb + i) * 4 + 2 * sl + dt) * 256 + r * 16 + 4 * g) = (v2u){pg8::cvt_pk_bf16(acc[i][0], acc[i][1]), pg8::cvt_pk_bf16(acc[i][2], acc[i][3])};
            acc[0] = (acc[0] + ta[q][0]) * eb4[q]; acc[1] = (acc[1] + ta[q][1]) * eb4[q]; }
        LBAR();
    }
    { float* So = OUTP + O_SP + (size_t)bh * 8192;
#pragma unroll
      for (int i = 0; i < 2; ++i)
#pragma unroll
          for (int j = 0; j < 4; ++j) So[(32 * sl + 16 * dt + 4 * g + j) * 128 + 16 * (eb + i) + r] = acc[i][j]; }
    __syncthreads();
}

__device__ __forceinline__ void sample_item(Frame& F, int n, int hh, float* Wl, int lane) {
    asm volatile("" : "+v"(lane));
    float* qv = Wl; float* kv = Wl + 128; float* vv = Wl + 256; float* al = Wl + 384;
    const size_t row = (size_t)MP + n;
    const bf16* Pr = PROJ + row * PS;
    const bool gla = hh >= 4; const int h = hh & 3;
    const int e4 = lane & 31, dh = lane >> 5;
    float cs = 1.f, wkk = 1.f, dinv = 1.f;
    if (!gla) {
        float qk2[2][2];
#pragma unroll
        for (int isk = 0; isk < 2; ++isk)
#pragma unroll
            for (int q = 0; q < 2; ++q) { const int d = lane + 64 * q, ch = isk * 512 + h * 128 + d;
                const float* scv = ST_CONV + (size_t)n * 3 * 1024 + ch;
                float a = CONV_B[ch] + CONV_W[ch] * scv[0] + CONV_W[1024 + ch] * scv[1024] + CONV_W[2048 + ch] * scv[2048] + CONV_W[3072 + ch] * bf2f(Pr[(isk ? C_MK : C_MQ) + h * 128 + d]);
                a = a * sigmoidf(a); if (isk) a *= KSCALE; qk2[isk][q] = a; (isk ? kv : qv)[d] = a; }
        vv[lane] = bf2f(Pr[C_MV + h * 128 + lane]); vv[lane + 64] = bf2f(Pr[C_MV + h * 128 + lane + 64]);
        const float* n0 = ST_N + ((size_t)n * 4 + h) * 128; const float n00 = n0[lane], n01 = n0[lane + 64];
        const float qk = wave_sum(qk2[0][0] * qk2[1][0] + qk2[0][1] * qk2[1][1]), qn = wave_sum(qk2[0][0] * n00 + qk2[0][1] * n01);
        const float ig = bf2f(Pr[C_SM + h]) + B_GATE[h], lf = logsig(bf2f(Pr[C_SM + 4 + h]) + B_GATE[4 + h]);
        const float m0 = ST_M[n * 4 + h], mn = fmaxf(lf + m0, ig);
        wkk = __expf(ig - mn); cs = __expf(lf + m0 - mn);
        const float den = cs * qn + qk * wkk;
        dinv = __builtin_amdgcn_rcpf(fmaxf(fabsf(den), __expf(-mn)));
        float* nsO = OUTP + O_NS + ((size_t)n * 4 + h) * 128; nsO[lane] = cs * n00 + wkk * qk2[1][0]; nsO[lane + 64] = cs * n01 + wkk * qk2[1][1];
        if (lane == 0) OUTP[O_MS + n * 4 + h] = mn;
    } else {
        qv[lane] = bf2f(Pr[C_GQ + h * 64 + lane]); kv[lane] = bf2f(Pr[C_GK + h * 64 + lane]);
        vv[lane] = bf2f(Pr[C_GV + h * 128 + lane]); vv[lane + 64] = bf2f(Pr[C_GV + h * 128 + lane + 64]);
        { const int col = h * 64 + lane; float z = B_A[col];
#pragma unroll
          for (int q = 0; q < 16; ++q) z += bf2f(Pr[C_SM + 8 + q]) * IN_F(13)[q * 256 + col];
          al[lane] = __expf(logsig(z) * (1.f / 16.f)); }
    }
    asm volatile("s_waitcnt lgkmcnt(0)" ::: "memory");
    const f32x4 v4 = *(const f32x4*)(vv + 4 * e4);
    f32x4 hp = (f32x4){0.f, 0.f, 0.f, 0.f};
    if (!gla) {
        const float* C0 = ST_C + ((size_t)n * 4 + h) * 16384 + (size_t)(64 * dh) * 128 + 4 * e4; float* Cn = OUTP + O_CS + ((size_t)n * 4 + h) * 16384 + (size_t)(64 * dh) * 128 + 4 * e4;
        for (int i0 = 0; i0 < 64; i0 += 8) { f32x4 c0[8];
#pragma unroll
            for (int i = 0; i < 8; ++i) c0[i] = __builtin_nontemporal_load((const f32x4*)(C0 + (i0 + i) * 128));
#pragma unroll
            for (int i = 0; i < 8; ++i) { const int d = 64 * dh + i0 + i; const f32x4 cn = c0[i] * cs + v4 * (wkk * kv[d]); __builtin_nontemporal_store(cn, (f32x4*)(Cn + (i0 + i) * 128)); hp += cn * qv[d]; } }
    } else {
        const float* S0 = ST_S + ((size_t)n * 4 + h) * 8192 + (size_t)(32 * dh) * 128 + 4 * e4; float* Sn = OUTP + O_SS + ((size_t)n * 4 + h) * 8192 + (size_t)(32 * dh) * 128 + 4 * e4;
        for (int i0 = 0; i0 < 32; i0 += 8) { f32x4 c0[8];
#pragma unroll
            for (int i = 0; i < 8; ++i) c0[i] = __builtin_nontemporal_load((const f32x4*)(S0 + (i0 + i) * 128));
#pragma unroll
            for (int i = 0; i < 8; ++i) { const int d = 32 * dh + i0 + i; const f32x4 sn = c0[i] * al[d] + v4 * kv[d]; __builtin_nontemporal_store(sn, (f32x4*)(Sn + (i0 + i) * 128)); hp += sn * qv[d]; } }
    }
#pragma unroll
    for (int j = 0; j < 4; ++j) hp[j] += __shfl_xor(hp[j], 32);
    hp = hp * dinv;
    float ssum = (hp[0] * hp[0] + hp[1] * hp[1]) + (hp[2] * hp[2] + hp[3] * hp[3]);
#pragma unroll
    for (int o = 1; o < 32; o <<= 1) ssum += __shfl_xor(ssum, o);
    const float rn = rsqrt_fast(ssum * (1.f / 128.f) + EPS);
    if (lane < 32) {
        const v2u gw = *(const v2u*)(Pr + (gla ? C_GR : C_MO) + h * 128 + 4 * e4);
        const f32x4 g4 = *(const f32x4*)((gla ? G_GHEAD : G_MHEAD) + h * 128 + 4 * e4);
        const float gt[4] = {bflo(gw[0]), bfhi(gw[0]), bflo(gw[1]), bfhi(gw[1])}; float o[4];
#pragma unroll
        for (int j = 0; j < 4; ++j) { const float sg_ = sigmoidf(gt[j]); o[j] = hp[j] * rn * g4[j] * (gla ? gt[j] * sg_ : sg_); }
        int e4o = e4; asm volatile("" : "+v"(e4o));
        *(v2u*)(R1B + row * D + (gla ? 512 : 0) + h * 128 + 4 * e4o) = (v2u){pg8::cvt_pk_bf16(o[0], o[1]), pg8::cvt_pk_bf16(o[2], o[3])};
    }
    asm volatile("s_waitcnt lgkmcnt(0)" ::: "memory");
}

constexpr int P2B_QS = 0, P2B_KS = 64 * QS_P, P2B_VT = P2B_KS + 80 * QS_P, P2B_PS = P2B_VT + 128 * TS, P2B_FL = P2B_PS + 64 * TS, P2B_HALF = P2B_FL + 2560;
static_assert(2 * P2B_HALF <= MISC_OFF, "P2b LDS");
__device__ __forceinline__ void p2b_unit(Frame& F, int u, const bool GLA, char* L, int ltid, int lw, int lane) {
    const int v = u & 1023, bh = v >> 5, c = v & 31, b = bh >> 2, h = bh & 3, r = lane & 15, g = lane >> 4;
    const size_t rowb = (size_t)b * SEQ + c * 64;
    const bf16* P = PROJ;
    char* QSp = L + P2B_QS; char* KSp = L + P2B_KS; char* VTp = L + P2B_VT; char* PSp = L + P2B_PS;
    float* af = (float*)(L + P2B_FL); float* Mf = af + 64; float* scf = af + 128; float* enf = af + 192; float* dinvf = af + 256; float* ssq = af + 320;
    const int QP = GLA ? TS : QS_P;
    const int NK = GLA ? 2 : 4;
    bf16x8 cfr[2][4];
    { const bf16* CT = GLA ? CSG + (size_t)(bh * NCH + c) * 8192 : CSM + (size_t)(bh * NCH + c) * 16384;
#pragma unroll
      for (int n2 = 0; n2 < 2; ++n2)
#pragma unroll
          for (int kk = 0; kk < 4; ++kk) if (kk < NK) cfr[n2][kk] = *(const bf16x8*)(CT + ((2 * lw + n2) * (GLA ? 4 : 8) + 2 * kk + (g >> 1)) * 256 + r * 16 + 8 * (g & 1)); }
    const int dp = ltid & 63, sg = ltid >> 6;
    v2u gwq[4][2];
#pragma unroll
    for (int mt = 0; mt < 4; ++mt)
#pragma unroll
        for (int n2 = 0; n2 < 2; ++n2) gwq[mt][n2] = *(const v2u*)(P + (rowb + 16 * mt + r) * PS + (GLA ? C_GR : C_MO) + h * 128 + 32 * lw + 16 * n2 + 4 * g);
    float* rsf = ssq + 256;
    if (!GLA) {
        { const float a = GA_A[(size_t)bh * SEQ + c * 64 + lane], bc = GA_B[(size_t)bh * SEQ + c * 64 + lane];
          const float pm = wave_scan_max(a, lane);
          const float mc = MCS[bh * NCH + c], pmx = PMXG[bh * NCH + c], Mt = fmaxf(mc, pm);
          if (lw == 0) { Mf[lane] = Mt; scf[lane] = __expf(mc - Mt); enf[lane] = __expf(-(bc + Mt)); rsf[lane] = __expf(pmx - Mt); } }
        {
#pragma unroll
          for (int i = 0; i < 4; ++i) { const int pc = ltid + 256 * i, row = pc >> 4, c16 = pc & 15;
              const v4u qq = *(const v4u*)(SCR + SC_QP + (rowb + row) * 512 + h * 128 + 8 * c16), kk4 = *(const v4u*)(SCR + SC_KW + (rowb + row) * 512 + h * 128 + 8 * c16);
              *(v4u*)(QSp + row * QS_P + 16 * c16) = qq; *(v4u*)(KSp + row * QS_P + 16 * c16) = kk4; } }
        if (ltid < 128) *(bf16*)(KSp + 64 * QS_P + 2 * ltid) = (bf16)f2bf(NCS[(size_t)(bh * NCH + c) * 128 + ltid]);
        for (int i = ltid; i < 15 * 64; i += 256) *(unsigned*)(KSp + (65 + i / 64) * QS_P + 4 * (i & 63)) = 0u;
    } else {
#pragma unroll
        for (int i = 0; i < 2; ++i) { const int pc = ltid + 256 * i, row = pc >> 3, c16 = pc & 7;
            const v4u qq = *(const v4u*)(SCR + SC_QG + (rowb + row) * 256 + h * 64 + 8 * c16), kk4 = *(const v4u*)(SCR + SC_KG + (rowb + row) * 256 + h * 64 + 8 * c16);
            *(v4u*)(QSp + row * TS + 16 * c16) = qq; *(v4u*)(KSp + row * TS + 16 * c16) = kk4; }
    }
    {
      unsigned vr[16];
#pragma unroll
      for (int i = 0; i < 16; ++i) vr[i] = *(const unsigned*)(P + (rowb + 16 * sg + i) * PS + (GLA ? C_GV : C_MV) + h * 128 + 2 * dp);
      unsigned v0p[8], v1p[8];
#pragma unroll
      for (int i = 0; i < 16; i += 2) { v0p[i >> 1] = (vr[i] & 0xffffu) | (vr[i + 1] << 16); v1p[i >> 1] = (vr[i] >> 16) | (vr[i + 1] & 0xffff0000u); }
      *(v4u*)(VTp + (2 * dp) * TS + 32 * sg) = (v4u){v0p[0], v0p[1], v0p[2], v0p[3]}; *(v4u*)(VTp + (2 * dp) * TS + 32 * sg + 16) = (v4u){v0p[4], v0p[5], v0p[6], v0p[7]};
      *(v4u*)(VTp + (2 * dp + 1) * TS + 32 * sg) = (v4u){v1p[0], v1p[1], v1p[2], v1p[3]}; *(v4u*)(VTp + (2 * dp + 1) * TS + 32 * sg + 16) = (v4u){v1p[4], v1p[5], v1p[6], v1p[7]}; }
    __syncthreads();
    {
        f32x4 pa[5];
#pragma unroll
        for (int i = 0; i < 5; ++i) pa[i] = (f32x4){0.f, 0.f, 0.f, 0.f};
#pragma unroll
        for (int kk = 0; kk < 4; ++kk) if (kk < NK) {
            const bf16x8 qf = lds_frag(QSp + (16 * lw + r) * QP + (32 * kk + 8 * g) * 2);
#pragma unroll
            for (int nt = 0; nt < 4; ++nt) if (nt <= lw) pa[nt] = mfma16(lds_frag(KSp + (16 * nt + r) * QP + (32 * kk + 8 * g) * 2), qf, pa[nt]);
            if (!GLA) pa[4] = mfma16(lds_frag(KSp + (64 + r) * QP + (32 * kk + 8 * g) * 2), qf, pa[4]);
        }
        const int t = 16 * lw + r;
        float rsc = 1.f; if (!GLA) rsc = rsf[t];
        float rs = 0.f;
#pragma unroll
        for (int nt = 0; nt < 4; ++nt) {
            f32x4 p = (f32x4){0.f, 0.f, 0.f, 0.f};
            if (nt <= lw) {
#pragma unroll
                for (int j = 0; j < 4; ++j) { const int s = 16 * nt + 4 * g + j; p[j] = (s <= t) ? pa[nt][j] * rsc : 0.f; }
            }
            rs += (p[0] + p[1]) + (p[2] + p[3]);
            *(v2u*)(PSp + t * TS + (16 * nt + 4 * g) * 2) = (v2u){pg8::cvt_pk_bf16(p[0], p[1]), pg8::cvt_pk_bf16(p[2], p[3])};
        }
        if (!GLA) {
            rs += __shfl_xor(rs, 16); rs += __shfl_xor(rs, 32);
            if (g == 0) { const float den = scf[t] * pa[4][0] + rs; dinvf[t] = __builtin_amdgcn_rcpf(fmaxf(fabsf(den), enf[t])); }
        }
    }
    __syncthreads();
    f32x4 hv[4][2];
    {
        f32x4 aV[4][2], aC[4][2];
#pragma unroll
        for (int mt = 0; mt < 4; ++mt)
#pragma unroll
            for (int n2 = 0; n2 < 2; ++n2) { aV[mt][n2] = (f32x4){0.f, 0.f, 0.f, 0.f}; aC[mt][n2] = (f32x4){0.f, 0.f, 0.f, 0.f}; }
#pragma unroll
        for (int kk = 0; kk < 2; ++kk) {
            bf16x8 vf[2];
#pragma unroll
            for (int n2 = 0; n2 < 2; ++n2) vf[n2] = lds_frag(VTp + (32 * lw + 16 * n2 + r) * TS + (32 * kk + 8 * g) * 2);
#pragma unroll
            for (int mt = 0; mt < 4; ++mt) { const bf16x8 pf = lds_frag(PSp + (16 * mt + r) * TS + (32 * kk + 8 * g) * 2);
#pragma unroll
                for (int n2 = 0; n2 < 2; ++n2) aV[mt][n2] = mfma16(vf[n2], pf, aV[mt][n2]); }
        }
#pragma unroll
        for (int kk = 0; kk < 4; ++kk) if (kk < NK)
#pragma unroll
            for (int mt = 0; mt < 4; ++mt) { const bf16x8 qf = lds_frag(QSp + (16 * mt + r) * QP + (32 * kk + 8 * g) * 2);
#pragma unroll
                for (int n2 = 0; n2 < 2; ++n2) aC[mt][n2] = mfma16(cfr[n2][kk], qf, aC[mt][n2]); }
#pragma unroll
        for (int mt = 0; mt < 4; ++mt) { const int t = 16 * mt + r;
            float sc = 1.f, di = 1.f; if (!GLA) { sc = scf[t]; di = dinvf[t]; }
            float s = 0.f;
#pragma unroll
            for (int n2 = 0; n2 < 2; ++n2) { hv[mt][n2] = (aC[mt][n2] * sc + aV[mt][n2]) * di;
                s += (hv[mt][n2][0] * hv[mt][n2][0] + hv[mt][n2][1] * hv[mt][n2][1]) + (hv[mt][n2][2] * hv[mt][n2][2] + hv[mt][n2][3] * hv[mt][n2][3]); }
            s += __shfl_xor(s, 16); s += __shfl_xor(s, 32);
            if (g == 0) ssq[t * 4 + lw] = s; }
    }
    __syncthreads();
    {
        const float* gn = (GLA ? G_GHEAD : G_MHEAD) + h * 128;
#pragma unroll
        for (int mt = 0; mt < 4; ++mt) { const int t = 16 * mt + r; const f32x4 s4 = *(const f32x4*)(ssq + 4 * t);
            const float rn = rsqrt_fast(((s4[0] + s4[1]) + (s4[2] + s4[3])) * (1.f / 128.f) + EPS);
#pragma unroll
            for (int n2 = 0; n2 < 2; ++n2) { const int e = 32 * lw + 16 * n2 + 4 * g;
                const v2u gw = gwq[mt][n2];
                const f32x4 g4 = *(const f32x4*)(gn + e);
                float gt[4] = {bflo(gw[0]), bfhi(gw[0]), bflo(gw[1]), bfhi(gw[1])}; float o[4];
#pragma unroll
                for (int j = 0; j < 4; ++j) { const float sg_ = sigmoidf(gt[j]); o[j] = hv[mt][n2][j] * rn * g4[j] * (GLA ? gt[j] * sg_ : sg_); }
                *(v2u*)(R1B + (rowb + t) * D + (GLA ? 512 : 0) + h * 128 + e) = (v2u){pg8::cvt_pk_bf16(o[0], o[1]), pg8::cvt_pk_bf16(o[2], o[3])}; } }
    }
    __syncthreads();
}

template <int K, int RT>
__device__ __forceinline__ void skinny_acc(const bf16* A, const bf16* Bt, int nsl, f32x4 (&acc)[RT], int w, int r, int g) {
    constexpr int KW = K / 8, NKS = KW / 32, KBMAX = RT <= 2 ? 8 : 4, KB = NKS < KBMAX ? NKS : KBMAX;
    const bf16* ap = A + (size_t)r * K + w * KW + 8 * g;
    const bf16* bp = Bt + (size_t)(nsl * 16 + r) * K + w * KW + 8 * g;
#pragma unroll 1
    for (int ks = 0; ks < NKS; ks += KB) {
        bf16x8 bfr[KB], afr[RT][KB];
#pragma unroll
        for (int kk = 0; kk < KB; ++kk) { bfr[kk] = *(const bf16x8*)(bp + 32 * (ks + kk));
#pragma unroll
            for (int rt = 0; rt < RT; ++rt) afr[rt][kk] = *(const bf16x8*)(ap + (size_t)rt * 16 * K + 32 * (ks + kk)); }
#pragma unroll
        for (int kk = 0; kk < KB; ++kk)
#pragma unroll
            for (int rt = 0; rt < RT; ++rt) acc[rt] = mfma16(bfr[kk], afr[rt][kk], acc[rt]);
    }
}
template <int RT> __device__ __forceinline__ void skinny_put(float* red, const f32x4 (&acc)[RT], int w, int r, int g) {
#pragma unroll
    for (int rt = 0; rt < RT; ++rt) *(f32x4*)(red + w * (RT * 256) + (16 * rt + r) * 16 + 4 * g) = acc[rt];
}
template <int RT> __device__ __forceinline__ f32x4 skinny_get(const float* red, int row, int c4) {
    f32x4 v = (f32x4){0.f, 0.f, 0.f, 0.f};
#pragma unroll
    for (int q = 0; q < 8; ++q) v += *(const f32x4*)(red + q * (RT * 256) + row * 16 + 4 * c4);
    return v;
}
template <int RT> __device__ __forceinline__ void zeroacc(f32x4 (&acc)[RT]) {
#pragma unroll
    for (int i = 0; i < RT; ++i) acc[i] = (f32x4){0.f, 0.f, 0.f, 0.f};
}
__device__ __forceinline__ float quad_sum(float s) { s += __shfl_xor(s, 1); s += __shfl_xor(s, 2); return s; }
__device__ __forceinline__ v2u pack4(f32x4 v) { return (v2u){pg8::cvt_pk_bf16(v[0], v[1]), pg8::cvt_pk_bf16(v[2], v[3])}; }
template <bool RES_BF16>
__device__ __forceinline__ void skinny_res(Frame& F, const bf16* A, const bf16* Bt, int K4096, const void* res, bf16* ob, float* ss) {
    float* red = (float*)F.ldsg; const int tid = F_TID, lane = F_LANE, w = F_WAVE, r = lane & 15, g = lane >> 4, lrow = tid >> 2, c4 = tid & 3;
    for (int it = blockIdx.x; it < 4 * (D / 16); it += F.G) { const int nsl = it >> 2, r0 = 32 * (it & 3);
        f32x4 acc[2]; zeroacc<2>(acc);
        if (K4096) skinny_acc<FF, 2>(A + (size_t)r0 * FF, Bt, nsl, acc, w, r, g); else skinny_acc<D, 2>(A + (size_t)r0 * D, Bt, nsl, acc, w, r, g);
        skinny_put<2>(red, acc, w, r, g); LBAR();
        if (tid < 128) { const int row = r0 + lrow;
            const size_t off = (size_t)row * D + nsl * 16 + 4 * c4;
            f32x4 rv;
            if constexpr (RES_BF16) { const v2u rw = *(const v2u*)((const bf16*)res + off); rv = (f32x4){bflo(rw.x), bfhi(rw.x), bflo(rw.y), bfhi(rw.y)}; }
            else rv = *(const f32x4*)((const float*)res + off);
            const f32x4 v = skinny_get<2>(red, lrow, c4) + rv;
            *(v2u*)(ob + off) = pack4(v);
            const float s = quad_sum((v[0] * v[0] + v[1] * v[1]) + (v[2] * v[2] + v[3] * v[3]));
            if (c4 == 0) atomicAdd(ss + row, s); }
        LBAR();
    }
}
__device__ __forceinline__ void skinny_up(Frame& F, const bf16* A, const bf16* Bt, const float* ss, bf16* U) {
    float* red = (float*)F.ldsg; const int tid = F_TID, lane = F_LANE, w = F_WAVE, r = lane & 15, g = lane >> 4, row = tid >> 2, c4 = tid & 3;
    for (int sl = blockIdx.x; sl < FF / 16; sl += F.G) {
        f32x4 acc[8]; zeroacc<8>(acc);
        skinny_acc<D, 8>(A, Bt, sl, acc, w, r, g);
        skinny_put<8>(red, acc, w, r, g); LBAR();
        const float rs = rsqrt_fast(ss[row] * (1.f / D) + EPS);
        f32x4 v = skinny_get<8>(red, row, c4) * rs;
#pragma unroll
        for (int j = 0; j < 4; ++j) { const float a = fmaxf(v[j], 0.f); v[j] = a * a; }
        *(v2u*)(U + (size_t)row * FF + sl * 16 + 4 * c4) = pack4(v);
        LBAR();
    }
}
__device__ __forceinline__ void skinny_ple(Frame& F, const bf16* pbs, const bf16* Wple, const bf16* x2b, const bf16* Wpg, const float* ss2, bf16* x3b, float* ss3,
                                           const bool FUSE, float* ysm, const float* gfin, float* slots  , unsigned* qcnt  ) {
    float* red = (float*)F.ldsg; float* red2 = red + 8 * 512; const int tid = F_TID, lane = F_LANE, w = F_WAVE, r = lane & 15, g = lane >> 4, lrow = tid >> 2, c4 = tid & 3;
    for (int it = blockIdx.x; it < 4 * (D / 16); it += F.G) { const int nsl = it >> 2, rq = it & 3, r0 = 32 * rq;
        f32x4 acc[2]; zeroacc<2>(acc);
        skinny_acc<DPLE, 2>(pbs + (size_t)r0 * DPLE, Wple, nsl, acc, w, r, g); skinny_put<2>(red2, acc, w, r, g);
        zeroacc<2>(acc);
        skinny_acc<D, 2>(x2b + (size_t)r0 * D, Wpg, nsl, acc, w, r, g); skinny_put<2>(red, acc, w, r, g); LBAR();
        const int row = r0 + (lrow & 31);
        const size_t off = (size_t)row * D + nsl * 16 + 4 * c4;
        f32x4 v = (f32x4){0.f, 0.f, 0.f, 0.f};
        if (tid < 128) {
            const float rs = rsqrt_fast(ss2[row] * (1.f / D) + EPS);
            const f32x4 gt = skinny_get<2>(red, lrow, c4) * rs, pp = skinny_get<2>(red2, lrow, c4); const v2u xw = *(const v2u*)(x2b + off);
            v = (f32x4){bflo(xw.x), bfhi(xw.x), bflo(xw.y), bfhi(xw.y)};
#pragma unroll
            for (int j = 0; j < 4; ++j) v[j] += pp[j] * sigmoidf(gt[j]);
            const float sq = quad_sum((v[0] * v[0] + v[1] * v[1]) + (v[2] * v[2] + v[3] * v[3]));
            if (!FUSE) { *(v2u*)(x3b + off) = pack4(v); if (c4 == 0) atomicAdd(ss3 + row, sq); }
            else if (c4 == 0) __hip_atomic_store(slots + row * 64 + nsl, sq, __ATOMIC_RELAXED, __HIP_MEMORY_SCOPE_AGENT);
        }
        if (FUSE) {
            asm volatile("s_waitcnt vmcnt(0)" ::: "memory");
            __syncthreads();
            if (tid == 0) { __hip_atomic_fetch_add(qcnt + 64 * rq, 1u, __ATOMIC_RELAXED, __HIP_MEMORY_SCOPE_AGENT);
                unsigned sp = 0;
                while (__hip_atomic_load(qcnt + 64 * rq, __ATOMIC_RELAXED, __HIP_MEMORY_SCOPE_AGENT) < (unsigned)(D / 16)) { __builtin_amdgcn_s_sleep(2); if (++sp > (1u << 22)) break; }
                __builtin_amdgcn_fence(__ATOMIC_ACQUIRE, "agent");
                asm volatile("s_waitcnt vmcnt(0)" ::: "memory"); }
            __syncthreads();
            if (tid < 128) { float t = 0.f;
#pragma unroll
                for (int q = 0; q < 16; ++q) t += __hip_atomic_load(slots + row * 64 + 16 * c4 + q, __ATOMIC_RELAXED, __HIP_MEMORY_SCOPE_AGENT);
                t = quad_sum(t);
                const float rn = rsqrt_fast(t * (1.f / D) + EPS);
                *(f32x4*)(ysm + off) = v * rn * *(const f32x4*)(gfin + nsl * 16 + 4 * c4); }
        }
        LBAR();
    }
}

constexpr int NPHASE = 9;

__global__ void __launch_bounds__(NWAVES * 64, 2) mk_fwd(Args args) {
    extern __shared__ __attribute__((aligned(16))) unsigned char lds[];
    Frame F;
    F.lds = (LAS unsigned char*)lds; F.ldsg = (char*)lds;
    F.G = gridDim.x;
    F.a = (CArgs*)__builtin_amdgcn_kernarg_segment_ptr();
    unsigned char* ws = F.a->ws;
    volatile LAS unsigned* MISC = (volatile LAS unsigned*)(F.lds + MISC_OFF);
    for (int u = F_TID; u < 64; u += NWAVES * 64) MISC[u] = 0u;
    __syncthreads();
    XcdBarrier bar; bar.bar = (unsigned*)(ws + CTL_BAR_B); bar.x = 0; bar.st = nullptr;
    bar = xcd_barrier_post((unsigned*)(ws + CTL_BAR_B), MISC + 8);
    const int lo = F.a->ph_lo, hi = F.a->ph_hi;
#define IN(k) (lo <= (k) && (k) < hi)
#define SEAM(k) do { if (IN(k) && IN((k) + 1)) xcd_barrier(bar); } while (0)

    if (IN(0)) { p0_prologue(F); SEAM(0); }
    if (IN(1)) {
        pg8::Gemm g{R1B, WIN_T, MR, PS, D}; pg8::StaticOrder S; S.init(MR, PS, F.G, (int)blockIdx.x);
        EpiProj E{PROJ, PS};
        pg8::gemm_phase<EpiProj, pg8::StaticOrder, PG8_ALIGN, PG8_SP2>(F.lds, g, S, E);
        SEAM(1);
    }
    if (IN(2)) {
        const int bx = blockIdx.x;
        for (int it = bx; it < NB * NCH; it += F.G) p2p_item(F, it >> 5, it & 31);
        xcd_barrier(bar);

#define P2A_CHAINS() do { const int cb_ = bx & 63; if (cb_ < 32) chain_mlstm(F, cb_ >> 2, cb_ & 3, bx >> 6); else chain_gla(F, (cb_ - 32) >> 2, (cb_ - 32) & 3, bx >> 6); } while (0)
#define P2A_SAMPLES() do { float* Wl = (float*)(F.ldsg + F_WAVE * 2048); \
              for (int it = (bx - 128) * NWAVES + F_WAVE; it < MSMP * 8; it += (F.G - 128) * NWAVES) sample_item(F, it >> 3, it & 7, Wl, F_LANE); } while (0)
        if (bx < 128) { P2A_CHAINS(); }
        else {
            const int nb = F.G - 128, gb = bx - 128;
            P2A_SAMPLES();
            for (int i = gb * 512 + F_TID; i < NB * 3 * 1024 + MSMP * 3 * 1024; i += nb * 512) {
                if (i < NB * 3 * 1024) { const int b = i / 3072, j = (i / 1024) % 3, ch = i & 1023; OUTP[O_CVP + i] = bf2f(PROJ[((size_t)b * SEQ + SEQ - 3 + j) * PS + ch]); }
                else { const int k = i - NB * 3 * 1024, n = k / 3072, j = (k / 1024) % 3, ch = k & 1023;
                    OUTP[O_CVS + k] = j < 2 ? ST_CONV[(size_t)n * 3072 + (j + 1) * 1024 + ch] : bf2f(PROJ[((size_t)MP + n) * PS + ch]); }
            }
            __syncthreads();
            late_weight_copies(F, gb, nb);
        }
        SEAM(2);
    }
    if (IN(3)) {
        const int hb = F_WAVE >> 2, ltid = F_TID & 255, lw = F_WAVE & 3;
        char* L = F.ldsg + hb * P2B_HALF;
        for (int it = 0; it * 2 * F.G < 2048; ++it) {
            const int u = (it * F.G + (int)blockIdx.x) * 2 + hb;
            if (u - hb >= 2048) break;
            p2b_unit(F, u, u >= 1024, L, ltid, lw, F_LANE);
        }
        SEAM(3);
    }
    if (IN(4)) {
        pg8::Gemm g{R1B, WOUT_T, MP, D, D}; pg8::StaticOrder S; S.init(MP, D, F.G, (int)blockIdx.x);
        EpiRes<false> E{X_P, X1B, SS1};
        pg8::gemm_phase<EpiRes<false>, pg8::StaticOrder, PG8_ALIGN, PG8_SP2>(F.lds, g, S, E);
        skinny_res<false>(F, R1B + (size_t)MP * D, WOUT_T, 0, X_S, X1B + (size_t)MP * D, SS1 + MP);
        SEAM(4);
    }
    if (IN(5)) {
        pg8::Gemm g{X1B, W1_T, MP, FF, D}; pg8::StaticOrder S; S.init(MP, FF, F.G, (int)blockIdx.x);
        EpiU E{UBUF, SS1};
        const bool skinny_first = (blockIdx.x & 8) != 0;
        if (skinny_first) skinny_up(F, X1B + (size_t)MP * D, W1_T, SS1 + MP, UBUF + (size_t)MP * FF);
        pg8::gemm_phase<EpiU, pg8::StaticOrder, PG8_ALIGN, PG8_SP2>(F.lds, g, S, E);
        if (!skinny_first) skinny_up(F, X1B + (size_t)MP * D, W1_T, SS1 + MP, UBUF + (size_t)MP * FF);
        SEAM(5);
    }
    if (IN(6)) {
        pg8::Gemm g{UBUF, W2_T, MP, D, FF}; pg8::StaticOrder S; S.init(MP, D, F.G, (int)blockIdx.x);
        EpiRes<true> E{X1B, R1B, SS2};
        pg8::gemm_phase<EpiRes<true>, pg8::StaticOrder, PG8_ALIGN, PG8_SP2>(F.lds, g, S, E);

        skinny_res<true>(F, UBUF + (size_t)MP * FF, W2_T, 1, X1B + (size_t)MP * D, R1B + (size_t)MP * D, SS2 + MP);
        SEAM(6);
    }
    if (IN(7)) {
        { pg8::Gemm g{PBUF, WPLE_T, MP, D, DPLE}; pg8::StaticOrder S; S.init(MP, D, F.G, (int)blockIdx.x);
          EpiProj E{PPB, D};
          pg8::gemm_phase<EpiProj, pg8::StaticOrder, PG8_ALIGN, PG8_SP2>(F.lds, g, S, E); }
        { pg8::Gemm g{R1B, WPG_T, MP, D, D}; pg8::StaticOrder S; S.init(MP, D, F.G, (int)blockIdx.x);
          EpiPleFinal E{R1B, PPB, OUTP, SS2, G_FINAL, (float*)(WSB + WS_XBUF), (unsigned*)(WSB + CTL_PCNT_B)};
          pg8::gemm_phase<EpiPleFinal, pg8::StaticOrder, false, PG8_SP2>(F.lds, g, S, E); }
        const bool fuse_s = F.G >= 4 * (D / 16);
        skinny_ple(F, PBUF + (size_t)MP * DPLE, WPLE_T, R1B + (size_t)MP * D, WPG_T, SS2 + MP, X1B + (size_t)MP * D, SS3 + MP,
                   fuse_s, OUTP + (size_t)MP * D, G_FINAL, (float*)(WSB + WS_XBUF + 262144), (unsigned*)(WSB + CTL_PCNT_B) + 64 * 64);
        if (!fuse_s) SEAM(7);
    }
    if (IN(8) && F.G < 4 * (D / 16)) {
        const int gw = blockIdx.x * NWAVES + F_WAVE, NGW = F.G * NWAVES;
        for (int m = MP + gw; m < MV; m += NGW) {
            const GAS v2u* xr = (const GAS v2u*)(X1B + (size_t)m * D) + F_LANE; GAS f32x4* yo = (GAS f32x4*)(OUTP + (size_t)m * D) + F_LANE;
            const float r = rsqrt_fast(SS3[m] * (1.f / D) + EPS);
#pragma unroll
            for (int j = 0; j < 4; ++j) { const f32x4 gf = ((const GAS f32x4*)G_FINAL)[F_LANE + 64 * j]; const v2u xw = xr[64 * j];
                yo[64 * j] = (f32x4){bflo(xw.x), bfhi(xw.x), bflo(xw.y), bfhi(xw.y)} * r * gf; }
        }

    }
#undef IN
#undef SEAM
}

extern "C" void kernel_launch(void* const* d_in, const int* in_sizes, int n_in, void* d_out, int out_size, void* d_ws, size_t ws_size, hipStream_t stream) {
    static int grid = 0;
    if (grid == 0) {
        if (n_in != 26 || ws_size < WS_END) { fprintf(stderr, "kernel_launch: unexpected n_in %d / ws %zu\n", n_in, ws_size); grid = -1; return; }
        int dev = 0, cus = 0, per_cu = 0;
        if (hipGetDevice(&dev) != hipSuccess || hipDeviceGetAttribute(&cus, hipDeviceAttributeMultiprocessorCount, dev) != hipSuccess) { grid = -1; return; }
        if (hipFuncSetAttribute((const void*)mk_fwd, hipFuncAttributeMaxDynamicSharedMemorySize, LDS_BYTES) != hipSuccess) { fprintf(stderr, "kernel_launch: hipFuncSetAttribute failed\n"); grid = -1; return; }
        if (hipOccupancyMaxActiveBlocksPerMultiprocessor(&per_cu, (const void*)mk_fwd, NWAVES * 64, LDS_BYTES) != hipSuccess || per_cu < 1) { fprintf(stderr, "kernel_launch: occupancy query says %d\n", per_cu); per_cu = 1; }
        (void)hipGetLastError();
        grid = cus;
        if (grid > 256) grid = 256;
    }
    if (grid < 0) return;
    (void)hipMemsetAsync((char*)d_ws + WS_CTL, 0, CTL_ZERO_BYTES, stream);
    Args a{};
    for (int i = 0; i < 26; ++i) a.in[i] = (const float*)d_in[i];
    a.out = (float*)d_out; a.ws = (unsigned char*)d_ws;
    a.ph_lo = 0; a.ph_hi = NPHASE; a.li = 0;
    hipLaunchKernelGGL(mk_fwd, dim3(grid), dim3(NWAVES * 64), LDS_BYTES, stream, a);
}
```

```cpp
#include <hip/hip_runtime.h>
#include <cstdio>
#include <cstdint>


namespace pg8 {
#define PG8_LAS __attribute__((address_space(3)))
typedef unsigned short bf16_t;
typedef short bf16x8 __attribute__((ext_vector_type(8)));
typedef float f32x4 __attribute__((ext_vector_type(4)));
typedef unsigned u32x4 __attribute__((ext_vector_type(4)));
constexpr int BM = 256, BK = 64, HALF = 128, HTB = HALF * BK * 2, STAGE_BYTES = 8 * HTB, NXCD = 8, WGM = 4, MP = 16384;

__host__ __device__ __forceinline__ int lds_byte(int r, int c) { const int st = (r >> 4) * 2 + (c >> 5), rr = r & 15, cc = c & 31, ob = rr * 64 + cc * 2; return st * 1024 + (ob ^ (((ob >> 9) & 1) << 5)); }
__host__ __device__ __forceinline__ void stage_rc(int b, int& R, int& C) { const int st = b / 1024, sb = b % 1024, swz = sb ^ (((sb >> 9) & 1) << 5); R = (st >> 1) * 16 + swz / 64; C = (st & 1) * 32 + (swz % 64) / 2; }
__host__ __device__ __forceinline__ int perm32(int rho) { const int n = rho >> 4, i = rho & 15; return 8 * (i >> 2) + 4 * n + (i & 3); }

struct Unit { int pm, pn; };
struct Gemm { const bf16_t* A; const bf16_t* Bt; int M, N, K; };

struct StaticOrder {
    int nM, nN, nwg, G, c;
    __host__ __device__ void init(int M, int N, int G_, int c_) { nM = M / BM; nN = N / BM; nwg = nM * nN; G = G_; c = c_; }
    __host__ __device__ bool next(int i, Unit& u) const {
        const long L = (long)i * G + c; if (L >= nwg) return false;
        int wgid = (int)L; { const int q = nwg / NXCD, r = nwg % NXCD, xcd = wgid % NXCD, off = wgid / NXCD; wgid = (xcd < r ? xcd * (q + 1) : r * (q + 1) + (xcd - r) * q) + off; }
        const int nig = WGM * nN, gid = wgid / nig, fm = gid * WGM, gsz = (nM - fm) < WGM ? (nM - fm) : WGM;
        u.pm = fm + ((wgid % nig) % gsz); u.pn = (wgid % nig) / gsz; return true;
    }
    __device__ __forceinline__ void a_ready(const Unit&) const {}
    __device__ __forceinline__ void done(const Unit&) const {}
};

__device__ __forceinline__ unsigned cvt_pk_bf16(float lo, float hi) { unsigned r; asm volatile("v_cvt_pk_bf16_f32 %0, %1, %2" : "=v"(r) : "v"(lo), "v"(hi)); return r; }


template <class Epi, class Sched, bool ALIGN_EPI = false, bool SP2 = false>
__device__ __forceinline__ void gemm_phase(PG8_LAS unsigned char* lds, const Gemm g, const Sched& S, const Epi& E) {
    int tid_ = threadIdx.x; asm volatile("" : "+v"(tid_));
    const int tid = tid_, wid = __builtin_amdgcn_readfirstlane(tid >> 6), lane = tid & 63, wr = wid >> 2, wc = wid & 3, fr = lane & 15, fq = lane >> 4;
    const int K = g.K, nt = K / BK;
    unsigned voffA[2], voffB[2];
#pragma unroll
    for (int i = 0; i < 2; ++i) { int R, C; stage_rc(tid * 16 + i * 8192, R, C); const int Rb = Epi::PERM ? ((R & ~31) + perm32(R & 31)) : R;
        voffA[i] = (unsigned)(R * K + C) * 2u; voffB[i] = (unsigned)(Rb * K + C) * 2u; }
    const size_t kstep = (size_t)(BK * 2);
    const size_t hstep = (size_t)HALF * K * 2;
    const size_t tstep = 2 * hstep;
    const unsigned ldsw = (unsigned)wid * 1024u;
    const int aoff = lds_byte(wr * 64 + fr, fq * 8), boff = lds_byte(wc * 32 + fr, fq * 8);
#define PG8_SA(b, h) (((b) * 2 + (h)) * HTB)
#define PG8_SB(b, h) ((4 + (b) * 2 + (h)) * HTB)
#define PG8_STAGE(bufoff, gbase, voff) do { _Pragma("unroll") for (int _i = 0; _i < 2; ++_i) \
        __builtin_amdgcn_global_load_lds((const unsigned*)((const char*)(gbase) + (voff)[_i]), (PG8_LAS unsigned*)(lds + (bufoff) + ldsw + _i * 8192), 16, 0, 0); } while (0)
#define PG8_LDA(dst, b, h) do { _Pragma("unroll") for (int m = 0; m < 4; ++m) _Pragma("unroll") for (int k = 0; k < 2; ++k) dst[m][k] = *(const PG8_LAS bf16x8*)(lds + PG8_SA(b, h) + aoff + m * 2048 + k * 1024); } while (0)
#define PG8_LDB(dst, b, h) do { _Pragma("unroll") for (int n = 0; n < 2; ++n) _Pragma("unroll") for (int k = 0; k < 2; ++k) dst[n][k] = *(const PG8_LAS bf16x8*)(lds + PG8_SB(b, h) + boff + n * 2048 + k * 1024); } while (0)
#define PG8_MMA(ai, bj, At, Bt) do { __builtin_amdgcn_s_setprio(1); _Pragma("unroll") for (int m = 0; m < 4; ++m) _Pragma("unroll") for (int n = 0; n < 2; ++n) _Pragma("unroll") for (int k = 0; k < 2; ++k) \
        acc[ai][bj][m][n] = __builtin_amdgcn_mfma_f32_16x16x32_bf16(Bt[n][k], At[m][k], acc[ai][bj][m][n], 0, 0, 0); __builtin_amdgcn_s_setprio(0); } while (0)
#define PG8_WAIT_V(n) asm volatile("s_waitcnt vmcnt(" #n ")" ::: "memory")
#define PG8_WAIT_L(n) asm volatile("s_waitcnt lgkmcnt(" #n ")" ::: "memory")
#define PG8_BAR __builtin_amdgcn_s_barrier()
#define PG8_SCHED __builtin_amdgcn_sched_barrier(0)
    Unit cur, nxt; int ui = 0;
    if (!S.next(0, cur)) return;
    f32x4 acc[2][2][4][2];
#pragma unroll
    for (int a = 0; a < 2; ++a)
#pragma unroll
        for (int b = 0; b < 2; ++b)
#pragma unroll
            for (int m = 0; m < 4; ++m)
#pragma unroll
                for (int n = 0; n < 2; ++n) acc[a][b][m][n] = (f32x4){0.f, 0.f, 0.f, 0.f};
    bf16x8 At[4][2], B0[2][2], B1[2][2];
    const char* cA = (const char*)g.A + (size_t)cur.pm * tstep; const char* cB = (const char*)g.Bt + (size_t)cur.pn * tstep;
    S.a_ready(cur);
    if constexpr (SP2) {
        PG8_STAGE(PG8_SB(0, 0), cB, voffB); PG8_STAGE(PG8_SB(0, 1), cB + hstep, voffB); PG8_STAGE(PG8_SA(0, 0), cA, voffA); PG8_STAGE(PG8_SA(0, 1), cA + hstep, voffA);
        if (wr == 1) PG8_BAR;
        PG8_WAIT_V(2); PG8_BAR;
        PG8_STAGE(PG8_SB(1, 0), cB + kstep, voffB); PG8_STAGE(PG8_SA(1, 0), cA + kstep, voffA); PG8_STAGE(PG8_SB(1, 1), cB + hstep + kstep, voffB);
        PG8_WAIT_V(6); PG8_BAR;
    } else {
        PG8_STAGE(PG8_SB(0, 0), cB, voffB); PG8_STAGE(PG8_SA(0, 0), cA, voffA); PG8_STAGE(PG8_SB(0, 1), cB + hstep, voffB); PG8_STAGE(PG8_SA(0, 1), cA + hstep, voffA);
        if (wr == 1) PG8_BAR;
        PG8_WAIT_V(4); PG8_BAR;
        PG8_STAGE(PG8_SB(1, 0), cB + kstep, voffB); PG8_STAGE(PG8_SA(1, 0), cA + kstep, voffA); PG8_STAGE(PG8_SB(1, 1), cB + hstep + kstep, voffB);
        PG8_WAIT_V(6); PG8_BAR;
    }
    for (;;) {
        const bool has_next = S.next(ui + 1, nxt);
        const char* nA = has_next ? (const char*)g.A + (size_t)nxt.pm * tstep : cA; const char* nB = has_next ? (const char*)g.Bt + (size_t)nxt.pn * tstep : cB;
        for (int t = 0; t < nt; t += 2) {
            const bool last = (t == nt - 2);
            const char* a1 = cA + (size_t)(t + 1) * kstep;
            const char* a2 = last ? nA : cA + (size_t)(t + 2) * kstep; const char* b2 = last ? nB : cB + (size_t)(t + 2) * kstep;
            const char* a3 = a2 + kstep; const char* b3 = b2 + kstep;
            if (last && has_next) S.a_ready(nxt);
            const bool fullm = cur.pm < MP / BM;
            if constexpr (SP2) {
            PG8_LDB(B0, 0, 0); PG8_LDB(B1, 0, 1); PG8_SCHED; PG8_LDA(At, 0, 0); PG8_STAGE(PG8_SA(1, 1), a1 + hstep, voffA);
            PG8_WAIT_V(8); PG8_WAIT_L(0); PG8_BAR; PG8_MMA(0, 0, At, B0); PG8_MMA(0, 1, At, B1); PG8_BAR; PG8_SCHED;
            PG8_LDA(At, 0, 1); PG8_STAGE(PG8_SB(0, 0), b2, voffB); PG8_STAGE(PG8_SB(0, 1), b2 + hstep, voffB); PG8_STAGE(PG8_SA(0, 0), a2, voffA);
            PG8_WAIT_V(8); PG8_WAIT_L(0); PG8_BAR; if (fullm) { PG8_MMA(1, 0, At, B0); PG8_MMA(1, 1, At, B1); } PG8_BAR; PG8_SCHED;
            PG8_LDB(B0, 1, 0); PG8_LDB(B1, 1, 1); PG8_SCHED; PG8_LDA(At, 1, 0); PG8_STAGE(PG8_SA(0, 1), a2 + hstep, voffA);
            PG8_WAIT_V(8); PG8_WAIT_L(0); PG8_BAR; PG8_MMA(0, 0, At, B0); PG8_MMA(0, 1, At, B1); PG8_BAR; PG8_SCHED;
            PG8_LDA(At, 1, 1); PG8_STAGE(PG8_SB(1, 0), b3, voffB); PG8_STAGE(PG8_SB(1, 1), b3 + hstep, voffB); PG8_STAGE(PG8_SA(1, 0), a3, voffA);
            PG8_WAIT_V(8); PG8_WAIT_L(0); PG8_BAR; if (fullm) { PG8_MMA(1, 0, At, B0); PG8_MMA(1, 1, At, B1); } PG8_BAR; PG8_SCHED;
            } else {
            PG8_LDB(B0, 0, 0); PG8_SCHED; PG8_LDA(At, 0, 0); PG8_STAGE(PG8_SA(1, 1), a1 + hstep, voffA);
            PG8_WAIT_L(8); PG8_BAR; PG8_WAIT_L(0); PG8_MMA(0, 0, At, B0); PG8_BAR; PG8_SCHED;
            PG8_LDB(B1, 0, 1); PG8_STAGE(PG8_SB(0, 0), b2, voffB);
            PG8_BAR; PG8_WAIT_L(0); PG8_MMA(0, 1, At, B1); PG8_BAR;
            PG8_LDA(At, 0, 1); PG8_STAGE(PG8_SA(0, 0), a2, voffA);
            PG8_BAR; PG8_WAIT_L(0); PG8_MMA(1, 0, At, B0); PG8_BAR; PG8_SCHED;
            PG8_STAGE(PG8_SB(0, 1), b2 + hstep, voffB);
            PG8_WAIT_V(6); PG8_BAR; PG8_MMA(1, 1, At, B1); PG8_BAR;
            PG8_LDB(B0, 1, 0); PG8_SCHED; PG8_LDA(At, 1, 0); PG8_STAGE(PG8_SA(0, 1), a2 + hstep, voffA);
            PG8_WAIT_L(8); PG8_BAR; PG8_WAIT_L(0); PG8_MMA(0, 0, At, B0); PG8_BAR; PG8_SCHED;
            PG8_LDB(B1, 1, 1); PG8_STAGE(PG8_SB(1, 0), b3, voffB);
            PG8_BAR; PG8_WAIT_L(0); PG8_MMA(0, 1, At, B1); PG8_BAR;
            PG8_LDA(At, 1, 1); PG8_STAGE(PG8_SA(1, 0), a3, voffA);
            PG8_BAR; PG8_WAIT_L(0); PG8_MMA(1, 0, At, B0); PG8_BAR; PG8_SCHED;
            PG8_STAGE(PG8_SB(1, 1), b3 + hstep, voffB);
            PG8_WAIT_V(6); PG8_BAR; PG8_MMA(1, 1, At, B1); PG8_BAR;
            }
        }
        if constexpr (ALIGN_EPI) { if (wr == 0) PG8_BAR; }
        if constexpr (!Epi::AFTER_DRAIN) { E(acc, cur, wr, wc, fr, fq); S.done(cur); }
        if (!has_next) break;
#pragma unroll
        for (int a = 0; a < 2; ++a)
#pragma unroll
            for (int b = 0; b < 2; ++b)
#pragma unroll
                for (int m = 0; m < 4; ++m)
#pragma unroll
                    for (int n = 0; n < 2; ++n) acc[a][b][m][n] = (f32x4){0.f, 0.f, 0.f, 0.f};
        cur = nxt; cA = nA; cB = nB; ++ui;
        if constexpr (ALIGN_EPI) { if (wr == 1) PG8_BAR; }
    }
    PG8_WAIT_V(0);
    if constexpr (!ALIGN_EPI) { if (wr == 0) PG8_BAR; }
    PG8_BAR;
    if constexpr (Epi::AFTER_DRAIN) { E.fused(acc, cur, wr, wc, fr, fq, lds, wid, lane); S.done(cur); }
#undef PG8_SA
#undef PG8_SB
#undef PG8_STAGE
#undef PG8_LDA
#undef PG8_LDB
#undef PG8_MMA
#undef PG8_WAIT_V
#undef PG8_WAIT_L
#undef PG8_BAR
#undef PG8_SCHED
}
}

#ifndef PG8_SP2
#define PG8_SP2 true
#endif
#ifndef PG8_ALIGN
#define PG8_ALIGN true
#endif

constexpr int NWAVES = 8;
constexpr int D = 1024, SEQ = 2048, NB = 8, MP = NB * SEQ  , MSMP = 128  , MV = MP + MSMP  , MR = 16640  ;
constexpr int FF = 4096, DPLE = 256, NCH = SEQ / 64  ;
constexpr int PS = 3840;
constexpr int C_MQ = 0, C_MK = 512, C_MV = 1024, C_MO = 1536, C_GQ = 2048, C_GK = 2304, C_GV = 2560, C_GR = 3072, C_SM = 3584;
constexpr float EPS = 1e-6f;
constexpr size_t O_YP = 0, O_YS = 16777216, O_CP = 16908288, O_NP = 17432576, O_MP = 17436672, O_CVP = 17436704, O_SP = 17461280,
                 O_CS = 17723424, O_NS = 26112032, O_MS = 26177568, O_CVS = 26178080, O_SS = 26571296;
constexpr size_t MiB = 1u << 20;
constexpr size_t WS_CTL = 0, CTL_ZERO_BYTES = 1 * MiB;
constexpr size_t CTL_BAR_B = 16384, CTL_SS1_B = 262144, CTL_SS2_B = 393216, CTL_SS3_B = 524288;
constexpr size_t WS_WIN = 1 * MiB, WS_WOUT = 9 * MiB, WS_W1 = 11 * MiB, WS_W2 = 19 * MiB, WS_WPG = 27 * MiB, WS_WPLE = 29 * MiB;
constexpr size_t WS_PB = 30 * MiB, WS_NC = 39 * MiB, WS_MC = WS_NC + 512 * 1024, WS_R1 = 40 * MiB, WS_R2 = 73 * MiB, WS_CSM = 195 * MiB, WS_CSG = 227 * MiB;
constexpr size_t WS_X1B = WS_R2, WS_U = 106 * MiB, WS_PP = 106 * MiB, WS_END = 247 * MiB;
static_assert(WS_R2 + (size_t)MR * PS * 2 <= WS_CSM && WS_R1 + (size_t)MR * D * 2 <= WS_R2 && WS_U + (size_t)MR * FF * 2 <= WS_END && WS_X1B + (size_t)MR * D * 2 <= WS_U && WS_PB + (size_t)MR * DPLE * 2 <= WS_NC, "ws map");
constexpr size_t SC_QP = 0, SC_KW = (size_t)MP * 512, SC_QG = (size_t)MP * 1024, SC_KG = (size_t)MP * 1280;
static_assert((SC_KG + (size_t)MP * 256) * 2 <= (size_t)MP * D * 4, "P2 scratch inside y_prompt");
constexpr size_t WS_GA = 244 * MiB, WS_GB = WS_GA + 256 * 1024, WS_EBL = WS_GB + 256 * 1024, WS_PMX = WS_EBL + 256 * 1024, WS_BLS = WS_PMX + 4096;
constexpr int LDS_BYTES = 147456, MISC_OFF = LDS_BYTES - 256;

#define GAS __attribute__((address_space(1)))
#define LAS __attribute__((address_space(3)))
typedef unsigned short bf16;
typedef unsigned v4u __attribute__((ext_vector_type(4)));
typedef unsigned v2u __attribute__((ext_vector_type(2)));
typedef float f32x4 __attribute__((ext_vector_type(4)));
typedef short bf16x8 __attribute__((ext_vector_type(8)));
typedef GAS unsigned gu32;
#define RLX_AGENT __ATOMIC_RELAXED, __HIP_MEMORY_SCOPE_AGENT
#define LDS_WAIT() asm volatile("s_waitcnt lgkmcnt(0)" ::: "memory")
#define VM_WAIT() asm volatile("s_waitcnt vmcnt(0)" ::: "memory")
#define LBAR() do { asm volatile("s_waitcnt lgkmcnt(0)" ::: "memory"); __builtin_amdgcn_s_barrier(); asm volatile("" ::: "memory"); } while (0)
__device__ __forceinline__ unsigned f2bf(float f) { unsigned u = __builtin_bit_cast(unsigned, f); return (u + 0x7fffu + ((u >> 16) & 1u)) >> 16; }
__device__ __forceinline__ unsigned pk2(float lo, float hi) { unsigned r; asm volatile("v_cvt_pk_bf16_f32 %0, %1, %2" : "=v"(r) : "v"(lo), "v"(hi)); return r; }
__device__ __forceinline__ float bf2f(unsigned b) { return __builtin_bit_cast(float, b << 16); }
__device__ __forceinline__ float bflo(unsigned w) { return __builtin_bit_cast(float, w << 16); }
__device__ __forceinline__ float bfhi(unsigned w) { return __builtin_bit_cast(float, w & 0xffff0000u); }
__device__ __forceinline__ float logsig(float x) { return fminf(x, 0.f) - __logf(1.f + __expf(-fabsf(x))); }
__device__ __forceinline__ float sigmoidf(float x) { return __builtin_amdgcn_rcpf(1.f + __expf(-x)); }
__device__ __forceinline__ float rsqrt_fast(float x) { return __builtin_amdgcn_rsqf(x); }

#define XB_TMO      128
#define XB_XCNT(j)  (256  + 64 * (j))
#define XB_XSUB(j)  (1280 + 64 * (j))
#define XB_XGEN(j)  (2304 + 64 * (j))
#define XB_TOP      3328
#define XB_TOPGEN   3392
#define XCD_BAR_WORDS 3456
#define XB_SPIN_CAP (1u << 22)
__device__ __forceinline__ unsigned xb_ld(unsigned* p)              { return __hip_atomic_load(p, __ATOMIC_RELAXED, __HIP_MEMORY_SCOPE_AGENT); }
__device__ __forceinline__ unsigned xb_add(unsigned* p, unsigned v) { return __hip_atomic_fetch_add(p, v, __ATOMIC_RELAXED, __HIP_MEMORY_SCOPE_AGENT); }
__device__ __forceinline__ unsigned xb_xcc_id() { return (unsigned)__builtin_amdgcn_s_getreg((3 << 11) | 20) & 0xFu; }
#define XB_SPIN(cond, bar) do { unsigned _sp = 0; while (cond) { __builtin_amdgcn_s_sleep(1); \
    if ((++_sp & 255u) == 0u) { if (xb_ld(&(bar)[XB_TMO])) break; if (_sp > XB_SPIN_CAP) { atomicAdd(&(bar)[XB_TMO], 1u); break; } } } } while (0)
struct XcdBarrier { unsigned* bar; unsigned x; volatile LAS unsigned* st; };
__device__ __forceinline__ XcdBarrier xcd_barrier_post(unsigned* bar, volatile LAS unsigned* st) {
    XcdBarrier b; b.bar = bar; b.x = xb_xcc_id(); b.st = st;
    if (threadIdx.x == 0) (void)xb_add(&bar[XB_XCNT(b.x)], 1u);
    return b;
}
__device__ __forceinline__ void xcd_barrier_complete(unsigned* bar, unsigned x, unsigned& nloc, unsigned& nx) {
    const unsigned G = gridDim.x * gridDim.y * gridDim.z;
    unsigned sum, cnt, mine, sp = 0u;
    for (;;) {
        sum = 0u; cnt = 0u; mine = 0u;
#pragma unroll
        for (unsigned j = 0; j < 16; ++j) { const unsigned c = xb_ld(&bar[XB_XCNT(j)]); sum += c; cnt += (c > 0u) ? 1u : 0u; mine = (j == x) ? c : mine; }
        if (sum == G) break;
        __builtin_amdgcn_s_sleep(1);
        if ((++sp & 255u) == 0u) { if (xb_ld(&bar[XB_TMO])) break; if (sp > XB_SPIN_CAP) { atomicAdd(&bar[XB_TMO], 1u); break; } }
    }
    nloc = mine > 0u ? mine : 1u; nx = cnt > 0u ? cnt : 1u;
}
__device__ __forceinline__ void xcd_barrier(const XcdBarrier& b) {
    asm volatile("s_waitcnt vmcnt(0)" ::: "memory");
    __syncthreads();
    if (threadIdx.x == 0) {
        unsigned* bar = b.bar;
        __builtin_amdgcn_s_waitcnt(0);
        unsigned nloc = b.st[0], nx = b.st[1];
        if (nloc == 0u) { xcd_barrier_complete(bar, b.x, nloc, nx); b.st[0] = nloc; b.st[1] = nx; }
        const unsigned old = xb_add(&bar[XB_XSUB(b.x)], 1u);
        const unsigned gen = old / nloc;
        if (old + 1u == (gen + 1u) * nloc) {
            __builtin_amdgcn_fence(__ATOMIC_RELEASE, "agent");
            asm volatile("s_waitcnt vmcnt(0)" ::: "memory");
            const unsigned og = xb_add(&bar[XB_TOP], 1u);
            const unsigned tg = og / nx;
            if (og + 1u == (tg + 1u) * nx) xb_add(&bar[XB_TOPGEN], 1u);
            else XB_SPIN(xb_ld(&bar[XB_TOPGEN]) == tg, bar);
            __builtin_amdgcn_fence(__ATOMIC_ACQUIRE, "agent");
            xb_add(&bar[XB_XGEN(b.x)], 1u);
            asm volatile("s_waitcnt vmcnt(0)" ::: "memory");
        } else {
            XB_SPIN(xb_ld(&bar[XB_XGEN(b.x)]) == gen, bar);
            __builtin_amdgcn_fence(__ATOMIC_ACQUIRE, "agent");
            asm volatile("s_waitcnt vmcnt(0)" ::: "memory");
        }
    }
    __syncthreads();
}

struct Args { const float* in[26]; float* out; unsigned char* ws; int ph_lo, ph_hi, li, pad; };
typedef const Args __attribute__((address_space(4))) CArgs;
struct Frame {
    LAS unsigned char* lds;
    char* ldsg;
    int G;
    CArgs* a;
};
#define F_TID ((int)threadIdx.x)
#define F_LANE ((int)(threadIdx.x & 63))
#define F_WAVE (__builtin_amdgcn_readfirstlane((int)(threadIdx.x >> 6)))
#define IN_F(k) (F.a->in[k])
#define X_P IN_F(0)
#define X_S IN_F(1)
#define P_P IN_F(2)
#define P_S IN_F(3)
#define ST_C IN_F(4)
#define ST_N IN_F(5)
#define ST_M IN_F(6)
#define ST_CONV IN_F(7)
#define ST_S IN_F(8)
#define W_IN IN_F(9)
#define CONV_W IN_F(10)
#define CONV_B IN_F(11)
#define B_GATE CONSTF(IN_F(12))
#define W_A2 CONSTF(IN_F(13))
#define B_A CONSTF(IN_F(14))
#define G_MHEAD IN_F(15)
#define G_GHEAD IN_F(16)
#define W_OUT IN_F(17)
#define G_MIX IN_F(18)
#define G_MLP IN_F(19)
#define W1 IN_F(20)
#define W2 IN_F(21)
#define G_PLE IN_F(22)
#define W_PLE IN_F(23)
#define W_PG IN_F(24)
#define G_FINAL IN_F(25)
typedef const float __attribute__((address_space(4))) cfloat;
#define CONSTF(p) ((cfloat*)(unsigned long long)(p))
#define OUTP (F.a->out)
#define WSB (F.a->ws)
#define WIN_T ((bf16*)(WSB + WS_WIN))
#define WOUT_T ((bf16*)(WSB + WS_WOUT))
#define W1_T ((bf16*)(WSB + WS_W1))
#define W2_T ((bf16*)(WSB + WS_W2))
#define WPG_T ((bf16*)(WSB + WS_WPG))
#define WPLE_T ((bf16*)(WSB + WS_WPLE))
#define PBUF ((bf16*)(WSB + WS_PB))
#define R1B ((bf16*)(WSB + WS_R1))
#define PROJ ((bf16*)(WSB + WS_R2))
#define X1B ((bf16*)(WSB + WS_X1B))
#define UBUF ((bf16*)(WSB + WS_U))
#define CSM ((bf16*)(WSB + WS_CSM))
#define CSG ((bf16*)(WSB + WS_CSG))
#define NCS ((float*)(WSB + WS_NC))
#define MCS ((float*)(WSB + WS_MC))
#define SS1 ((float*)(WSB + CTL_SS1_B))
#define SS2 ((float*)(WSB + CTL_SS2_B))
#define SS3 ((float*)(WSB + CTL_SS3_B))
#define PPB ((bf16*)(WSB + WS_PP))
#define GA_A ((float*)(WSB + WS_GA))
#define GA_B ((float*)(WSB + WS_GB))
#define EBLG ((float*)(WSB + WS_EBL))
#define PMXG ((float*)(WSB + WS_PMX))
#define BLSG ((float*)(WSB + WS_BLS))
#define SCR ((bf16*)OUTP)

__device__ __forceinline__ float wave_sum(float v) {
#pragma unroll
    for (int o = 1; o < 64; o <<= 1) v += __shfl_xor(v, o);
    return v;
}
__device__ __forceinline__ float wave_max(float v) {
#pragma unroll
    for (int o = 1; o < 64; o <<= 1) v = fmaxf(v, __shfl_xor(v, o));
    return v;
}
template <int CTRL, int ROWMASK> __device__ __forceinline__ float dpp_f(float idv, float v) {
    return __builtin_bit_cast(float, __builtin_amdgcn_update_dpp(__builtin_bit_cast(int, idv), __builtin_bit_cast(int, v), CTRL, ROWMASK, 0xf, false));
}
__device__ __forceinline__ float wave_scan_sum(float v, int) {
    v += dpp_f<0x111, 0xf>(0.f, v); v += dpp_f<0x112, 0xf>(0.f, v); v += dpp_f<0x114, 0xf>(0.f, v); v += dpp_f<0x118, 0xf>(0.f, v);
    v += dpp_f<0x142, 0xa>(0.f, v); v += dpp_f<0x143, 0xc>(0.f, v);
    return v;
}
__device__ __forceinline__ float wave_scan_max(float v, int) {
    const float ninf = -__builtin_inff();
    v = fmaxf(v, dpp_f<0x111, 0xf>(ninf, v)); v = fmaxf(v, dpp_f<0x112, 0xf>(ninf, v)); v = fmaxf(v, dpp_f<0x114, 0xf>(ninf, v)); v = fmaxf(v, dpp_f<0x118, 0xf>(ninf, v));
    v = fmaxf(v, dpp_f<0x142, 0xa>(ninf, v)); v = fmaxf(v, dpp_f<0x143, 0xc>(ninf, v));
    return v;
}

__device__ __forceinline__ int win_src_col(int np) {
    if (np < 2048) return np;
    if (np < 3584) return np + 8;
    const int j = np - 3584;
    if (j < 8) return 2048 + j;
    if (j < 24) return 3592 + (j - 8);
    return -1;
}
template <int MODE>
__device__ __forceinline__ void p0_transpose_item(const float* W, int K, int N, bf16* WT, const float* gain, LAS float* scr, int item, int nblk, int lane) {
    const int kb = item / nblk, nb = item % nblk, k0 = 64 * kb, n0 = 32 * nb;
    if (MODE == 1 && n0 >= 3584) {
        const int src = win_src_col(n0 + (lane & 31));
#pragma unroll 8
        for (int i = 0; i < 32; ++i) { const int kk = 2 * i + (lane >> 5); float v = 0.f; if (src >= 0) v = W[(size_t)(k0 + kk) * N + src] * gain[k0 + kk]; scr[kk * 33 + (lane & 31)] = v; }
    } else {
        const int s0 = (MODE == 1 && n0 >= 2048) ? n0 + 8 : n0; const float cs = (MODE == 1 && n0 >= C_GQ && n0 < C_GK) ? 0.125f : 1.f;
        const int n4 = lane & 7, kq = lane >> 3;
        f32x4 v[8];
#pragma unroll
        for (int i = 0; i < 8; ++i) v[i] = *(const f32x4*)(W + (size_t)(k0 + kq + 8 * i) * N + s0 + 4 * n4);
#pragma unroll
        for (int i = 0; i < 8; ++i) { const int kk = kq + 8 * i; const float gsc = gain ? gain[k0 + kk] * cs : cs; LAS float* d = scr + kk * 33 + 4 * n4;
            d[0] = v[i][0] * gsc; d[1] = v[i][1] * gsc; d[2] = v[i][2] * gsc; d[3] = v[i][3] * gsc; }
    }
    LDS_WAIT(); asm volatile("" ::: "memory");
    const int c = lane & 7;
#pragma unroll
    for (int j = 0; j < 4; ++j) { const int n = (lane >> 3) + 8 * j; const LAS float* s = scr + (8 * c) * 33 + n;
        v4u o; o.x = pk2(s[0 * 33], s[1 * 33]); o.y = pk2(s[2 * 33], s[3 * 33]); o.z = pk2(s[4 * 33], s[5 * 33]); o.w = pk2(s[6 * 33], s[7 * 33]);
        *(GAS v4u*)(WT + (size_t)(n0 + n) * K + k0 + 8 * c) = o; }
    LDS_WAIT(); asm volatile("" ::: "memory");
}
__device__ __forceinline__ void p0_prologue(Frame& F) {
    LAS float* scr = (LAS float*)(F.lds + F_WAVE * 16384);
    const int gw = blockIdx.x * NWAVES + F_WAVE, NGW = F.G * NWAVES, lane = F_LANE;
    for (int m0 = gw; m0 < MV; m0 += 4 * NGW) {
        f32x4 v[4][4]; f32x4 pv[4];
#pragma unroll
        for (int q = 0; q < 4; ++q) { const int m = m0 + q * NGW; if (m < MV) {
            const float* xrow = m < MP ? X_P + (size_t)m * D : X_S + (size_t)(m - MP) * D; const float* prow = m < MP ? P_P + (size_t)m * DPLE : P_S + (size_t)(m - MP) * DPLE;
#pragma unroll
            for (int j = 0; j < 4; ++j) v[q][j] = __builtin_nontemporal_load((const GAS f32x4*)xrow + lane + 64 * j);
            pv[q] = __builtin_nontemporal_load((const GAS f32x4*)prow + lane); } }
#pragma unroll
        for (int q = 0; q < 4; ++q) { const int m = m0 + q * NGW; if (m < MV) {
            float s = 0.f;
#pragma unroll
            for (int j = 0; j < 4; ++j) s += (v[q][j].x * v[q][j].x + v[q][j].y * v[q][j].y) + (v[q][j].z * v[q][j].z + v[q][j].w * v[q][j].w);
            const float r = rsqrt_fast(wave_sum(s) * (1.f / D) + EPS);
            GAS unsigned long long* o8 = (GAS unsigned long long*)(R1B + (size_t)m * D) + lane;
#pragma unroll
            for (int j = 0; j < 4; ++j) o8[64 * j] = (unsigned long long)pk2(v[q][j].x * r, v[q][j].y * r) | ((unsigned long long)pk2(v[q][j].z * r, v[q][j].w * r) << 32);
            ((GAS unsigned long long*)(PBUF + (size_t)m * DPLE))[lane] = (unsigned long long)pk2(pv[q].x, pv[q].y) | ((unsigned long long)pk2(pv[q].z, pv[q].w) << 32); } }
    }
    constexpr int NB_IN = PS / 32, I_IN = (D / 64) * NB_IN;
    for (int it = gw; it < I_IN; it += NGW) p0_transpose_item<1>(W_IN, D, 3608, WIN_T, G_MIX, scr, it, NB_IN, lane);
}
__device__ __forceinline__ void late_weight_copies(Frame& F, int wg, int nwg) {
    LAS float* scr = (LAS float*)(F.lds + F_WAVE * 16384);
    const int gw = wg * NWAVES + F_WAVE, NGW = nwg * NWAVES, lane = F_LANE;
    constexpr int NB_D = D / 32, NB_FF = FF / 32;
    constexpr int I_OUT = (D / 64) * NB_D, I_1 = (D / 64) * NB_FF, I_2 = (FF / 64) * NB_D, I_PG = I_OUT, I_PLE = (DPLE / 64) * NB_D;
    constexpr int NITEMS = I_OUT + I_1 + I_2 + I_PG + I_PLE;
    for (int it = gw; it < NITEMS; it += NGW) {
        int r = it;
        if (r < I_OUT) { p0_transpose_item<0>(W_OUT, D, D, WOUT_T, nullptr, scr, r, NB_D, lane); continue; } r -= I_OUT;
        if (r < I_1) { p0_transpose_item<0>(W1, D, FF, W1_T, G_MLP, scr, r, NB_FF, lane); continue; } r -= I_1;
        if (r < I_2) { p0_transpose_item<0>(W2, FF, D, W2_T, nullptr, scr, r, NB_D, lane); continue; } r -= I_2;
        if (r < I_PG) { p0_transpose_item<0>(W_PG, D, D, WPG_T, G_PLE, scr, r, NB_D, lane); continue; } r -= I_PG;
        p0_transpose_item<0>(W_PLE, DPLE, D, WPLE_T, nullptr, scr, r, NB_D, lane);
    }
}

struct EpiProj {
    static constexpr bool PERM = true, AFTER_DRAIN = false;
    bf16* O; int ldc;
    __device__ __forceinline__ void operator()(const f32x4 (&acc)[2][2][4][2], const pg8::Unit& u, int wr, int wc, int fr, int fq) const {
        const int row0 = u.pm * 256 + wr * 64 + fr, col0 = u.pn * 256 + wc * 32 + 8 * fq;
#pragma unroll
        for (int ai = 0; ai < 2; ++ai)
#pragma unroll
            for (int m = 0; m < 4; ++m) { bf16* rowp = O + (size_t)(row0 + ai * 128 + m * 16) * ldc + col0;
#pragma unroll
                for (int bj = 0; bj < 2; ++bj) { const f32x4 v0 = acc[ai][bj][m][0], v1 = acc[ai][bj][m][1];
                    v4u w; w.x = pg8::cvt_pk_bf16(v0[0], v0[1]); w.y = pg8::cvt_pk_bf16(v0[2], v0[3]); w.z = pg8::cvt_pk_bf16(v1[0], v1[1]); w.w = pg8::cvt_pk_bf16(v1[2], v1[3]);
                    *(v4u*)(rowp + bj * 128) = w; } }
    }
};
template <bool RES_BF16> struct EpiRes {
    static constexpr bool PERM = true, AFTER_DRAIN = false;
    const void* res; bf16* ob; float* ss; const float* rsq;
    __device__ __forceinline__ void operator()(const f32x4 (&acc)[2][2][4][2], const pg8::Unit& u, int wr, int wc, int fr, int fq) const {
        const int row0 = u.pm * 256 + wr * 64 + fr, col0 = u.pn * 256 + wc * 32 + 8 * fq;
#pragma unroll
        for (int ai = 0; ai < 2; ++ai)
#pragma unroll
            for (int m = 0; m < 4; ++m) { const int row = row0 + ai * 128 + m * 16;
                const size_t off = (size_t)row * D + col0;
                float s = 0.f, q = 1.f;
                if constexpr (RES_BF16) q = __builtin_amdgcn_rcpf(rsq[row] * (1.f / D) + EPS);
#pragma unroll
                for (int bj = 0; bj < 2; ++bj) {
                    f32x4 r0, r1;
                    if constexpr (RES_BF16) { const v4u rw = *(const v4u*)((const bf16*)res + off + bj * 128);
                        r0 = (f32x4){bflo(rw.x), bfhi(rw.x), bflo(rw.y), bfhi(rw.y)}; r1 = (f32x4){bflo(rw.z), bfhi(rw.z), bflo(rw.w), bfhi(rw.w)}; }
                    else { r0 = *(const f32x4*)((const float*)res + off + bj * 128); r1 = *(const f32x4*)((const float*)res + off + bj * 128 + 4); }
                    const f32x4 v0 = RES_BF16 ? acc[ai][bj][m][0] * q + r0 : acc[ai][bj][m][0] + r0, v1 = RES_BF16 ? acc[ai][bj][m][1] * q + r1 : acc[ai][bj][m][1] + r1;
                    v4u w; w.x = pg8::cvt_pk_bf16(v0[0], v0[1]); w.y = pg8::cvt_pk_bf16(v0[2], v0[3]); w.z = pg8::cvt_pk_bf16(v1[0], v1[1]); w.w = pg8::cvt_pk_bf16(v1[2], v1[3]);
                    *(v4u*)(ob + off + bj * 128) = w;
                    s += (v0[0] * v0[0] + v0[1] * v0[1]) + (v0[2] * v0[2] + v0[3] * v0[3]) + (v1[0] * v1[0] + v1[1] * v1[1]) + (v1[2] * v1[2] + v1[3] * v1[3]);
                }
                s += __shfl_xor(s, 16); s += __shfl_xor(s, 32);
                if (fq == 0) atomicAdd(ss + row, s);
                asm volatile("" ::: "memory"); }
    }
};
struct EpiU {
    static constexpr bool PERM = true, AFTER_DRAIN = false;
    bf16* O;
    __device__ __forceinline__ void operator()(const f32x4 (&acc)[2][2][4][2], const pg8::Unit& u, int wr, int wc, int fr, int fq) const {
        const int row0 = u.pm * 256 + wr * 64 + fr, col0 = u.pn * 256 + wc * 32 + 8 * fq;
#pragma unroll
        for (int ai = 0; ai < 2; ++ai)
#pragma unroll
            for (int m = 0; m < 4; ++m) { const int row = row0 + ai * 128 + m * 16;
                bf16* rowp = O + (size_t)row * FF + col0;
#pragma unroll
                for (int bj = 0; bj < 2; ++bj) { f32x4 v0 = acc[ai][bj][m][0], v1 = acc[ai][bj][m][1];
#pragma unroll
                    for (int j = 0; j < 4; ++j) { v0[j] = fmaxf(v0[j], 0.f); v1[j] = fmaxf(v1[j], 0.f); }
                    v0 = v0 * v0; v1 = v1 * v1;
                    v4u w; w.x = pg8::cvt_pk_bf16(v0[0], v0[1]); w.y = pg8::cvt_pk_bf16(v0[2], v0[3]); w.z = pg8::cvt_pk_bf16(v1[0], v1[1]); w.w = pg8::cvt_pk_bf16(v1[2], v1[3]);
                    *(v4u*)(rowp + bj * 128) = w; } }
    }
};
struct EpiPle {
    static constexpr bool PERM = true, AFTER_DRAIN = false;
    const bf16* x2b; const bf16* Pp; bf16* x3b; const float* ss2; float* ss3;
    __device__ __forceinline__ void operator()(const f32x4 (&acc)[2][2][4][2], const pg8::Unit& u, int wr, int wc, int fr, int fq) const {
        const int row0 = u.pm * 256 + wr * 64 + fr, col0 = u.pn * 256 + wc * 32 + 8 * fq;
#pragma unroll
        for (int ai = 0; ai < 2; ++ai)
#pragma unroll
            for (int m = 0; m < 4; ++m) { const int row = row0 + ai * 128 + m * 16;
                const float r = rsqrt_fast(ss2[row] * (1.f / D) + EPS);
                float s = 0.f;
#pragma unroll
                for (int bj = 0; bj < 2; ++bj) {
                    const size_t off = (size_t)row * D + col0 + bj * 128;
                    const v4u pw = *(const v4u*)(Pp + off), xw = *(const v4u*)(x2b + off);
                    unsigned o[4];
#pragma unroll
                    for (int n = 0; n < 2; ++n) {
                        const float p0[4] = {bflo(pw[2 * n]), bfhi(pw[2 * n]), bflo(pw[2 * n + 1]), bfhi(pw[2 * n + 1])};
                        const float x0[4] = {bflo(xw[2 * n]), bfhi(xw[2 * n]), bflo(xw[2 * n + 1]), bfhi(xw[2 * n + 1])};
                        float v0[4];
#pragma unroll
                        for (int j = 0; j < 4; ++j) v0[j] = x0[j] + p0[j] * sigmoidf(acc[ai][bj][m][n][j] * r);
                        o[2 * n] = pg8::cvt_pk_bf16(v0[0], v0[1]); o[2 * n + 1] = pg8::cvt_pk_bf16(v0[2], v0[3]);
                        s += (v0[0] * v0[0] + v0[1] * v0[1]) + (v0[2] * v0[2] + v0[3] * v0[3]);
                    }
                    *(v4u*)(x3b + off) = (v4u){o[0], o[1], o[2], o[3]};
                    asm volatile("" ::: "memory");
                }
                s += __shfl_xor(s, 16); s += __shfl_xor(s, 32);
                if (fq == 0) atomicAdd(ss3 + row, s);
                asm volatile("" ::: "memory"); }
    }
};

constexpr size_t CTL_PCNT_B = 655360, WS_XBUF = 246 * MiB;
struct EpiPleFinal {
    static constexpr bool PERM = true, AFTER_DRAIN = true;
    const bf16* x2b; const bf16* Pp; float* y; const float* ss2; const float* gfin; float* xbuf; unsigned* cnt;
    __device__ __forceinline__ void fused(f32x4 (&acc)[2][2][4][2], const pg8::Unit& u, int wr, int wc, int fr, int fq, LAS unsigned char* lds, int wid, int lane) const {
        LAS float* Pt = (LAS float*)lds;
        LAS float* St = (LAS float*)(lds + 4096);
        const int lrow0 = wr * 64 + fr, col0 = u.pn * 256 + wc * 32 + 8 * fq;
#pragma unroll
        for (int ai = 0; ai < 2; ++ai)
#pragma unroll
            for (int m = 0; m < 4; ++m) { const int lrow = lrow0 + ai * 128 + m * 16, row = u.pm * 256 + lrow;
                const float r = rsqrt_fast(ss2[row] * (1.f / D) + EPS);
                float s = 0.f;
#pragma unroll
                for (int bj = 0; bj < 2; ++bj) {
                    const size_t off = (size_t)row * D + col0 + bj * 128;
                    const v4u pw = *(const v4u*)(Pp + off), xw = *(const v4u*)(x2b + off);
#pragma unroll
                    for (int n = 0; n < 2; ++n) {
                        const float p0[4] = {bflo(pw[2 * n]), bfhi(pw[2 * n]), bflo(pw[2 * n + 1]), bfhi(pw[2 * n + 1])};
                        const float x0[4] = {bflo(xw[2 * n]), bfhi(xw[2 * n]), bflo(xw[2 * n + 1]), bfhi(xw[2 * n + 1])};
#pragma unroll
                        for (int j = 0; j < 4; ++j) { const float v = x0[j] + p0[j] * sigmoidf(acc[ai][bj][m][n][j] * r); acc[ai][bj][m][n][j] = v; s += v * v; }
                    }
                    asm volatile("" ::: "memory");
                }
                s += __shfl_xor(s, 16); s += __shfl_xor(s, 32);
                if (fq == 0) Pt[lrow * 4 + wc] = s; }
        asm volatile("s_waitcnt lgkmcnt(0)" ::: "memory"); __builtin_amdgcn_s_barrier(); asm volatile("" ::: "memory");
        const int prow = wid * 32 + (lane & 31);
        if (lane < 32) { const f32x4 p4 = *(const LAS f32x4*)(Pt + prow * 4);
            __hip_atomic_store(xbuf + ((size_t)u.pm * 256 + prow) * 4 + u.pn, (p4[0] + p4[1]) + (p4[2] + p4[3]), __ATOMIC_RELAXED, __HIP_MEMORY_SCOPE_AGENT); }
        asm volatile("s_waitcnt vmcnt(0)" ::: "memory");
        if (lane == 0) __hip_atomic_fetch_add(cnt + 64 * u.pm, 1u, __ATOMIC_RELAXED, __HIP_MEMORY_SCOPE_AGENT);
        if (wid == 0) {
            unsigned sp = 0;
            while ((unsigned)__builtin_amdgcn_readfirstlane(__hip_atomic_load(cnt + 64 * u.pm, __ATOMIC_RELAXED, __HIP_MEMORY_SCOPE_AGENT)) < 32u) { __builtin_amdgcn_s_sleep(2); if (++sp > (1u << 22)) break; }
            __builtin_amdgcn_fence(__ATOMIC_ACQUIRE, "agent");
        }
        asm volatile("s_waitcnt vmcnt(0) lgkmcnt(0)" ::: "memory"); __builtin_amdgcn_s_barrier(); asm volatile("" ::: "memory");
        if (lane < 32) { const float* sl = xbuf + ((size_t)u.pm * 256 + prow) * 4; float t = 0.f;
#pragma unroll
            for (int q = 0; q < 4; ++q) t += __hip_atomic_load(sl + q, __ATOMIC_RELAXED, __HIP_MEMORY_SCOPE_AGENT);
            St[prow] = rsqrt_fast(t * (1.f / D) + EPS); }
        asm volatile("s_waitcnt lgkmcnt(0)" ::: "memory"); __builtin_amdgcn_s_barrier(); asm volatile("" ::: "memory");
        f32x4 gf[2][2];
#pragma unroll
        for (int bj = 0; bj < 2; ++bj)
#pragma unroll
            for (int n = 0; n < 2; ++n) gf[bj][n] = *(const f32x4*)(gfin + col0 + bj * 128 + 4 * n);
#pragma unroll
        for (int ai = 0; ai < 2; ++ai)
#pragma unroll
            for (int m = 0; m < 4; ++m) { const int lrow = lrow0 + ai * 128 + m * 16; const float rs = St[lrow];
                float* yp = y + (size_t)(u.pm * 256 + lrow) * D + col0;
#pragma unroll
                for (int bj = 0; bj < 2; ++bj)
#pragma unroll
                    for (int n = 0; n < 2; ++n) *(f32x4*)(yp + bj * 128 + 4 * n) = acc[ai][bj][m][n] * rs * gf[bj][n]; }
        asm volatile("s_waitcnt lgkmcnt(0)" ::: "memory"); __builtin_amdgcn_s_barrier(); asm volatile("" ::: "memory");
    }
};

__device__ __forceinline__ f32x4 mfma16(bf16x8 a, bf16x8 b, f32x4 c) { return __builtin_amdgcn_mfma_f32_16x16x32_bf16(a, b, c, 0, 0, 0); }
__device__ __forceinline__ bf16x8 lds_frag(const char* p) { return *(const bf16x8*)p; }
constexpr int TS = 144;
constexpr int QS_P = 272;
constexpr float KSCALE = 0.08838834764831845f;

__device__ __forceinline__ void p2p_item(Frame& F, int b, int c) {
    float* WKL = (float*)F.ldsg;
    const int tid = F_TID, lane = F_LANE, w = F_WAVE;
    const size_t row0 = (size_t)b * SEQ + c * 64;
    const bf16* P = PROJ;
    if (w < 4) { const int h = w, bh = b * 4 + h; const size_t row = row0 + lane;
        const float ig = bf2f(P[row * PS + C_SM + h]) + B_GATE[h], lf = logsig(bf2f(P[row * PS + C_SM + 4 + h]) + B_GATE[4 + h]);
        const float bc = wave_scan_sum(lf, lane), a = ig - bc; const float pmax = wave_max(a);
        GA_A[(size_t)bh * SEQ + c * 64 + lane] = a; GA_B[(size_t)bh * SEQ + c * 64 + lane] = bc;
        if (lane == 63) { PMXG[bh * NCH + c] = pmax; BLSG[bh * NCH + c] = bc; }
        WKL[h * 64 + lane] = __expf(a - pmax) * KSCALE; }
    {
      constexpr int GP = 528;
      char* QL = F.ldsg + 1024; char* KL = QL + 64 * GP;
#pragma unroll
      for (int i = 0; i < 4; ++i) { const int pc = tid + 512 * i, r_ = pc >> 5, c16 = pc & 31;
          *(v4u*)(QL + r_ * GP + 16 * c16) = *(const v4u*)(P + (row0 + r_) * PS + C_GQ + 8 * c16); *(v4u*)(KL + r_ * GP + 16 * c16) = *(const v4u*)(P + (row0 + r_) * PS + C_GK + 8 * c16); }
      const int hg = w >> 1, d0 = 32 * (w & 1), bh = b * 4 + hg, colb = hg * 64 + d0; const size_t row = row0 + lane;
      const v4u ga0 = *(const v4u*)(P + row * PS + C_SM + 8), ga1 = *(const v4u*)(P + row * PS + C_SM + 16);
      float ga[16];
#pragma unroll
      for (int i = 0; i < 4; ++i) { ga[2 * i] = bflo(ga0[i]); ga[2 * i + 1] = bfhi(ga0[i]); ga[8 + 2 * i] = bflo(ga1[i]); ga[8 + 2 * i + 1] = bfhi(ga1[i]); }
      cfloat* wa = W_A2 + colb; cfloat* ba = B_A + colb; float* ebl = EBLG + (size_t)(bh * NCH + c) * 64 + d0;
      unsigned* myq = (unsigned*)(QL + lane * GP + 2 * colb); unsigned* myk = (unsigned*)(KL + lane * GP + 2 * colb);
      LBAR();
#pragma unroll 1
      for (int j = 0; j < 16; ++j) {
          float z0 = ba[2 * j], z1 = ba[2 * j + 1];
#pragma unroll
          for (int q = 0; q < 16; ++q) { z0 += ga[q] * wa[q * 256 + 2 * j]; z1 += ga[q] * wa[q * 256 + 2 * j + 1]; }
          const float b0 = wave_scan_sum(logsig(z0) * (1.f / 16.f), lane), b1 = wave_scan_sum(logsig(z1) * (1.f / 16.f), lane);
          if (lane == 63) { ebl[2 * j] = __expf(b0); ebl[2 * j + 1] = __expf(b1); }
          const unsigned qw = myq[j], kw = myk[j];
          myq[j] = pk2(bflo(qw) * __expf(b0), bfhi(qw) * __expf(b1)); myk[j] = pk2(bflo(kw) * __expf(-b0), bfhi(kw) * __expf(-b1));
      }
      LBAR();
#pragma unroll
      for (int i = 0; i < 4; ++i) { const int pc = tid + 512 * i, r_ = pc >> 5, c16 = pc & 31;
          *(v4u*)(SCR + SC_QG + (row0 + r_) * 256 + 8 * c16) = *(const v4u*)(QL + r_ * GP + 16 * c16); *(v4u*)(SCR + SC_KG + (row0 + r_) * 256 + 8 * c16) = *(const v4u*)(KL + r_ * GP + 16 * c16); } }
    {
      const int isk = tid >> 8, pc = tid & 255, h = pc >> 6, ch = isk * 512 + 2 * pc;
      float cw[4][2], cb[2];
#pragma unroll
      for (int j = 0; j < 4; ++j) { cw[j][0] = CONV_W[j * 1024 + ch]; cw[j][1] = CONV_W[j * 1024 + ch + 1]; }
      cb[0] = CONV_B[ch]; cb[1] = CONV_B[ch + 1];
      const bf16* src = P + row0 * PS + (isk ? C_MK : C_MQ) + 2 * pc;
      bf16* dst = SCR + (isk ? SC_KW : SC_QP) + row0 * 512 + 2 * pc;
      unsigned cur[19], nxt[16];
#pragma unroll
      for (int i = 0; i < 3; ++i) cur[i] = (c > 0) ? *(const unsigned*)(src + (long)(i - 3) * PS) : 0u;
#pragma unroll
      for (int i = 0; i < 16; ++i) nxt[i] = *(const unsigned*)(src + (long)i * PS);
#pragma unroll 1
      for (int gq = 0; gq < 4; ++gq) {
#pragma unroll
          for (int i = 0; i < 16; ++i) cur[3 + i] = nxt[i];
          if (gq < 3) {
#pragma unroll
              for (int i = 0; i < 16; ++i) nxt[i] = *(const unsigned*)(src + (long)(16 * (gq + 1) + i) * PS);
          }
#pragma unroll
          for (int i = 0; i < 16; ++i) { float a0 = cb[0], a1 = cb[1];
#pragma unroll
              for (int j = 0; j < 4; ++j) { a0 += cw[j][0] * bflo(cur[i + j]); a1 += cw[j][1] * bfhi(cur[i + j]); }
              a0 = a0 * sigmoidf(a0); a1 = a1 * sigmoidf(a1);
              if (isk) { const float wk = WKL[h * 64 + 16 * gq + i]; a0 *= wk; a1 *= wk; }
              *(unsigned*)(dst + (size_t)(16 * gq + i) * 512) = pk2(a0, a1); }
#pragma unroll
          for (int i = 0; i < 3; ++i) cur[i] = cur[16 + i];
      } }
    LBAR();
}

constexpr int NCI = 2;
__device__ __forceinline__ void chain_mlstm(Frame& F, int b, int h, int sl) {
    char* L = F.ldsg;
    constexpr int KT_B = 64 * TS, VT_B = 128 * TS, NP_B = 16 * 64 * 4, BUF_B = KT_B + VT_B + NP_B;
    float* PM = (float*)(L + NCI * BUF_B); float* BLs = PM + 32; float* MCc = BLs + 32; float* CSs = MCc + 40; float* E2s = CSs + 32;
    const int tid = F_TID, lane = F_LANE, w = F_WAVE, r = lane & 15, g = lane >> 4;
    const int bh = b * 4 + h; const size_t rowb = (size_t)b * SEQ;
    if (tid < 32) { PM[tid] = PMXG[bh * NCH + tid]; BLs[tid] = BLSG[bh * NCH + tid]; }
    __syncthreads();
    if (tid == 0) { float m = 0.f; for (int c = 0; c < NCH; ++c) { const float M = fmaxf(m, PM[c]); MCc[c] = m; CSs[c] = __expf(m - M); E2s[c] = __expf(PM[c] - M); m = BLs[c] + M; } MCc[32] = m; }
    __syncthreads();
    const int dpk = tid & 31, tg = tid >> 5, dpv = tid & 63, sg = tid >> 6;
    const int dt = w & 3, eb = 4 * (w >> 2);
    f32x4 acc[4];
#pragma unroll
    for (int i = 0; i < 4; ++i) acc[i] = (f32x4){0.f, 0.f, 0.f, 0.f};
    float nst = 0.f;
    unsigned krq[NCI][4], vrq[NCI][8];
    const bf16* kbase = SCR + SC_KW + (rowb + 4 * tg) * 512 + h * 128 + 64 * sl + 2 * dpk; const bf16* vbase = PROJ + (rowb + 8 * sg) * PS + C_MV + h * 128 + 2 * dpv;
#pragma unroll
    for (int q = 0; q < NCI; ++q) {
#pragma unroll
        for (int i = 0; i < 4; ++i) krq[q][i] = *(const unsigned*)(kbase + (size_t)(64 * q + i) * 512);
#pragma unroll
        for (int i = 0; i < 8; ++i) vrq[q][i] = *(const unsigned*)(vbase + (size_t)(64 * q + i) * PS);
    }
    for (int c0 = 0; c0 < NCH; c0 += NCI) {
#pragma unroll
        for (int q = 0; q < NCI; ++q) { char* KT = L + q * BUF_B; char* VT = KT + KT_B; float* NP = (float*)(VT + VT_B);
            const unsigned* kr = krq[q]; const unsigned* vr = vrq[q];
            *(v2u*)(KT + (2 * dpk) * TS + 8 * tg) = (v2u){(kr[0] & 0xffffu) | (kr[1] << 16), (kr[2] & 0xffffu) | (kr[3] << 16)};
            *(v2u*)(KT + (2 * dpk + 1) * TS + 8 * tg) = (v2u){(kr[0] >> 16) | (kr[1] & 0xffff0000u), (kr[2] >> 16) | (kr[3] & 0xffff0000u)};
            NP[tg * 64 + 2 * dpk] = (bflo(kr[0]) + bflo(kr[1])) + (bflo(kr[2]) + bflo(kr[3])); NP[tg * 64 + 2 * dpk + 1] = (bfhi(kr[0]) + bfhi(kr[1])) + (bfhi(kr[2]) + bfhi(kr[3]));
            unsigned v0p[4], v1p[4];
#pragma unroll
            for (int i = 0; i < 8; i += 2) { v0p[i >> 1] = (vr[i] & 0xffffu) | (vr[i + 1] << 16); v1p[i >> 1] = (vr[i] >> 16) | (vr[i + 1] & 0xffff0000u); }
            *(v4u*)(VT + (2 * dpv) * TS + 16 * sg) = (v4u){v0p[0], v0p[1], v0p[2], v0p[3]};
            *(v4u*)(VT + (2 * dpv + 1) * TS + 16 * sg) = (v4u){v1p[0], v1p[1], v1p[2], v1p[3]}; }
        if (c0 + NCI < NCH) {
#pragma unroll
            for (int q = 0; q < NCI; ++q) {
#pragma unroll
                for (int i = 0; i < 4; ++i) krq[q][i] = *(const unsigned*)(kbase + (size_t)(64 * (c0 + NCI + q) + i) * 512);
#pragma unroll
                for (int i = 0; i < 8; ++i) vrq[q][i] = *(const unsigned*)(vbase + (size_t)(64 * (c0 + NCI + q) + i) * PS);
            }
        }
        LBAR();
        f32x4 ta[NCI][4];
#pragma unroll
        for (int q = 0; q < NCI; ++q) { const char* KT = L + q * BUF_B; const char* VT = KT + KT_B;
#pragma unroll
            for (int i = 0; i < 4; ++i) ta[q][i] = (f32x4){0.f, 0.f, 0.f, 0.f};
#pragma unroll
            for (int kk = 0; kk < 2; ++kk) {
                const bf16x8 af = lds_frag(KT + (16 * dt + r) * TS + (32 * kk + 8 * g) * 2);
#pragma unroll
                for (int i = 0; i < 4; ++i) ta[q][i] = mfma16(af, lds_frag(VT + (16 * (eb + i) + r) * TS + (32 * kk + 8 * g) * 2), ta[q][i]);
            } }
#pragma unroll
        for (int q = 0; q < NCI; ++q) { const int c = c0 + q;
            { bf16* cst = CSM + (size_t)(bh * NCH + c) * 16384;
#pragma unroll
              for (int i = 0; i < 4; ++i)
                  *(v2u*)(cst + ((eb + i) * 8 + 4 * sl + dt) * 256 + r * 16 + 4 * g) = (v2u){pg8::cvt_pk_bf16(acc[i][0], acc[i][1]), pg8::cvt_pk_bf16(acc[i][2], acc[i][3])};
              if (tid < 64) NCS[(size_t)(bh * NCH + c) * 128 + 64 * sl + tid] = nst;
              if (tid == 0 && sl == 0) MCS[bh * NCH + c] = MCc[c]; }
            const float cs = CSs[c], e2 = E2s[c];
            if (tid < 64) { const float* NP = (const float*)(L + q * BUF_B + KT_B + VT_B); float s = 0.f;
#pragma unroll
                for (int k = 0; k < 16; ++k) s += NP[k * 64 + tid];
                nst = cs * nst + e2 * s; }
#pragma unroll
            for (int i = 0; i < 4; ++i) acc[i] = acc[i] * cs + ta[q][i] * e2; }
        LBAR();
    }
    { float* Co = OUTP + O_CP + (size_t)bh * 16384;
#pragma unroll
      for (int i = 0; i < 4; ++i)
#pragma unroll
          for (int j = 0; j < 4; ++j) Co[(64 * sl + 16 * dt + 4 * g + j) * 128 + 16 * (eb + i) + r] = acc[i][j];
      if (tid < 64) OUTP[O_NP + (size_t)bh * 128 + 64 * sl + tid] = nst;
      if (tid == 0 && sl == 0) OUTP[O_MP + bh] = MCc[32]; }
    __syncthreads();
}

__device__ __forceinline__ void chain_gla(Frame& F, int b, int hg, int sl) {
    char* L = F.ldsg;
    constexpr int KT_B = 32 * TS, VT_B = 128 * TS, BUF_B = KT_B + VT_B;
    const int tid = F_TID, lane = F_LANE, w = F_WAVE, r = lane & 15, g = lane >> 4;
    const int bh = b * 4 + hg; const size_t rowb = (size_t)b * SEQ;
    const int dpv = tid & 63, sg = tid >> 6;
    const int dt = w & 1, eb = 2 * (w >> 1);
    f32x4 acc[2];
    acc[0] = (f32x4){0.f, 0.f, 0.f, 0.f}; acc[1] = acc[0];
    v2u k4q[NCI]; f32x4 ebq[NCI]; unsigned vrq[NCI][8];
    const bf16* kbase = SCR + SC_KG + (rowb + lane) * 256 + hg * 64 + 32 * sl + 4 * w; const bf16* vbase = PROJ + (rowb + 8 * sg) * PS + C_GV + hg * 128 + 2 * dpv;
    const float* ebase = EBLG + (size_t)bh * NCH * 64 + 32 * sl + 16 * dt + 4 * g;
#pragma unroll
    for (int q = 0; q < NCI; ++q) { k4q[q] = *(const v2u*)(kbase + (size_t)(64 * q) * 256); ebq[q] = *(const f32x4*)(ebase + q * 64);
#pragma unroll
        for (int i = 0; i < 8; ++i) vrq[q][i] = *(const unsigned*)(vbase + (size_t)(64 * q + i) * PS); }
    for (int c0 = 0; c0 < NCH; c0 += NCI) {
        f32x4 eb4[NCI];
#pragma unroll
        for (int q = 0; q < NCI; ++q) { char* KT = L + q * BUF_B; char* VT = KT + KT_B; const v2u k4 = k4q[q]; const unsigned* vr = vrq[q]; eb4[q] = ebq[q];
            *(bf16*)(KT + (4 * w + 0) * TS + 2 * lane) = (bf16)(k4[0] & 0xffffu); *(bf16*)(KT + (4 * w + 1) * TS + 2 * lane) = (bf16)(k4[0] >> 16);
            *(bf16*)(KT + (4 * w + 2) * TS + 2 * lane) = (bf16)(k4[1] & 0xffffu); *(bf16*)(KT + (4 * w + 3) * TS + 2 * lane) = (bf16)(k4[1] >> 16);
            unsigned v0p[4], v1p[4];
#pragma unroll
            for (int i = 0; i < 8; i += 2) { v0p[i >> 1] = (vr[i] & 0xffffu) | (vr[i + 1] << 16); v1p[i >> 1] = (vr[i] >> 16) | (vr[i + 1] & 0xffff0000u); }
            *(v4u*)(VT + (2 * dpv) * TS + 16 * sg) = (v4u){v0p[0], v0p[1], v0p[2], v0p[3]};
            *(v4u*)(VT + (2 * dpv + 1) * TS + 16 * sg) = (v4u){v1p[0], v1p[1], v1p[2], v1p[3]}; }
        if (c0 + NCI < NCH) {
#pragma unroll
            for (int q = 0; q < NCI; ++q) { k4q[q] = *(const v2u*)(kbase + (size_t)(64 * (c0 + NCI + q)) * 256); ebq[q] = *(const f32x4*)(ebase + (c0 + NCI + q) * 64);
#pragma unroll
                for (int i = 0; i < 8; ++i) vrq[q][i] = *(const unsigned*)(vbase + (size_t)(64 * (c0 + NCI + q) + i) * PS); }
        }
        LBAR();
        f32x4 ta[NCI][2];
#pragma unroll
        for (int q = 0; q < NCI; ++q) { const char* KT = L + q * BUF_B; const char* VT = KT + KT_B;
            ta[q][0] = (f32x4){0.f, 0.f, 0.f, 0.f}; ta[q][1] = ta[q][0];
#pragma unroll
            for (int kk = 0; kk < 2; ++kk) {
                const bf16x8 af = lds_frag(KT + (16 * dt + r) * TS + (32 * kk + 8 * g) * 2);
#pragma unroll
                for (int i = 0; i < 2; ++i) ta[q][i] = mfma16(af, lds_frag(VT + (16 * (eb + i) + r) * TS + (32 * kk + 8 * g) * 2), ta[q][i]);
            } }
#pragma unroll
        for (int q = 0; q < NCI; ++q) { const int c = c0 + q;
            bf16* cst = CSG + (size_t)(bh * NCH + c) * 8192;
#pragma unroll
            for (int i = 0; i < 2; ++i)
                *(v2u*)(cst + ((eb + i) * 4 + 2 * sl + dt) * 256 + r * 16 + 4 * g) = (v2u){pg8::cvt_pk_bf16(acc[i][0], acc[i][1]), pg8::cvt_pk_bf16(acc[i][2], acc[i][3])};
            acc[0] = (acc[0] + ta[q][0]) * eb4[q]; acc[1] = (acc[1] + ta[q][1]) * eb4[q]; }
        LBAR();
    }
    { float* So = OUTP + O_SP + (size_t)bh * 8192;
#pragma unroll
      for (int i = 0; i < 2; ++i)
#pragma unroll
          for (int j = 0; j < 4; ++j) So[(32 * sl + 16 * dt + 4 * g + j) * 128 + 16 * (eb + i) + r] = acc[i][j]; }
    __syncthreads();
}

__device__ __forceinline__ void sample_item(Frame& F, int n, int hh, float* Wl, int lane) {
    asm volatile("" : "+v"(lane));
    float* qv = Wl; float* kv = Wl + 128; float* vv = Wl + 256; float* al = Wl + 384;
    const size_t row = (size_t)MP + n;
    const bf16* Pr = PROJ + row * PS;
    const bool gla = hh >= 4; const int h = hh & 3;
    const int e4 = lane & 31, dh = lane >> 5;
    float cs = 1.f, wkk = 1.f, dinv = 1.f;
    if (!gla) {
        float qk2[2][2];
#pragma unroll
        for (int isk = 0; isk < 2; ++isk)
#pragma unroll
            for (int q = 0; q < 2; ++q) { const int d = lane + 64 * q, ch = isk * 512 + h * 128 + d;
                const float* scv = ST_CONV + (size_t)n * 3 * 1024 + ch;
                float a = CONV_B[ch] + CONV_W[ch] * scv[0] + CONV_W[1024 + ch] * scv[1024] + CONV_W[2048 + ch] * scv[2048] + CONV_W[3072 + ch] * bf2f(Pr[(isk ? C_MK : C_MQ) + h * 128 + d]);
                a = a * sigmoidf(a); if (isk) a *= KSCALE; qk2[isk][q] = a; (isk ? kv : qv)[d] = a; }
        vv[lane] = bf2f(Pr[C_MV + h * 128 + lane]); vv[lane + 64] = bf2f(Pr[C_MV + h * 128 + lane + 64]);
        const float* n0 = ST_N + ((size_t)n * 4 + h) * 128; const float n00 = n0[lane], n01 = n0[lane + 64];
        const float qk = wave_sum(qk2[0][0] * qk2[1][0] + qk2[0][1] * qk2[1][1]), qn = wave_sum(qk2[0][0] * n00 + qk2[0][1] * n01);
        const float ig = bf2f(Pr[C_SM + h]) + B_GATE[h], lf = logsig(bf2f(Pr[C_SM + 4 + h]) + B_GATE[4 + h]);
        const float m0 = ST_M[n * 4 + h], mn = fmaxf(lf + m0, ig);
        wkk = __expf(ig - mn); cs = __expf(lf + m0 - mn);
        const float den = cs * qn + qk * wkk;
        dinv = __builtin_amdgcn_rcpf(fmaxf(fabsf(den), __expf(-mn)));
        float* nsO = OUTP + O_NS + ((size_t)n * 4 + h) * 128; nsO[lane] = cs * n00 + wkk * qk2[1][0]; nsO[lane + 64] = cs * n01 + wkk * qk2[1][1];
        if (lane == 0) OUTP[O_MS + n * 4 + h] = mn;
    } else {
        qv[lane] = bf2f(Pr[C_GQ + h * 64 + lane]); kv[lane] = bf2f(Pr[C_GK + h * 64 + lane]);
        vv[lane] = bf2f(Pr[C_GV + h * 128 + lane]); vv[lane + 64] = bf2f(Pr[C_GV + h * 128 + lane + 64]);
        { const int col = h * 64 + lane; float z = B_A[col];
#pragma unroll
          for (int q = 0; q < 16; ++q) z += bf2f(Pr[C_SM + 8 + q]) * IN_F(13)[q * 256 + col];
          al[lane] = __expf(logsig(z) * (1.f / 16.f)); }
    }
    asm volatile("s_waitcnt lgkmcnt(0)" ::: "memory");
    const f32x4 v4 = *(const f32x4*)(vv + 4 * e4);
    f32x4 hp = (f32x4){0.f, 0.f, 0.f, 0.f};
    if (!gla) {
        const float* C0 = ST_C + ((size_t)n * 4 + h) * 16384 + (size_t)(64 * dh) * 128 + 4 * e4; float* Cn = OUTP + O_CS + ((size_t)n * 4 + h) * 16384 + (size_t)(64 * dh) * 128 + 4 * e4;
        for (int i0 = 0; i0 < 64; i0 += 8) { f32x4 c0[8];
#pragma unroll
            for (int i = 0; i < 8; ++i) c0[i] = __builtin_nontemporal_load((const f32x4*)(C0 + (i0 + i) * 128));
#pragma unroll
            for (int i = 0; i < 8; ++i) { const int d = 64 * dh + i0 + i; const f32x4 cn = c0[i] * cs + v4 * (wkk * kv[d]); __builtin_nontemporal_store(cn, (f32x4*)(Cn + (i0 + i) * 128)); hp += cn * qv[d]; } }
    } else {
        const float* S0 = ST_S + ((size_t)n * 4 + h) * 8192 + (size_t)(32 * dh) * 128 + 4 * e4; float* Sn = OUTP + O_SS + ((size_t)n * 4 + h) * 8192 + (size_t)(32 * dh) * 128 + 4 * e4;
        for (int i0 = 0; i0 < 32; i0 += 8) { f32x4 c0[8];
#pragma unroll
            for (int i = 0; i < 8; ++i) c0[i] = __builtin_nontemporal_load((const f32x4*)(S0 + (i0 + i) * 128));
#pragma unroll
            for (int i = 0; i < 8; ++i) { const int d = 32 * dh + i0 + i; const f32x4 sn = c0[i] * al[d] + v4 * kv[d]; __builtin_nontemporal_store(sn, (f32x4*)(Sn + (i0 + i) * 128)); hp += sn * qv[d]; } }
    }
#pragma unroll
    for (int j = 0; j < 4; ++j) hp[j] += __shfl_xor(hp[j], 32);
    hp = hp * dinv;
    float ssum = (hp[0] * hp[0] + hp[1] * hp[1]) + (hp[2] * hp[2] + hp[3] * hp[3]);
#pragma unroll
    for (int o = 1; o < 32; o <<= 1) ssum += __shfl_xor(ssum, o);
    const float rn = rsqrt_fast(ssum * (1.f / 128.f) + EPS);
    if (lane < 32) {
        const v2u gw = *(const v2u*)(Pr + (gla ? C_GR : C_MO) + h * 128 + 4 * e4);
        const f32x4 g4 = *(const f32x4*)((gla ? G_GHEAD : G_MHEAD) + h * 128 + 4 * e4);
        const float gt[4] = {bflo(gw[0]), bfhi(gw[0]), bflo(gw[1]), bfhi(gw[1])}; float o[4];
#pragma unroll
        for (int j = 0; j < 4; ++j) { const float sg_ = sigmoidf(gt[j]); o[j] = hp[j] * rn * g4[j] * (gla ? gt[j] * sg_ : sg_); }
        int e4o = e4; asm volatile("" : "+v"(e4o));
        *(v2u*)(R1B + row * D + (gla ? 512 : 0) + h * 128 + 4 * e4o) = (v2u){pg8::cvt_pk_bf16(o[0], o[1]), pg8::cvt_pk_bf16(o[2], o[3])};
    }
    asm volatile("s_waitcnt lgkmcnt(0)" ::: "memory");
}

constexpr int P2B_QS = 0, P2B_KS = 64 * QS_P, P2B_VT = P2B_KS + 80 * QS_P, P2B_PS = P2B_VT + 128 * TS, P2B_FL = P2B_PS + 64 * TS, P2B_HALF = P2B_FL + 2560;
static_assert(2 * P2B_HALF <= MISC_OFF, "P2b LDS");
__device__ __forceinline__ void p2b_unit(Frame& F, int u, const bool GLA, char* L, int ltid, int lw, int lane) {
    const int v = u & 1023, bh = v >> 5, c = v & 31, b = bh >> 2, h = bh & 3, r = lane & 15, g = lane >> 4;
    const size_t rowb = (size_t)b * SEQ + c * 64;
    const bf16* P = PROJ;
    char* QSp = L + P2B_QS; char* KSp = L + P2B_KS; char* VTp = L + P2B_VT; char* PSp = L + P2B_PS;
    float* af = (float*)(L + P2B_FL); float* Mf = af + 64; float* scf = af + 128; float* enf = af + 192; float* dinvf = af + 256; float* ssq = af + 320;
    const int QP = GLA ? TS : QS_P;
    const int NK = GLA ? 2 : 4;
    bf16x8 cfr[2][4];
    { const bf16* CT = GLA ? CSG + (size_t)(bh * NCH + c) * 8192 : CSM + (size_t)(bh * NCH + c) * 16384;
#pragma unroll
      for (int n2 = 0; n2 < 2; ++n2)
#pragma unroll
          for (int kk = 0; kk < 4; ++kk) if (kk < NK) cfr[n2][kk] = *(const bf16x8*)(CT + ((2 * lw + n2) * (GLA ? 4 : 8) + 2 * kk + (g >> 1)) * 256 + r * 16 + 8 * (g & 1)); }
    const int dp = ltid & 63, sg = ltid >> 6;
    v2u gwq[4][2];
#pragma unroll
    for (int mt = 0; mt < 4; ++mt)
#pragma unroll
        for (int n2 = 0; n2 < 2; ++n2) gwq[mt][n2] = *(const v2u*)(P + (rowb + 16 * mt + r) * PS + (GLA ? C_GR : C_MO) + h * 128 + 32 * lw + 16 * n2 + 4 * g);
    float* rsf = ssq + 256;
    if (!GLA) {
        { const float a = GA_A[(size_t)bh * SEQ + c * 64 + lane], bc = GA_B[(size_t)bh * SEQ + c * 64 + lane];
          const float pm = wave_scan_max(a, lane);
          const float mc = MCS[bh * NCH + c], pmx = PMXG[bh * NCH + c], Mt = fmaxf(mc, pm);
          if (lw == 0) { Mf[lane] = Mt; scf[lane] = __expf(mc - Mt); enf[lane] = __expf(-(bc + Mt)); rsf[lane] = __expf(pmx - Mt); } }
        {
#pragma unroll
          for (int i = 0; i < 4; ++i) { const int pc = ltid + 256 * i, row = pc >> 4, c16 = pc & 15;
              const v4u qq = *(const v4u*)(SCR + SC_QP + (rowb + row) * 512 + h * 128 + 8 * c16), kk4 = *(const v4u*)(SCR + SC_KW + (rowb + row) * 512 + h * 128 + 8 * c16);
              *(v4u*)(QSp + row * QS_P + 16 * c16) = qq; *(v4u*)(KSp + row * QS_P + 16 * c16) = kk4; } }
        if (ltid < 128) *(bf16*)(KSp + 64 * QS_P + 2 * ltid) = (bf16)f2bf(NCS[(size_t)(bh * NCH + c) * 128 + ltid]);
        for (int i = ltid; i < 15 * 64; i += 256) *(unsigned*)(KSp + (65 + i / 64) * QS_P + 4 * (i & 63)) = 0u;
    } else {
#pragma unroll
        for (int i = 0; i < 2; ++i) { const int pc = ltid + 256 * i, row = pc >> 3, c16 = pc & 7;
            const v4u qq = *(const v4u*)(SCR + SC_QG + (rowb + row) * 256 + h * 64 + 8 * c16), kk4 = *(const v4u*)(SCR + SC_KG + (rowb + row) * 256 + h * 64 + 8 * c16);
            *(v4u*)(QSp + row * TS + 16 * c16) = qq; *(v4u*)(KSp + row * TS + 16 * c16) = kk4; }
    }
    {
      unsigned vr[16];
#pragma unroll
      for (int i = 0; i < 16; ++i) vr[i] = *(const unsigned*)(P + (rowb + 16 * sg + i) * PS + (GLA ? C_GV : C_MV) + h * 128 + 2 * dp);
      unsigned v0p[8], v1p[8];
#pragma unroll
      for (int i = 0; i < 16; i += 2) { v0p[i >> 1] = (vr[i] & 0xffffu) | (vr[i + 1] << 16); v1p[i >> 1] = (vr[i] >> 16) | (vr[i + 1] & 0xffff0000u); }
      *(v4u*)(VTp + (2 * dp) * TS + 32 * sg) = (v4u){v0p[0], v0p[1], v0p[2], v0p[3]}; *(v4u*)(VTp + (2 * dp) * TS + 32 * sg + 16) = (v4u){v0p[4], v0p[5], v0p[6], v0p[7]};
      *(v4u*)(VTp + (2 * dp + 1) * TS + 32 * sg) = (v4u){v1p[0], v1p[1], v1p[2], v1p[3]}; *(v4u*)(VTp + (2 * dp + 1) * TS + 32 * sg + 16) = (v4u){v1p[4], v1p[5], v1p[6], v1p[7]}; }
    __syncthreads();
    {
        f32x4 pa[5];
#pragma unroll
        for (int i = 0; i < 5; ++i) pa[i] = (f32x4){0.f, 0.f, 0.f, 0.f};
#pragma unroll
        for (int kk = 0; kk < 4; ++kk) if (kk < NK) {
            const bf16x8 qf = lds_frag(QSp + (16 * lw + r) * QP + (32 * kk + 8 * g) * 2);
#pragma unroll
            for (int nt = 0; nt < 4; ++nt) if (nt <= lw) pa[nt] = mfma16(lds_frag(KSp + (16 * nt + r) * QP + (32 * kk + 8 * g) * 2), qf, pa[nt]);
            if (!GLA) pa[4] = mfma16(lds_frag(KSp + (64 + r) * QP + (32 * kk + 8 * g) * 2), qf, pa[4]);
        }
        const int t = 16 * lw + r;
        float rsc = 1.f; if (!GLA) rsc = rsf[t];
        float rs = 0.f;
#pragma unroll
        for (int nt = 0; nt < 4; ++nt) {
            f32x4 p = (f32x4){0.f, 0.f, 0.f, 0.f};
            if (nt <= lw) {
#pragma unroll
                for (int j = 0; j < 4; ++j) { const int s = 16 * nt + 4 * g + j; p[j] = (s <= t) ? pa[nt][j] * rsc : 0.f; }
            }
            rs += (p[0] + p[1]) + (p[2] + p[3]);
            *(v2u*)(PSp + t * TS + (16 * nt + 4 * g) * 2) = (v2u){pg8::cvt_pk_bf16(p[0], p[1]), pg8::cvt_pk_bf16(p[2], p[3])};
        }
        if (!GLA) {
            rs += __shfl_xor(rs, 16); rs += __shfl_xor(rs, 32);
            if (g == 0) { const float den = scf[t] * pa[4][0] + rs; dinvf[t] = __builtin_amdgcn_rcpf(fmaxf(fabsf(den), enf[t])); }
        }
    }
    __syncthreads();
    f32x4 hv[4][2];
    {
        f32x4 aV[4][2], aC[4][2];
#pragma unroll
        for (int mt = 0; mt < 4; ++mt)
#pragma unroll
            for (int n2 = 0; n2 < 2; ++n2) { aV[mt][n2] = (f32x4){0.f, 0.f, 0.f, 0.f}; aC[mt][n2] = (f32x4){0.f, 0.f, 0.f, 0.f}; }
#pragma unroll
        for (int kk = 0; kk < 2; ++kk) {
            bf16x8 vf[2];
#pragma unroll
            for (int n2 = 0; n2 < 2; ++n2) vf[n2] = lds_frag(VTp + (32 * lw + 16 * n2 + r) * TS + (32 * kk + 8 * g) * 2);
#pragma unroll
            for (int mt = 0; mt < 4; ++mt) { const bf16x8 pf = lds_frag(PSp + (16 * mt + r) * TS + (32 * kk + 8 * g) * 2);
#pragma unroll
                for (int n2 = 0; n2 < 2; ++n2) aV[mt][n2] = mfma16(vf[n2], pf, aV[mt][n2]); }
        }
#pragma unroll
        for (int kk = 0; kk < 4; ++kk) if (kk < NK)
#pragma unroll
            for (int mt = 0; mt < 4; ++mt) { const bf16x8 qf = lds_frag(QSp + (16 * mt + r) * QP + (32 * kk + 8 * g) * 2);
#pragma unroll
                for (int n2 = 0; n2 < 2; ++n2) aC[mt][n2] = mfma16(cfr[n2][kk], qf, aC[mt][n2]); }
#pragma unroll
        for (int mt = 0; mt < 4; ++mt) { const int t = 16 * mt + r;
            float sc = 1.f, di = 1.f; if (!GLA) { sc = scf[t]; di = dinvf[t]; }
            float s = 0.f;
#pragma unroll
            for (int n2 = 0; n2 < 2; ++n2) { hv[mt][n2] = (aC[mt][n2] * sc + aV[mt][n2]) * di;
                s += (hv[mt][n2][0] * hv[mt][n2][0] + hv[mt][n2][1] * hv[mt][n2][1]) + (hv[mt][n2][2] * hv[mt][n2][2] + hv[mt][n2][3] * hv[mt][n2][3]); }
            s += __shfl_xor(s, 16); s += __shfl_xor(s, 32);
            if (g == 0) ssq[t * 4 + lw] = s; }
    }
    __syncthreads();
    {
        const float* gn = (GLA ? G_GHEAD : G_MHEAD) + h * 128;
#pragma unroll
        for (int mt = 0; mt < 4; ++mt) { const int t = 16 * mt + r; const f32x4 s4 = *(const f32x4*)(ssq + 4 * t);
            const float rn = rsqrt_fast(((s4[0] + s4[1]) + (s4[2] + s4[3])) * (1.f / 128.f) + EPS);
#pragma unroll
            for (int n2 = 0; n2 < 2; ++n2) { const int e = 32 * lw + 16 * n2 + 4 * g;
                const v2u gw = gwq[mt][n2];
                const f32x4 g4 = *(const f32x4*)(gn + e);
                float gt[4] = {bflo(gw[0]), bfhi(gw[0]), bflo(gw[1]), bfhi(gw[1])}; float o[4];
#pragma unroll
                for (int j = 0; j < 4; ++j) { const float sg_ = sigmoidf(gt[j]); o[j] = hv[mt][n2][j] * rn * g4[j] * (GLA ? gt[j] * sg_ : sg_); }
                *(v2u*)(R1B + (rowb + t) * D + (GLA ? 512 : 0) + h * 128 + e) = (v2u){pg8::cvt_pk_bf16(o[0], o[1]), pg8::cvt_pk_bf16(o[2], o[3])}; } }
    }
    __syncthreads();
}

template <int K, int RT>
__device__ __forceinline__ void skinny_acc(const bf16* A, const bf16* Bt, int nsl, f32x4 (&acc)[RT], int w, int r, int g) {
    constexpr int KW = K / 8, NKS = KW / 32, KBMAX = RT <= 2 ? 8 : 4, KB = NKS < KBMAX ? NKS : KBMAX;
    const bf16* ap = A + (size_t)r * K + w * KW + 8 * g;
    const bf16* bp = Bt + (size_t)(nsl * 16 + r) * K + w * KW + 8 * g;
#pragma unroll 1
    for (int ks = 0; ks < NKS; ks += KB) {
        bf16x8 bfr[KB], afr[RT][KB];
#pragma unroll
        for (int kk = 0; kk < KB; ++kk) { bfr[kk] = *(const bf16x8*)(bp + 32 * (ks + kk));
#pragma unroll
            for (int rt = 0; rt < RT; ++rt) afr[rt][kk] = *(const bf16x8*)(ap + (size_t)rt * 16 * K + 32 * (ks + kk)); }
#pragma unroll
        for (int kk = 0; kk < KB; ++kk)
#pragma unroll
            for (int rt = 0; rt < RT; ++rt) acc[rt] = mfma16(bfr[kk], afr[rt][kk], acc[rt]);
    }
}
template <int RT> __device__ __forceinline__ void skinny_put(float* red, const f32x4 (&acc)[RT], int w, int r, int g) {
#pragma unroll
    for (int rt = 0; rt < RT; ++rt) *(f32x4*)(red + w * (RT * 256) + (16 * rt + r) * 16 + 4 * g) = acc[rt];
}
template <int RT> __device__ __forceinline__ f32x4 skinny_get(const float* red, int row, int c4) {
    f32x4 v = (f32x4){0.f, 0.f, 0.f, 0.f};
#pragma unroll
    for (int q = 0; q < 8; ++q) v += *(const f32x4*)(red + q * (RT * 256) + row * 16 + 4 * c4);
    return v;
}
template <int RT> __device__ __forceinline__ void zeroacc(f32x4 (&acc)[RT]) {
#pragma unroll
    for (int i = 0; i < RT; ++i) acc[i] = (f32x4){0.f, 0.f, 0.f, 0.f};
}
__device__ __forceinline__ float quad_sum(float s) { s += __shfl_xor(s, 1); s += __shfl_xor(s, 2); return s; }
__device__ __forceinline__ v2u pack4(f32x4 v) { return (v2u){pg8::cvt_pk_bf16(v[0], v[1]), pg8::cvt_pk_bf16(v[2], v[3])}; }
template <bool RES_BF16>
__device__ __forceinline__ void skinny_res(Frame& F, const bf16* A, const bf16* Bt, int K4096, const void* res, bf16* ob, float* ss, const float* rsq) {
    float* red = (float*)F.ldsg; const int tid = F_TID, lane = F_LANE, w = F_WAVE, r = lane & 15, g = lane >> 4, lrow = tid >> 2, c4 = tid & 3;
    for (int it = blockIdx.x; it < 4 * (D / 16); it += F.G) { const int nsl = it >> 2, r0 = 32 * (it & 3);
        f32x4 acc[2]; zeroacc<2>(acc);
        if (K4096) skinny_acc<FF, 2>(A + (size_t)r0 * FF, Bt, nsl, acc, w, r, g); else skinny_acc<D, 2>(A + (size_t)r0 * D, Bt, nsl, acc, w, r, g);
        skinny_put<2>(red, acc, w, r, g); LBAR();
        if (tid < 128) { const int row = r0 + lrow;
            const size_t off = (size_t)row * D + nsl * 16 + 4 * c4;
            f32x4 rv;
            if constexpr (RES_BF16) { const v2u rw = *(const v2u*)((const bf16*)res + off); rv = (f32x4){bflo(rw.x), bfhi(rw.x), bflo(rw.y), bfhi(rw.y)}; }
            else rv = *(const f32x4*)((const float*)res + off);
            float q = 1.f; if constexpr (RES_BF16) q = __builtin_amdgcn_rcpf(rsq[row] * (1.f / D) + EPS);
            const f32x4 v = skinny_get<2>(red, lrow, c4) * q + rv;
            *(v2u*)(ob + off) = pack4(v);
            const float s = quad_sum((v[0] * v[0] + v[1] * v[1]) + (v[2] * v[2] + v[3] * v[3]));
            if (c4 == 0) atomicAdd(ss + row, s); }
        LBAR();
    }
}
__device__ __forceinline__ void skinny_up(Frame& F, const bf16* A, const bf16* Bt, bf16* U) {
    float* red = (float*)F.ldsg; const int tid = F_TID, lane = F_LANE, w = F_WAVE, r = lane & 15, g = lane >> 4, row = tid >> 2, c4 = tid & 3;
    for (int sl = blockIdx.x; sl < FF / 16; sl += F.G) {
        f32x4 acc[8]; zeroacc<8>(acc);
        skinny_acc<D, 8>(A, Bt, sl, acc, w, r, g);
        skinny_put<8>(red, acc, w, r, g); LBAR();
        f32x4 v = skinny_get<8>(red, row, c4);
#pragma unroll
        for (int j = 0; j < 4; ++j) { const float a = fmaxf(v[j], 0.f); v[j] = a * a; }
        *(v2u*)(U + (size_t)row * FF + sl * 16 + 4 * c4) = pack4(v);
        LBAR();
    }
}
__device__ __forceinline__ void skinny_ple(Frame& F, const bf16* pbs, const bf16* Wple, const bf16* x2b, const bf16* Wpg, const float* ss2, bf16* x3b, float* ss3,
                                           const bool FUSE, float* ysm, const float* gfin, float* slots  , unsigned* qcnt  ) {
    float* red = (float*)F.ldsg; float* red2 = red + 8 * 512; const int tid = F_TID, lane = F_LANE, w = F_WAVE, r = lane & 15, g = lane >> 4, lrow = tid >> 2, c4 = tid & 3;
    for (int it = blockIdx.x; it < 4 * (D / 16); it += F.G) { const int nsl = it >> 2, rq = it & 3, r0 = 32 * rq;
        f32x4 acc[2]; zeroacc<2>(acc);
        skinny_acc<DPLE, 2>(pbs + (size_t)r0 * DPLE, Wple, nsl, acc, w, r, g); skinny_put<2>(red2, acc, w, r, g);
        zeroacc<2>(acc);
        skinny_acc<D, 2>(x2b + (size_t)r0 * D, Wpg, nsl, acc, w, r, g); skinny_put<2>(red, acc, w, r, g); LBAR();
        const int row = r0 + (lrow & 31);
        const size_t off = (size_t)row * D + nsl * 16 + 4 * c4;
        f32x4 v = (f32x4){0.f, 0.f, 0.f, 0.f};
        if (tid < 128) {
            const float rs = rsqrt_fast(ss2[row] * (1.f / D) + EPS);
            const f32x4 gt = skinny_get<2>(red, lrow, c4) * rs, pp = skinny_get<2>(red2, lrow, c4); const v2u xw = *(const v2u*)(x2b + off);
            v = (f32x4){bflo(xw.x), bfhi(xw.x), bflo(xw.y), bfhi(xw.y)};
#pragma unroll
            for (int j = 0; j < 4; ++j) v[j] += pp[j] * sigmoidf(gt[j]);
            const float sq = quad_sum((v[0] * v[0] + v[1] * v[1]) + (v[2] * v[2] + v[3] * v[3]));
            if (!FUSE) { *(v2u*)(x3b + off) = pack4(v); if (c4 == 0) atomicAdd(ss3 + row, sq); }
            else if (c4 == 0) __hip_atomic_store(slots + row * 64 + nsl, sq, __ATOMIC_RELAXED, __HIP_MEMORY_SCOPE_AGENT);
        }
        if (FUSE) {
            asm volatile("s_waitcnt vmcnt(0)" ::: "memory");
            __syncthreads();
            if (tid == 0) { __hip_atomic_fetch_add(qcnt + 64 * rq, 1u, __ATOMIC_RELAXED, __HIP_MEMORY_SCOPE_AGENT);
                unsigned sp = 0;
                while (__hip_atomic_load(qcnt + 64 * rq, __ATOMIC_RELAXED, __HIP_MEMORY_SCOPE_AGENT) < (unsigned)(D / 16)) { __builtin_amdgcn_s_sleep(2); if (++sp > (1u << 22)) break; }
                __builtin_amdgcn_fence(__ATOMIC_ACQUIRE, "agent");
                asm volatile("s_waitcnt vmcnt(0)" ::: "memory"); }
            __syncthreads();
            if (tid < 128) { float t = 0.f;
#pragma unroll
                for (int q = 0; q < 16; ++q) t += __hip_atomic_load(slots + row * 64 + 16 * c4 + q, __ATOMIC_RELAXED, __HIP_MEMORY_SCOPE_AGENT);
                t = quad_sum(t);
                const float rn = rsqrt_fast(t * (1.f / D) + EPS);
                *(f32x4*)(ysm + off) = v * rn * *(const f32x4*)(gfin + nsl * 16 + 4 * c4); }
        }
        LBAR();
    }
}

constexpr int NPHASE = 9;

__global__ void __launch_bounds__(NWAVES * 64, 2) mk_fwd(Args args) {
    extern __shared__ __attribute__((aligned(16))) unsigned char lds[];
    Frame F;
    F.lds = (LAS unsigned char*)lds; F.ldsg = (char*)lds;
    F.G = gridDim.x;
    F.a = (CArgs*)__builtin_amdgcn_kernarg_segment_ptr();
    unsigned char* ws = F.a->ws;
    volatile LAS unsigned* MISC = (volatile LAS unsigned*)(F.lds + MISC_OFF);
    for (int u = F_TID; u < 64; u += NWAVES * 64) MISC[u] = 0u;
    __syncthreads();
    XcdBarrier bar; bar.bar = (unsigned*)(ws + CTL_BAR_B); bar.x = 0; bar.st = nullptr;
    bar = xcd_barrier_post((unsigned*)(ws + CTL_BAR_B), MISC + 8);
    const int lo = F.a->ph_lo, hi = F.a->ph_hi;
#define IN(k) (lo <= (k) && (k) < hi)
#define SEAM(k) do { if (IN(k) && IN((k) + 1)) xcd_barrier(bar); } while (0)

    if (IN(0)) { p0_prologue(F); SEAM(0); }
    if (IN(1)) {
        pg8::Gemm g{R1B, WIN_T, MR, PS, D}; pg8::StaticOrder S; S.init(MR, PS, F.G, (int)blockIdx.x);
        EpiProj E{PROJ, PS};
        pg8::gemm_phase<EpiProj, pg8::StaticOrder, PG8_ALIGN, PG8_SP2>(F.lds, g, S, E);
        SEAM(1);
    }
    if (IN(2)) {
        const int bx = blockIdx.x;
        for (int it = bx; it < NB * NCH; it += F.G) p2p_item(F, it >> 5, it & 31);
        xcd_barrier(bar);

#define P2A_CHAINS() do { const int cb_ = bx & 63; if (cb_ < 32) chain_mlstm(F, cb_ >> 2, cb_ & 3, bx >> 6); else chain_gla(F, (cb_ - 32) >> 2, (cb_ - 32) & 3, bx >> 6); } while (0)
#define P2A_SAMPLES() do { float* Wl = (float*)(F.ldsg + F_WAVE * 2048); \
              for (int it = (bx - 128) * NWAVES + F_WAVE; it < MSMP * 8; it += (F.G - 128) * NWAVES) sample_item(F, it >> 3, it & 7, Wl, F_LANE); } while (0)
        if (bx < 128) { P2A_CHAINS(); }
        else {
            const int nb = F.G - 128, gb = bx - 128;
            P2A_SAMPLES();
            for (int i = gb * 512 + F_TID; i < NB * 3 * 1024 + MSMP * 3 * 1024; i += nb * 512) {
                if (i < NB * 3 * 1024) { const int b = i / 3072, j = (i / 1024) % 3, ch = i & 1023; OUTP[O_CVP + i] = bf2f(PROJ[((size_t)b * SEQ + SEQ - 3 + j) * PS + ch]); }
                else { const int k = i - NB * 3 * 1024, n = k / 3072, j = (k / 1024) % 3, ch = k & 1023;
                    OUTP[O_CVS + k] = j < 2 ? ST_CONV[(size_t)n * 3072 + (j + 1) * 1024 + ch] : bf2f(PROJ[((size_t)MP + n) * PS + ch]); }
            }
            __syncthreads();
            late_weight_copies(F, gb, nb);
        }
        SEAM(2);
    }
    if (IN(3)) {
        const int hb = F_WAVE >> 2, ltid = F_TID & 255, lw = F_WAVE & 3;
        char* L = F.ldsg + hb * P2B_HALF;
        for (int it = 0; it * 2 * F.G < 2048; ++it) {
            const int u = (it * F.G + (int)blockIdx.x) * 2 + hb;
            if (u - hb >= 2048) break;
            p2b_unit(F, u, u >= 1024, L, ltid, lw, F_LANE);
        }
        SEAM(3);
    }
    if (IN(4)) {
        pg8::Gemm g{R1B, WOUT_T, MP, D, D}; pg8::StaticOrder S; S.init(MP, D, F.G, (int)blockIdx.x);
        EpiRes<false> E{X_P, X1B, SS1, nullptr};
        pg8::gemm_phase<EpiRes<false>, pg8::StaticOrder, PG8_ALIGN, PG8_SP2>(F.lds, g, S, E);
        skinny_res<false>(F, R1B + (size_t)MP * D, WOUT_T, 0, X_S, X1B + (size_t)MP * D, SS1 + MP, nullptr);
        SEAM(4);
    }
    if (IN(5)) {
        pg8::Gemm g{X1B, W1_T, MP, FF, D}; pg8::StaticOrder S; S.init(MP, FF, F.G, (int)blockIdx.x);
        EpiU E{UBUF};
        const bool skinny_first = (blockIdx.x & 8) != 0;
        if (skinny_first) skinny_up(F, X1B + (size_t)MP * D, W1_T, UBUF + (size_t)MP * FF);
        pg8::gemm_phase<EpiU, pg8::StaticOrder, PG8_ALIGN, PG8_SP2>(F.lds, g, S, E);
        if (!skinny_first) skinny_up(F, X1B + (size_t)MP * D, W1_T, UBUF + (size_t)MP * FF);
        SEAM(5);
    }
    if (IN(6)) {
        pg8::Gemm g{UBUF, W2_T, MP, D, FF}; pg8::StaticOrder S; S.init(MP, D, F.G, (int)blockIdx.x);
        EpiRes<true> E{X1B, R1B, SS2, SS1};
        pg8::gemm_phase<EpiRes<true>, pg8::StaticOrder, PG8_ALIGN, PG8_SP2>(F.lds, g, S, E);

        skinny_res<true>(F, UBUF + (size_t)MP * FF, W2_T, 1, X1B + (size_t)MP * D, R1B + (size_t)MP * D, SS2 + MP, SS1 + MP);
        SEAM(6);
    }
    if (IN(7)) {
        { pg8::Gemm g{PBUF, WPLE_T, MP, D, DPLE}; pg8::StaticOrder S; S.init(MP, D, F.G, (int)blockIdx.x);
          EpiProj E{PPB, D};
          pg8::gemm_phase<EpiProj, pg8::StaticOrder, PG8_ALIGN, PG8_SP2>(F.lds, g, S, E); }
        { pg8::Gemm g{R1B, WPG_T, MP, D, D}; pg8::StaticOrder S; S.init(MP, D, F.G, (int)blockIdx.x);
          EpiPleFinal E{R1B, PPB, OUTP, SS2, G_FINAL, (float*)(WSB + WS_XBUF), (unsigned*)(WSB + CTL_PCNT_B)};
          pg8::gemm_phase<EpiPleFinal, pg8::StaticOrder, false, PG8_SP2>(F.lds, g, S, E); }
        const bool fuse_s = F.G >= 4 * (D / 16);
        skinny_ple(F, PBUF + (size_t)MP * DPLE, WPLE_T, R1B + (size_t)MP * D, WPG_T, SS2 + MP, X1B + (size_t)MP * D, SS3 + MP,
                   fuse_s, OUTP + (size_t)MP * D, G_FINAL, (float*)(WSB + WS_XBUF + 262144), (unsigned*)(WSB + CTL_PCNT_B) + 64 * 64);
        if (!fuse_s) SEAM(7);
    }
    if (IN(8) && F.G < 4 * (D / 16)) {
        const int gw = blockIdx.x * NWAVES + F_WAVE, NGW = F.G * NWAVES;
        for (int m = MP + gw; m < MV; m += NGW) {
            const GAS v2u* xr = (const GAS v2u*)(X1B + (size_t)m * D) + F_LANE; GAS f32x4* yo = (GAS f32x4*)(OUTP + (size_t)m * D) + F_LANE;
            const float r = rsqrt_fast(SS3[m] * (1.f / D) + EPS);
#pragma unroll
            for (int j = 0; j < 4; ++j) { const f32x4 gf = ((const GAS f32x4*)G_FINAL)[F_LANE + 64 * j]; const v2u xw = xr[64 * j];
                yo[64 * j] = (f32x4){bflo(xw.x), bfhi(xw.x), bflo(xw.y), bfhi(xw.y)} * r * gf; }
        }

    }
#undef IN
#undef SEAM
}

extern "C" void kernel_launch(void* const* d_in, const int* in_sizes, int n_in, void* d_out, int out_size, void* d_ws, size_t ws_size, hipStream_t stream) {
    static int grid = 0;
    if (grid == 0) {
        if (n_in != 26 || ws_size < WS_END) { fprintf(stderr, "kernel_launch: unexpected n_in %d / ws %zu\n", n_in, ws_size); grid = -1; return; }
        int dev = 0, cus = 0, per_cu = 0;
        if (hipGetDevice(&dev) != hipSuccess || hipDeviceGetAttribute(&cus, hipDeviceAttributeMultiprocessorCount, dev) != hipSuccess) { grid = -1; return; }
        if (hipFuncSetAttribute((const void*)mk_fwd, hipFuncAttributeMaxDynamicSharedMemorySize, LDS_BYTES) != hipSuccess) { fprintf(stderr, "kernel_launch: hipFuncSetAttribute failed\n"); grid = -1; return; }
        if (hipOccupancyMaxActiveBlocksPerMultiprocessor(&per_cu, (const void*)mk_fwd, NWAVES * 64, LDS_BYTES) != hipSuccess || per_cu < 1) { fprintf(stderr, "kernel_launch: occupancy query says %d\n", per_cu); per_cu = 1; }
        (void)hipGetLastError();
        grid = cus;
        if (grid > 256) grid = 256;
    }
    if (grid < 0) return;
    (void)hipMemsetAsync((char*)d_ws + WS_CTL, 0, CTL_ZERO_BYTES, stream);
    Args a{};
    for (int i = 0; i < 26; ++i) a.in[i] = (const float*)d_in[i];
    a.out = (float*)d_out; a.ws = (unsigned char*)d_ws;
    a.ph_lo = 0; a.ph_hi = NPHASE; a.li = 0;
    hipLaunchKernelGGL(mk_fwd, dim3(grid), dim3(NWAVES * 64), LDS_BYTES, stream, a);
}
```

```cpp
#include <hip/hip_runtime.h>
#include <cstdio>
#include <cstdint>


namespace pg8 {
#define PG8_LAS __attribute__((address_space(3)))
typedef unsigned short bf16_t;
typedef short bf16x8 __attribute__((ext_vector_type(8)));
typedef float f32x4 __attribute__((ext_vector_type(4)));
typedef unsigned u32x4 __attribute__((ext_vector_type(4)));
constexpr int BM = 256, BK = 64, HALF = 128, HTB = HALF * BK * 2, STAGE_BYTES = 8 * HTB, NXCD = 8, WGM = 4, MP = 16384;

__host__ __device__ __forceinline__ int lds_byte(int r, int c) { const int st = (r >> 4) * 2 + (c >> 5), rr = r & 15, cc = c & 31, ob = rr * 64 + cc * 2; return st * 1024 + (ob ^ (((ob >> 9) & 1) << 5)); }
__host__ __device__ __forceinline__ void stage_rc(int b, int& R, int& C) { const int st = b / 1024, sb = b % 1024, swz = sb ^ (((sb >> 9) & 1) << 5); R = (st >> 1) * 16 + swz / 64; C = (st & 1) * 32 + (swz % 64) / 2; }
__host__ __device__ __forceinline__ int perm32(int rho) { const int n = rho >> 4, i = rho & 15; return 8 * (i >> 2) + 4 * n + (i & 3); }

struct Unit { int pm, pn; };
struct Gemm { const bf16_t* A; const bf16_t* Bt; int M, N, K; };

struct StaticOrder {
    int nM, nN, nwg, G, c;
    __host__ __device__ void init(int M, int N, int G_, int c_) { nM = M / BM; nN = N / BM; nwg = nM * nN; G = G_; c = c_; }
    __host__ __device__ bool next(int i, Unit& u) const {
        const long L = (long)i * G + c; if (L >= nwg) return false;
        int wgid = (int)L; { const int q = nwg / NXCD, r = nwg % NXCD, xcd = wgid % NXCD, off = wgid / NXCD; wgid = (xcd < r ? xcd * (q + 1) : r * (q + 1) + (xcd - r) * q) + off; }
        const int nig = WGM * nN, gid = wgid / nig, fm = gid * WGM, gsz = (nM - fm) < WGM ? (nM - fm) : WGM;
        u.pm = fm + ((wgid % nig) % gsz); u.pn = (wgid % nig) / gsz;
        if (gid & 1) u.pn = nN - 1 - u.pn;
        return true;
    }
    __device__ __forceinline__ void a_ready(const Unit&) const {}
    __device__ __forceinline__ void done(const Unit&) const {}
};

__device__ __forceinline__ unsigned cvt_pk_bf16(float lo, float hi) { unsigned r; asm volatile("v_cvt_pk_bf16_f32 %0, %1, %2" : "=v"(r) : "v"(lo), "v"(hi)); return r; }


template <class Epi, class Sched, bool ALIGN_EPI = false, bool SP2 = false>
__device__ __forceinline__ void gemm_phase(PG8_LAS unsigned char* lds, const Gemm g, const Sched& S, const Epi& E) {
    int tid_ = threadIdx.x; asm volatile("" : "+v"(tid_));
    const int tid = tid_, wid = __builtin_amdgcn_readfirstlane(tid >> 6), lane = tid & 63, wr = wid >> 2, wc = wid & 3, fr = lane & 15, fq = lane >> 4;
    const int K = g.K, nt = K / BK;
    unsigned voffA[2], voffB[2];
#pragma unroll
    for (int i = 0; i < 2; ++i) { int R, C; stage_rc(tid * 16 + i * 8192, R, C); const int Rb = Epi::PERM ? ((R & ~31) + perm32(R & 31)) : R;
        voffA[i] = (unsigned)(R * K + C) * 2u; voffB[i] = (unsigned)(Rb * K + C) * 2u; }
    const size_t kstep = (size_t)(BK * 2);
    const size_t hstep = (size_t)HALF * K * 2;
    const size_t tstep = 2 * hstep;
    const unsigned ldsw = (unsigned)wid * 1024u;
    const int aoff = lds_byte(wr * 64 + fr, fq * 8), boff = lds_byte(wc * 32 + fr, fq * 8);
#define PG8_SA(b, h) (((b) * 2 + (h)) * HTB)
#define PG8_SB(b, h) ((4 + (b) * 2 + (h)) * HTB)
#define PG8_STAGE(bufoff, gbase, voff) do { _Pragma("unroll") for (int _i = 0; _i < 2; ++_i) \
        __builtin_amdgcn_global_load_lds((const unsigned*)((const char*)(gbase) + (voff)[_i]), (PG8_LAS unsigned*)(lds + (bufoff) + ldsw + _i * 8192), 16, 0, 0); } while (0)
#define PG8_LDA(dst, b, h) do { _Pragma("unroll") for (int m = 0; m < 4; ++m) _Pragma("unroll") for (int k = 0; k < 2; ++k) dst[m][k] = *(const PG8_LAS bf16x8*)(lds + PG8_SA(b, h) + aoff + m * 2048 + k * 1024); } while (0)
#define PG8_LDB(dst, b, h) do { _Pragma("unroll") for (int n = 0; n < 2; ++n) _Pragma("unroll") for (int k = 0; k < 2; ++k) dst[n][k] = *(const PG8_LAS bf16x8*)(lds + PG8_SB(b, h) + boff + n * 2048 + k * 1024); } while (0)
#define PG8_MMA(ai, bj, At, Bt) do { __builtin_amdgcn_s_setprio(1); _Pragma("unroll") for (int m = 0; m < 4; ++m) _Pragma("unroll") for (int n = 0; n < 2; ++n) _Pragma("unroll") for (int k = 0; k < 2; ++k) \
        acc[ai][bj][m][n] = __builtin_amdgcn_mfma_f32_16x16x32_bf16(Bt[n][k], At[m][k], acc[ai][bj][m][n], 0, 0, 0); __builtin_amdgcn_s_setprio(0); } while (0)
#define PG8_WAIT_V(n) asm volatile("s_waitcnt vmcnt(" #n ")" ::: "memory")
#define PG8_WAIT_L(n) asm volatile("s_waitcnt lgkmcnt(" #n ")" ::: "memory")
#define PG8_BAR __builtin_amdgcn_s_barrier()
#define PG8_SCHED __builtin_amdgcn_sched_barrier(0)
    Unit cur, nxt; int ui = 0;
    if (!S.next(0, cur)) return;
    f32x4 acc[2][2][4][2];
#pragma unroll
    for (int a = 0; a < 2; ++a)
#pragma unroll
        for (int b = 0; b < 2; ++b)
#pragma unroll
            for (int m = 0; m < 4; ++m)
#pragma unroll
                for (int n = 0; n < 2; ++n) acc[a][b][m][n] = (f32x4){0.f, 0.f, 0.f, 0.f};
    bf16x8 At[4][2], B0[2][2], B1[2][2];
    const char* cA = (const char*)g.A + (size_t)cur.pm * tstep; const char* cB = (const char*)g.Bt + (size_t)cur.pn * tstep;
    S.a_ready(cur);
    if constexpr (SP2) {
        PG8_STAGE(PG8_SB(0, 0), cB, voffB); PG8_STAGE(PG8_SB(0, 1), cB + hstep, voffB); PG8_STAGE(PG8_SA(0, 0), cA, voffA); PG8_STAGE(PG8_SA(0, 1), cA + hstep, voffA);
        if (wr == 1) PG8_BAR;
        PG8_WAIT_V(2); PG8_BAR;
        PG8_STAGE(PG8_SB(1, 0), cB + kstep, voffB); PG8_STAGE(PG8_SA(1, 0), cA + kstep, voffA); PG8_STAGE(PG8_SB(1, 1), cB + hstep + kstep, voffB);
        PG8_WAIT_V(6); PG8_BAR;
    } else {
        PG8_STAGE(PG8_SB(0, 0), cB, voffB); PG8_STAGE(PG8_SA(0, 0), cA, voffA); PG8_STAGE(PG8_SB(0, 1), cB + hstep, voffB); PG8_STAGE(PG8_SA(0, 1), cA + hstep, voffA);
        if (wr == 1) PG8_BAR;
        PG8_WAIT_V(4); PG8_BAR;
        PG8_STAGE(PG8_SB(1, 0), cB + kstep, voffB); PG8_STAGE(PG8_SA(1, 0), cA + kstep, voffA); PG8_STAGE(PG8_SB(1, 1), cB + hstep + kstep, voffB);
        PG8_WAIT_V(6); PG8_BAR;
    }
    for (;;) {
        const bool has_next = S.next(ui + 1, nxt);
        const char* nA = has_next ? (const char*)g.A + (size_t)nxt.pm * tstep : cA; const char* nB = has_next ? (const char*)g.Bt + (size_t)nxt.pn * tstep : cB;
        for (int t = 0; t < nt; t += 2) {
            const bool last = (t == nt - 2);
            const char* a1 = cA + (size_t)(t + 1) * kstep;
            const char* a2 = last ? nA : cA + (size_t)(t + 2) * kstep; const char* b2 = last ? nB : cB + (size_t)(t + 2) * kstep;
            const char* a3 = a2 + kstep; const char* b3 = b2 + kstep;
            if (last && has_next) S.a_ready(nxt);
            const bool fullm = cur.pm < MP / BM;
            if constexpr (SP2) {
            PG8_LDB(B0, 0, 0); PG8_LDB(B1, 0, 1); PG8_SCHED; PG8_LDA(At, 0, 0); PG8_STAGE(PG8_SA(1, 1), a1 + hstep, voffA);
            PG8_WAIT_V(8); PG8_WAIT_L(0); PG8_BAR; PG8_MMA(0, 0, At, B0); PG8_MMA(0, 1, At, B1); PG8_BAR; PG8_SCHED;
            PG8_LDA(At, 0, 1); PG8_STAGE(PG8_SB(0, 0), b2, voffB); PG8_STAGE(PG8_SB(0, 1), b2 + hstep, voffB); PG8_STAGE(PG8_SA(0, 0), a2, voffA);
            PG8_WAIT_V(8); PG8_WAIT_L(0); PG8_BAR; if (fullm) { PG8_MMA(1, 0, At, B0); PG8_MMA(1, 1, At, B1); } PG8_BAR; PG8_SCHED;
            PG8_LDB(B0, 1, 0); PG8_LDB(B1, 1, 1); PG8_SCHED; PG8_LDA(At, 1, 0); PG8_STAGE(PG8_SA(0, 1), a2 + hstep, voffA);
            PG8_WAIT_V(8); PG8_WAIT_L(0); PG8_BAR; PG8_MMA(0, 0, At, B0); PG8_MMA(0, 1, At, B1); PG8_BAR; PG8_SCHED;
            PG8_LDA(At, 1, 1); PG8_STAGE(PG8_SB(1, 0), b3, voffB); PG8_STAGE(PG8_SB(1, 1), b3 + hstep, voffB); PG8_STAGE(PG8_SA(1, 0), a3, voffA);
            PG8_WAIT_V(8); PG8_WAIT_L(0); PG8_BAR; if (fullm) { PG8_MMA(1, 0, At, B0); PG8_MMA(1, 1, At, B1); } PG8_BAR; PG8_SCHED;
            } else {
            PG8_LDB(B0, 0, 0); PG8_SCHED; PG8_LDA(At, 0, 0); PG8_STAGE(PG8_SA(1, 1), a1 + hstep, voffA);
            PG8_WAIT_L(8); PG8_BAR; PG8_WAIT_L(0); PG8_MMA(0, 0, At, B0); PG8_BAR; PG8_SCHED;
            PG8_LDB(B1, 0, 1); PG8_STAGE(PG8_SB(0, 0), b2, voffB);
            PG8_BAR; PG8_WAIT_L(0); PG8_MMA(0, 1, At, B1); PG8_BAR;
            PG8_LDA(At, 0, 1); PG8_STAGE(PG8_SA(0, 0), a2, voffA);
            PG8_BAR; PG8_WAIT_L(0); PG8_MMA(1, 0, At, B0); PG8_BAR; PG8_SCHED;
            PG8_STAGE(PG8_SB(0, 1), b2 + hstep, voffB);
            PG8_WAIT_V(6); PG8_BAR; PG8_MMA(1, 1, At, B1); PG8_BAR;
            PG8_LDB(B0, 1, 0); PG8_SCHED; PG8_LDA(At, 1, 0); PG8_STAGE(PG8_SA(0, 1), a2 + hstep, voffA);
            PG8_WAIT_L(8); PG8_BAR; PG8_WAIT_L(0); PG8_MMA(0, 0, At, B0); PG8_BAR; PG8_SCHED;
            PG8_LDB(B1, 1, 1); PG8_STAGE(PG8_SB(1, 0), b3, voffB);
            PG8_BAR; PG8_WAIT_L(0); PG8_MMA(0, 1, At, B1); PG8_BAR;
            PG8_LDA(At, 1, 1); PG8_STAGE(PG8_SA(1, 0), a3, voffA);
            PG8_BAR; PG8_WAIT_L(0); PG8_MMA(1, 0, At, B0); PG8_BAR; PG8_SCHED;
            PG8_STAGE(PG8_SB(1, 1), b3 + hstep, voffB);
            PG8_WAIT_V(6); PG8_BAR; PG8_MMA(1, 1, At, B1); PG8_BAR;
            }
        }
        if constexpr (ALIGN_EPI) { if (wr == 0) PG8_BAR; }
        if constexpr (!Epi::AFTER_DRAIN) { E(acc, cur, wr, wc, fr, fq); S.done(cur); }
        if (!has_next) break;
#pragma unroll
        for (int a = 0; a < 2; ++a)
#pragma unroll
            for (int b = 0; b < 2; ++b)
#pragma unroll
                for (int m = 0; m < 4; ++m)
#pragma unroll
                    for (int n = 0; n < 2; ++n) acc[a][b][m][n] = (f32x4){0.f, 0.f, 0.f, 0.f};
        cur = nxt; cA = nA; cB = nB; ++ui;
        if constexpr (ALIGN_EPI) { if (wr == 1) PG8_BAR; }
    }
    PG8_WAIT_V(0);
    if constexpr (!ALIGN_EPI) { if (wr == 0) PG8_BAR; }
    PG8_BAR;
    if constexpr (Epi::AFTER_DRAIN) { E.fused(acc, cur, wr, wc, fr, fq, lds, wid, lane); S.done(cur); }
#undef PG8_SA
#undef PG8_SB
#undef PG8_STAGE
#undef PG8_LDA
#undef PG8_LDB
#undef PG8_MMA
#undef PG8_WAIT_V
#undef PG8_WAIT_L
#undef PG8_BAR
#undef PG8_SCHED
}

template <class Epi0, class Epi1>
__device__ __forceinline__ void gemm_pair(PG8_LAS unsigned char* lds, const Gemm g0, const Gemm g1, const Unit cur, const Epi0& E0, const Epi1& E1) {
    static_assert(Epi0::PERM == Epi1::PERM && !Epi0::AFTER_DRAIN && Epi1::AFTER_DRAIN, "gemm_pair epilogues");
    int tid_ = threadIdx.x; asm volatile("" : "+v"(tid_));
    const int tid = tid_, wid = __builtin_amdgcn_readfirstlane(tid >> 6), lane = tid & 63, wr = wid >> 2, wc = wid & 3, fr = lane & 15, fq = lane >> 4;
    unsigned voffA[2], voffB[2];
#define PG8_VOFF(KK) do { _Pragma("unroll") for (int i = 0; i < 2; ++i) { int R, C; stage_rc(tid * 16 + i * 8192, R, C); const int Rb = Epi0::PERM ? ((R & ~31) + perm32(R & 31)) : R; \
        voffA[i] = (unsigned)(R * (KK) + C) * 2u; voffB[i] = (unsigned)(Rb * (KK) + C) * 2u; } } while (0)
    PG8_VOFF(g0.K);
    const size_t kstep = (size_t)(BK * 2);
    size_t hstep = (size_t)HALF * g0.K * 2; const size_t hstepn = (size_t)HALF * g1.K * 2;
    int nt = g0.K / BK;
    const unsigned ldsw = (unsigned)wid * 1024u;
    const int aoff = lds_byte(wr * 64 + fr, fq * 8), boff = lds_byte(wc * 32 + fr, fq * 8);
#define PG8_SA(b, h) (((b) * 2 + (h)) * HTB)
#define PG8_SB(b, h) ((4 + (b) * 2 + (h)) * HTB)
#define PG8_STAGE(bufoff, gbase, voff) do { _Pragma("unroll") for (int _i = 0; _i < 2; ++_i) \
        __builtin_amdgcn_global_load_lds((const unsigned*)((const char*)(gbase) + (voff)[_i]), (PG8_LAS unsigned*)(lds + (bufoff) + ldsw + _i * 8192), 16, 0, 0); } while (0)
#define PG8_LDA(dst, b, h) do { _Pragma("unroll") for (int m = 0; m < 4; ++m) _Pragma("unroll") for (int k = 0; k < 2; ++k) dst[m][k] = *(const PG8_LAS bf16x8*)(lds + PG8_SA(b, h) + aoff + m * 2048 + k * 1024); } while (0)
#define PG8_LDB(dst, b, h) do { _Pragma("unroll") for (int n = 0; n < 2; ++n) _Pragma("unroll") for (int k = 0; k < 2; ++k) dst[n][k] = *(const PG8_LAS bf16x8*)(lds + PG8_SB(b, h) + boff + n * 2048 + k * 1024); } while (0)
#define PG8_MMA(ai, bj, At, Bt) do { __builtin_amdgcn_s_setprio(1); _Pragma("unroll") for (int m = 0; m < 4; ++m) _Pragma("unroll") for (int n = 0; n < 2; ++n) _Pragma("unroll") for (int k = 0; k < 2; ++k) \
        acc[ai][bj][m][n] = __builtin_amdgcn_mfma_f32_16x16x32_bf16(Bt[n][k], At[m][k], acc[ai][bj][m][n], 0, 0, 0); __builtin_amdgcn_s_setprio(0); } while (0)
#define PG8_WAIT_V(n) asm volatile("s_waitcnt vmcnt(" #n ")" ::: "memory")
#define PG8_WAIT_L(n) asm volatile("s_waitcnt lgkmcnt(" #n ")" ::: "memory")
#define PG8_BAR __builtin_amdgcn_s_barrier()
#define PG8_SCHED __builtin_amdgcn_sched_barrier(0)
    f32x4 acc[2][2][4][2];
#pragma unroll
    for (int a = 0; a < 2; ++a)
#pragma unroll
        for (int b = 0; b < 2; ++b)
#pragma unroll
            for (int m = 0; m < 4; ++m)
#pragma unroll
                for (int n = 0; n < 2; ++n) acc[a][b][m][n] = (f32x4){0.f, 0.f, 0.f, 0.f};
    bf16x8 At[4][2], B0[2][2], B1[2][2];
    const char* cA = (const char*)g0.A + (size_t)cur.pm * 2 * hstep; const char* cB = (const char*)g0.Bt + (size_t)cur.pn * 2 * hstep;
    const char* const nA1 = (const char*)g1.A + (size_t)cur.pm * 2 * hstepn; const char* const nB1 = (const char*)g1.Bt + (size_t)cur.pn * 2 * hstepn;
    PG8_STAGE(PG8_SB(0, 0), cB, voffB); PG8_STAGE(PG8_SB(0, 1), cB + hstep, voffB); PG8_STAGE(PG8_SA(0, 0), cA, voffA); PG8_STAGE(PG8_SA(0, 1), cA + hstep, voffA);
    if (wr == 1) PG8_BAR;
    PG8_WAIT_V(2); PG8_BAR;
    PG8_STAGE(PG8_SB(1, 0), cB + kstep, voffB); PG8_STAGE(PG8_SA(1, 0), cA + kstep, voffA); PG8_STAGE(PG8_SB(1, 1), cB + hstep + kstep, voffB);
    PG8_WAIT_V(6); PG8_BAR;
    for (int ui = 0; ui < 2; ++ui) {
        const bool has_next = (ui == 0);
        for (int t = 0; t < nt; t += 2) {
            const bool last = (t == nt - 2), nx = last && has_next;
            const char* a1 = cA + (size_t)(t + 1) * kstep;
            const char* a2 = last ? (has_next ? nA1 : cA) : cA + (size_t)(t + 2) * kstep; const char* b2 = last ? (has_next ? nB1 : cB) : cB + (size_t)(t + 2) * kstep;
            const char* a3 = a2 + kstep; const char* b3 = b2 + kstep;
            PG8_LDB(B0, 0, 0); PG8_LDB(B1, 0, 1); PG8_SCHED; PG8_LDA(At, 0, 0); PG8_STAGE(PG8_SA(1, 1), a1 + hstep, voffA);
            if (nx) { PG8_VOFF(g1.K); hstep = hstepn; }
            PG8_WAIT_V(8); PG8_WAIT_L(0); PG8_BAR; PG8_MMA(0, 0, At, B0); PG8_MMA(0, 1, At, B1); PG8_BAR; PG8_SCHED;
            PG8_LDA(At, 0, 1); PG8_STAGE(PG8_SB(0, 0), b2, voffB); PG8_STAGE(PG8_SB(0, 1), b2 + hstep, voffB); PG8_STAGE(PG8_SA(0, 0), a2, voffA);
            PG8_WAIT_V(8); PG8_WAIT_L(0); PG8_BAR; PG8_MMA(1, 0, At, B0); PG8_MMA(1, 1, At, B1); PG8_BAR; PG8_SCHED;
            PG8_LDB(B0, 1, 0); PG8_LDB(B1, 1, 1); PG8_SCHED; PG8_LDA(At, 1, 0); PG8_STAGE(PG8_SA(0, 1), a2 + hstep, voffA);
            PG8_WAIT_V(8); PG8_WAIT_L(0); PG8_BAR; PG8_MMA(0, 0, At, B0); PG8_MMA(0, 1, At, B1); PG8_BAR; PG8_SCHED;
            PG8_LDA(At, 1, 1); PG8_STAGE(PG8_SB(1, 0), b3, voffB); PG8_STAGE(PG8_SB(1, 1), b3 + hstep, voffB); PG8_STAGE(PG8_SA(1, 0), a3, voffA);
            PG8_WAIT_V(8); PG8_WAIT_L(0); PG8_BAR; PG8_MMA(1, 0, At, B0); PG8_MMA(1, 1, At, B1); PG8_BAR; PG8_SCHED;
        }
        if (wr == 0) PG8_BAR;
        if (!has_next) break;
        { int t2 = threadIdx.x; asm volatile("" : "+v"(t2)); const int l2 = t2 & 63; E0(acc, cur, wr, wc, l2 & 15, l2 >> 4); }
#pragma unroll
        for (int a = 0; a < 2; ++a)
#pragma unroll
            for (int b = 0; b < 2; ++b)
#pragma unroll
                for (int m = 0; m < 4; ++m)
#pragma unroll
                    for (int n = 0; n < 2; ++n) acc[a][b][m][n] = (f32x4){0.f, 0.f, 0.f, 0.f};
        cA = nA1; cB = nB1; nt = g1.K / BK;
        if (wr == 1) PG8_BAR;
    }
    PG8_WAIT_V(0);
    PG8_BAR;
    { int t2 = threadIdx.x; asm volatile("" : "+v"(t2)); const int l2 = t2 & 63; E1.fused(acc, cur, wr, wc, l2 & 15, l2 >> 4, lds, wid, l2); }
#undef PG8_VOFF
#undef PG8_SA
#undef PG8_SB
#undef PG8_STAGE
#undef PG8_LDA
#undef PG8_LDB
#undef PG8_MMA
#undef PG8_WAIT_V
#undef PG8_WAIT_L
#undef PG8_BAR
#undef PG8_SCHED
}
}

#ifndef PG8_SP2
#define PG8_SP2 true
#endif
#ifndef PG8_ALIGN
#define PG8_ALIGN true
#endif

typedef float f32x2 __attribute__((ext_vector_type(2)));
constexpr int NWAVES = 8;
constexpr int D = 1024, SEQ = 2048, NB = 8, MP = NB * SEQ  , MSMP = 128  , MV = MP + MSMP  , MR = 16640  ;
constexpr int FF = 4096, DPLE = 256, NCH = SEQ / 64  ;
constexpr int PS = 3840;
constexpr int C_MQ = 0, C_MK = 512, C_MV = 1024, C_MO = 1536, C_GQ = 2048, C_GK = 2304, C_GV = 2560, C_GR = 3072, C_SM = 3584;
constexpr float EPS = 1e-6f;
constexpr size_t O_YP = 0, O_YS = 16777216, O_CP = 16908288, O_NP = 17432576, O_MP = 17436672, O_CVP = 17436704, O_SP = 17461280,
                 O_CS = 17723424, O_NS = 26112032, O_MS = 26177568, O_CVS = 26178080, O_SS = 26571296;
constexpr size_t MiB = 1u << 20;
constexpr size_t WS_CTL = 0, CTL_ZERO_BYTES = 1 * MiB;
constexpr size_t CTL_BAR_B = 16384, CTL_SS1_B = 262144, CTL_SS2_B = 393216, CTL_SS3_B = 524288;
constexpr size_t WS_WIN = 1 * MiB, WS_WOUT = 9 * MiB, WS_W1 = 11 * MiB, WS_W2 = 19 * MiB, WS_WPG = 27 * MiB, WS_WPLE = 29 * MiB;
constexpr size_t WS_PB = 30 * MiB, WS_NC = 39 * MiB, WS_MC = WS_NC + 512 * 1024, WS_R1 = 40 * MiB, WS_R2 = 73 * MiB, WS_CSM = 195 * MiB, WS_CSG = 227 * MiB;
constexpr size_t WS_X1B = WS_R2, WS_U = 106 * MiB, WS_PP = 106 * MiB, WS_END = 247 * MiB;
static_assert(WS_R2 + (size_t)MR * PS * 2 <= WS_CSM && WS_R1 + (size_t)MR * D * 2 <= WS_R2 && WS_U + (size_t)MR * FF * 2 <= WS_END && WS_X1B + (size_t)MR * D * 2 <= WS_U && WS_PB + (size_t)MR * DPLE * 2 <= WS_NC, "ws map");
constexpr size_t SC_QP = 0, SC_KW = (size_t)MP * 512, SC_QG = (size_t)MP * 1024, SC_KG = (size_t)MP * 1280;
static_assert((SC_KG + (size_t)MP * 256) * 2 <= (size_t)MP * D * 4, "P2 scratch inside y_prompt");
constexpr size_t WS_GA = 244 * MiB, WS_GB = WS_GA + 256 * 1024, WS_EBL = WS_GB + 256 * 1024, WS_PMX = WS_EBL + 256 * 1024, WS_BLS = WS_PMX + 4096;
constexpr int LDS_BYTES = 147456, MISC_OFF = LDS_BYTES - 256;

#define GAS __attribute__((address_space(1)))
#define LAS __attribute__((address_space(3)))
typedef unsigned short bf16;
typedef unsigned v4u __attribute__((ext_vector_type(4)));
typedef unsigned v2u __attribute__((ext_vector_type(2)));
typedef float f32x4 __attribute__((ext_vector_type(4)));
typedef short bf16x8 __attribute__((ext_vector_type(8)));
typedef GAS unsigned gu32;
#define RLX_AGENT __ATOMIC_RELAXED, __HIP_MEMORY_SCOPE_AGENT
#define LDS_WAIT() asm volatile("s_waitcnt lgkmcnt(0)" ::: "memory")
#define VM_WAIT() asm volatile("s_waitcnt vmcnt(0)" ::: "memory")
#define LBAR() do { asm volatile("s_waitcnt lgkmcnt(0)" ::: "memory"); __builtin_amdgcn_s_barrier(); asm volatile("" ::: "memory"); } while (0)
__device__ __forceinline__ unsigned f2bf(float f) { unsigned u = __builtin_bit_cast(unsigned, f); return (u + 0x7fffu + ((u >> 16) & 1u)) >> 16; }
__device__ __forceinline__ unsigned pk2(float lo, float hi) { unsigned r; asm volatile("v_cvt_pk_bf16_f32 %0, %1, %2" : "=v"(r) : "v"(lo), "v"(hi)); return r; }
__device__ __forceinline__ float bf2f(unsigned b) { return __builtin_bit_cast(float, b << 16); }
__device__ __forceinline__ float bflo(unsigned w) { return __builtin_bit_cast(float, w << 16); }
__device__ __forceinline__ float bfhi(unsigned w) { return __builtin_bit_cast(float, w & 0xffff0000u); }
__device__ __forceinline__ float logsig(float x) { return fminf(x, 0.f) - __logf(1.f + __expf(-fabsf(x))); }
__device__ __forceinline__ float sigmoidf(float x) { return __builtin_amdgcn_rcpf(1.f + __expf(-x)); }
__device__ __forceinline__ float rsqrt_fast(float x) { return __builtin_amdgcn_rsqf(x); }

#define XB_TMO      128
#define XB_XCNT(j)  (256  + 64 * (j))
#define XB_XSUB(j)  (1280 + 64 * (j))
#define XB_XGEN(j)  (2304 + 64 * (j))
#define XB_TOP      3328
#define XB_TOPGEN   3392
#define XCD_BAR_WORDS 3456
#define XB_SPIN_CAP (1u << 22)
__device__ __forceinline__ unsigned xb_ld(unsigned* p)              { return __hip_atomic_load(p, __ATOMIC_RELAXED, __HIP_MEMORY_SCOPE_AGENT); }
__device__ __forceinline__ unsigned xb_add(unsigned* p, unsigned v) { return __hip_atomic_fetch_add(p, v, __ATOMIC_RELAXED, __HIP_MEMORY_SCOPE_AGENT); }
__device__ __forceinline__ unsigned xb_xcc_id() { return (unsigned)__builtin_amdgcn_s_getreg((3 << 11) | 20) & 0xFu; }
#define XB_SPIN(cond, bar) do { unsigned _sp = 0; while (cond) { __builtin_amdgcn_s_sleep(1); \
    if ((++_sp & 255u) == 0u) { if (xb_ld(&(bar)[XB_TMO])) break; if (_sp > XB_SPIN_CAP) { atomicAdd(&(bar)[XB_TMO], 1u); break; } } } } while (0)
struct XcdBarrier { unsigned* bar; unsigned x; volatile LAS unsigned* st; };
__device__ __forceinline__ XcdBarrier xcd_barrier_post(unsigned* bar, volatile LAS unsigned* st) {
    XcdBarrier b; b.bar = bar; b.x = xb_xcc_id(); b.st = st;
    if (threadIdx.x == 0) (void)xb_add(&bar[XB_XCNT(b.x)], 1u);
    return b;
}
__device__ __forceinline__ void xcd_barrier_complete(unsigned* bar, unsigned x, unsigned& nloc, unsigned& nx) {
    const unsigned G = gridDim.x * gridDim.y * gridDim.z;
    unsigned sum, cnt, mine, sp = 0u;
    for (;;) {
        sum = 0u; cnt = 0u; mine = 0u;
#pragma unroll
        for (unsigned j = 0; j < 16; ++j) { const unsigned c = xb_ld(&bar[XB_XCNT(j)]); sum += c; cnt += (c > 0u) ? 1u : 0u; mine = (j == x) ? c : mine; }
        if (sum == G) break;
        __builtin_amdgcn_s_sleep(1);
        if ((++sp & 255u) == 0u) { if (xb_ld(&bar[XB_TMO])) break; if (sp > XB_SPIN_CAP) { atomicAdd(&bar[XB_TMO], 1u); break; } }
    }
    nloc = mine > 0u ? mine : 1u; nx = cnt > 0u ? cnt : 1u;
}
__device__ __forceinline__ void xcd_barrier(const XcdBarrier& b) {
    asm volatile("s_waitcnt vmcnt(0)" ::: "memory");
    __syncthreads();
    if (threadIdx.x == 0) {
        unsigned* bar = b.bar;
        __builtin_amdgcn_s_waitcnt(0);
        unsigned nloc = b.st[0], nx = b.st[1];
        if (nloc == 0u) { xcd_barrier_complete(bar, b.x, nloc, nx); b.st[0] = nloc; b.st[1] = nx; }
        const unsigned old = xb_add(&bar[XB_XSUB(b.x)], 1u);
        const unsigned gen = old / nloc;
        if (old + 1u == (gen + 1u) * nloc) {
            __builtin_amdgcn_fence(__ATOMIC_RELEASE, "agent");
            asm volatile("s_waitcnt vmcnt(0)" ::: "memory");
            const unsigned og = xb_add(&bar[XB_TOP], 1u);
            const unsigned tg = og / nx;
            if (og + 1u == (tg + 1u) * nx) xb_add(&bar[XB_TOPGEN], 1u);
            else XB_SPIN(xb_ld(&bar[XB_TOPGEN]) == tg, bar);
            xb_add(&bar[XB_XGEN(b.x)], 1u);
            __builtin_amdgcn_fence(__ATOMIC_ACQUIRE, "agent");
            asm volatile("s_waitcnt vmcnt(0)" ::: "memory");
        } else {
            XB_SPIN(xb_ld(&bar[XB_XGEN(b.x)]) == gen, bar);
            __builtin_amdgcn_fence(__ATOMIC_ACQUIRE, "agent");
            asm volatile("s_waitcnt vmcnt(0)" ::: "memory");
        }
    }
    __syncthreads();
}

__device__ __forceinline__ void xcd_barrier_arrive(const XcdBarrier& b) {
    asm volatile("s_waitcnt vmcnt(0)" ::: "memory");
    __syncthreads();
    if (threadIdx.x == 0) {
        unsigned* bar = b.bar;
        __builtin_amdgcn_s_waitcnt(0);
        unsigned nloc = b.st[0], nx = b.st[1];
        if (nloc == 0u) { xcd_barrier_complete(bar, b.x, nloc, nx); b.st[0] = nloc; b.st[1] = nx; }
        const unsigned old = xb_add(&bar[XB_XSUB(b.x)], 1u);
        const unsigned gen = old / nloc;
        if (old + 1u == (gen + 1u) * nloc) {
            __builtin_amdgcn_fence(__ATOMIC_RELEASE, "agent");
            asm volatile("s_waitcnt vmcnt(0)" ::: "memory");
            const unsigned og = xb_add(&bar[XB_TOP], 1u);
            const unsigned tg = og / nx;
            if (og + 1u == (tg + 1u) * nx) xb_add(&bar[XB_TOPGEN], 1u);
            else XB_SPIN(xb_ld(&bar[XB_TOPGEN]) == tg, bar);
            xb_add(&bar[XB_XGEN(b.x)], 1u);
            __builtin_amdgcn_fence(__ATOMIC_ACQUIRE, "agent");
            asm volatile("s_waitcnt vmcnt(0)" ::: "memory");
            b.st[2] = 0xffffffffu;
        } else b.st[2] = gen;
    }
}
__device__ __forceinline__ void xcd_barrier_makeup(const XcdBarrier& b) {
    if (threadIdx.x == 0) {
        unsigned* bar = b.bar;
        const unsigned gen = b.st[2];
        if (gen != 0xffffffffu) {
            XB_SPIN(xb_ld(&bar[XB_XGEN(b.x)]) == gen, bar);
            __builtin_amdgcn_fence(__ATOMIC_ACQUIRE, "agent");
            asm volatile("s_waitcnt vmcnt(0)" ::: "memory");
        }
    }
    __syncthreads();
}

struct Args { const float* in[26]; float* out; unsigned char* ws; int ph_lo, ph_hi, li, pad; };
typedef const Args __attribute__((address_space(4))) CArgs;
struct Frame {
    LAS unsigned char* lds;
    char* ldsg;
    int G;
    CArgs* a;
};
#define F_TID ((int)threadIdx.x)
#define F_LANE ((int)(threadIdx.x & 63))
#define F_WAVE (__builtin_amdgcn_readfirstlane((int)(threadIdx.x >> 6)))
#define IN_F(k) (F.a->in[k])
#define X_P IN_F(0)
#define X_S IN_F(1)
#define P_P IN_F(2)
#define P_S IN_F(3)
#define ST_C IN_F(4)
#define ST_N IN_F(5)
#define ST_M IN_F(6)
#define ST_CONV IN_F(7)
#define ST_S IN_F(8)
#define W_IN IN_F(9)
#define CONV_W IN_F(10)
#define CONV_B IN_F(11)
#define B_GATE CONSTF(IN_F(12))
#define W_A2 CONSTF(IN_F(13))
#define B_A CONSTF(IN_F(14))
#define G_MHEAD IN_F(15)
#define G_GHEAD IN_F(16)
#define W_OUT IN_F(17)
#define G_MIX IN_F(18)
#define G_MLP IN_F(19)
#define W1 IN_F(20)
#define W2 IN_F(21)
#define G_PLE IN_F(22)
#define W_PLE IN_F(23)
#define W_PG IN_F(24)
#define G_FINAL IN_F(25)
typedef const float __attribute__((address_space(4))) cfloat;
#define CONSTF(p) ((cfloat*)(unsigned long long)(p))
#define OUTP (F.a->out)
#define WSB (F.a->ws)
#define WIN_T ((bf16*)(WSB + WS_WIN))
#define WOUT_T ((bf16*)(WSB + WS_WOUT))
#define W1_T ((bf16*)(WSB + WS_W1))
#define W2_T ((bf16*)(WSB + WS_W2))
#define WPG_T ((bf16*)(WSB + WS_WPG))
#define WPLE_T ((bf16*)(WSB + WS_WPLE))
#define PBUF ((bf16*)(WSB + WS_PB))
#define R1B ((bf16*)(WSB + WS_R1))
#define PROJ ((bf16*)(WSB + WS_R2))
#define X1B ((bf16*)(WSB + WS_X1B))
#define UBUF ((bf16*)(WSB + WS_U))
#define CSM ((bf16*)(WSB + WS_CSM))
#define CSG ((bf16*)(WSB + WS_CSG))
#define NCS ((float*)(WSB + WS_NC))
#define MCS ((float*)(WSB + WS_MC))
#define SS1 ((float*)(WSB + CTL_SS1_B))
#define SS2 ((float*)(WSB + CTL_SS2_B))
#define SS3 ((float*)(WSB + CTL_SS3_B))
#define PPB ((bf16*)(WSB + WS_PP))
#define GA_A ((float*)(WSB + WS_GA))
#define GA_B ((float*)(WSB + WS_GB))
#define EBLG ((float*)(WSB + WS_EBL))
#define PMXG ((float*)(WSB + WS_PMX))
#define BLSG ((float*)(WSB + WS_BLS))
#define SCR ((bf16*)OUTP)

__device__ __forceinline__ float wave_sum(float v) {
#pragma unroll
    for (int o = 1; o < 64; o <<= 1) v += __shfl_xor(v, o);
    return v;
}
__device__ __forceinline__ float wave_max(float v) {
#pragma unroll
    for (int o = 1; o < 64; o <<= 1) v = fmaxf(v, __shfl_xor(v, o));
    return v;
}
template <int CTRL, int ROWMASK> __device__ __forceinline__ float dpp_f(float idv, float v) {
    return __builtin_bit_cast(float, __builtin_amdgcn_update_dpp(__builtin_bit_cast(int, idv), __builtin_bit_cast(int, v), CTRL, ROWMASK, 0xf, false));
}
__device__ __forceinline__ float wave_scan_sum(float v, int) {
    v += dpp_f<0x111, 0xf>(0.f, v); v += dpp_f<0x112, 0xf>(0.f, v); v += dpp_f<0x114, 0xf>(0.f, v); v += dpp_f<0x118, 0xf>(0.f, v);
    v += dpp_f<0x142, 0xa>(0.f, v); v += dpp_f<0x143, 0xc>(0.f, v);
    return v;
}
__device__ __forceinline__ float wave_scan_max(float v, int) {
    const float ninf = -__builtin_inff();
    v = fmaxf(v, dpp_f<0x111, 0xf>(ninf, v)); v = fmaxf(v, dpp_f<0x112, 0xf>(ninf, v)); v = fmaxf(v, dpp_f<0x114, 0xf>(ninf, v)); v = fmaxf(v, dpp_f<0x118, 0xf>(ninf, v));
    v = fmaxf(v, dpp_f<0x142, 0xa>(ninf, v)); v = fmaxf(v, dpp_f<0x143, 0xc>(ninf, v));
    return v;
}

__device__ __forceinline__ int win_src_col(int np) {
    if (np < 2048) return np;
    if (np < 3584) return np + 8;
    const int j = np - 3584;
    if (j < 8) return 2048 + j;
    if (j < 24) return 3592 + (j - 8);
    return -1;
}
template <int MODE>
__device__ __forceinline__ void p0_transpose_item(const float* W, int K, int N, bf16* WT, const float* gain, LAS float* scr, int item, int nblk, int lane) {
    const int kb = item / nblk, nb = item % nblk, k0 = 64 * kb, n0 = 32 * nb;
    if (MODE == 1 && n0 >= 3584) {
        const int src = win_src_col(n0 + (lane & 31));
#pragma unroll 8
        for (int i = 0; i < 32; ++i) { const int kk = 2 * i + (lane >> 5); float v = 0.f; if (src >= 0) v = W[(size_t)(k0 + kk) * N + src] * gain[k0 + kk]; scr[kk * 33 + (lane & 31)] = v; }
    } else {
        const int s0 = (MODE == 1 && n0 >= 2048) ? n0 + 8 : n0; const float cs = (MODE == 1 && n0 >= C_GQ && n0 < C_GK) ? 0.125f : 1.f;
        const int n4 = lane & 7, kq = lane >> 3;
        f32x4 v[8];
#pragma unroll
        for (int i = 0; i < 8; ++i) v[i] = *(const f32x4*)(W + (size_t)(k0 + kq + 8 * i) * N + s0 + 4 * n4);
#pragma unroll
        for (int i = 0; i < 8; ++i) { const int kk = kq + 8 * i; const float gsc = gain ? gain[k0 + kk] * cs : cs; LAS float* d = scr + kk * 33 + 4 * n4;
            d[0] = v[i][0] * gsc; d[1] = v[i][1] * gsc; d[2] = v[i][2] * gsc; d[3] = v[i][3] * gsc; }
    }
    LDS_WAIT(); asm volatile("" ::: "memory");
    const int c = lane & 7;
#pragma unroll
    for (int j = 0; j < 4; ++j) { const int n = (lane >> 3) + 8 * j; const LAS float* s = scr + (8 * c) * 33 + n;
        v4u o; o.x = pk2(s[0 * 33], s[1 * 33]); o.y = pk2(s[2 * 33], s[3 * 33]); o.z = pk2(s[4 * 33], s[5 * 33]); o.w = pk2(s[6 * 33], s[7 * 33]);
        *(GAS v4u*)(WT + (size_t)(n0 + n) * K + k0 + 8 * c) = o; }
    LDS_WAIT(); asm volatile("" ::: "memory");
}
__device__ __forceinline__ void p0_prologue(Frame& F) {
    LAS float* scr = (LAS float*)(F.lds + F_WAVE * 16384);
    const int gw = blockIdx.x * NWAVES + F_WAVE, NGW = F.G * NWAVES, lane = F_LANE;
    for (int m0 = gw; m0 < MV; m0 += 8 * NGW) {
        f32x4 v[8][4]; f32x4 pv[8];
#pragma unroll
        for (int q = 0; q < 8; ++q) { const int m = m0 + q * NGW; if (m < MV) {
            const float* xrow = m < MP ? X_P + (size_t)m * D : X_S + (size_t)(m - MP) * D; const float* prow = m < MP ? P_P + (size_t)m * DPLE : P_S + (size_t)(m - MP) * DPLE;
#pragma unroll
            for (int j = 0; j < 4; ++j) v[q][j] = __builtin_nontemporal_load((const GAS f32x4*)xrow + lane + 64 * j);
            pv[q] = __builtin_nontemporal_load((const GAS f32x4*)prow + lane); } }
#pragma unroll
        for (int q = 0; q < 8; ++q) { const int m = m0 + q * NGW; if (m < MV) {
            float s = 0.f;
#pragma unroll
            for (int j = 0; j < 4; ++j) s += (v[q][j].x * v[q][j].x + v[q][j].y * v[q][j].y) + (v[q][j].z * v[q][j].z + v[q][j].w * v[q][j].w);
            const float r = rsqrt_fast(wave_sum(s) * (1.f / D) + EPS);
            GAS unsigned long long* o8 = (GAS unsigned long long*)(R1B + (size_t)m * D) + lane;
#pragma unroll
            for (int j = 0; j < 4; ++j) o8[64 * j] = (unsigned long long)pk2(v[q][j].x * r, v[q][j].y * r) | ((unsigned long long)pk2(v[q][j].z * r, v[q][j].w * r) << 32);
            ((GAS unsigned long long*)(PBUF + (size_t)m * DPLE))[lane] = (unsigned long long)pk2(pv[q].x, pv[q].y) | ((unsigned long long)pk2(pv[q].z, pv[q].w) << 32); } }
    }
    constexpr int NB_IN = PS / 32, I_IN = (D / 64) * NB_IN;
    for (int it = gw; it < I_IN; it += NGW) p0_transpose_item<1>(W_IN, D, 3608, WIN_T, G_MIX, scr, it, NB_IN, lane);
}
__device__ __forceinline__ void late_weight_copies(Frame& F, int wg, int nwg) {
    LAS float* scr = (LAS float*)(F.lds + F_WAVE * 16384);
    const int gw = wg * NWAVES + F_WAVE, NGW = nwg * NWAVES, lane = F_LANE;
    constexpr int NB_D = D / 32, NB_FF = FF / 32;
    constexpr int I_OUT = (D / 64) * NB_D, I_1 = (D / 64) * NB_FF, I_2 = (FF / 64) * NB_D, I_PG = I_OUT, I_PLE = (DPLE / 64) * NB_D;
    constexpr int NITEMS = I_OUT + I_1 + I_2 + I_PG + I_PLE;
    static_assert(NITEMS == 41 * 128, "item deal");
    const bool asym = (nwg == 128);
    const int w_ = F_WAVE, nsl = asym ? (w_ < 4 ? 4 : (w_ == 4 ? 7 : 6)) : (NITEMS - gw + NGW - 1) / NGW;
    for (int k = 0; k < nsl; ++k) {
        const int it = asym ? ((w_ < 4 ? w_ + 4 * k : (k < 6 ? 16 + (w_ - 4) + 4 * k : 40)) * nwg + wg) : gw + k * NGW;
        int r = it;
        if (r < I_OUT) { p0_transpose_item<0>(W_OUT, D, D, WOUT_T, nullptr, scr, r, NB_D, lane); continue; } r -= I_OUT;
        if (r < I_1) { p0_transpose_item<0>(W1, D, FF, W1_T, G_MLP, scr, r, NB_FF, lane); continue; } r -= I_1;
        if (r < I_2) { p0_transpose_item<0>(W2, FF, D, W2_T, nullptr, scr, r, NB_D, lane); continue; } r -= I_2;
        if (r < I_PG) { p0_transpose_item<0>(W_PG, D, D, WPG_T, G_PLE, scr, r, NB_D, lane); continue; } r -= I_PG;
        p0_transpose_item<0>(W_PLE, DPLE, D, WPLE_T, nullptr, scr, r, NB_D, lane);
    }
}

struct EpiProj {
    static constexpr bool PERM = true, AFTER_DRAIN = false;
    bf16* O; int ldc;
    __device__ __forceinline__ void operator()(const f32x4 (&acc)[2][2][4][2], const pg8::Unit& u, int wr, int wc, int fr, int fq) const {
        const int row0 = u.pm * 256 + wr * 64 + fr, col0 = u.pn * 256 + wc * 32 + 8 * fq;
#pragma unroll
        for (int ai = 0; ai < 2; ++ai)
#pragma unroll
            for (int m = 0; m < 4; ++m) { bf16* rowp = O + (size_t)(row0 + ai * 128 + m * 16) * ldc + col0;
#pragma unroll
                for (int bj = 0; bj < 2; ++bj) { const f32x4 v0 = acc[ai][bj][m][0], v1 = acc[ai][bj][m][1];
                    v4u w; w.x = pg8::cvt_pk_bf16(v0[0], v0[1]); w.y = pg8::cvt_pk_bf16(v0[2], v0[3]); w.z = pg8::cvt_pk_bf16(v1[0], v1[1]); w.w = pg8::cvt_pk_bf16(v1[2], v1[3]);
                    *(v4u*)(rowp + bj * 128) = w; } }
    }
};
template <bool RES_BF16> struct EpiRes {
    static constexpr bool PERM = true, AFTER_DRAIN = false;
    const void* res; bf16* ob; float* ss; const float* rsq;
    __device__ __forceinline__ void operator()(const f32x4 (&acc)[2][2][4][2], const pg8::Unit& u, int wr, int wc, int fr, int fq) const {
        const int row0 = u.pm * 256 + wr * 64 + fr, col0 = u.pn * 256 + wc * 32 + 8 * fq;
#pragma unroll
        for (int ai = 0; ai < 2; ++ai)
#pragma unroll
            for (int m = 0; m < 4; ++m) { const int row = row0 + ai * 128 + m * 16;
                const size_t off = (size_t)row * D + col0;
                float s = 0.f, q = 1.f;
                if constexpr (RES_BF16) q = __builtin_amdgcn_rcpf(rsq[row] * (1.f / D) + EPS);
#pragma unroll
                for (int bj = 0; bj < 2; ++bj) {
                    f32x4 r0, r1;
                    if constexpr (RES_BF16) { const v4u rw = *(const v4u*)((const bf16*)res + off + bj * 128);
                        r0 = (f32x4){bflo(rw.x), bfhi(rw.x), bflo(rw.y), bfhi(rw.y)}; r1 = (f32x4){bflo(rw.z), bfhi(rw.z), bflo(rw.w), bfhi(rw.w)}; }
                    else { r0 = *(const f32x4*)((const float*)res + off + bj * 128); r1 = *(const f32x4*)((const float*)res + off + bj * 128 + 4); }
                    const f32x4 v0 = RES_BF16 ? acc[ai][bj][m][0] * q + r0 : acc[ai][bj][m][0] + r0, v1 = RES_BF16 ? acc[ai][bj][m][1] * q + r1 : acc[ai][bj][m][1] + r1;
                    v4u w; w.x = pg8::cvt_pk_bf16(v0[0], v0[1]); w.y = pg8::cvt_pk_bf16(v0[2], v0[3]); w.z = pg8::cvt_pk_bf16(v1[0], v1[1]); w.w = pg8::cvt_pk_bf16(v1[2], v1[3]);
                    *(v4u*)(ob + off + bj * 128) = w;
                    s += (v0[0] * v0[0] + v0[1] * v0[1]) + (v0[2] * v0[2] + v0[3] * v0[3]) + (v1[0] * v1[0] + v1[1] * v1[1]) + (v1[2] * v1[2] + v1[3] * v1[3]);
                }
                s += __shfl_xor(s, 16); s += __shfl_xor(s, 32);
                if (fq == 0) atomicAdd(ss + row, s);
                asm volatile("" ::: "memory"); }
    }
};
struct EpiU {
    static constexpr bool PERM = true, AFTER_DRAIN = false;
    bf16* O;
    __device__ __forceinline__ void operator()(const f32x4 (&acc)[2][2][4][2], const pg8::Unit& u, int wr, int wc, int fr, int fq) const {
        const int row0 = u.pm * 256 + wr * 64 + fr, col0 = u.pn * 256 + wc * 32 + 8 * fq;
#pragma unroll
        for (int ai = 0; ai < 2; ++ai)
#pragma unroll
            for (int m = 0; m < 4; ++m) { const int row = row0 + ai * 128 + m * 16;
                bf16* rowp = O + (size_t)row * FF + col0;
#pragma unroll
                for (int bj = 0; bj < 2; ++bj) { f32x4 v0 = acc[ai][bj][m][0], v1 = acc[ai][bj][m][1];
#pragma unroll
                    for (int j = 0; j < 4; ++j) { v0[j] = fmaxf(v0[j], 0.f); v1[j] = fmaxf(v1[j], 0.f); }
                    v0 = v0 * v0; v1 = v1 * v1;
                    v4u w; w.x = pg8::cvt_pk_bf16(v0[0], v0[1]); w.y = pg8::cvt_pk_bf16(v0[2], v0[3]); w.z = pg8::cvt_pk_bf16(v1[0], v1[1]); w.w = pg8::cvt_pk_bf16(v1[2], v1[3]);
                    *(v4u*)(rowp + bj * 128) = w; } }
    }
};
struct EpiPle {
    static constexpr bool PERM = true, AFTER_DRAIN = false;
    const bf16* x2b; const bf16* Pp; bf16* x3b; const float* ss2; float* ss3;
    __device__ __forceinline__ void operator()(const f32x4 (&acc)[2][2][4][2], const pg8::Unit& u, int wr, int wc, int fr, int fq) const {
        const int row0 = u.pm * 256 + wr * 64 + fr, col0 = u.pn * 256 + wc * 32 + 8 * fq;
#pragma unroll
        for (int ai = 0; ai < 2; ++ai)
#pragma unroll
            for (int m = 0; m < 4; ++m) { const int row = row0 + ai * 128 + m * 16;
                const float r = rsqrt_fast(ss2[row] * (1.f / D) + EPS);
                float s = 0.f;
#pragma unroll
                for (int bj = 0; bj < 2; ++bj) {
                    const size_t off = (size_t)row * D + col0 + bj * 128;
                    const v4u pw = *(const v4u*)(Pp + off), xw = *(const v4u*)(x2b + off);
                    unsigned o[4];
#pragma unroll
                    for (int n = 0; n < 2; ++n) {
                        const float p0[4] = {bflo(pw[2 * n]), bfhi(pw[2 * n]), bflo(pw[2 * n + 1]), bfhi(pw[2 * n + 1])};
                        const float x0[4] = {bflo(xw[2 * n]), bfhi(xw[2 * n]), bflo(xw[2 * n + 1]), bfhi(xw[2 * n + 1])};
                        float v0[4];
#pragma unroll
                        for (int j = 0; j < 4; ++j) v0[j] = x0[j] + p0[j] * sigmoidf(acc[ai][bj][m][n][j] * r);
                        o[2 * n] = pg8::cvt_pk_bf16(v0[0], v0[1]); o[2 * n + 1] = pg8::cvt_pk_bf16(v0[2], v0[3]);
                        s += (v0[0] * v0[0] + v0[1] * v0[1]) + (v0[2] * v0[2] + v0[3] * v0[3]);
                    }
                    *(v4u*)(x3b + off) = (v4u){o[0], o[1], o[2], o[3]};
                    asm volatile("" ::: "memory");
                }
                s += __shfl_xor(s, 16); s += __shfl_xor(s, 32);
                if (fq == 0) atomicAdd(ss3 + row, s);
                asm volatile("" ::: "memory"); }
    }
};

constexpr size_t CTL_PCNT_B = 655360, WS_XBUF = 246 * MiB;
struct EpiPleFinal {
    static constexpr bool PERM = true, AFTER_DRAIN = true;
    const bf16* x2b; const bf16* Pp; float* y; const float* ss2; const float* gfin; float* xbuf; unsigned* cnt;
    __device__ __forceinline__ void fused(f32x4 (&acc)[2][2][4][2], const pg8::Unit& u, int wr, int wc, int fr, int fq, LAS unsigned char* lds, int wid, int lane) const {
        LAS float* Pt = (LAS float*)lds;
        LAS float* St = (LAS float*)(lds + 4096);
        const int lrow0 = wr * 64 + fr, col0 = u.pn * 256 + wc * 32 + 8 * fq;
#pragma unroll
        for (int ai = 0; ai < 2; ++ai)
#pragma unroll
            for (int m = 0; m < 4; ++m) { const int lrow = lrow0 + ai * 128 + m * 16, row = u.pm * 256 + lrow;
                const float r = rsqrt_fast(ss2[row] * (1.f / D) + EPS);
                float s = 0.f;
#pragma unroll
                for (int bj = 0; bj < 2; ++bj) {
                    const size_t off = (size_t)row * D + col0 + bj * 128;
                    const v4u pw = *(const v4u*)(Pp + off), xw = *(const v4u*)(x2b + off);
#pragma unroll
                    for (int n = 0; n < 2; ++n) {
                        const float p0[4] = {bflo(pw[2 * n]), bfhi(pw[2 * n]), bflo(pw[2 * n + 1]), bfhi(pw[2 * n + 1])};
                        const float x0[4] = {bflo(xw[2 * n]), bfhi(xw[2 * n]), bflo(xw[2 * n + 1]), bfhi(xw[2 * n + 1])};
#pragma unroll
                        for (int j = 0; j < 4; ++j) { const float v = x0[j] + p0[j] * sigmoidf(acc[ai][bj][m][n][j] * r); acc[ai][bj][m][n][j] = v; s += v * v; }
                    }
                    asm volatile("" ::: "memory");
                }
                s += __shfl_xor(s, 16); s += __shfl_xor(s, 32);
                if (fq == 0) Pt[lrow * 4 + wc] = s; }
        asm volatile("s_waitcnt lgkmcnt(0)" ::: "memory"); __builtin_amdgcn_s_barrier(); asm volatile("" ::: "memory");
        const int prow = wid * 32 + (lane & 31);
        if (lane < 32) { const f32x4 p4 = *(const LAS f32x4*)(Pt + prow * 4);
            __hip_atomic_store(xbuf + ((size_t)u.pm * 256 + prow) * 4 + u.pn, (p4[0] + p4[1]) + (p4[2] + p4[3]), __ATOMIC_RELAXED, __HIP_MEMORY_SCOPE_AGENT); }
        asm volatile("s_waitcnt vmcnt(0)" ::: "memory");
        if (lane == 0) __hip_atomic_fetch_add(cnt + 64 * u.pm, 1u, __ATOMIC_RELAXED, __HIP_MEMORY_SCOPE_AGENT);
        if (wid == 0) {
            unsigned sp = 0;
            while ((unsigned)__builtin_amdgcn_readfirstlane(__hip_atomic_load(cnt + 64 * u.pm, __ATOMIC_RELAXED, __HIP_MEMORY_SCOPE_AGENT)) < 32u) { __builtin_amdgcn_s_sleep(2); if (++sp > (1u << 22)) break; }
            __builtin_amdgcn_fence(__ATOMIC_ACQUIRE, "agent");
        }
        asm volatile("s_waitcnt vmcnt(0) lgkmcnt(0)" ::: "memory"); __builtin_amdgcn_s_barrier(); asm volatile("" ::: "memory");
        if (lane < 32) { const float* sl = xbuf + ((size_t)u.pm * 256 + prow) * 4; float t = 0.f;
#pragma unroll
            for (int q = 0; q < 4; ++q) t += __hip_atomic_load(sl + q, __ATOMIC_RELAXED, __HIP_MEMORY_SCOPE_AGENT);
            St[prow] = rsqrt_fast(t * (1.f / D) + EPS); }
        asm volatile("s_waitcnt lgkmcnt(0)" ::: "memory"); __builtin_amdgcn_s_barrier(); asm volatile("" ::: "memory");
        f32x4 gf[2][2];
#pragma unroll
        for (int bj = 0; bj < 2; ++bj)
#pragma unroll
            for (int n = 0; n < 2; ++n) gf[bj][n] = *(const f32x4*)(gfin + col0 + bj * 128 + 4 * n);
#pragma unroll
        for (int ai = 0; ai < 2; ++ai)
#pragma unroll
            for (int m = 0; m < 4; ++m) { const int lrow = lrow0 + ai * 128 + m * 16; const float rs = St[lrow];
                float* yp = y + (size_t)(u.pm * 256 + lrow) * D + col0;
#pragma unroll
                for (int bj = 0; bj < 2; ++bj)
#pragma unroll
                    for (int n = 0; n < 2; ++n) *(f32x4*)(yp + bj * 128 + 4 * n) = acc[ai][bj][m][n] * rs * gf[bj][n]; }
        asm volatile("s_waitcnt lgkmcnt(0)" ::: "memory"); __builtin_amdgcn_s_barrier(); asm volatile("" ::: "memory");
    }
};

__device__ __forceinline__ f32x4 mfma16(bf16x8 a, bf16x8 b, f32x4 c) { return __builtin_amdgcn_mfma_f32_16x16x32_bf16(a, b, c, 0, 0, 0); }
__device__ __forceinline__ bf16x8 lds_frag(const char* p) { return *(const bf16x8*)p; }
constexpr int TS = 144;
constexpr int QS_P = 272;
constexpr float KSCALE = 0.08838834764831845f;

__device__ __forceinline__ void p2p_item(Frame& F, int b, int c) {
    float* WKL = (float*)F.ldsg;
    const int tid = F_TID, lane = F_LANE, w = F_WAVE;
    const size_t row0 = (size_t)b * SEQ + c * 64;
    const bf16* P = PROJ;
    if (w < 4) { const int h = w, bh = b * 4 + h; const size_t row = row0 + lane;
        const float ig = bf2f(P[row * PS + C_SM + h]) + B_GATE[h], lf = logsig(bf2f(P[row * PS + C_SM + 4 + h]) + B_GATE[4 + h]);
        const float bc = wave_scan_sum(lf, lane), a = ig - bc; const float pmax = wave_max(a);
        GA_A[(size_t)bh * SEQ + c * 64 + lane] = a; GA_B[(size_t)bh * SEQ + c * 64 + lane] = bc;
        if (lane == 63) { PMXG[bh * NCH + c] = pmax; BLSG[bh * NCH + c] = bc; }
        WKL[h * 64 + lane] = __expf(a - pmax) * KSCALE; }
    {
      constexpr int GP = 528;
      char* QL = F.ldsg + 1024; char* KL = QL + 64 * GP;
#pragma unroll
      for (int i = 0; i < 4; ++i) { const int pc = tid + 512 * i, r_ = pc >> 5, c16 = pc & 31;
          *(v4u*)(QL + r_ * GP + 16 * c16) = *(const v4u*)(P + (row0 + r_) * PS + C_GQ + 8 * c16); *(v4u*)(KL + r_ * GP + 16 * c16) = *(const v4u*)(P + (row0 + r_) * PS + C_GK + 8 * c16); }
      const int hg = w >> 1, d0 = 32 * (w & 1), bh = b * 4 + hg, colb = hg * 64 + d0; const size_t row = row0 + lane;
      const v4u ga0 = *(const v4u*)(P + row * PS + C_SM + 8), ga1 = *(const v4u*)(P + row * PS + C_SM + 16);
      float ga[16];
#pragma unroll
      for (int i = 0; i < 4; ++i) { ga[2 * i] = bflo(ga0[i]); ga[2 * i + 1] = bfhi(ga0[i]); ga[8 + 2 * i] = bflo(ga1[i]); ga[8 + 2 * i + 1] = bfhi(ga1[i]); }
      cfloat* ba = B_A + colb; float* ebl = EBLG + (size_t)(bh * NCH + c) * 64 + d0;
      unsigned* myq = (unsigned*)(QL + lane * GP + 2 * colb); unsigned* myk = (unsigned*)(KL + lane * GP + 2 * colb);
      float* WAL = (float*)(F.ldsg + 69632);
#pragma unroll
      for (int i = 0; i < 2; ++i) { const int q = (tid >> 6) + 8 * i, col4 = (tid & 63) * 4; const f32x4 wv_ = *(const f32x4*)(IN_F(13) + q * 256 + col4);
          float* d_ = WAL + (((col4 >> 5) * 16 + ((col4 & 31) >> 1)) * 16 + q) * 2;
          *(f32x2*)d_ = (f32x2){wv_[0], wv_[1]}; *(f32x2*)(d_ + 32) = (f32x2){wv_[2], wv_[3]}; }
      LBAR();
      const float* wl = WAL + w * 512;
      f32x4 wA[8], wB[8];
#pragma unroll
      for (int i = 0; i < 8; ++i) wA[i] = *(const f32x4*)(wl + 4 * i);
#define P2P_GLA_PAIR(j, wv) do { f32x2 z = (f32x2){ba[2 * (j)], ba[2 * (j) + 1]}; \
          _Pragma("unroll") for (int q = 0; q < 16; ++q) z = (f32x2){ga[q], ga[q]} * (f32x2){wv[q >> 1][2 * (q & 1)], wv[q >> 1][2 * (q & 1) + 1]} + z; \
          const float b0 = wave_scan_sum(logsig(z.x) * (1.f / 16.f), lane), b1 = wave_scan_sum(logsig(z.y) * (1.f / 16.f), lane); \
          const f32x2 e = (f32x2){__expf(b0), __expf(b1)}, ei = (f32x2){__expf(-b0), __expf(-b1)}; \
          if (lane == 63) { ebl[2 * (j)] = e.x; ebl[2 * (j) + 1] = e.y; } \
          const unsigned qw = myq[(j)], kw = myk[(j)]; \
          const f32x2 qn = (f32x2){bflo(qw), bfhi(qw)} * e, kn = (f32x2){bflo(kw), bfhi(kw)} * ei; \
          myq[(j)] = pk2(qn.x, qn.y); myk[(j)] = pk2(kn.x, kn.y); } while (0)
#pragma unroll 1
      for (int j = 0; j < 16; j += 2) {
#pragma unroll
          for (int i = 0; i < 8; ++i) wB[i] = *(const f32x4*)(wl + 32 * (j + 1) + 4 * i);
          P2P_GLA_PAIR(j, wA);
          if (j + 2 < 16) {
#pragma unroll
              for (int i = 0; i < 8; ++i) wA[i] = *(const f32x4*)(wl + 32 * (j + 2) + 4 * i);
          }
          P2P_GLA_PAIR(j + 1, wB);
      }
#undef P2P_GLA_PAIR
      LBAR();
#pragma unroll
      for (int i = 0; i < 4; ++i) { const int pc = tid + 512 * i, r_ = pc >> 5, c16 = pc & 31;
          *(v4u*)(SCR + SC_QG + (row0 + r_) * 256 + 8 * c16) = *(const v4u*)(QL + r_ * GP + 16 * c16); *(v4u*)(SCR + SC_KG + (row0 + r_) * 256 + 8 * c16) = *(const v4u*)(KL + r_ * GP + 16 * c16); } }
    {
      const int isk = tid >> 8, pc = tid & 255, h = pc >> 6, ch = isk * 512 + 2 * pc;
      f32x2 cw2[4], cb2;
#pragma unroll
      for (int j = 0; j < 4; ++j) cw2[j] = (f32x2){CONV_W[j * 1024 + ch], CONV_W[j * 1024 + ch + 1]};
      cb2 = (f32x2){CONV_B[ch], CONV_B[ch + 1]};
      const bf16* src = P + row0 * PS + (isk ? C_MK : C_MQ) + 2 * pc;
      bf16* dst = SCR + (isk ? SC_KW : SC_QP) + row0 * 512 + 2 * pc;
      f32x2 x2[19]; unsigned nxt[16];
#pragma unroll
      for (int i = 0; i < 3; ++i) { const unsigned cv = (c > 0) ? *(const unsigned*)(src + (long)(i - 3) * PS) : 0u; x2[i] = (f32x2){bflo(cv), bfhi(cv)}; }
#pragma unroll
      for (int i = 0; i < 16; ++i) nxt[i] = *(const unsigned*)(src + (long)i * PS);
#pragma unroll 1
      for (int gq = 0; gq < 4; ++gq) {
#pragma unroll
          for (int i = 0; i < 16; ++i) x2[3 + i] = (f32x2){bflo(nxt[i]), bfhi(nxt[i])};
          if (gq < 3) {
#pragma unroll
              for (int i = 0; i < 16; ++i) nxt[i] = *(const unsigned*)(src + (long)(16 * (gq + 1) + i) * PS);
          }
          f32x4 wk4[4];
#pragma unroll
          for (int i = 0; i < 4; ++i) wk4[i] = isk ? *(const f32x4*)(WKL + h * 64 + 16 * gq + 4 * i) : (f32x4){1.f, 1.f, 1.f, 1.f};
#pragma unroll
          for (int i = 0; i < 16; ++i) { f32x2 a = cb2;
#pragma unroll
              for (int j = 0; j < 4; ++j) a = cw2[j] * x2[i + j] + a;
              const f32x2 t = a * -1.4426950408889634f;
              const f32x2 d = (f32x2){__builtin_amdgcn_exp2f(t.x), __builtin_amdgcn_exp2f(t.y)} + 1.f;
              a = a * (f32x2){__builtin_amdgcn_rcpf(d.x), __builtin_amdgcn_rcpf(d.y)};
              a = a * wk4[i >> 2][i & 3];
              *(unsigned*)(dst + (size_t)(16 * gq + i) * 512) = pk2(a.x, a.y); }
#pragma unroll
          for (int i = 0; i < 3; ++i) x2[i] = x2[16 + i];
      } }
    LBAR();
}

constexpr int NCI = 2;
__device__ __forceinline__ void chain_mlstm(Frame& F, int b, int h, int sl) {
    char* L = F.ldsg;
    constexpr int KT_B = 64 * TS, VT_B = 128 * TS, NP_B = 16 * 64 * 4, BUF_B = KT_B + VT_B + NP_B;
    float* PM = (float*)(L + NCI * BUF_B); float* BLs = PM + 32; float* MCc = BLs + 32; float* CSs = MCc + 40; float* E2s = CSs + 32;
    const int tid = F_TID, lane = F_LANE, w = F_WAVE, r = lane & 15, g = lane >> 4;
    const int bh = b * 4 + h; const size_t rowb = (size_t)b * SEQ;
    if (tid < 32) { PM[tid] = PMXG[bh * NCH + tid]; BLs[tid] = BLSG[bh * NCH + tid]; }
    __syncthreads();
    if (tid == 0) { float m = 0.f; for (int c = 0; c < NCH; ++c) { const float M = fmaxf(m, PM[c]); MCc[c] = m; CSs[c] = __expf(m - M); E2s[c] = __expf(PM[c] - M); m = BLs[c] + M; } MCc[32] = m; }
    __syncthreads();
    const int dpk = tid & 31, tg = tid >> 5, dpv = tid & 63, sg = tid >> 6;
    const int dt = w & 3, eb = 4 * (w >> 2);
    f32x4 acc[4];
#pragma unroll
    for (int i = 0; i < 4; ++i) acc[i] = (f32x4){0.f, 0.f, 0.f, 0.f};
    float nst = 0.f;
    unsigned krq[NCI][4], vrq[NCI][8];
    const bf16* kbase = SCR + SC_KW + (rowb + 4 * tg) * 512 + h * 128 + 64 * sl + 2 * dpk; const bf16* vbase = PROJ + (rowb + 8 * sg) * PS + C_MV + h * 128 + 2 * dpv;
#pragma unroll
    for (int q = 0; q < NCI; ++q) {
#pragma unroll
        for (int i = 0; i < 4; ++i) krq[q][i] = *(const unsigned*)(kbase + (size_t)(64 * q + i) * 512);
#pragma unroll
        for (int i = 0; i < 8; ++i) vrq[q][i] = *(const unsigned*)(vbase + (size_t)(64 * q + i) * PS);
    }
    for (int c0 = 0; c0 < NCH; c0 += NCI) {
#pragma unroll
        for (int q = 0; q < NCI; ++q) { char* KT = L + q * BUF_B; char* VT = KT + KT_B; float* NP = (float*)(VT + VT_B);
            const unsigned* kr = krq[q]; const unsigned* vr = vrq[q];
            *(v2u*)(KT + (2 * dpk) * TS + 8 * tg) = (v2u){(kr[0] & 0xffffu) | (kr[1] << 16), (kr[2] & 0xffffu) | (kr[3] << 16)};
            *(v2u*)(KT + (2 * dpk + 1) * TS + 8 * tg) = (v2u){(kr[0] >> 16) | (kr[1] & 0xffff0000u), (kr[2] >> 16) | (kr[3] & 0xffff0000u)};
            NP[tg * 64 + 2 * dpk] = (bflo(kr[0]) + bflo(kr[1])) + (bflo(kr[2]) + bflo(kr[3])); NP[tg * 64 + 2 * dpk + 1] = (bfhi(kr[0]) + bfhi(kr[1])) + (bfhi(kr[2]) + bfhi(kr[3]));
            unsigned v0p[4], v1p[4];
#pragma unroll
            for (int i = 0; i < 8; i += 2) { v0p[i >> 1] = (vr[i] & 0xffffu) | (vr[i + 1] << 16); v1p[i >> 1] = (vr[i] >> 16) | (vr[i + 1] & 0xffff0000u); }
            *(v4u*)(VT + (2 * dpv) * TS + 16 * sg) = (v4u){v0p[0], v0p[1], v0p[2], v0p[3]};
            *(v4u*)(VT + (2 * dpv + 1) * TS + 16 * sg) = (v4u){v1p[0], v1p[1], v1p[2], v1p[3]}; }
        if (c0 + NCI < NCH) {
#pragma unroll
            for (int q = 0; q < NCI; ++q) {
#pragma unroll
                for (int i = 0; i < 4; ++i) krq[q][i] = *(const unsigned*)(kbase + (size_t)(64 * (c0 + NCI + q) + i) * 512);
#pragma unroll
                for (int i = 0; i < 8; ++i) vrq[q][i] = *(const unsigned*)(vbase + (size_t)(64 * (c0 + NCI + q) + i) * PS);
            }
        }
        LBAR();
        f32x4 ta[NCI][4];
#pragma unroll
        for (int q = 0; q < NCI; ++q) { const char* KT = L + q * BUF_B; const char* VT = KT + KT_B;
#pragma unroll
            for (int i = 0; i < 4; ++i) ta[q][i] = (f32x4){0.f, 0.f, 0.f, 0.f};
#pragma unroll
            for (int kk = 0; kk < 2; ++kk) {
                const bf16x8 af = lds_frag(KT + (16 * dt + r) * TS + (32 * kk + 8 * g) * 2);
#pragma unroll
                for (int i = 0; i < 4; ++i) ta[q][i] = mfma16(af, lds_frag(VT + (16 * (eb + i) + r) * TS + (32 * kk + 8 * g) * 2), ta[q][i]);
            } }
#pragma unroll
        for (int q = 0; q < NCI; ++q) { const int c = c0 + q;
            { bf16* cst = CSM + (size_t)(bh * NCH + c) * 16384;
#pragma unroll
              for (int i = 0; i < 4; ++i)
                  *(v2u*)(cst + ((eb + i) * 8 + 4 * sl + dt) * 256 + r * 16 + 4 * g) = (v2u){pg8::cvt_pk_bf16(acc[i][0], acc[i][1]), pg8::cvt_pk_bf16(acc[i][2], acc[i][3])};
              if (tid < 64) NCS[(size_t)(bh * NCH + c) * 128 + 64 * sl + tid] = nst;
              if (tid == 0 && sl == 0) MCS[bh * NCH + c] = MCc[c]; }
            const float cs = CSs[c], e2 = E2s[c];
            if (tid < 64) { const float* NP = (const float*)(L + q * BUF_B + KT_B + VT_B); float s = 0.f;
#pragma unroll
                for (int k = 0; k < 16; ++k) s += NP[k * 64 + tid];
                nst = cs * nst + e2 * s; }
#pragma unroll
            for (int i = 0; i < 4; ++i) acc[i] = acc[i] * cs + ta[q][i] * e2; }
        LBAR();
    }
    { float* Co = OUTP + O_CP + (size_t)bh * 16384;
#pragma unroll
      for (int i = 0; i < 4; ++i)
#pragma unroll
          for (int j = 0; j < 4; ++j) Co[(64 * sl + 16 * dt + 4 * g + j) * 128 + 16 * (eb + i) + r] = acc[i][j];
      if (tid < 64) OUTP[O_NP + (size_t)bh * 128 + 64 * sl + tid] = nst;
      if (tid == 0 && sl == 0) OUTP[O_MP + bh] = MCc[32]; }
    __syncthreads();
}

__device__ __forceinline__ void chain_gla(Frame& F, int b, int hg, int sl) {
    char* L = F.ldsg;
    constexpr int KT_B = 32 * TS, VT_B = 128 * TS, BUF_B = KT_B + VT_B;
    const int tid = F_TID, lane = F_LANE, w = F_WAVE, r = lane & 15, g = lane >> 4;
    const int bh = b * 4 + hg; const size_t rowb = (size_t)b * SEQ;
    const int dpv = tid & 63, sg = tid >> 6;
    const int dt = w & 1, eb = 2 * (w >> 1);
    f32x4 acc[2];
    acc[0] = (f32x4){0.f, 0.f, 0.f, 0.f}; acc[1] = acc[0];
    v2u k4q[NCI]; f32x4 ebq[NCI]; unsigned vrq[NCI][8];
    const bf16* kbase = SCR + SC_KG + (rowb + lane) * 256 + hg * 64 + 32 * sl + 4 * w; const bf16* vbase = PROJ + (rowb + 8 * sg) * PS + C_GV + hg * 128 + 2 * dpv;
    const float* ebase = EBLG + (size_t)bh * NCH * 64 + 32 * sl + 16 * dt + 4 * g;
#pragma unroll
    for (int q = 0; q < NCI; ++q) { k4q[q] = *(const v2u*)(kbase + (size_t)(64 * q) * 256); ebq[q] = *(const f32x4*)(ebase + q * 64);
#pragma unroll
        for (int i = 0; i < 8; ++i) vrq[q][i] = *(const unsigned*)(vbase + (size_t)(64 * q + i) * PS); }
    for (int c0 = 0; c0 < NCH; c0 += NCI) {
        f32x4 eb4[NCI];
#pragma unroll
        for (int q = 0; q < NCI; ++q) { char* KT = L + q * BUF_B; char* VT = KT + KT_B; const v2u k4 = k4q[q]; const unsigned* vr = vrq[q]; eb4[q] = ebq[q];
            *(bf16*)(KT + (4 * w + 0) * TS + 2 * lane) = (bf16)(k4[0] & 0xffffu); *(bf16*)(KT + (4 * w + 1) * TS + 2 * lane) = (bf16)(k4[0] >> 16);
            *(bf16*)(KT + (4 * w + 2) * TS + 2 * lane) = (bf16)(k4[1] & 0xffffu); *(bf16*)(KT + (4 * w + 3) * TS + 2 * lane) = (bf16)(k4[1] >> 16);
            unsigned v0p[4], v1p[4];
#pragma unroll
            for (int i = 0; i < 8; i += 2) { v0p[i >> 1] = (vr[i] & 0xffffu) | (vr[i + 1] << 16); v1p[i >> 1] = (vr[i] >> 16) | (vr[i + 1] & 0xffff0000u); }
            *(v4u*)(VT + (2 * dpv) * TS + 16 * sg) = (v4u){v0p[0], v0p[1], v0p[2], v0p[3]};
            *(v4u*)(VT + (2 * dpv + 1) * TS + 16 * sg) = (v4u){v1p[0], v1p[1], v1p[2], v1p[3]}; }
        if (c0 + NCI < NCH) {
#pragma unroll
            for (int q = 0; q < NCI; ++q) { k4q[q] = *(const v2u*)(kbase + (size_t)(64 * (c0 + NCI + q)) * 256); ebq[q] = *(const f32x4*)(ebase + (c0 + NCI + q) * 64);
#pragma unroll
                for (int i = 0; i < 8; ++i) vrq[q][i] = *(const unsigned*)(vbase + (size_t)(64 * (c0 + NCI + q) + i) * PS); }
        }
        LBAR();
        f32x4 ta[NCI][2];
#pragma unroll
        for (int q = 0; q < NCI; ++q) { const char* KT = L + q * BUF_B; const char* VT = KT + KT_B;
            ta[q][0] = (f32x4){0.f, 0.f, 0.f, 0.f}; ta[q][1] = ta[q][0];
#pragma unroll
            for (int kk = 0; kk < 2; ++kk) {
                const bf16x8 af = lds_frag(KT + (16 * dt + r) * TS + (32 * kk + 8 * g) * 2);
#pragma unroll
                for (int i = 0; i < 2; ++i) ta[q][i] = mfma16(af, lds_frag(VT + (16 * (eb + i) + r) * TS + (32 * kk + 8 * g) * 2), ta[q][i]);
            } }
#pragma unroll
        for (int q = 0; q < NCI; ++q) { const int c = c0 + q;
            bf16* cst = CSG + (size_t)(bh * NCH + c) * 8192;
#pragma unroll
            for (int i = 0; i < 2; ++i)
                *(v2u*)(cst + ((eb + i) * 4 + 2 * sl + dt) * 256 + r * 16 + 4 * g) = (v2u){pg8::cvt_pk_bf16(acc[i][0], acc[i][1]), pg8::cvt_pk_bf16(acc[i][2], acc[i][3])};
            acc[0] = (acc[0] + ta[q][0]) * eb4[q]; acc[1] = (acc[1] + ta[q][1]) * eb4[q]; }
        LBAR();
    }
    { float* So = OUTP + O_SP + (size_t)bh * 8192;
#pragma unroll
      for (int i = 0; i < 2; ++i)
#pragma unroll
          for (int j = 0; j < 4; ++j) So[(32 * sl + 16 * dt + 4 * g + j) * 128 + 16 * (eb + i) + r] = acc[i][j]; }
    __syncthreads();
}

__device__ __forceinline__ void sample_item(Frame& F, int n, int hh, float* Wl, int lane) {
    asm volatile("" : "+v"(lane));
    float* qv = Wl; float* kv = Wl + 128; float* vv = Wl + 256; float* al = Wl + 384; float* bw = Wl + 512;
    const size_t row = (size_t)MP + n;
    const bf16* Pr = PROJ + row * PS;
    const bool gla = hh >= 4; const int h = hh & 3;
    const int e4 = lane & 31, dh = lane >> 5;
    float cs = 1.f, wkk = 1.f, dinv = 1.f;
    const int nrow = gla ? 32 : 64;
    const float* S0 = gla ? ST_S + ((size_t)n * 4 + h) * 8192 + (size_t)(32 * dh) * 128 + 4 * e4 : ST_C + ((size_t)n * 4 + h) * 16384 + (size_t)(64 * dh) * 128 + 4 * e4;
    float* Sn = gla ? OUTP + O_SS + ((size_t)n * 4 + h) * 8192 + (size_t)(32 * dh) * 128 + 4 * e4 : OUTP + O_CS + ((size_t)n * 4 + h) * 16384 + (size_t)(64 * dh) * 128 + 4 * e4;
    f32x4 ca[8], cb[8];
#pragma unroll
    for (int i = 0; i < 8; ++i) ca[i] = __builtin_nontemporal_load((const f32x4*)(S0 + i * 128));
    if (!gla) {
        float qk2[2][2];
#pragma unroll
        for (int isk = 0; isk < 2; ++isk)
#pragma unroll
            for (int q = 0; q < 2; ++q) { const int d = lane + 64 * q, ch = isk * 512 + h * 128 + d;
                const float* scv = ST_CONV + (size_t)n * 3 * 1024 + ch;
                float a = CONV_B[ch] + CONV_W[ch] * scv[0] + CONV_W[1024 + ch] * scv[1024] + CONV_W[2048 + ch] * scv[2048] + CONV_W[3072 + ch] * bf2f(Pr[(isk ? C_MK : C_MQ) + h * 128 + d]);
                a = a * sigmoidf(a); if (isk) a *= KSCALE; qk2[isk][q] = a; (isk ? kv : qv)[d] = a; }
        vv[lane] = bf2f(Pr[C_MV + h * 128 + lane]); vv[lane + 64] = bf2f(Pr[C_MV + h * 128 + lane + 64]);
        const float* n0 = ST_N + ((size_t)n * 4 + h) * 128; const float n00 = n0[lane], n01 = n0[lane + 64];
        const float qk = wave_sum(qk2[0][0] * qk2[1][0] + qk2[0][1] * qk2[1][1]), qn = wave_sum(qk2[0][0] * n00 + qk2[0][1] * n01);
        const float ig = bf2f(Pr[C_SM + h]) + B_GATE[h], lf = logsig(bf2f(Pr[C_SM + 4 + h]) + B_GATE[4 + h]);
        const float m0 = ST_M[n * 4 + h], mn = fmaxf(lf + m0, ig);
        wkk = __expf(ig - mn); cs = __expf(lf + m0 - mn);
        const float den = cs * qn + qk * wkk;
        dinv = __builtin_amdgcn_rcpf(fmaxf(fabsf(den), __expf(-mn)));
        float* nsO = OUTP + O_NS + ((size_t)n * 4 + h) * 128; nsO[lane] = cs * n00 + wkk * qk2[1][0]; nsO[lane + 64] = cs * n01 + wkk * qk2[1][1];
        if (lane == 0) OUTP[O_MS + n * 4 + h] = mn;
        al[lane] = cs; al[lane + 64] = cs; bw[lane] = wkk * qk2[1][0]; bw[lane + 64] = wkk * qk2[1][1];
    } else {
        qv[lane] = bf2f(Pr[C_GQ + h * 64 + lane]); kv[lane] = bf2f(Pr[C_GK + h * 64 + lane]);
        vv[lane] = bf2f(Pr[C_GV + h * 128 + lane]); vv[lane + 64] = bf2f(Pr[C_GV + h * 128 + lane + 64]);
        { const int col = h * 64 + lane; float z = B_A[col];
#pragma unroll
          for (int q = 0; q < 16; ++q) z += bf2f(Pr[C_SM + 8 + q]) * IN_F(13)[q * 256 + col];
          al[lane] = __expf(logsig(z) * (1.f / 16.f)); bw[lane] = bf2f(Pr[C_GK + h * 64 + lane]); }
    }
    asm volatile("s_waitcnt lgkmcnt(0)" ::: "memory");
    const f32x4 v4 = *(const f32x4*)(vv + 4 * e4);
    f32x4 hp = (f32x4){0.f, 0.f, 0.f, 0.f};
#define SMP_BATCH(c, base) do { _Pragma("unroll") for (int i = 0; i < 8; ++i) { const int d = nrow * dh + (base) + i; const f32x4 cn = c[i] * al[d] + v4 * bw[d]; \
        __builtin_nontemporal_store(cn, (f32x4*)(Sn + ((base) + i) * 128)); hp += cn * qv[d]; } } while (0)
    for (int i0 = 0; i0 < nrow; i0 += 16) {
#pragma unroll
        for (int i = 0; i < 8; ++i) cb[i] = __builtin_nontemporal_load((const f32x4*)(S0 + (i0 + 8 + i) * 128));
        SMP_BATCH(ca, i0);
        if (i0 + 16 < nrow) {
#pragma unroll
            for (int i = 0; i < 8; ++i) ca[i] = __builtin_nontemporal_load((const f32x4*)(S0 + (i0 + 16 + i) * 128));
        }
        SMP_BATCH(cb, i0 + 8);
    }
#undef SMP_BATCH
#pragma unroll
    for (int j = 0; j < 4; ++j) hp[j] += __shfl_xor(hp[j], 32);
    hp = hp * dinv;
    float ssum = (hp[0] * hp[0] + hp[1] * hp[1]) + (hp[2] * hp[2] + hp[3] * hp[3]);
#pragma unroll
    for (int o = 1; o < 32; o <<= 1) ssum += __shfl_xor(ssum, o);
    const float rn = rsqrt_fast(ssum * (1.f / 128.f) + EPS);
    if (lane < 32) {
        const v2u gw = *(const v2u*)(Pr + (gla ? C_GR : C_MO) + h * 128 + 4 * e4);
        const f32x4 g4 = *(const f32x4*)((gla ? G_GHEAD : G_MHEAD) + h * 128 + 4 * e4);
        const float gt[4] = {bflo(gw[0]), bfhi(gw[0]), bflo(gw[1]), bfhi(gw[1])}; float o[4];
#pragma unroll
        for (int j = 0; j < 4; ++j) { const float sg_ = sigmoidf(gt[j]); o[j] = hp[j] * rn * g4[j] * (gla ? gt[j] * sg_ : sg_); }
        int e4o = e4; asm volatile("" : "+v"(e4o));
        *(v2u*)(R1B + row * D + (gla ? 512 : 0) + h * 128 + 4 * e4o) = (v2u){pg8::cvt_pk_bf16(o[0], o[1]), pg8::cvt_pk_bf16(o[2], o[3])};
    }
    asm volatile("s_waitcnt lgkmcnt(0)" ::: "memory");
}

constexpr int P2B_QS = 0, P2B_KS = 64 * QS_P, P2B_VT = P2B_KS + 80 * QS_P, P2B_PS = P2B_VT + 128 * TS, P2B_FL = P2B_PS + 64 * TS, P2B_HALF = P2B_FL + 2560;
static_assert(2 * P2B_HALF <= MISC_OFF, "P2b LDS");
__device__ __forceinline__ void p2b_loop(Frame& F, char* L, int hb, int lw, int lane_in) {
    const bf16* P = PROJ;
    char* QSp = L + P2B_QS; char* KSp = L + P2B_KS; char* VTp = L + P2B_VT; char* PSp = L + P2B_PS;
    float* af = (float*)(L + P2B_FL); float* Mf = af + 64; float* scf = af + 128; float* enf = af + 192; float* dinvf = af + 256; float* ssq = af + 320;
    float* rsf = ssq + 256;
    bf16x8 cfr[2][4]; v2u gwq[4][2]; v4u qq[4], kq[4]; unsigned vr[16]; float ga = 0.f, gbc = 0.f, gmc = 0.f, gpx = 0.f, gnc = 0.f;
#define P2B_DEC(u_) const int v_ = (u_) & 1023, bh_ = v_ >> 5, c_ = v_ & 31, b_ = bh_ >> 2, h_ = bh_ & 3; const bool G_ = (u_) >= 1024; const size_t rowb_ = (size_t)b_ * SEQ + c_ * 64
#define P2B_ISSUE_STAGE(u_) do { P2B_DEC(u_); \
        if (!G_) { ga = GA_A[(size_t)bh_ * SEQ + c_ * 64 + lane]; gbc = GA_B[(size_t)bh_ * SEQ + c_ * 64 + lane]; gmc = MCS[bh_ * NCH + c_]; gpx = PMXG[bh_ * NCH + c_]; \
            if (ltid < 128) gnc = NCS[(size_t)(bh_ * NCH + c_) * 128 + ltid]; \
            _Pragma("unroll") for (int i = 0; i < 4; ++i) { const int pc = ltid + 256 * i, row = pc >> 4, c16 = pc & 15; \
                qq[i] = *(const v4u*)(SCR + SC_QP + (rowb_ + row) * 512 + h_ * 128 + 8 * c16); kq[i] = *(const v4u*)(SCR + SC_KW + (rowb_ + row) * 512 + h_ * 128 + 8 * c16); } \
        } else { \
            _Pragma("unroll") for (int i = 0; i < 2; ++i) { const int pc = ltid + 256 * i, row = pc >> 3, c16 = pc & 7; \
                qq[i] = *(const v4u*)(SCR + SC_QG + (rowb_ + row) * 256 + h_ * 64 + 8 * c16); kq[i] = *(const v4u*)(SCR + SC_KG + (rowb_ + row) * 256 + h_ * 64 + 8 * c16); } } \
        _Pragma("unroll") for (int i = 0; i < 16; ++i) vr[i] = *(const unsigned*)(P + (rowb_ + 16 * sg + i) * PS + (G_ ? C_GV : C_MV) + h_ * 128 + 2 * dp); } while (0)
#define P2B_ISSUE_CFR(u_) do { P2B_DEC(u_); (void)b_; (void)h_; (void)rowb_; \
        const bf16* CT = G_ ? CSG + (size_t)(bh_ * NCH + c_) * 8192 : CSM + (size_t)(bh_ * NCH + c_) * 16384; \
        _Pragma("unroll") for (int n2 = 0; n2 < 2; ++n2) _Pragma("unroll") for (int kk = 0; kk < 4; ++kk) if (kk < (G_ ? 2 : 4)) \
            cfr[n2][kk] = *(const bf16x8*)(CT + ((2 * lw + n2) * (G_ ? 4 : 8) + 2 * kk + (g >> 1)) * 256 + r * 16 + 8 * (g & 1)); } while (0)
#define P2B_ISSUE_GWQ(u_) do { P2B_DEC(u_); (void)b_; \
        _Pragma("unroll") for (int mt = 0; mt < 4; ++mt) _Pragma("unroll") for (int n2 = 0; n2 < 2; ++n2) \
            gwq[mt][n2] = *(const v2u*)(P + (rowb_ + 16 * mt + r) * PS + (G_ ? C_GR : C_MO) + h_ * 128 + 32 * lw + 16 * n2 + 4 * g); } while (0)
#define P2B_LANES() int lane = lane_in; asm volatile("" : "+v"(lane)); const int r = lane & 15, g = lane >> 4, ltid = lw * 64 + lane, dp = lane, sg = lw
    const int G2 = 2 * F.G;
    int u = 2 * (int)blockIdx.x + hb;
    if (u - hb >= 2048) return;
    { P2B_LANES(); P2B_ISSUE_STAGE(u); P2B_ISSUE_CFR(u); P2B_ISSUE_GWQ(u); }
    for (;;) {
        P2B_LANES();
        const int un = u + G2; const bool has_next = (un - hb) < 2048;
        const int v = u & 1023, bh = v >> 5, c = v & 31, b = bh >> 2, h = bh & 3; const bool GLA = u >= 1024;
        const size_t rowb = (size_t)b * SEQ + c * 64;
        const int QP = GLA ? TS : QS_P;
        const int NK = GLA ? 2 : 4;
        if (!GLA) {
            { const float pm = wave_scan_max(ga, lane);
              const float Mt = fmaxf(gmc, pm);
              if (lw == 0) { Mf[lane] = Mt; scf[lane] = __expf(gmc - Mt); enf[lane] = __expf(-(gbc + Mt)); rsf[lane] = __expf(gpx - Mt); } }
#pragma unroll
            for (int i = 0; i < 4; ++i) { const int pc = ltid + 256 * i, row = pc >> 4, c16 = pc & 15;
                *(v4u*)(QSp + row * QS_P + 16 * c16) = qq[i]; *(v4u*)(KSp + row * QS_P + 16 * c16) = kq[i]; }
            if (ltid < 128) *(bf16*)(KSp + 64 * QS_P + 2 * ltid) = (bf16)f2bf(gnc);
            for (int i = ltid; i < 15 * 64; i += 256) *(unsigned*)(KSp + (65 + i / 64) * QS_P + 4 * (i & 63)) = 0u;
        } else {
#pragma unroll
            for (int i = 0; i < 2; ++i) { const int pc = ltid + 256 * i, row = pc >> 3, c16 = pc & 7;
                *(v4u*)(QSp + row * TS + 16 * c16) = qq[i]; *(v4u*)(KSp + row * TS + 16 * c16) = kq[i]; }
        }
        {
          unsigned v0p[8], v1p[8];
#pragma unroll
          for (int i = 0; i < 16; i += 2) { v0p[i >> 1] = (vr[i] & 0xffffu) | (vr[i + 1] << 16); v1p[i >> 1] = (vr[i] >> 16) | (vr[i + 1] & 0xffff0000u); }
          *(v4u*)(VTp + (2 * dp) * TS + 32 * sg) = (v4u){v0p[0], v0p[1], v0p[2], v0p[3]}; *(v4u*)(VTp + (2 * dp) * TS + 32 * sg + 16) = (v4u){v0p[4], v0p[5], v0p[6], v0p[7]};
          *(v4u*)(VTp + (2 * dp + 1) * TS + 32 * sg) = (v4u){v1p[0], v1p[1], v1p[2], v1p[3]}; *(v4u*)(VTp + (2 * dp + 1) * TS + 32 * sg + 16) = (v4u){v1p[4], v1p[5], v1p[6], v1p[7]}; }
        LBAR();
        if (has_next) P2B_ISSUE_STAGE(un);
        {
            f32x4 pa[5];
#pragma unroll
            for (int i = 0; i < 5; ++i) pa[i] = (f32x4){0.f, 0.f, 0.f, 0.f};
#pragma unroll
            for (int kk = 0; kk < 4; ++kk) if (kk < NK) {
                const bf16x8 qf = lds_frag(QSp + (16 * lw + r) * QP + (32 * kk + 8 * g) * 2);
#pragma unroll
                for (int nt = 0; nt < 4; ++nt) if (nt <= lw) pa[nt] = mfma16(lds_frag(KSp + (16 * nt + r) * QP + (32 * kk + 8 * g) * 2), qf, pa[nt]);
                if (!GLA) pa[4] = mfma16(lds_frag(KSp + (64 + r) * QP + (32 * kk + 8 * g) * 2), qf, pa[4]);
            }
            const int t = 16 * lw + r;
            float rsc = 1.f; if (!GLA) rsc = rsf[t];
            float rs = 0.f;
#pragma unroll
            for (int nt = 0; nt < 4; ++nt) {
                f32x4 p = (f32x4){0.f, 0.f, 0.f, 0.f};
                if (nt <= lw) {
#pragma unroll
                    for (int j = 0; j < 4; ++j) { const int s_ = 16 * nt + 4 * g + j; p[j] = (s_ <= t) ? pa[nt][j] * rsc : 0.f; }
                }
                rs += (p[0] + p[1]) + (p[2] + p[3]);
                *(v2u*)(PSp + t * TS + (16 * nt + 4 * g) * 2) = (v2u){pg8::cvt_pk_bf16(p[0], p[1]), pg8::cvt_pk_bf16(p[2], p[3])};
            }
            if (!GLA) {
                rs += __shfl_xor(rs, 16); rs += __shfl_xor(rs, 32);
                if (g == 0) { const float den = scf[t] * pa[4][0] + rs; dinvf[t] = __builtin_amdgcn_rcpf(fmaxf(fabsf(den), enf[t])); }
            }
        }
        LBAR();
        f32x4 hv[4][2];
        {
            f32x4 aV[4][2], aC[4][2];
#pragma unroll
            for (int mt = 0; mt < 4; ++mt)
#pragma unroll
                for (int n2 = 0; n2 < 2; ++n2) { aV[mt][n2] = (f32x4){0.f, 0.f, 0.f, 0.f}; aC[mt][n2] = (f32x4){0.f, 0.f, 0.f, 0.f}; }
#pragma unroll
            for (int kk = 0; kk < 2; ++kk) {
                bf16x8 vf[2];
#pragma unroll
                for (int n2 = 0; n2 < 2; ++n2) vf[n2] = lds_frag(VTp + (32 * lw + 16 * n2 + r) * TS + (32 * kk + 8 * g) * 2);
#pragma unroll
                for (int mt = 0; mt < 4; ++mt) { const bf16x8 pf = lds_frag(PSp + (16 * mt + r) * TS + (32 * kk + 8 * g) * 2);
#pragma unroll
                    for (int n2 = 0; n2 < 2; ++n2) aV[mt][n2] = mfma16(vf[n2], pf, aV[mt][n2]); }
                __builtin_amdgcn_sched_barrier(0);
            }
#pragma unroll
            for (int kk = 0; kk < 4; ++kk) if (kk < NK)
#pragma unroll
                for (int mt = 0; mt < 4; ++mt) { const bf16x8 qf = lds_frag(QSp + (16 * mt + r) * QP + (32 * kk + 8 * g) * 2);
#pragma unroll
                    for (int n2 = 0; n2 < 2; ++n2) aC[mt][n2] = mfma16(cfr[n2][kk], qf, aC[mt][n2]); __builtin_amdgcn_sched_barrier(0); }
            if (has_next) P2B_ISSUE_CFR(un);
#pragma unroll
            for (int mt = 0; mt < 4; ++mt) { const int t = 16 * mt + r;
                float sc = 1.f, di = 1.f; if (!GLA) { sc = scf[t]; di = dinvf[t]; }
                float s_ = 0.f;
#pragma unroll
                for (int n2 = 0; n2 < 2; ++n2) { hv[mt][n2] = (aC[mt][n2] * sc + aV[mt][n2]) * di;
                    s_ += (hv[mt][n2][0] * hv[mt][n2][0] + hv[mt][n2][1] * hv[mt][n2][1]) + (hv[mt][n2][2] * hv[mt][n2][2] + hv[mt][n2][3] * hv[mt][n2][3]); }
                s_ += __shfl_xor(s_, 16); s_ += __shfl_xor(s_, 32);
                if (g == 0) ssq[t * 4 + lw] = s_; }
        }
        LBAR();
        {
            const float* gn = (GLA ? G_GHEAD : G_MHEAD) + h * 128;
#pragma unroll
            for (int mt = 0; mt < 4; ++mt) { const int t = 16 * mt + r; const f32x4 s4 = *(const f32x4*)(ssq + 4 * t);
                const float rn = rsqrt_fast(((s4[0] + s4[1]) + (s4[2] + s4[3])) * (1.f / 128.f) + EPS);
#pragma unroll
                for (int n2 = 0; n2 < 2; ++n2) { const int e = 32 * lw + 16 * n2 + 4 * g;
                    const v2u gw = gwq[mt][n2];
                    const f32x4 g4 = *(const f32x4*)(gn + e);
                    float gt[4] = {bflo(gw[0]), bfhi(gw[0]), bflo(gw[1]), bfhi(gw[1])}; float o[4];
#pragma unroll
                    for (int j = 0; j < 4; ++j) { const float sg_ = sigmoidf(gt[j]); o[j] = hv[mt][n2][j] * rn * g4[j] * (GLA ? gt[j] * sg_ : sg_); }
                    *(v2u*)(R1B + (rowb + t) * D + (GLA ? 512 : 0) + h * 128 + e) = (v2u){pg8::cvt_pk_bf16(o[0], o[1]), pg8::cvt_pk_bf16(o[2], o[3])}; } }
        }
        if (has_next) P2B_ISSUE_GWQ(un);
        if (!has_next) break;
        u = un;
    }
#undef P2B_DEC
#undef P2B_LANES
#undef P2B_ISSUE_STAGE
#undef P2B_ISSUE_CFR
#undef P2B_ISSUE_GWQ
}

template <int K, int RT>
__device__ __forceinline__ void skinny_acc(const bf16* A, const bf16* Bt, int nsl, f32x4 (&acc)[RT], int w, int r, int g) {
    constexpr int KW = K / 8, NKS = KW / 32, KBMAX = RT <= 2 ? 8 : 4, KB = NKS < KBMAX ? NKS : KBMAX;
    const bf16* ap = A + (size_t)r * K + w * KW + 8 * g;
    const bf16* bp = Bt + (size_t)(nsl * 16 + r) * K + w * KW + 8 * g;
#pragma unroll 1
    for (int ks = 0; ks < NKS; ks += KB) {
        bf16x8 bfr[KB], afr[RT][KB];
#pragma unroll
        for (int kk = 0; kk < KB; ++kk) { bfr[kk] = *(const bf16x8*)(bp + 32 * (ks + kk));
#pragma unroll
            for (int rt = 0; rt < RT; ++rt) afr[rt][kk] = *(const bf16x8*)(ap + (size_t)rt * 16 * K + 32 * (ks + kk)); }
#pragma unroll
        for (int kk = 0; kk < KB; ++kk)
#pragma unroll
            for (int rt = 0; rt < RT; ++rt) acc[rt] = mfma16(bfr[kk], afr[rt][kk], acc[rt]);
    }
}
template <int RT> __device__ __forceinline__ void skinny_put(float* red, const f32x4 (&acc)[RT], int w, int r, int g) {
#pragma unroll
    for (int rt = 0; rt < RT; ++rt) *(f32x4*)(red + w * (RT * 256) + (16 * rt + r) * 16 + 4 * g) = acc[rt];
}
template <int RT> __device__ __forceinline__ f32x4 skinny_get(const float* red, int row, int c4) {
    f32x4 v = (f32x4){0.f, 0.f, 0.f, 0.f};
#pragma unroll
    for (int q = 0; q < 8; ++q) v += *(const f32x4*)(red + q * (RT * 256) + row * 16 + 4 * c4);
    return v;
}
template <int RT> __device__ __forceinline__ void zeroacc(f32x4 (&acc)[RT]) {
#pragma unroll
    for (int i = 0; i < RT; ++i) acc[i] = (f32x4){0.f, 0.f, 0.f, 0.f};
}
__device__ __forceinline__ float quad_sum(float s) { s += __shfl_xor(s, 1); s += __shfl_xor(s, 2); return s; }
__device__ __forceinline__ v2u pack4(f32x4 v) { return (v2u){pg8::cvt_pk_bf16(v[0], v[1]), pg8::cvt_pk_bf16(v[2], v[3])}; }
template <bool RES_BF16>
__device__ __forceinline__ void skinny_res(Frame& F, const bf16* A, const bf16* Bt, int K4096, const void* res, bf16* ob, float* ss, const float* rsq) {
    float* red = (float*)F.ldsg; const int tid = F_TID, lane = F_LANE, w = F_WAVE, r = lane & 15, g = lane >> 4, lrow = tid >> 2, c4 = tid & 3;
    for (int it = blockIdx.x; it < 4 * (D / 16); it += F.G) { const int nsl = it >> 2, r0 = 32 * (it & 3);
        f32x4 acc[2]; zeroacc<2>(acc);
        if (K4096) skinny_acc<FF, 2>(A + (size_t)r0 * FF, Bt, nsl, acc, w, r, g); else skinny_acc<D, 2>(A + (size_t)r0 * D, Bt, nsl, acc, w, r, g);
        skinny_put<2>(red, acc, w, r, g); LBAR();
        if (tid < 128) { const int row = r0 + lrow;
            const size_t off = (size_t)row * D + nsl * 16 + 4 * c4;
            f32x4 rv;
            if constexpr (RES_BF16) { const v2u rw = *(const v2u*)((const bf16*)res + off); rv = (f32x4){bflo(rw.x), bfhi(rw.x), bflo(rw.y), bfhi(rw.y)}; }
            else rv = *(const f32x4*)((const float*)res + off);
            float q = 1.f; if constexpr (RES_BF16) q = __builtin_amdgcn_rcpf(rsq[row] * (1.f / D) + EPS);
            const f32x4 v = skinny_get<2>(red, lrow, c4) * q + rv;
            *(v2u*)(ob + off) = pack4(v);
            const float s = quad_sum((v[0] * v[0] + v[1] * v[1]) + (v[2] * v[2] + v[3] * v[3]));
            if (c4 == 0) atomicAdd(ss + row, s); }
        LBAR();
    }
}
__device__ __forceinline__ void skinny_up(Frame& F, const bf16* A, const bf16* Bt, bf16* U) {
    float* red = (float*)F.ldsg; const int tid = F_TID, lane = F_LANE, w = F_WAVE, r = lane & 15, g = lane >> 4, row = tid >> 2, c4 = tid & 3;
    for (int sl = blockIdx.x; sl < FF / 16; sl += F.G) {
        f32x4 acc[8]; zeroacc<8>(acc);
        skinny_acc<D, 8>(A, Bt, sl, acc, w, r, g);
        skinny_put<8>(red, acc, w, r, g); LBAR();
        f32x4 v = skinny_get<8>(red, row, c4);
#pragma unroll
        for (int j = 0; j < 4; ++j) { const float a = fmaxf(v[j], 0.f); v[j] = a * a; }
        *(v2u*)(U + (size_t)row * FF + sl * 16 + 4 * c4) = pack4(v);
        LBAR();
    }
}
__device__ __forceinline__ void skinny_ple(Frame& F, const bf16* pbs, const bf16* Wple, const bf16* x2b, const bf16* Wpg, const float* ss2, bf16* x3b, float* ss3,
                                           const bool FUSE, float* ysm, const float* gfin, float* slots  , unsigned* qcnt  ) {
    float* red = (float*)F.ldsg; float* red2 = red + 8 * 512; const int tid = F_TID, lane = F_LANE, w = F_WAVE, r = lane & 15, g = lane >> 4, lrow = tid >> 2, c4 = tid & 3;
    for (int it = blockIdx.x; it < 4 * (D / 16); it += F.G) { const int nsl = it >> 2, rq = it & 3, r0 = 32 * rq;
        f32x4 acc[2]; zeroacc<2>(acc);
        skinny_acc<DPLE, 2>(pbs + (size_t)r0 * DPLE, Wple, nsl, acc, w, r, g); skinny_put<2>(red2, acc, w, r, g);
        zeroacc<2>(acc);
        skinny_acc<D, 2>(x2b + (size_t)r0 * D, Wpg, nsl, acc, w, r, g); skinny_put<2>(red, acc, w, r, g); LBAR();
        const int row = r0 + (lrow & 31);
        const size_t off = (size_t)row * D + nsl * 16 + 4 * c4;
        f32x4 v = (f32x4){0.f, 0.f, 0.f, 0.f};
        if (tid < 128) {
            const float rs = rsqrt_fast(ss2[row] * (1.f / D) + EPS);
            const f32x4 gt = skinny_get<2>(red, lrow, c4) * rs, pp = skinny_get<2>(red2, lrow, c4); const v2u xw = *(const v2u*)(x2b + off);
            v = (f32x4){bflo(xw.x), bfhi(xw.x), bflo(xw.y), bfhi(xw.y)};
#pragma unroll
            for (int j = 0; j < 4; ++j) v[j] += pp[j] * sigmoidf(gt[j]);
            const float sq = quad_sum((v[0] * v[0] + v[1] * v[1]) + (v[2] * v[2] + v[3] * v[3]));
            if (!FUSE) { *(v2u*)(x3b + off) = pack4(v); if (c4 == 0) atomicAdd(ss3 + row, sq); }
            else if (c4 == 0) __hip_atomic_store(slots + row * 64 + nsl, sq, __ATOMIC_RELAXED, __HIP_MEMORY_SCOPE_AGENT);
        }
        if (FUSE) {
            asm volatile("s_waitcnt vmcnt(0)" ::: "memory");
            __syncthreads();
            if (tid == 0) { __hip_atomic_fetch_add(qcnt + 64 * rq, 1u, __ATOMIC_RELAXED, __HIP_MEMORY_SCOPE_AGENT);
                unsigned sp = 0;
                while (__hip_atomic_load(qcnt + 64 * rq, __ATOMIC_RELAXED, __HIP_MEMORY_SCOPE_AGENT) < (unsigned)(D / 16)) { __builtin_amdgcn_s_sleep(2); if (++sp > (1u << 22)) break; }
                __builtin_amdgcn_fence(__ATOMIC_ACQUIRE, "agent");
                asm volatile("s_waitcnt vmcnt(0)" ::: "memory"); }
            __syncthreads();
            if (tid < 128) { float t = 0.f;
#pragma unroll
                for (int q = 0; q < 16; ++q) t += __hip_atomic_load(slots + row * 64 + 16 * c4 + q, __ATOMIC_RELAXED, __HIP_MEMORY_SCOPE_AGENT);
                t = quad_sum(t);
                const float rn = rsqrt_fast(t * (1.f / D) + EPS);
                *(f32x4*)(ysm + off) = v * rn * *(const f32x4*)(gfin + nsl * 16 + 4 * c4); }
        }
        LBAR();
    }
}

constexpr int NPHASE = 9;

__global__ void __launch_bounds__(NWAVES * 64, 2) mk_fwd(Args args) {
    extern __shared__ __attribute__((aligned(16))) unsigned char lds[];
    Frame F;
    F.lds = (LAS unsigned char*)lds; F.ldsg = (char*)lds;
    F.G = gridDim.x;
    F.a = (CArgs*)__builtin_amdgcn_kernarg_segment_ptr();
    unsigned char* ws = F.a->ws;
    volatile LAS unsigned* MISC = (volatile LAS unsigned*)(F.lds + MISC_OFF);
    for (int u = F_TID; u < 64; u += NWAVES * 64) MISC[u] = 0u;
    __syncthreads();
    XcdBarrier bar; bar.bar = (unsigned*)(ws + CTL_BAR_B); bar.x = 0; bar.st = nullptr;
    bar = xcd_barrier_post((unsigned*)(ws + CTL_BAR_B), MISC + 8);
    const int lo = F.a->ph_lo, hi = F.a->ph_hi;
#define IN(k) (lo <= (k) && (k) < hi)
#define SEAM(k) do { if (IN(k) && IN((k) + 1)) xcd_barrier(bar); } while (0)

    if (IN(0)) { p0_prologue(F); SEAM(0); }
    if (IN(1)) {
        pg8::Gemm g{R1B, WIN_T, MR, PS, D}; pg8::StaticOrder S; S.init(MR, PS, F.G, (int)blockIdx.x);
        EpiProj E{PROJ, PS};
        pg8::gemm_phase<EpiProj, pg8::StaticOrder, PG8_ALIGN, PG8_SP2>(F.lds, g, S, E);
        SEAM(1);
    }
    if (IN(2)) {
        const int bx = blockIdx.x;
        for (int it = bx; it < NB * NCH; it += F.G) p2p_item(F, it >> 5, it & 31);
        const bool early = (F.G == 256) && bx >= 128;
        if (early) xcd_barrier_arrive(bar); else xcd_barrier(bar);

#define P2A_CHAINS() do { const int cb_ = bx & 63; if (cb_ < 32) chain_mlstm(F, cb_ >> 2, cb_ & 3, bx >> 6); else chain_gla(F, (cb_ - 32) >> 2, (cb_ - 32) & 3, bx >> 6); } while (0)
#define P2A_SAMPLES() do { float* Wl = (float*)(F.ldsg + F_WAVE * 16384 + 12288);   \
              for (int it = (bx - 128) * NWAVES + F_WAVE; it < MSMP * 8; it += (F.G - 128) * NWAVES) sample_item(F, it >> 3, it & 7, Wl, F_LANE); } while (0)
        if (bx < 128) { P2A_CHAINS(); }
        else {
            const int nb = F.G - 128, gb = bx - 128;
            P2A_SAMPLES();
            for (int i = gb * 512 + F_TID; i < NB * 3 * 1024 + MSMP * 3 * 1024; i += nb * 512) {
                if (i < NB * 3 * 1024) { const int b = i / 3072, j = (i / 1024) % 3, ch = i & 1023; OUTP[O_CVP + i] = bf2f(PROJ[((size_t)b * SEQ + SEQ - 3 + j) * PS + ch]); }
                else { const int k = i - NB * 3 * 1024, n = k / 3072, j = (k / 1024) % 3, ch = k & 1023;
                    OUTP[O_CVS + k] = j < 2 ? ST_CONV[(size_t)n * 3072 + (j + 1) * 1024 + ch] : bf2f(PROJ[((size_t)MP + n) * PS + ch]); }
            }
            late_weight_copies(F, gb, nb);
            if (early) xcd_barrier_makeup(bar);
        }
        SEAM(2);
    }
    if (IN(3)) {
        const int hb = F_WAVE >> 2, ltid = F_TID & 255, lw = F_WAVE & 3;
        char* L = F.ldsg + hb * P2B_HALF;
        p2b_loop(F, L, hb, lw, F_LANE);
        SEAM(3);
    }
    if (IN(4)) {
        pg8::Gemm g{R1B, WOUT_T, MP, D, D}; pg8::StaticOrder S; S.init(MP, D, F.G, (int)blockIdx.x);
        EpiRes<false> E{X_P, X1B, SS1, nullptr};
        pg8::gemm_phase<EpiRes<false>, pg8::StaticOrder, PG8_ALIGN, PG8_SP2>(F.lds, g, S, E);
        skinny_res<false>(F, R1B + (size_t)MP * D, WOUT_T, 0, X_S, X1B + (size_t)MP * D, SS1 + MP, nullptr);
        SEAM(4);
    }
    if (IN(5)) {
        pg8::Gemm g{X1B, W1_T, MP, FF, D}; pg8::StaticOrder S; S.init(MP, FF, F.G, (int)blockIdx.x);
        EpiU E{UBUF};
        const bool skinny_first = (blockIdx.x & 8) != 0;
        if (skinny_first) skinny_up(F, X1B + (size_t)MP * D, W1_T, UBUF + (size_t)MP * FF);
        pg8::gemm_phase<EpiU, pg8::StaticOrder, PG8_ALIGN, PG8_SP2>(F.lds, g, S, E);
        if (!skinny_first) skinny_up(F, X1B + (size_t)MP * D, W1_T, UBUF + (size_t)MP * FF);
        SEAM(5);
    }
    if (IN(6)) {
        pg8::Gemm g{UBUF, W2_T, MP, D, FF}; pg8::StaticOrder S; S.init(MP, D, F.G, (int)blockIdx.x);
        EpiRes<true> E{X1B, R1B, SS2, SS1};
        pg8::gemm_phase<EpiRes<true>, pg8::StaticOrder, PG8_ALIGN, PG8_SP2>(F.lds, g, S, E);

        skinny_res<true>(F, UBUF + (size_t)MP * FF, W2_T, 1, X1B + (size_t)MP * D, R1B + (size_t)MP * D, SS2 + MP, SS1 + MP);
        SEAM(6);
    }
    if (IN(7)) {
        const bool fuse_s = F.G >= 4 * (D / 16);
        skinny_ple(F, PBUF + (size_t)MP * DPLE, WPLE_T, R1B + (size_t)MP * D, WPG_T, SS2 + MP, X1B + (size_t)MP * D, SS3 + MP,
                   fuse_s, OUTP + (size_t)MP * D, G_FINAL, (float*)(WSB + WS_XBUF + 262144), (unsigned*)(WSB + CTL_PCNT_B) + 64 * 64);
        __syncthreads();
        if (F.G == 256) {
          pg8::Gemm g0{PBUF, WPLE_T, MP, D, DPLE}, g1{R1B, WPG_T, MP, D, D}; pg8::StaticOrder S; S.init(MP, D, F.G, (int)blockIdx.x);
          EpiProj E0{PPB, D};
          EpiPleFinal E1{R1B, PPB, OUTP, SS2, G_FINAL, (float*)(WSB + WS_XBUF), (unsigned*)(WSB + CTL_PCNT_B)};
          pg8::Unit u; if (S.next(0, u)) pg8::gemm_pair<EpiProj, EpiPleFinal>(F.lds, g0, g1, u, E0, E1);
        } else {
        { pg8::Gemm g{PBUF, WPLE_T, MP, D, DPLE}; pg8::StaticOrder S; S.init(MP, D, F.G, (int)blockIdx.x);
          EpiProj E{PPB, D};
          pg8::gemm_phase<EpiProj, pg8::StaticOrder, PG8_ALIGN, PG8_SP2>(F.lds, g, S, E); }
        { pg8::Gemm g{R1B, WPG_T, MP, D, D}; pg8::StaticOrder S; S.init(MP, D, F.G, (int)blockIdx.x);
          EpiPleFinal E{R1B, PPB, OUTP, SS2, G_FINAL, (float*)(WSB + WS_XBUF), (unsigned*)(WSB + CTL_PCNT_B)};
          pg8::gemm_phase<EpiPleFinal, pg8::StaticOrder, false, PG8_SP2>(F.lds, g, S, E); }
        }
        if (!fuse_s) SEAM(7);
    }
    if (IN(8) && F.G < 4 * (D / 16)) {
        const int gw = blockIdx.x * NWAVES + F_WAVE, NGW = F.G * NWAVES;
        for (int m = MP + gw; m < MV; m += NGW) {
            const GAS v2u* xr = (const GAS v2u*)(X1B + (size_t)m * D) + F_LANE; GAS f32x4* yo = (GAS f32x4*)(OUTP + (size_t)m * D) + F_LANE;
            const float r = rsqrt_fast(SS3[m] * (1.f / D) + EPS);
#pragma unroll
            for (int j = 0; j < 4; ++j) { const f32x4 gf = ((const GAS f32x4*)G_FINAL)[F_LANE + 64 * j]; const v2u xw = xr[64 * j];
                yo[64 * j] = (f32x4){bflo(xw.x), bfhi(xw.x), bflo(xw.y), bfhi(xw.y)} * r * gf; }
        }

    }
#undef IN
#undef SEAM
}

extern "C" void kernel_launch(void* const* d_in, const int* in_sizes, int n_in, void* d_out, int out_size, void* d_ws, size_t ws_size, hipStream_t stream) {
    static int grid = 0;
    if (grid == 0) {
        if (n_in != 26 || ws_size < WS_END) { fprintf(stderr, "kernel_launch: unexpected n_in %d / ws %zu\n", n_in, ws_size); grid = -1; return; }
        int dev = 0, cus = 0, per_cu = 0;
        if (hipGetDevice(&dev) != hipSuccess || hipDeviceGetAttribute(&cus, hipDeviceAttributeMultiprocessorCount, dev) != hipSuccess) { grid = -1; return; }
        if (hipFuncSetAttribute((const void*)mk_fwd, hipFuncAttributeMaxDynamicSharedMemorySize, LDS_BYTES) != hipSuccess) { fprintf(stderr, "kernel_launch: hipFuncSetAttribute failed\n"); grid = -1; return; }
        if (hipOccupancyMaxActiveBlocksPerMultiprocessor(&per_cu, (const void*)mk_fwd, NWAVES * 64, LDS_BYTES) != hipSuccess || per_cu < 1) { fprintf(stderr, "kernel_launch: occupancy query says %d\n", per_cu); per_cu = 1; }
        (void)hipGetLastError();
        grid = cus;
        if (grid > 256) grid = 256;
    }
    if (grid < 0) return;
    (void)hipMemsetAsync((char*)d_ws + WS_CTL, 0, CTL_ZERO_BYTES, stream);
    Args a{};
    for (int i = 0; i < 26; ++i) a.in[i] = (const float*)d_in[i];
    a.out = (float*)d_out; a.ws = (unsigned char*)d_ws;
    a.ph_lo = 0; a.ph_hi = NPHASE; a.li = 0;
    hipLaunchKernelGGL(mk_fwd, dim3(grid), dim3(NWAVES * 64), LDS_BYTES, stream, a);
}
```
